# Optimizing an MI355X kernel written in HIP

```python
import math
import jax, jax.numpy as jnp
from jax import lax
import numpy as np

D_MODEL = 1024
BATCH = 16
SEQ = 256
DEPTH = 4
DEC_BATCH = 4
DEC_SEQ = 1024
PAST_LEN = 512

GRID_W = 64
N_MIXERS = 2
N_HYENA_LAYERS = (DEPTH + N_MIXERS - 1) // N_MIXERS
N_ATTN_LAYERS = DEPTH // N_MIXERS
HEAD_DIM = 128
N_HEADS = D_MODEL // HEAD_DIM
N_KV_HEADS = 2
GROUP = N_HEADS // N_KV_HEADS
QKV_DIM = (N_HEADS + 2 * N_KV_HEADS) * HEAD_DIM
Q_BLOCK = 128
ROPE_THETA = 10000.0
D_FF = ((8 * D_MODEL + 3 * 256 - 1) // (3 * 256)) * 256
N_BANDS = 16
FILTER_EMB = 1 + 2 * N_BANDS
FILTER_HIDDEN = 64
DECAY_TARGET = 1e-2
FAST_DECAY_PCT = 0.3
SLOW_DECAY_PCT = 1.5
MIN_DECAY = math.log(DECAY_TARGET) / SLOW_DECAY_PCT
MAX_DECAY = math.log(DECAY_TARGET) / FAST_DECAY_PCT
EPS = 1e-6

kernel_name = "hyena_gqa_prefix_dit_step"


def rmsnorm(x, g):
    x32 = x.astype(jnp.float32)
    y = x32 * lax.rsqrt(jnp.mean(x32 * x32, axis=-1, keepdims=True) + EPS)
    return (y * g.astype(jnp.float32)).astype(x.dtype)


def adaln(cond, w, b):
    m = jax.nn.silu(cond) @ w + b
    return jnp.split(m[..., None, :], 6, axis=-1)


def modulate(x, g, shift, scale):
    return rmsnorm(x, g) * (1.0 + scale) + shift


def short_conv3(z, w, b):
    zp = jnp.pad(z, ((0, 0), (1, 1), (0, 0)))
    return zp[:, :-2] * w[0] + zp[:, 1:-1] * w[1] + zp[:, 2:] * w[2] + b


def hyena_filters(L, w1, b1, freq, w2, b2, w3):
    f32 = jnp.float32
    t = jnp.arange(L, dtype=f32) / L
    bands = jnp.arange(1, N_BANDS + 1, dtype=f32)
    ang = 2.0 * math.pi * t[:, None] * bands[None, :]
    feats = jnp.concatenate([t[:, None], jnp.cos(ang), jnp.sin(ang)], axis=-1)
    freq = freq.astype(f32)
    h = jnp.sin(freq[0] * (feats @ w1.astype(f32) + b1.astype(f32)))
    h = jnp.sin(freq[1] * (h @ w2.astype(f32) + b2.astype(f32)))
    h = h @ w3.astype(f32)
    deltas = jnp.abs(jnp.linspace(MIN_DECAY, MAX_DECAY, D_MODEL, dtype=f32))
    window = jnp.exp(-t[:, None] * deltas[None, :])
    h_f = h[:, :D_MODEL] * window
    h_b = h[:, D_MODEL:] * window * (jnp.arange(L) > 0).astype(f32)[:, None]
    norm = jnp.sqrt(jnp.sum(h_f * h_f + h_b * h_b, axis=0, keepdims=True) + EPS)
    return h_f / norm, h_b / norm


def bidir_long_conv(u, h_f, h_b, bias):
    L = u.shape[1]
    n = 2 * L
    u32 = u.astype(jnp.float32)
    Hf = jnp.fft.rfft(h_f, n=n, axis=0)
    Hb = jnp.fft.rfft(h_b, n=n, axis=0)
    y_f = jnp.fft.irfft(jnp.fft.rfft(u32, n=n, axis=1) * Hf, n=n, axis=1)[:, :L]
    y_b = jnp.flip(jnp.fft.irfft(jnp.fft.rfft(jnp.flip(u32, axis=1), n=n, axis=1) * Hb, n=n, axis=1)[:, :L], axis=1)
    return (y_f + y_b + u32 * bias.astype(jnp.float32)).astype(u.dtype)


def hyena_mixer(h, w_in, conv_w, conv_b, f_w1, f_b1, f_freq, f_w2, f_b2, f_w3, bias, w_out):
    L = h.shape[1]
    z = short_conv3(h @ w_in, conv_w, conv_b)
    x0, x1, v = jnp.split(z, 3, axis=-1)
    h_f, h_b = hyena_filters(L, f_w1, f_b1, f_freq, f_w2, f_b2, f_w3)
    y = x0 * bidir_long_conv(x1 * v, h_f, h_b, bias)
    return y @ w_out


def qkv_heads(h, w_qkv, q_g, k_g):
    B, T, _ = h.shape
    qkv = h @ w_qkv
    q = qkv[..., :N_HEADS * HEAD_DIM].reshape(B, T, N_HEADS, HEAD_DIM)
    k = qkv[..., N_HEADS * HEAD_DIM:(N_HEADS + N_KV_HEADS) * HEAD_DIM].reshape(B, T, N_KV_HEADS, HEAD_DIM)
    v = qkv[..., (N_HEADS + N_KV_HEADS) * HEAD_DIM:].reshape(B, T, N_KV_HEADS, HEAD_DIM)
    return rmsnorm(q, q_g), rmsnorm(k, k_g), v


def axial_rope_tables(T):
    ROWS = T // GRID_W
    row = jnp.repeat(jnp.arange(ROWS), GRID_W).astype(jnp.float32)
    col = jnp.tile(jnp.arange(GRID_W), ROWS).astype(jnp.float32)
    half = HEAD_DIM // 2
    freqs = ROPE_THETA ** (-jnp.arange(0, half, 2, dtype=jnp.float32) / half)
    ang = jnp.concatenate([row[:, None] * freqs[None, :], col[:, None] * freqs[None, :]], axis=-1)
    return jnp.cos(ang), jnp.sin(ang)


def apply_rope(x, cos, sin):
    B, T, H, Dh = x.shape
    xr = x.astype(jnp.float32).reshape(B, T, H, Dh // 2, 2)
    a, b = xr[..., 0], xr[..., 1]
    c = cos[None, :, None, :]
    s = sin[None, :, None, :]
    out = jnp.stack([a * c - b * s, a * s + b * c], axis=-1)
    return out.reshape(B, T, H, Dh).astype(x.dtype)


def block_attention(q, k, v):
    B, Tq, _, _ = q.shape
    nblk = Tq // Q_BLOCK
    scale = HEAD_DIM ** -0.5
    qb = q.reshape(B, nblk, Q_BLOCK, N_KV_HEADS, GROUP, HEAD_DIM).swapaxes(0, 1)
    k32 = k.astype(jnp.float32)

    def one_block(qblk):
        s = jnp.einsum('bqkgd,bskd->bkgqs', qblk.astype(jnp.float32), k32) * scale
        p = jax.nn.softmax(s, axis=-1)
        return jnp.einsum('bkgqs,bskd->bqkgd', p.astype(v.dtype), v)

    o = lax.map(one_block, qb)
    return o.swapaxes(0, 1).reshape(B, Tq, N_HEADS * HEAD_DIM)


def swiglu(h, wg, wu, wd):
    return (jax.nn.silu(h @ wg) * (h @ wu)) @ wd


def setup_inputs(seed: int = 0) -> dict:
    key = jax.random.key(seed)
    ks = jax.random.split(key, 32)
    f32 = jnp.float32

    def nrm(k, shape, s):
        return jax.random.normal(k, shape, f32) * s

    D = D_MODEL
    NH, NA = N_HYENA_LAYERS, N_ATTN_LAYERS
    return {
        "x_prompt": nrm(ks[0], (BATCH, SEQ, D), 1.0),
        "x_sample": nrm(ks[1], (DEC_BATCH, DEC_SEQ, D), 1.0),
        "cache_k": nrm(ks[2], (DEC_BATCH, NA, PAST_LEN, N_KV_HEADS, HEAD_DIM), 1.0),
        "cache_v": nrm(ks[3], (DEC_BATCH, NA, PAST_LEN, N_KV_HEADS, HEAD_DIM), 1.0),
        "c": nrm(ks[4], (DEC_BATCH, D), 1.0),
        "c_ctx": nrm(ks[5], (D,), 1.0),
        "mod_w": nrm(ks[6], (DEPTH, D, 6 * D), 0.5 * D ** -0.5),
        "mod_b": nrm(ks[7], (DEPTH, 6 * D), 0.02),
        "norm_mix": 1.0 + nrm(ks[8], (DEPTH, D), 0.02),
        "norm_ffn": 1.0 + nrm(ks[9], (DEPTH, D), 0.02),
        "hy_w_in": nrm(ks[10], (NH, D, 3 * D), D ** -0.5),
        "hy_conv_w": nrm(ks[11], (NH, 3, 3 * D), 3 ** -0.5),
        "hy_conv_b": nrm(ks[12], (NH, 3 * D), 0.02),
        "hy_f_w1": nrm(ks[13], (NH, FILTER_EMB, FILTER_HIDDEN), FILTER_EMB ** -0.5),
        "hy_f_b1": nrm(ks[14], (NH, FILTER_HIDDEN), 0.02),
        "hy_f_freq": 1.0 + nrm(ks[15], (NH, 2, FILTER_HIDDEN), 0.02),
        "hy_f_w2": nrm(ks[16], (NH, FILTER_HIDDEN, FILTER_HIDDEN), FILTER_HIDDEN ** -0.5),
        "hy_f_b2": nrm(ks[17], (NH, FILTER_HIDDEN), 0.02),
        "hy_f_w3": nrm(ks[18], (NH, FILTER_HIDDEN, 2 * D), FILTER_HIDDEN ** -0.5),
        "hy_bias": nrm(ks[19], (NH, D), 0.1),
        "hy_w_out": nrm(ks[20], (NH, D, D), D ** -0.5),
        "at_w_qkv": nrm(ks[21], (NA, D, QKV_DIM), D ** -0.5),
        "at_q_norm": 1.0 + nrm(ks[22], (NA, HEAD_DIM), 0.02),
        "at_k_norm": 1.0 + nrm(ks[23], (NA, HEAD_DIM), 0.02),
        "at_w_out": nrm(ks[24], (NA, N_HEADS * HEAD_DIM, D), (N_HEADS * HEAD_DIM) ** -0.5),
        "ffn_w_gate": nrm(ks[25], (DEPTH, D, D_FF), D ** -0.5),
        "ffn_w_up": nrm(ks[26], (DEPTH, D, D_FF), D ** -0.5),
        "ffn_w_down": nrm(ks[27], (DEPTH, D_FF, D), D_FF ** -0.5),
        "final_norm": 1.0 + nrm(ks[28], (D,), 0.02),
    }


def reference(x_prompt, x_sample, cache_k, cache_v, c, c_ctx,
              mod_w, mod_b, norm_mix, norm_ffn,
              hy_w_in, hy_conv_w, hy_conv_b, hy_f_w1, hy_f_b1, hy_f_freq, hy_f_w2, hy_f_b2, hy_f_w3,
              hy_bias, hy_w_out,
              at_w_qkv, at_q_norm, at_k_norm, at_w_out,
              ffn_w_gate, ffn_w_up, ffn_w_down, final_norm):
    y_p = x_prompt
    y_s = x_sample
    cos_s, sin_s = axial_rope_tables(y_s.shape[1])
    new_k_list, new_v_list = [], []

    for i in range(DEPTH):
        sh_p, sc_p, g_p, sh2_p, sc2_p, g2_p = adaln(c_ctx, mod_w[i], mod_b[i])
        sh_s, sc_s, g_s, sh2_s, sc2_s, g2_s = adaln(c, mod_w[i], mod_b[i])
        h_p = modulate(y_p, norm_mix[i], sh_p, sc_p)
        h_s = modulate(y_s, norm_mix[i], sh_s, sc_s)
        j = i // N_MIXERS
        if i % N_MIXERS == 0:
            hy = (hy_w_in[j], hy_conv_w[j], hy_conv_b[j], hy_f_w1[j], hy_f_b1[j], hy_f_freq[j],
                  hy_f_w2[j], hy_f_b2[j], hy_f_w3[j], hy_bias[j], hy_w_out[j])
            m_p = hyena_mixer(h_p, *hy)
            m_s = hyena_mixer(h_s, *hy)
        else:
            q_p, k_p, v_p = qkv_heads(h_p, at_w_qkv[j], at_q_norm[j], at_k_norm[j])
            new_k_list.append(k_p)
            new_v_list.append(v_p)
            m_p = block_attention(q_p, k_p, v_p) @ at_w_out[j]
            q_s, k_s, v_s = qkv_heads(h_s, at_w_qkv[j], at_q_norm[j], at_k_norm[j])
            q_s = apply_rope(q_s, cos_s, sin_s)
            k_s = apply_rope(k_s, cos_s, sin_s)
            k_all = jnp.concatenate([k_s, cache_k[:, j]], axis=1)
            v_all = jnp.concatenate([v_s, cache_v[:, j]], axis=1)
            m_s = block_attention(q_s, k_all, v_all) @ at_w_out[j]
        y_p = y_p + g_p * m_p
        y_s = y_s + g_s * m_s
        f_p = modulate(y_p, norm_ffn[i], sh2_p, sc2_p)
        f_s = modulate(y_s, norm_ffn[i], sh2_s, sc2_s)
        y_p = y_p + g2_p * swiglu(f_p, ffn_w_gate[i], ffn_w_up[i], ffn_w_down[i])
        y_s = y_s + g2_s * swiglu(f_s, ffn_w_gate[i], ffn_w_up[i], ffn_w_down[i])

    y_prompt = rmsnorm(y_p, final_norm)
    y_sample = rmsnorm(y_s, final_norm)
    new_k = jnp.stack(new_k_list, axis=1)
    new_v = jnp.stack(new_v_list, axis=1)
    return (y_prompt, y_sample, new_k, new_v)
```

```cpp
#include <hip/hip_runtime.h>
#include <hip/hip_cooperative_groups.h>
#include <cstdio>
#include <cstdint>
namespace cg = cooperative_groups;

typedef unsigned short bf16_t;
typedef short bf16x8 __attribute__((ext_vector_type(8)));
typedef float f32x4 __attribute__((ext_vector_type(4)));
typedef unsigned u32x4 __attribute__((ext_vector_type(4)));

constexpr int D = 1024, MTOK = 8192, NPR = 4096;
constexpr int DFF = 2816, QKVD = 1536;
constexpr float EPS = 1e-6f;
constexpr float MIN_DECAY = -3.0701134573253944f, MAX_DECAY = -15.350567286626972f;

constexpr size_t MiB = 1u << 20;
constexpr size_t WS_MOD = 1 * MiB, WS_MODP = 2 * MiB, WS_FSQP = 6 * MiB, WS_RNORM = 7 * MiB, WS_FILT = 8 * MiB;
constexpr size_t WS_WIN = 28 * MiB, WS_WHO = 40 * MiB, WS_WQKV = 44 * MiB, WS_WAO = 50 * MiB, WS_WGU = 54 * MiB, WS_WDN = 98 * MiB;
constexpr size_t WS_Y = 120 * MiB, WS_XN = 152 * MiB, WS_R = 168 * MiB;
constexpr size_t WS_ZT = WS_R, WS_U = WS_R + 48 * MiB, WS_X0C = WS_R + 64 * MiB, WS_YG = WS_R + 80 * MiB;
constexpr size_t WS_QKV = WS_R, WS_Q = WS_R + 24 * MiB, WS_KP = WS_R + 40 * MiB, WS_VP = WS_R + 42 * MiB, WS_O = WS_R + 44 * MiB;
constexpr size_t WS_H = WS_R;
constexpr size_t WS_KS = WS_R + 96 * MiB, WS_VS = WS_R + 102 * MiB, WS_END = WS_R + 108 * MiB;
constexpr size_t FILT_J = 10 * MiB / 4;
constexpr size_t FILT_L1 = 1024 * 512;

constexpr int LDS_BYTES = 147456;

struct Params {
  const float* in[29];
  float* out;
  unsigned char* ws;
  int ph_lo, ph_hi;
};
enum { I_XP = 0, I_XS, I_CK, I_CV, I_C, I_CCTX, I_MODW, I_MODB, I_NMIX, I_NFFN, I_HWIN, I_HCW, I_HCB, I_FW1, I_FB1, I_FFREQ, I_FW2, I_FB2, I_FW3,
       I_HBIAS, I_HWOUT, I_WQKV, I_QN, I_KN, I_WAO, I_WG, I_WU, I_WD, I_FN };

__device__ __forceinline__ bf16_t f2bf(float f) { unsigned u = __float_as_uint(f); u += 0x7FFFu + ((u >> 16) & 1u); return (bf16_t)(u >> 16); }
__device__ __forceinline__ float bf2f(bf16_t b) { return __uint_as_float(((unsigned)b) << 16); }
__device__ __forceinline__ unsigned pack2(float lo, float hi) { return (unsigned)f2bf(lo) | ((unsigned)f2bf(hi) << 16); }
__device__ __forceinline__ float wave_sum(float v) {
#pragma unroll
  for (int o = 32; o >= 1; o >>= 1) v += __shfl_xor(v, o);
  return v;
}
__device__ __forceinline__ float wave_max(float v) {
#pragma unroll
  for (int o = 32; o >= 1; o >>= 1) v = fmaxf(v, __shfl_xor(v, o));
  return v;
}
__device__ __forceinline__ int cond_of(int m) { return m < NPR ? 4 : ((m - NPR) >> 10); }
__device__ __forceinline__ float silu_f(float x) { return x / (1.f + expf(-x)); }
__device__ __forceinline__ float sin_rev(float r) { return __builtin_amdgcn_sinf(r - rintf(r)); }
__device__ __forceinline__ float cos_rev(float r) { return __builtin_amdgcn_cosf(r - rintf(r)); }
constexpr float INV_2PI = 0.15915494309189535f;

__device__ __forceinline__ void cvt_tile(const float* __restrict__ src, int K, int N, int kt, int nt, bf16_t* __restrict__ dst, int mode, float* tile  ) {
  const int tid = threadIdx.x;
  const int k0 = kt * 64, n0 = nt * 64;
  {
    const int r = tid >> 4, c4 = (tid & 15) * 4;
#pragma unroll
    for (int h = 0; h < 2; ++h) {
      const int rr = r + 32 * h;
      const f32x4 v = *(const f32x4*)(src + (size_t)(k0 + rr) * N + n0 + c4);
      tile[rr * 65 + c4 + 0] = v[0]; tile[rr * 65 + c4 + 1] = v[1]; tile[rr * 65 + c4 + 2] = v[2]; tile[rr * 65 + c4 + 3] = v[3];
    }
  }
  __syncthreads();
  {
    const int n = tid >> 3, kc = (tid & 7) * 8;
    u32x4 w;
    w.x = pack2(tile[(kc + 0) * 65 + n], tile[(kc + 1) * 65 + n]);
    w.y = pack2(tile[(kc + 2) * 65 + n], tile[(kc + 3) * 65 + n]);
    w.z = pack2(tile[(kc + 4) * 65 + n], tile[(kc + 5) * 65 + n]);
    w.w = pack2(tile[(kc + 6) * 65 + n], tile[(kc + 7) * 65 + n]);
    const int ng = n0 + n;
    const int row = mode == 0 ? ng : ((ng >> 7) * 256 + (ng & 127) + (mode == 2 ? 128 : 0));
    *(u32x4*)(dst + (size_t)row * K + k0 + kc) = w;
  }
  __syncthreads();
}

constexpr int NT_FILT = 320, NT_MOD = 384;
constexpr int NT_WIN = 2 * 16 * 48, NT_WHO = 2 * 16 * 16, NT_WQKV = 2 * 16 * 24, NT_WAO = 2 * 16 * 16, NT_G = 4 * 16 * 44, NT_DN = 4 * 44 * 16;
constexpr int NT_CVT = NT_WIN + NT_WHO + NT_WQKV + NT_WAO + 2 * NT_G + NT_DN;

__device__ void task_cvt(const Params& p, int t, float* tile) {
  if (t < NT_WIN) { const int l = t / (16 * 48), r = t % (16 * 48); cvt_tile(p.in[I_HWIN] + (size_t)l * D * 3072, D, 3072, r / 48, r % 48, (bf16_t*)(p.ws + WS_WIN) + (size_t)l * 3072 * D, 0, tile); return; }
  t -= NT_WIN;
  if (t < NT_WHO) { const int l = t / 256, r = t % 256; cvt_tile(p.in[I_HWOUT] + (size_t)l * D * D, D, D, r / 16, r % 16, (bf16_t*)(p.ws + WS_WHO) + (size_t)l * D * D, 0, tile); return; }
  t -= NT_WHO;
  if (t < NT_WQKV) { const int l = t / (16 * 24), r = t % (16 * 24); cvt_tile(p.in[I_WQKV] + (size_t)l * D * QKVD, D, QKVD, r / 24, r % 24, (bf16_t*)(p.ws + WS_WQKV) + (size_t)l * QKVD * D, 0, tile); return; }
  t -= NT_WQKV;
  if (t < NT_WAO) { const int l = t / 256, r = t % 256; cvt_tile(p.in[I_WAO] + (size_t)l * D * D, D, D, r / 16, r % 16, (bf16_t*)(p.ws + WS_WAO) + (size_t)l * D * D, 0, tile); return; }
  t -= NT_WAO;
  if (t < NT_G) { const int l = t / (16 * 44), r = t % (16 * 44); cvt_tile(p.in[I_WG] + (size_t)l * D * DFF, D, DFF, r / 44, r % 44, (bf16_t*)(p.ws + WS_WGU) + (size_t)l * 2 * DFF * D, 1, tile); return; }
  t -= NT_G;
  if (t < NT_G) { const int l = t / (16 * 44), r = t % (16 * 44); cvt_tile(p.in[I_WU] + (size_t)l * D * DFF, D, DFF, r / 44, r % 44, (bf16_t*)(p.ws + WS_WGU) + (size_t)l * 2 * DFF * D, 2, tile); return; }
  t -= NT_G;
  { const int l = t / (44 * 16), r = t % (44 * 16); cvt_tile(p.in[I_WD] + (size_t)l * DFF * D, DFF, D, r / 16, r % 16, (bf16_t*)(p.ws + WS_WDN) + (size_t)l * D * DFF, 0, tile); }
}

__device__ void task_mod(const Params& p, int t, float* sl  ) {
  const int tid = threadIdx.x;
  const int l = t / 96, rem = t % 96, cb = rem / 8, kc = rem % 8;
  __syncthreads();
  for (int i = tid; i < 640; i += 512) {
    const int j = i >> 7, k = kc * 128 + (i & 127);
    const float x = j < 4 ? p.in[I_C][j * D + k] : p.in[I_CCTX][k];
    sl[i] = silu_f(x);
  }
  __syncthreads();
  const int n = cb * 512 + tid;
  const float* w = p.in[I_MODW] + ((size_t)l * D + kc * 128) * 6144 + n;
  float a0 = 0.f, a1 = 0.f, a2 = 0.f, a3 = 0.f, a4 = 0.f;
#pragma unroll 4
  for (int k = 0; k < 128; ++k) {
    const float wv = w[(size_t)k * 6144];
    a0 += sl[k] * wv; a1 += sl[128 + k] * wv; a2 += sl[256 + k] * wv; a3 += sl[384 + k] * wv; a4 += sl[512 + k] * wv;
  }
  float* o = (float*)(p.ws + WS_MODP) + ((size_t)(kc * 4 + l) * 5) * 6144 + n;
  o[0] = a0; o[6144] = a1; o[2 * 6144] = a2; o[3 * 6144] = a3; o[4 * 6144] = a4;
}

__device__ void task_filt(const Params& p, int t, float* h1  , float* h2  ) {
  const int tid = threadIdx.x, lane = tid & 63, wid = tid >> 6;
  const int combo = t >> 3, nchunk = t & 7;
  const int j = combo / 20, r = combo % 20;
  const int lsel = r < 4 ? 0 : 1, tchunk = r < 4 ? r : r - 4, L = lsel ? 1024 : 256;
  const int tt = lane, tpos = tchunk * 64 + tt;
  const float tn = (float)tpos / (float)L;
  const float* w1 = p.in[I_FW1] + (size_t)j * 33 * 64;
  const float* b1 = p.in[I_FB1] + j * 64;
  const float* fr = p.in[I_FFREQ] + j * 128;
  const float* w2 = p.in[I_FW2] + (size_t)j * 64 * 64;
  const float* b2 = p.in[I_FB2] + j * 64;
  const float* w3 = p.in[I_FW3] + (size_t)j * 64 * 2048;
  __syncthreads();
  {
    const int u0 = wid * 8;
    float acc[8];
#pragma unroll
    for (int uu = 0; uu < 8; ++uu) acc[uu] = tn * w1[u0 + uu];
    for (int b = 1; b <= 16; ++b) {
      const float rev = tn * (float)b;
      const float cs = cos_rev(rev), sn = sin_rev(rev);
#pragma unroll
      for (int uu = 0; uu < 8; ++uu) acc[uu] += cs * w1[b * 64 + u0 + uu] + sn * w1[(16 + b) * 64 + u0 + uu];
    }
#pragma unroll
    for (int uu = 0; uu < 8; ++uu) h1[tt * 65 + u0 + uu] = sin_rev(INV_2PI * (fr[u0 + uu] * (acc[uu] + b1[u0 + uu])));
  }
  __syncthreads();
  {
    const int u0 = wid * 8;
    float acc[8];
#pragma unroll
    for (int uu = 0; uu < 8; ++uu) acc[uu] = 0.f;
    for (int v = 0; v < 64; ++v) {
      const float hv = h1[tt * 65 + v];
#pragma unroll
      for (int uu = 0; uu < 8; ++uu) acc[uu] += hv * w2[v * 64 + u0 + uu];
    }
#pragma unroll
    for (int uu = 0; uu < 8; ++uu) h2[tt * 65 + u0 + uu] = sin_rev(INV_2PI * (fr[64 + u0 + uu] * (acc[uu] + b2[u0 + uu])));
  }
  __syncthreads();
  float* G2 = (float*)(p.ws + WS_FILT) + (size_t)j * FILT_J + (lsel ? FILT_L1 : 0);
  float* fsq = (float*)(p.ws + WS_FSQP) + ((size_t)((j * 2 + lsel) * 16 + tchunk)) * 2048;
  for (int q = 0; q < 32; ++q) {
    const int n = nchunk * 256 + wid * 32 + q;
    float acc = 0.f;
    for (int v = 0; v < 64; ++v) acc += h2[tt * 65 + v] * w3[v * 2048 + n];
    const int c = n & 1023; const bool isb = n >= 1024;
    const float delta = fabsf(MIN_DECAY + (MAX_DECAY - MIN_DECAY) * ((float)c / 1023.f));
    float val = acc * expf(-tn * delta);
    if (isb && tpos == 0) val = 0.f;
    if (!(isb && tpos == 0)) G2[(size_t)c * (2 * L) + (isb ? (L - tpos) : (L + tpos))] = val;
    const float s = wave_sum(val * val);
    if (lane == 0) fsq[n] = s;
  }
}

__device__ void phase_p0(const Params& p, unsigned char* lds) {
  float* fl = (float*)lds;
  const int G = gridDim.x, b = blockIdx.x, tid = threadIdx.x;
  for (int t = b; t < NT_FILT + NT_MOD + NT_CVT; t += G) {
    __syncthreads();
    if (t < NT_FILT) task_filt(p, t, fl, fl + 64 * 65);
    else if (t < NT_FILT + NT_MOD) task_mod(p, t - NT_FILT, fl);
    else task_cvt(p, t - NT_FILT - NT_MOD, fl);
  }
  {
    f32x4* Y = (f32x4*)(p.ws + WS_Y);
    const f32x4* xp = (const f32x4*)p.in[I_XP]; const f32x4* xs = (const f32x4*)p.in[I_XS];
    const int half = NPR * D / 4;
    for (int i = b * 512 + tid; i < 2 * half; i += G * 512) Y[i] = i < half ? xp[i] : xs[i - half];
  }
  {
    bf16_t* KS = (bf16_t*)(p.ws + WS_KS); bf16_t* VS = (bf16_t*)(p.ws + WS_VS);
    const int n = 4 * 2 * 512 * 256;
    for (int i = b * 512 + tid; i < n; i += G * 512) {
      const int e = i & 255, pos = (i >> 8) & 511, j = (i >> 17) & 1, bb = i >> 18;
      const size_t o = ((size_t)(j * 4 + bb) * 1536 + 1024 + pos) * 256 + e;
      KS[o] = f2bf(p.in[I_CK][i]); VS[o] = f2bf(p.in[I_CV][i]);
    }
  }
}

__device__ void phase_p0b(const Params& p) {
  const int G = gridDim.x, b = blockIdx.x, tid = threadIdx.x;
  float* MOD = (float*)(p.ws + WS_MOD); const float* MP = (const float*)(p.ws + WS_MODP);
  for (int i = b * 512 + tid; i < 4 * 5 * 6144; i += G * 512) {
    const int n = i % 6144, l = i / (5 * 6144);
    float s = p.in[I_MODB][l * 6144 + n];
#pragma unroll
    for (int kc = 0; kc < 8; ++kc) s += MP[(size_t)kc * (4 * 5 * 6144) + i];
    MOD[i] = s;
  }
  float* RN = (float*)(p.ws + WS_RNORM); const float* FS = (const float*)(p.ws + WS_FSQP);
  for (int i = b * 512 + tid; i < 4096; i += G * 512) {
    const int c = i & 1023, jl = i >> 10, nch = (jl & 1) ? 16 : 4;
    float s = 0.f;
    for (int ch = 0; ch < nch; ++ch) s += FS[((size_t)jl * 16 + ch) * 2048 + c] + FS[((size_t)jl * 16 + ch) * 2048 + 1024 + c];
    RN[i] = 1.f / sqrtf(s + EPS);
  }
}

__device__ void phase_nm(const Params& p, int layer, int which) {
  const int lane = threadIdx.x & 63, wid = threadIdx.x >> 6;
  const float* Y = (const float*)(p.ws + WS_Y); bf16_t* XN = (bf16_t*)(p.ws + WS_XN);
  const float* g = p.in[which ? I_NFFN : I_NMIX] + layer * D;
  for (int m = blockIdx.x * 8 + wid; m < MTOK; m += gridDim.x * 8) {
    const float* y = Y + (size_t)m * D;
    f32x4 v[4]; float ss = 0.f;
#pragma unroll
    for (int i = 0; i < 4; ++i) { v[i] = *(const f32x4*)(y + i * 256 + lane * 4); ss += v[i][0] * v[i][0] + v[i][1] * v[i][1] + v[i][2] * v[i][2] + v[i][3] * v[i][3]; }
    ss = wave_sum(ss);
    const float r = rsqrtf(ss * (1.f / D) + EPS);
    const float* mod = (const float*)(p.ws + WS_MOD) + (size_t)(layer * 5 + cond_of(m)) * 6144 + which * 3072;
#pragma unroll
    for (int i = 0; i < 4; ++i) {
      const int k = i * 256 + lane * 4;
      const f32x4 gg = *(const f32x4*)(g + k), sh = *(const f32x4*)(mod + k), sc = *(const f32x4*)(mod + 1024 + k);
      float o[4];
#pragma unroll
      for (int e = 0; e < 4; ++e) o[e] = (v[i][e] * r * gg[e]) * (1.f + sc[e]) + sh[e];
      uint2 w; w.x = pack2(o[0], o[1]); w.y = pack2(o[2], o[3]);
      *(uint2*)(XN + (size_t)m * D + k) = w;
    }
  }
}

__device__ void phase_final(const Params& p) {
  const int lane = threadIdx.x & 63, wid = threadIdx.x >> 6;
  const float* Y = (const float*)(p.ws + WS_Y);
  const float* g = p.in[I_FN];
  for (int m = blockIdx.x * 8 + wid; m < MTOK; m += gridDim.x * 8) {
    const float* y = Y + (size_t)m * D;
    f32x4 v[4]; float ss = 0.f;
#pragma unroll
    for (int i = 0; i < 4; ++i) { v[i] = *(const f32x4*)(y + i * 256 + lane * 4); ss += v[i][0] * v[i][0] + v[i][1] * v[i][1] + v[i][2] * v[i][2] + v[i][3] * v[i][3]; }
    ss = wave_sum(ss);
    const float r = rsqrtf(ss * (1.f / D) + EPS);
#pragma unroll
    for (int i = 0; i < 4; ++i) {
      const int k = i * 256 + lane * 4;
      const f32x4 gg = *(const f32x4*)(g + k);
      f32x4 o; o[0] = v[i][0] * r * gg[0]; o[1] = v[i][1] * r * gg[1]; o[2] = v[i][2] * r * gg[2]; o[3] = v[i][3] * r * gg[3];
      *(f32x4*)(p.out + (size_t)m * D + k) = o;
    }
  }
}

struct EpiStoreBf16 { bf16_t* C; int ld; __device__ __forceinline__ void operator()(int m, int n, float v) const { C[(size_t)m * ld + n] = f2bf(v); } };
struct EpiGateRes { float* Y; const float* gate; __device__ __forceinline__ void operator()(int m, int n, float v) const { Y[(size_t)m * D + n] += gate[cond_of(m) * 6144 + n] * v; } };

template <bool SWIGLU, class Epi>
__device__ __forceinline__ void gemm_naive(const bf16_t* __restrict__ A, const bf16_t* __restrict__ Bt, int M, int N, int K, const Epi& epi, bf16_t* Hout) {
  const int lane = threadIdx.x & 63, wid = threadIdx.x >> 6, r16 = lane & 15, kg = lane >> 4;
  const int tilesN = SWIGLU ? N / 32 : N / 64, total = (M / 64) * tilesN;
  for (int tile = blockIdx.x * 8 + wid; tile < total; tile += gridDim.x * 8) {
    const int tm = tile / tilesN, tn = tile % tilesN, m0 = tm * 64;
    f32x4 acc[4][4];
#pragma unroll
    for (int i = 0; i < 4; ++i)
#pragma unroll
      for (int f = 0; f < 4; ++f) acc[i][f] = (f32x4){0.f, 0.f, 0.f, 0.f};
    const bf16_t* ap = A + (size_t)(m0 + r16) * K + kg * 8;
    int brow[4];
#pragma unroll
    for (int f = 0; f < 4; ++f) {
      if (SWIGLU) { const int hc = tn * 32 + 16 * (f & 1) + r16; brow[f] = (hc >> 7) * 256 + (hc & 127) + 128 * (f >> 1); }
      else brow[f] = tn * 64 + 16 * f + r16;
    }
    const bf16_t* bp0 = Bt + (size_t)brow[0] * K + kg * 8; const bf16_t* bp1 = Bt + (size_t)brow[1] * K + kg * 8;
    const bf16_t* bp2 = Bt + (size_t)brow[2] * K + kg * 8; const bf16_t* bp3 = Bt + (size_t)brow[3] * K + kg * 8;
    for (int k0 = 0; k0 < K; k0 += 32) {
      bf16x8 a[4], b[4];
#pragma unroll
      for (int i = 0; i < 4; ++i) a[i] = *(const bf16x8*)(ap + (size_t)(16 * i) * K + k0);
      b[0] = *(const bf16x8*)(bp0 + k0); b[1] = *(const bf16x8*)(bp1 + k0); b[2] = *(const bf16x8*)(bp2 + k0); b[3] = *(const bf16x8*)(bp3 + k0);
#pragma unroll
      for (int i = 0; i < 4; ++i)
#pragma unroll
        for (int f = 0; f < 4; ++f) acc[i][f] = __builtin_amdgcn_mfma_f32_16x16x32_bf16(a[i], b[f], acc[i][f], 0, 0, 0);
    }
    if (SWIGLU) {
#pragma unroll
      for (int i = 0; i < 4; ++i)
#pragma unroll
        for (int f = 0; f < 2; ++f)
#pragma unroll
          for (int e = 0; e < 4; ++e) {
            const int m = m0 + 16 * i + 4 * kg + e, hc = tn * 32 + 16 * f + r16;
            const float gv = acc[i][f][e], uv = acc[i][f + 2][e];
            Hout[(size_t)m * DFF + hc] = f2bf(silu_f(gv) * uv);
          }
    } else {
#pragma unroll
      for (int i = 0; i < 4; ++i)
#pragma unroll
        for (int f = 0; f < 4; ++f)
#pragma unroll
          for (int e = 0; e < 4; ++e) epi(m0 + 16 * i + 4 * kg + e, tn * 64 + 16 * f + r16, acc[i][f][e]);
    }
  }
}

__device__ void phase_lca(const Params& p, int j) {
  const bf16_t* ZT = (const bf16_t*)(p.ws + WS_ZT); bf16_t* U = (bf16_t*)(p.ws + WS_U); bf16_t* X0 = (bf16_t*)(p.ws + WS_X0C);
  const float* cw = p.in[I_HCW] + (size_t)j * 3 * 3072; const float* cb = p.in[I_HCB] + (size_t)j * 3072;
  for (int i = blockIdx.x * 512 + threadIdx.x; i < D * MTOK; i += gridDim.x * 512) {
    const int c = i >> 13, m = i & 8191;
    const int L = m < NPR ? 256 : 1024, t = m & (L - 1);
    float sc[3];
#pragma unroll
    for (int part = 0; part < 3; ++part) {
      const int ch = part * 1024 + c;
      const bf16_t* z = ZT + (size_t)ch * MTOK + m;
      const float zm = t > 0 ? bf2f(z[-1]) : 0.f, z0 = bf2f(z[0]), zp = t < L - 1 ? bf2f(z[1]) : 0.f;
      sc[part] = zm * cw[ch] + z0 * cw[3072 + ch] + zp * cw[2 * 3072 + ch] + cb[ch];
    }
    X0[i] = f2bf(sc[0]); U[i] = f2bf(sc[1] * sc[2]);
  }
}
__device__ void phase_lcb(const Params& p, int j) {
  const bf16_t* U = (const bf16_t*)(p.ws + WS_U); const bf16_t* X0 = (const bf16_t*)(p.ws + WS_X0C); bf16_t* YG = (bf16_t*)(p.ws + WS_YG);
  const float* RN = (const float*)(p.ws + WS_RNORM); const float* bias = p.in[I_HBIAS] + j * D;
  for (int i = blockIdx.x * 512 + threadIdx.x; i < D * MTOK; i += gridDim.x * 512) {
    const int c = i >> 13, m = i & 8191;
    const int lsel = m < NPR ? 0 : 1, L = lsel ? 1024 : 256, t = m & (L - 1);
    const float* g2 = (const float*)(p.ws + WS_FILT) + (size_t)j * FILT_J + (lsel ? FILT_L1 : 0) + (size_t)c * (2 * L) + L + t;
    const bf16_t* u = U + (size_t)c * MTOK + (m - t);
    float acc = 0.f;
    for (int s = 0; s < L; ++s) acc += g2[-s] * bf2f(u[s]);
    const float uu = bf2f(u[t]);
    const float y = acc * RN[(j * 2 + lsel) * 1024 + c] + uu * bias[c];
    YG[(size_t)m * D + c] = f2bf(bf2f(X0[i]) * y);
  }
}

__device__ void phase_qkvpost(const Params& p, int j) {
  const int lane = threadIdx.x & 63, wid = threadIdx.x >> 6;
  const unsigned* QKV = (const unsigned*)(p.ws + WS_QKV);
  unsigned* Q = (unsigned*)(p.ws + WS_Q); unsigned* KP = (unsigned*)(p.ws + WS_KP); unsigned* VP = (unsigned*)(p.ws + WS_VP);
  unsigned* KS = (unsigned*)(p.ws + WS_KS) + (size_t)j * 4 * 1536 * 128; unsigned* VS = (unsigned*)(p.ws + WS_VS) + (size_t)j * 4 * 1536 * 128;
  const float* qn = p.in[I_QN] + j * 128; const float* kn = p.in[I_KN] + j * 128;
  float* newk = p.out + (size_t)2 * NPR * D; float* newv = newk + (size_t)16 * 2 * 256 * 256;
  const float qg0 = qn[2 * lane], qg1 = qn[2 * lane + 1], kg0 = kn[2 * lane], kg1 = kn[2 * lane + 1];
  const float freq = exp2f(-(float)(lane & 31) * 0.41524101186092029f);
  for (int m = blockIdx.x * 8 + wid; m < MTOK; m += gridDim.x * 8) {
    const bool smp = m >= NPR;
    float cs = 1.f, sn = 0.f;
    if (smp) { const int t = (m - NPR) & 1023; const float pos = (float)(lane < 32 ? (t >> 6) : (t & 63)); const float rev = (pos * freq) * INV_2PI; cs = cos_rev(rev); sn = sin_rev(rev); }
    for (int s = 0; s < 12; ++s) {
      const unsigned raw = QKV[(size_t)m * 768 + s * 64 + lane];
      float x0 = __uint_as_float(raw << 16), x1 = __uint_as_float(raw & 0xFFFF0000u);
      if (s < 10) {
        const float ss = wave_sum(x0 * x0 + x1 * x1);
        const float r = rsqrtf(ss * (1.f / 128.f) + EPS);
        x0 = x0 * r * (s < 8 ? qg0 : kg0); x1 = x1 * r * (s < 8 ? qg1 : kg1);
        if (smp) { const float a = x0, b = x1; x0 = a * cs - b * sn; x1 = a * sn + b * cs; }
      }
      const unsigned w = pack2(x0, x1);
      if (s < 8) Q[(size_t)m * 512 + s * 64 + lane] = w;
      else {
        const int kv = (s - 8) & 1; const bool isk = s < 10;
        if (!smp) {
          (isk ? KP : VP)[(size_t)m * 128 + kv * 64 + lane] = w;
          const int b = m >> 8, t = m & 255;
          float* o = (isk ? newk : newv) + ((((size_t)b * 2 + j) * 256 + t) * 2 + kv) * 128 + 2 * lane;
          o[0] = x0; o[1] = x1;
        } else {
          const int b = (m - NPR) >> 10, t = (m - NPR) & 1023;
          (isk ? KS : VS)[((size_t)b * 1536 + t) * 128 + kv * 64 + lane] = w;
        }
      }
    }
  }
}

__device__ void phase_att_naive(const Params& p, int j, unsigned char* lds) {
  const int lane = threadIdx.x & 63, wid = threadIdx.x >> 6;
  float* qs = (float*)lds + wid * 1664; float* sl = qs + 128;
  const bf16_t* Q = (const bf16_t*)(p.ws + WS_Q); bf16_t* O = (bf16_t*)(p.ws + WS_O);
  const bf16_t* KP = (const bf16_t*)(p.ws + WS_KP); const bf16_t* VP = (const bf16_t*)(p.ws + WS_VP);
  const bf16_t* KS = (const bf16_t*)(p.ws + WS_KS) + (size_t)j * 4 * 1536 * 256; const bf16_t* VS = (const bf16_t*)(p.ws + WS_VS) + (size_t)j * 4 * 1536 * 256;
  const float scale = 0.08838834764831845f;
  for (int u = blockIdx.x * 8 + wid; u < MTOK * 8; u += gridDim.x * 8) {
    const int m = u >> 3, h = u & 7, kv = h >> 2;
    const bool smp = m >= NPR;
    const int nk = smp ? 1536 : 256;
    const size_t kb = smp ? ((size_t)((m - NPR) >> 10) * 1536) * 256 : ((size_t)(m >> 8) * 256) * 256;
    const bf16_t* Kb = (smp ? KS : KP) + kb + kv * 128; const bf16_t* Vb = (smp ? VS : VP) + kb + kv * 128;
    { const unsigned raw = *(const unsigned*)(Q + (size_t)m * D + h * 128 + 2 * lane); qs[2 * lane] = __uint_as_float(raw << 16); qs[2 * lane + 1] = __uint_as_float(raw & 0xFFFF0000u); }
    float mx = -1e30f;
    for (int k = lane; k < nk; k += 64) {
      const bf16_t* kr = Kb + (size_t)k * 256;
      float acc = 0.f;
      for (int d0 = 0; d0 < 128; d0 += 8) {
        const u32x4 w = *(const u32x4*)(kr + d0);
        acc += qs[d0 + 0] * __uint_as_float(w.x << 16) + qs[d0 + 1] * __uint_as_float(w.x & 0xFFFF0000u)
             + qs[d0 + 2] * __uint_as_float(w.y << 16) + qs[d0 + 3] * __uint_as_float(w.y & 0xFFFF0000u)
             + qs[d0 + 4] * __uint_as_float(w.z << 16) + qs[d0 + 5] * __uint_as_float(w.z & 0xFFFF0000u)
             + qs[d0 + 6] * __uint_as_float(w.w << 16) + qs[d0 + 7] * __uint_as_float(w.w & 0xFFFF0000u);
      }
      acc *= scale; sl[k] = acc; mx = fmaxf(mx, acc);
    }
    mx = wave_max(mx);
    float sum = 0.f;
    for (int k = lane; k < nk; k += 64) { const float e = expf(sl[k] - mx); sl[k] = e; sum += e; }
    sum = wave_sum(sum);
    float a0 = 0.f, a1 = 0.f;
    for (int k = 0; k < nk; ++k) {
      const float pk = sl[k];
      const unsigned raw = *(const unsigned*)(Vb + (size_t)k * 256 + 2 * lane);
      a0 += pk * __uint_as_float(raw << 16); a1 += pk * __uint_as_float(raw & 0xFFFF0000u);
    }
    const float inv = 1.f / sum;
    *(unsigned*)(O + (size_t)m * D + h * 128 + 2 * lane) = pack2(a0 * inv, a1 * inv);
  }
}

__global__ void __launch_bounds__(512, 2) mega(Params p) {
  extern __shared__ __attribute__((aligned(16))) unsigned char lds[];
  cg::grid_group grid = cg::this_grid();
  int ph = 0;
#define RUN(stmt) do { if (ph >= p.ph_lo && ph < p.ph_hi) { stmt; if (ph + 1 < p.ph_hi) grid.sync(); } ++ph; } while (0)
  bf16_t* XN = (bf16_t*)(p.ws + WS_XN); float* Y = (float*)(p.ws + WS_Y); const float* MOD = (const float*)(p.ws + WS_MOD);
  RUN(phase_p0(p, lds));
  RUN(phase_p0b(p));
#pragma unroll 1
  for (int l = 0; l < 4; ++l) {
    const int j = l >> 1;
    RUN(phase_nm(p, l, 0));
    if ((l & 1) == 0) {
      RUN((gemm_naive<false>((const bf16_t*)(p.ws + WS_WIN) + (size_t)j * 3072 * D, XN, 3072, MTOK, D, EpiStoreBf16{(bf16_t*)(p.ws + WS_ZT), MTOK}, nullptr)));
      RUN(phase_lca(p, j));
      RUN(phase_lcb(p, j));
      RUN((gemm_naive<false>((const bf16_t*)(p.ws + WS_YG), (const bf16_t*)(p.ws + WS_WHO) + (size_t)j * D * D, MTOK, D, D, EpiGateRes{Y, MOD + (size_t)l * 5 * 6144 + 2048}, nullptr)));
    } else {
      RUN((gemm_naive<false>(XN, (const bf16_t*)(p.ws + WS_WQKV) + (size_t)j * QKVD * D, MTOK, QKVD, D, EpiStoreBf16{(bf16_t*)(p.ws + WS_QKV), QKVD}, nullptr)));
      RUN(phase_qkvpost(p, j));
      RUN(phase_att_naive(p, j, lds));
      RUN((gemm_naive<false>((const bf16_t*)(p.ws + WS_O), (const bf16_t*)(p.ws + WS_WAO) + (size_t)j * D * D, MTOK, D, D, EpiGateRes{Y, MOD + (size_t)l * 5 * 6144 + 2048}, nullptr)));
    }
    RUN(phase_nm(p, l, 1));
    RUN((gemm_naive<true>(XN, (const bf16_t*)(p.ws + WS_WGU) + (size_t)l * 2 * DFF * D, MTOK, DFF, D, EpiStoreBf16{nullptr, 0}, (bf16_t*)(p.ws + WS_H))));
    RUN((gemm_naive<false>((const bf16_t*)(p.ws + WS_H), (const bf16_t*)(p.ws + WS_WDN) + (size_t)l * D * DFF, MTOK, D, DFF, EpiGateRes{Y, MOD + (size_t)l * 5 * 6144 + 5 * 1024}, nullptr)));
  }
  RUN(phase_final(p));
#undef RUN
}
constexpr int N_PHASES = 2 + 4 * 8 + 1;

#ifndef MK_SPLIT
#define MK_SPLIT 0
#endif

extern "C" void kernel_launch(void* const* d_in, const int* in_sizes, int n_in, void* d_out, int out_size, void* d_ws, size_t ws_size, hipStream_t stream) {
  static int grid = 0;
  if (grid == 0) {
    if (n_in != 29 || ws_size < WS_END) { fprintf(stderr, "kernel_launch: n_in %d ws %zu (need 29, >= %zu)\n", n_in, ws_size, (size_t)WS_END); grid = -1; return; }
    int dev = 0, cus = 0, per_cu = 0;
    hipGetDevice(&dev);
    hipDeviceGetAttribute(&cus, hipDeviceAttributeMultiprocessorCount, dev);
    if (hipFuncSetAttribute((const void*)mega, hipFuncAttributeMaxDynamicSharedMemorySize, LDS_BYTES) != hipSuccess) { fprintf(stderr, "kernel_launch: hipFuncSetAttribute failed\n"); grid = -1; return; }
    hipOccupancyMaxActiveBlocksPerMultiprocessor(&per_cu, (const void*)mega, 512, LDS_BYTES);
    if (per_cu < 1) { fprintf(stderr, "kernel_launch: occupancy query says %d blocks per CU\n", per_cu); per_cu = 1; }
    grid = cus * per_cu;
  }
  if (grid < 0) return;
  Params p{};
  for (int i = 0; i < 29; ++i) p.in[i] = (const float*)d_in[i];
  p.out = (float*)d_out; p.ws = (unsigned char*)d_ws;
#if MK_SPLIT
  for (int ph = 0; ph < N_PHASES; ++ph) {
    p.ph_lo = ph; p.ph_hi = ph + 1;
    void* args[] = {&p};
    hipError_t e = hipLaunchCooperativeKernel((const void*)mega, dim3(grid), dim3(512), args, LDS_BYTES, stream);
    if (e != hipSuccess) { fprintf(stderr, "cooperative launch failed: %s (grid %d)\n", hipGetErrorString(e), grid); break; }
  }
#else
  p.ph_lo = 0; p.ph_hi = N_PHASES;
  void* args[] = {&p};
  hipError_t e = hipLaunchCooperativeKernel((const void*)mega, dim3(grid), dim3(512), args, LDS_BYTES, stream);
  if (e != hipSuccess) fprintf(stderr, "cooperative launch failed: %s (grid %d)\n", hipGetErrorString(e), grid);
#endif
}
```

```cpp
#include <hip/hip_runtime.h>
#include <hip/hip_cooperative_groups.h>
#include <cstdio>
#include <cstdint>
namespace cg = cooperative_groups;

typedef unsigned short bf16_t;
typedef short bf16x8 __attribute__((ext_vector_type(8)));
typedef float f32x4 __attribute__((ext_vector_type(4)));
typedef unsigned u32x4 __attribute__((ext_vector_type(4)));

constexpr int D = 1024, MTOK = 8192, NPR = 4096;
constexpr int DFF = 2816, QKVD = 1536;
constexpr float EPS = 1e-6f;
constexpr float MIN_DECAY = -3.0701134573253944f, MAX_DECAY = -15.350567286626972f;

constexpr size_t MiB = 1u << 20;
constexpr size_t WS_MOD = 1 * MiB, WS_MODP = 2 * MiB, WS_FSQP = 6 * MiB, WS_RNORM = 7 * MiB, WS_FILT = 8 * MiB;
constexpr size_t WS_WIN = 28 * MiB, WS_WHO = 40 * MiB, WS_WQKV = 44 * MiB, WS_WAO = 50 * MiB, WS_WGU = 54 * MiB, WS_WDN = 98 * MiB;
constexpr size_t WS_Y = 120 * MiB, WS_XN = 152 * MiB, WS_R = 168 * MiB;
constexpr size_t WS_ZT = WS_R, WS_U = WS_R + 48 * MiB, WS_X0C = WS_R + 64 * MiB, WS_YG = WS_R + 80 * MiB;
constexpr size_t WS_QKV = WS_R, WS_Q = WS_R + 24 * MiB, WS_KP = WS_R + 40 * MiB, WS_VP = WS_R + 42 * MiB, WS_O = WS_R + 44 * MiB;
constexpr size_t WS_H = WS_R;
constexpr size_t WS_KS = WS_R + 96 * MiB, WS_VS = WS_R + 102 * MiB, WS_END = WS_R + 108 * MiB;
constexpr size_t FILT_J = 10 * MiB / 4;
constexpr size_t FILT_L1 = 1024 * 512;

constexpr int LDS_BYTES = 147456;

struct Params {
  const float* in[29];
  float* out;
  unsigned char* ws;
  int ph_lo, ph_hi;
};
enum { I_XP = 0, I_XS, I_CK, I_CV, I_C, I_CCTX, I_MODW, I_MODB, I_NMIX, I_NFFN, I_HWIN, I_HCW, I_HCB, I_FW1, I_FB1, I_FFREQ, I_FW2, I_FB2, I_FW3,
       I_HBIAS, I_HWOUT, I_WQKV, I_QN, I_KN, I_WAO, I_WG, I_WU, I_WD, I_FN };

__device__ __forceinline__ bf16_t f2bf(float f) { unsigned u = __float_as_uint(f); u += 0x7FFFu + ((u >> 16) & 1u); return (bf16_t)(u >> 16); }
__device__ __forceinline__ float bf2f(bf16_t b) { return __uint_as_float(((unsigned)b) << 16); }
__device__ __forceinline__ unsigned pack2(float lo, float hi) { return (unsigned)f2bf(lo) | ((unsigned)f2bf(hi) << 16); }
__device__ __forceinline__ float wave_sum(float v) {
#pragma unroll
  for (int o = 32; o >= 1; o >>= 1) v += __shfl_xor(v, o);
  return v;
}
__device__ __forceinline__ float wave_max(float v) {
#pragma unroll
  for (int o = 32; o >= 1; o >>= 1) v = fmaxf(v, __shfl_xor(v, o));
  return v;
}
__device__ __forceinline__ int tidx() { int t = threadIdx.x; asm volatile("" : "+v"(t)); return t; }
__device__ __forceinline__ int cond_of(int m) { return m < NPR ? 4 : ((m - NPR) >> 10); }
__device__ __forceinline__ float silu_f(float x) { return x / (1.f + expf(-x)); }
__device__ __forceinline__ float sin_rev(float r) { return __builtin_amdgcn_sinf(r - rintf(r)); }
__device__ __forceinline__ float cos_rev(float r) { return __builtin_amdgcn_cosf(r - rintf(r)); }
constexpr float INV_2PI = 0.15915494309189535f;

__device__ __forceinline__ void cvt_tile(const float* __restrict__ src, int K, int N, int kt, int nt, bf16_t* __restrict__ dst, int mode, float* tile  ) {
  const int tid = tidx();
  const int k0 = kt * 64, n0 = nt * 64;
  {
    const int r = tid >> 4, c4 = (tid & 15) * 4;
#pragma unroll
    for (int h = 0; h < 2; ++h) {
      const int rr = r + 32 * h;
      const f32x4 v = *(const f32x4*)(src + (size_t)(k0 + rr) * N + n0 + c4);
      tile[rr * 65 + c4 + 0] = v[0]; tile[rr * 65 + c4 + 1] = v[1]; tile[rr * 65 + c4 + 2] = v[2]; tile[rr * 65 + c4 + 3] = v[3];
    }
  }
  __syncthreads();
  {
    const int n = tid >> 3, kc = (tid & 7) * 8;
    u32x4 w;
    w.x = pack2(tile[(kc + 0) * 65 + n], tile[(kc + 1) * 65 + n]);
    w.y = pack2(tile[(kc + 2) * 65 + n], tile[(kc + 3) * 65 + n]);
    w.z = pack2(tile[(kc + 4) * 65 + n], tile[(kc + 5) * 65 + n]);
    w.w = pack2(tile[(kc + 6) * 65 + n], tile[(kc + 7) * 65 + n]);
    const int ng = n0 + n;
    const int row = mode == 0 ? ng : ((ng >> 7) * 256 + (ng & 127) + (mode == 2 ? 128 : 0));
    *(u32x4*)(dst + (size_t)row * K + k0 + kc) = w;
  }
  __syncthreads();
}

constexpr int NT_FILT = 320, NT_MOD = 384;
constexpr int NT_WIN = 2 * 16 * 48, NT_WHO = 2 * 16 * 16, NT_WQKV = 2 * 16 * 24, NT_WAO = 2 * 16 * 16, NT_G = 4 * 16 * 44, NT_DN = 4 * 44 * 16;
constexpr int NT_CVT = NT_WIN + NT_WHO + NT_WQKV + NT_WAO + 2 * NT_G + NT_DN;

__device__ void task_cvt(const Params& p, int t, float* tile) {
  if (t < NT_WIN) { const int l = t / (16 * 48), r = t % (16 * 48); cvt_tile(p.in[I_HWIN] + (size_t)l * D * 3072, D, 3072, r / 48, r % 48, (bf16_t*)(p.ws + WS_WIN) + (size_t)l * 3072 * D, 0, tile); return; }
  t -= NT_WIN;
  if (t < NT_WHO) { const int l = t / 256, r = t % 256; cvt_tile(p.in[I_HWOUT] + (size_t)l * D * D, D, D, r / 16, r % 16, (bf16_t*)(p.ws + WS_WHO) + (size_t)l * D * D, 0, tile); return; }
  t -= NT_WHO;
  if (t < NT_WQKV) { const int l = t / (16 * 24), r = t % (16 * 24); cvt_tile(p.in[I_WQKV] + (size_t)l * D * QKVD, D, QKVD, r / 24, r % 24, (bf16_t*)(p.ws + WS_WQKV) + (size_t)l * QKVD * D, 0, tile); return; }
  t -= NT_WQKV;
  if (t < NT_WAO) { const int l = t / 256, r = t % 256; cvt_tile(p.in[I_WAO] + (size_t)l * D * D, D, D, r / 16, r % 16, (bf16_t*)(p.ws + WS_WAO) + (size_t)l * D * D, 0, tile); return; }
  t -= NT_WAO;
  if (t < NT_G) { const int l = t / (16 * 44), r = t % (16 * 44); cvt_tile(p.in[I_WG] + (size_t)l * D * DFF, D, DFF, r / 44, r % 44, (bf16_t*)(p.ws + WS_WGU) + (size_t)l * 2 * DFF * D, 1, tile); return; }
  t -= NT_G;
  if (t < NT_G) { const int l = t / (16 * 44), r = t % (16 * 44); cvt_tile(p.in[I_WU] + (size_t)l * D * DFF, D, DFF, r / 44, r % 44, (bf16_t*)(p.ws + WS_WGU) + (size_t)l * 2 * DFF * D, 2, tile); return; }
  t -= NT_G;
  { const int l = t / (44 * 16), r = t % (44 * 16); cvt_tile(p.in[I_WD] + (size_t)l * DFF * D, DFF, D, r / 16, r % 16, (bf16_t*)(p.ws + WS_WDN) + (size_t)l * D * DFF, 0, tile); }
}

__device__ void task_mod(const Params& p, int t, float* sl  ) {
  const int tid = tidx();
  const int l = t / 96, rem = t % 96, cb = rem / 8, kc = rem % 8;
  __syncthreads();
  for (int i = tid; i < 640; i += 512) {
    const int j = i >> 7, k = kc * 128 + (i & 127);
    const float x = j < 4 ? p.in[I_C][j * D + k] : p.in[I_CCTX][k];
    sl[i] = silu_f(x);
  }
  __syncthreads();
  const int n = cb * 512 + tid;
  const float* w = p.in[I_MODW] + ((size_t)l * D + kc * 128) * 6144 + n;
  float a0 = 0.f, a1 = 0.f, a2 = 0.f, a3 = 0.f, a4 = 0.f;
#pragma unroll 4
  for (int k = 0; k < 128; ++k) {
    const float wv = w[(size_t)k * 6144];
    a0 += sl[k] * wv; a1 += sl[128 + k] * wv; a2 += sl[256 + k] * wv; a3 += sl[384 + k] * wv; a4 += sl[512 + k] * wv;
  }
  float* o = (float*)(p.ws + WS_MODP) + ((size_t)(kc * 4 + l) * 5) * 6144 + n;
  o[0] = a0; o[6144] = a1; o[2 * 6144] = a2; o[3 * 6144] = a3; o[4 * 6144] = a4;
}

__device__ void task_filt(const Params& p, int t, float* h1  , float* h2  ) {
  const int tid = tidx(), lane = tid & 63, wid = tid >> 6;
  const int combo = t >> 3, nchunk = t & 7;
  const int j = combo / 20, r = combo % 20;
  const int lsel = r < 4 ? 0 : 1, tchunk = r < 4 ? r : r - 4, L = lsel ? 1024 : 256;
  const int tt = lane, tpos = tchunk * 64 + tt;
  const float tn = (float)tpos / (float)L;
  const float* w1 = p.in[I_FW1] + (size_t)j * 33 * 64;
  const float* b1 = p.in[I_FB1] + j * 64;
  const float* fr = p.in[I_FFREQ] + j * 128;
  const float* w2 = p.in[I_FW2] + (size_t)j * 64 * 64;
  const float* b2 = p.in[I_FB2] + j * 64;
  const float* w3 = p.in[I_FW3] + (size_t)j * 64 * 2048;
  __syncthreads();
  {
    const int u0 = wid * 8;
    float acc[8];
#pragma unroll
    for (int uu = 0; uu < 8; ++uu) acc[uu] = tn * w1[u0 + uu];
    for (int b = 1; b <= 16; ++b) {
      const float rev = tn * (float)b;
      const float cs = cos_rev(rev), sn = sin_rev(rev);
#pragma unroll
      for (int uu = 0; uu < 8; ++uu) acc[uu] += cs * w1[b * 64 + u0 + uu] + sn * w1[(16 + b) * 64 + u0 + uu];
    }
#pragma unroll
    for (int uu = 0; uu < 8; ++uu) h1[tt * 65 + u0 + uu] = sin_rev(INV_2PI * (fr[u0 + uu] * (acc[uu] + b1[u0 + uu])));
  }
  __syncthreads();
  {
    const int u0 = wid * 8;
    float acc[8];
#pragma unroll
    for (int uu = 0; uu < 8; ++uu) acc[uu] = 0.f;
    for (int v = 0; v < 64; ++v) {
      const float hv = h1[tt * 65 + v];
#pragma unroll
      for (int uu = 0; uu < 8; ++uu) acc[uu] += hv * w2[v * 64 + u0 + uu];
    }
#pragma unroll
    for (int uu = 0; uu < 8; ++uu) h2[tt * 65 + u0 + uu] = sin_rev(INV_2PI * (fr[64 + u0 + uu] * (acc[uu] + b2[u0 + uu])));
  }
  __syncthreads();
  float* G2 = (float*)(p.ws + WS_FILT) + (size_t)j * FILT_J + (lsel ? FILT_L1 : 0);
  float* fsq = (float*)(p.ws + WS_FSQP) + ((size_t)((j * 2 + lsel) * 16 + tchunk)) * 2048;
  for (int q = 0; q < 32; ++q) {
    const int n = nchunk * 256 + wid * 32 + q;
    float acc = 0.f;
    for (int v = 0; v < 64; ++v) acc += h2[tt * 65 + v] * w3[v * 2048 + n];
    const int c = n & 1023; const bool isb = n >= 1024;
    const float delta = fabsf(MIN_DECAY + (MAX_DECAY - MIN_DECAY) * ((float)c / 1023.f));
    float val = acc * expf(-tn * delta);
    if (isb && tpos == 0) val = 0.f;
    if (!(isb && tpos == 0)) G2[(size_t)c * (2 * L) + (isb ? (L - tpos) : (L + tpos))] = val;
    const float s = wave_sum(val * val);
    if (lane == 0) fsq[n] = s;
  }
}

__device__ void phase_p0(const Params& p, unsigned char* lds) {
  float* fl = (float*)lds;
  const int G = gridDim.x, b = blockIdx.x, tid = tidx();
  for (int t = b; t < NT_FILT + NT_MOD + NT_CVT; t += G) {
    __syncthreads();
    if (t < NT_FILT) task_filt(p, t, fl, fl + 64 * 65);
    else if (t < NT_FILT + NT_MOD) task_mod(p, t - NT_FILT, fl);
    else task_cvt(p, t - NT_FILT - NT_MOD, fl);
  }
  {
    f32x4* Y = (f32x4*)(p.ws + WS_Y);
    const f32x4* xp = (const f32x4*)p.in[I_XP]; const f32x4* xs = (const f32x4*)p.in[I_XS];
    const int half = NPR * D / 4;
    for (int i = b * 512 + tid; i < 2 * half; i += G * 512) Y[i] = i < half ? xp[i] : xs[i - half];
  }
  {
    bf16_t* KS = (bf16_t*)(p.ws + WS_KS); bf16_t* VS = (bf16_t*)(p.ws + WS_VS);
    const int n = 4 * 2 * 512 * 256;
    for (int i = b * 512 + tid; i < n; i += G * 512) {
      const int e = i & 255, pos = (i >> 8) & 511, j = (i >> 17) & 1, bb = i >> 18;
      const size_t o = ((size_t)(j * 4 + bb) * 1536 + 1024 + pos) * 256 + e;
      KS[o] = f2bf(p.in[I_CK][i]); VS[o] = f2bf(p.in[I_CV][i]);
    }
  }
}

__device__ void phase_p0b(const Params& p) {
  const int G = gridDim.x, b = blockIdx.x, tid = tidx();
  float* MOD = (float*)(p.ws + WS_MOD); const float* MP = (const float*)(p.ws + WS_MODP);
  for (int i = b * 512 + tid; i < 4 * 5 * 6144; i += G * 512) {
    const int n = i % 6144, l = i / (5 * 6144);
    float s = p.in[I_MODB][l * 6144 + n];
#pragma unroll
    for (int kc = 0; kc < 8; ++kc) s += MP[(size_t)kc * (4 * 5 * 6144) + i];
    MOD[i] = s;
  }
  float* RN = (float*)(p.ws + WS_RNORM); const float* FS = (const float*)(p.ws + WS_FSQP);
  for (int i = b * 512 + tid; i < 4096; i += G * 512) {
    const int c = i & 1023, jl = i >> 10, nch = (jl & 1) ? 16 : 4;
    float s = 0.f;
    for (int ch = 0; ch < nch; ++ch) s += FS[((size_t)jl * 16 + ch) * 2048 + c] + FS[((size_t)jl * 16 + ch) * 2048 + 1024 + c];
    RN[i] = 1.f / sqrtf(s + EPS);
  }
}

__device__ void phase_nm(const Params& p, int layer, int which) {
  const int lane = tidx() & 63, wid = tidx() >> 6;
  const float* Y = (const float*)(p.ws + WS_Y); bf16_t* XN = (bf16_t*)(p.ws + WS_XN);
  const float* g = p.in[which ? I_NFFN : I_NMIX] + layer * D;
  for (int m = blockIdx.x * 8 + wid; m < MTOK; m += gridDim.x * 8) {
    const float* y = Y + (size_t)m * D;
    f32x4 v[4]; float ss = 0.f;
#pragma unroll
    for (int i = 0; i < 4; ++i) { v[i] = *(const f32x4*)(y + i * 256 + lane * 4); ss += v[i][0] * v[i][0] + v[i][1] * v[i][1] + v[i][2] * v[i][2] + v[i][3] * v[i][3]; }
    ss = wave_sum(ss);
    const float r = rsqrtf(ss * (1.f / D) + EPS);
    const float* mod = (const float*)(p.ws + WS_MOD) + (size_t)(layer * 5 + cond_of(m)) * 6144 + which * 3072;
#pragma unroll
    for (int i = 0; i < 4; ++i) {
      const int k = i * 256 + lane * 4;
      const f32x4 gg = *(const f32x4*)(g + k), sh = *(const f32x4*)(mod + k), sc = *(const f32x4*)(mod + 1024 + k);
      float o[4];
#pragma unroll
      for (int e = 0; e < 4; ++e) o[e] = (v[i][e] * r * gg[e]) * (1.f + sc[e]) + sh[e];
      uint2 w; w.x = pack2(o[0], o[1]); w.y = pack2(o[2], o[3]);
      *(uint2*)(XN + (size_t)m * D + k) = w;
    }
  }
}

__device__ void phase_final(const Params& p) {
  const int lane = tidx() & 63, wid = tidx() >> 6;
  const float* Y = (const float*)(p.ws + WS_Y);
  const float* g = p.in[I_FN];
  for (int m = blockIdx.x * 8 + wid; m < MTOK; m += gridDim.x * 8) {
    const float* y = Y + (size_t)m * D;
    f32x4 v[4]; float ss = 0.f;
#pragma unroll
    for (int i = 0; i < 4; ++i) { v[i] = *(const f32x4*)(y + i * 256 + lane * 4); ss += v[i][0] * v[i][0] + v[i][1] * v[i][1] + v[i][2] * v[i][2] + v[i][3] * v[i][3]; }
    ss = wave_sum(ss);
    const float r = rsqrtf(ss * (1.f / D) + EPS);
#pragma unroll
    for (int i = 0; i < 4; ++i) {
      const int k = i * 256 + lane * 4;
      const f32x4 gg = *(const f32x4*)(g + k);
      f32x4 o; o[0] = v[i][0] * r * gg[0]; o[1] = v[i][1] * r * gg[1]; o[2] = v[i][2] * r * gg[2]; o[3] = v[i][3] * r * gg[3];
      *(f32x4*)(p.out + (size_t)m * D + k) = o;
    }
  }
}

struct EpiStoreBf16 { bf16_t* C; int ld; __device__ __forceinline__ void operator()(int m, int n, float v) const { C[(size_t)m * ld + n] = f2bf(v); } };
struct EpiGateRes { float* Y; const float* gate; __device__ __forceinline__ void operator()(int m, int n, float v) const { Y[(size_t)m * D + n] += gate[cond_of(m) * 6144 + n] * v; } };

template <bool SWIGLU, class Epi>
__device__ __forceinline__ void gemm_naive(const bf16_t* __restrict__ A, const bf16_t* __restrict__ Bt, int M, int N, int K, const Epi& epi, bf16_t* Hout) {
  const int lane = tidx() & 63, wid = tidx() >> 6, r16 = lane & 15, kg = lane >> 4;
  const int tilesN = SWIGLU ? N / 32 : N / 64, total = (M / 64) * tilesN;
  for (int tile = blockIdx.x * 8 + wid; tile < total; tile += gridDim.x * 8) {
    const int tm = tile / tilesN, tn = tile % tilesN, m0 = tm * 64;
    f32x4 acc[4][4];
#pragma unroll
    for (int i = 0; i < 4; ++i)
#pragma unroll
      for (int f = 0; f < 4; ++f) acc[i][f] = (f32x4){0.f, 0.f, 0.f, 0.f};
    const bf16_t* ap = A + (size_t)(m0 + r16) * K + kg * 8;
    int brow[4];
#pragma unroll
    for (int f = 0; f < 4; ++f) {
      if (SWIGLU) { const int hc = tn * 32 + 16 * (f & 1) + r16; brow[f] = (hc >> 7) * 256 + (hc & 127) + 128 * (f >> 1); }
      else brow[f] = tn * 64 + 16 * f + r16;
    }
    const bf16_t* bp0 = Bt + (size_t)brow[0] * K + kg * 8; const bf16_t* bp1 = Bt + (size_t)brow[1] * K + kg * 8;
    const bf16_t* bp2 = Bt + (size_t)brow[2] * K + kg * 8; const bf16_t* bp3 = Bt + (size_t)brow[3] * K + kg * 8;
    for (int k0 = 0; k0 < K; k0 += 32) {
      bf16x8 a[4], b[4];
#pragma unroll
      for (int i = 0; i < 4; ++i) a[i] = *(const bf16x8*)(ap + (size_t)(16 * i) * K + k0);
      b[0] = *(const bf16x8*)(bp0 + k0); b[1] = *(const bf16x8*)(bp1 + k0); b[2] = *(const bf16x8*)(bp2 + k0); b[3] = *(const bf16x8*)(bp3 + k0);
#pragma unroll
      for (int i = 0; i < 4; ++i)
#pragma unroll
        for (int f = 0; f < 4; ++f) acc[i][f] = __builtin_amdgcn_mfma_f32_16x16x32_bf16(a[i], b[f], acc[i][f], 0, 0, 0);
    }
    if (SWIGLU) {
#pragma unroll
      for (int i = 0; i < 4; ++i)
#pragma unroll
        for (int f = 0; f < 2; ++f)
#pragma unroll
          for (int e = 0; e < 4; ++e) {
            const int m = m0 + 16 * i + 4 * kg + e, hc = tn * 32 + 16 * f + r16;
            const float gv = acc[i][f][e], uv = acc[i][f + 2][e];
            Hout[(size_t)m * DFF + hc] = f2bf(silu_f(gv) * uv);
          }
    } else {
#pragma unroll
      for (int i = 0; i < 4; ++i)
#pragma unroll
        for (int f = 0; f < 4; ++f)
#pragma unroll
          for (int e = 0; e < 4; ++e) epi(m0 + 16 * i + 4 * kg + e, tn * 64 + 16 * f + r16, acc[i][f][e]);
    }
  }
}


namespace pg8 {
#define PG8_LAS __attribute__((address_space(3)))
constexpr int BM = 256, BK = 64, HALF = 128, HTB = HALF * BK * 2, STAGE_BYTES = 8 * HTB, NXCD = 8, WGM = 8;
__host__ __device__ __forceinline__ int lds_byte(int r, int c) { const int st = (r >> 4) * 2 + (c >> 5), rr = r & 15, cc = c & 31, ob = rr * 64 + cc * 2; return st * 1024 + (ob ^ (((ob >> 9) & 1) << 5)); }
__host__ __device__ __forceinline__ void stage_rc(int b, int& R, int& C) { const int st = b / 1024, sb = b % 1024, swz = sb ^ (((sb >> 9) & 1) << 5); R = (st >> 1) * 16 + swz / 64; C = (st & 1) * 32 + (swz % 64) / 2; }
__host__ __device__ __forceinline__ int perm32(int rho) { const int n = rho >> 4, i = rho & 15; return 8 * (i >> 2) + 4 * n + (i & 3); }
struct Unit { int pm, pn, ks; };
struct Gemm { const bf16_t* A; const bf16_t* Bt; int M, N, K, ld; };
struct StaticOrder {
    int nM, nN, nwg, G, c, KS;
    __device__ void init(int M, int N, int KS_, int G_, int c_) { nM = M / BM; KS = KS_; nN = (N / BM) * KS_; nwg = nM * nN; G = G_; c = c_; }
    __device__ bool next(int i, Unit& u) const {
        const long L = (long)i * G + c; if (L >= nwg) return false;
        int wgid = (int)L; { const int q = nwg / NXCD, r = nwg % NXCD, xcd = wgid % NXCD, off = wgid / NXCD; wgid = (xcd < r ? xcd * (q + 1) : r * (q + 1) + (xcd - r) * q) + off; }
        const int nig = WGM * nN, gid = wgid / nig, fm = gid * WGM, gsz = (nM - fm) < WGM ? (nM - fm) : WGM;
        u.pm = fm + ((wgid % nig) % gsz); const int pn2 = (wgid % nig) / gsz; u.pn = pn2 / KS; u.ks = pn2 % KS; return true;
    }
    __device__ __forceinline__ void a_ready(const Unit&) const {}
    __device__ __forceinline__ void done(const Unit&) const {}
};
__device__ __forceinline__ unsigned cvt_pk_bf16(float lo, float hi) { unsigned r; asm volatile("v_cvt_pk_bf16_f32 %0, %1, %2" : "=v"(r) : "v"(lo), "v"(hi)); return r; }
struct EpiBf16 {
    static constexpr bool PERM = true, AFTER_DRAIN = false;
    bf16_t* O; int ldc;
    __device__ __forceinline__ void operator()(const f32x4 (&acc)[2][2][4][2], const Unit& u, int wr, int wc, int fr, int fq) const {
        const int row0 = u.pm * BM + wr * 64 + fr, col0 = u.pn * BM + wc * 32 + 8 * fq;
#pragma unroll
        for (int ai = 0; ai < 2; ++ai)
#pragma unroll
            for (int m = 0; m < 4; ++m) { bf16_t* rowp = O + (size_t)(row0 + ai * HALF + m * 16) * ldc + col0;
#pragma unroll
                for (int bj = 0; bj < 2; ++bj) { const f32x4 v0 = acc[ai][bj][m][0], v1 = acc[ai][bj][m][1];
                    u32x4 w; w.x = cvt_pk_bf16(v0[0], v0[1]); w.y = cvt_pk_bf16(v0[2], v0[3]); w.z = cvt_pk_bf16(v1[0], v1[1]); w.w = cvt_pk_bf16(v1[2], v1[3]);
                    *(u32x4*)(rowp + bj * HALF) = w; } }
    }
};
struct EpiSwiglu {
    static constexpr bool PERM = true, AFTER_DRAIN = false;
    bf16_t* H;
    __device__ __forceinline__ void operator()(const f32x4 (&acc)[2][2][4][2], const Unit& u, int wr, int wc, int fr, int fq) const {
        const int row0 = u.pm * BM + wr * 64 + fr, col0 = u.pn * HALF + wc * 32 + 8 * fq;
#pragma unroll
        for (int ai = 0; ai < 2; ++ai)
#pragma unroll
            for (int m = 0; m < 4; ++m) {
                float h[8];
#pragma unroll
                for (int n = 0; n < 2; ++n)
#pragma unroll
                    for (int e = 0; e < 4; ++e) { const float gv = acc[ai][0][m][n][e], uv = acc[ai][1][m][n][e]; h[4 * n + e] = gv * __builtin_amdgcn_rcpf(1.f + __expf(-gv)) * uv; }
                u32x4 w; w.x = cvt_pk_bf16(h[0], h[1]); w.y = cvt_pk_bf16(h[2], h[3]); w.z = cvt_pk_bf16(h[4], h[5]); w.w = cvt_pk_bf16(h[6], h[7]);
                *(u32x4*)(H + (size_t)(row0 + ai * HALF + m * 16) * DFF + col0) = w; }
    }
};
template <bool ATOMIC> struct EpiGate {
    static constexpr bool PERM = false, AFTER_DRAIN = false;
    float* Y; const float* gate;
    __device__ __forceinline__ void operator()(const f32x4 (&acc)[2][2][4][2], const Unit& u, int wr, int wc, int fr, int fq) const {
        const int row0 = u.pm * BM + wr * 64 + fr, col0 = u.pn * BM + wc * 32 + 4 * fq;
#pragma unroll
        for (int ai = 0; ai < 2; ++ai)
#pragma unroll
            for (int m = 0; m < 4; ++m) { const int row = row0 + ai * HALF + m * 16; const float* gp = gate + cond_of(row) * 6144 + col0; float* yp = Y + (size_t)row * D + col0;
#pragma unroll
                for (int bj = 0; bj < 2; ++bj)
#pragma unroll
                    for (int n = 0; n < 2; ++n) { const int o = bj * HALF + n * 16; const f32x4 gv = *(const f32x4*)(gp + o); const f32x4 v = acc[ai][bj][m][n] * gv;
                        if (ATOMIC) { unsafeAtomicAdd(yp + o, v[0]); unsafeAtomicAdd(yp + o + 1, v[1]); unsafeAtomicAdd(yp + o + 2, v[2]); unsafeAtomicAdd(yp + o + 3, v[3]); }
                        else { *(f32x4*)(yp + o) = *(const f32x4*)(yp + o) + v; } } }
    }
};
template <class Epi, class Sched, bool ALIGN_EPI = false, bool SP2 = false>
__device__ __forceinline__ void gemm_phase(PG8_LAS unsigned char* lds, const Gemm g, const Sched& S, const Epi& E) {
    int tid_ = tidx();
    const int tid = tid_, wid = __builtin_amdgcn_readfirstlane(tid >> 6), lane = tid & 63, wr = wid >> 2, wc = wid & 3, fr = lane & 15, fq = lane >> 4;
    const int K = g.ld, nt = g.K / BK;
    unsigned voffA[2], voffB[2];
#pragma unroll
    for (int i = 0; i < 2; ++i) { int R, C; stage_rc(tid * 16 + i * 8192, R, C); const int Rb = Epi::PERM ? ((R & ~31) + perm32(R & 31)) : R;
        voffA[i] = (unsigned)(R * K + C) * 2u; voffB[i] = (unsigned)(Rb * K + C) * 2u; }
    const size_t kstep = (size_t)(BK * 2);
    const size_t hstep = (size_t)HALF * K * 2;
    const size_t tstep = 2 * hstep;
    const unsigned ldsw = (unsigned)wid * 1024u;
    const int aoff = lds_byte(wr * 64 + fr, fq * 8), boff = lds_byte(wc * 32 + fr, fq * 8);
#define PG8_SA(b, h) (((b) * 2 + (h)) * HTB)
#define PG8_SB(b, h) ((4 + (b) * 2 + (h)) * HTB)
#define PG8_STAGE(bufoff, gbase, voff) do { _Pragma("unroll") for (int _i = 0; _i < 2; ++_i) \
        __builtin_amdgcn_global_load_lds((const unsigned*)((const char*)(gbase) + (voff)[_i]), (PG8_LAS unsigned*)(lds + (bufoff) + ldsw + _i * 8192), 16, 0, 0); } while (0)
#define PG8_LDA(dst, b, h) do { _Pragma("unroll") for (int m = 0; m < 4; ++m) _Pragma("unroll") for (int k = 0; k < 2; ++k) dst[m][k] = *(const PG8_LAS bf16x8*)(lds + PG8_SA(b, h) + aoff + m * 2048 + k * 1024); } while (0)
#define PG8_LDB(dst, b, h) do { _Pragma("unroll") for (int n = 0; n < 2; ++n) _Pragma("unroll") for (int k = 0; k < 2; ++k) dst[n][k] = *(const PG8_LAS bf16x8*)(lds + PG8_SB(b, h) + boff + n * 2048 + k * 1024); } while (0)
#define PG8_MMA(ai, bj, At, Bt) do { __builtin_amdgcn_s_setprio(1); _Pragma("unroll") for (int m = 0; m < 4; ++m) _Pragma("unroll") for (int n = 0; n < 2; ++n) _Pragma("unroll") for (int k = 0; k < 2; ++k) \
        acc[ai][bj][m][n] = __builtin_amdgcn_mfma_f32_16x16x32_bf16(Bt[n][k], At[m][k], acc[ai][bj][m][n], 0, 0, 0); __builtin_amdgcn_s_setprio(0); } while (0)
#define PG8_WAIT_V(n) asm volatile("s_waitcnt vmcnt(" #n ")" ::: "memory")
#define PG8_WAIT_L(n) asm volatile("s_waitcnt lgkmcnt(" #n ")" ::: "memory")
#define PG8_BAR __builtin_amdgcn_s_barrier()
#define PG8_SCHED __builtin_amdgcn_sched_barrier(0)
    Unit cur, nxt; int ui = 0;
    if (!S.next(0, cur)) return;
    f32x4 acc[2][2][4][2];
#pragma unroll
    for (int a = 0; a < 2; ++a)
#pragma unroll
        for (int b = 0; b < 2; ++b)
#pragma unroll
            for (int m = 0; m < 4; ++m)
#pragma unroll
                for (int n = 0; n < 2; ++n) acc[a][b][m][n] = (f32x4){0.f, 0.f, 0.f, 0.f};
    bf16x8 At[4][2], B0[2][2], B1[2][2];
    const size_t ksb = (size_t)g.K * 2; const char* cA = (const char*)g.A + (size_t)cur.pm * tstep + cur.ks * ksb; const char* cB = (const char*)g.Bt + (size_t)cur.pn * tstep + cur.ks * ksb;
    S.a_ready(cur);
    if constexpr (SP2) {
        PG8_STAGE(PG8_SB(0, 0), cB, voffB); PG8_STAGE(PG8_SB(0, 1), cB + hstep, voffB); PG8_STAGE(PG8_SA(0, 0), cA, voffA); PG8_STAGE(PG8_SA(0, 1), cA + hstep, voffA);
        if (wr == 1) PG8_BAR;
        PG8_WAIT_V(2); PG8_BAR;
        PG8_STAGE(PG8_SB(1, 0), cB + kstep, voffB); PG8_STAGE(PG8_SA(1, 0), cA + kstep, voffA); PG8_STAGE(PG8_SB(1, 1), cB + hstep + kstep, voffB);
        PG8_WAIT_V(6); PG8_BAR;
    } else {
        PG8_STAGE(PG8_SB(0, 0), cB, voffB); PG8_STAGE(PG8_SA(0, 0), cA, voffA); PG8_STAGE(PG8_SB(0, 1), cB + hstep, voffB); PG8_STAGE(PG8_SA(0, 1), cA + hstep, voffA);
        if (wr == 1) PG8_BAR;
        PG8_WAIT_V(4); PG8_BAR;
        PG8_STAGE(PG8_SB(1, 0), cB + kstep, voffB); PG8_STAGE(PG8_SA(1, 0), cA + kstep, voffA); PG8_STAGE(PG8_SB(1, 1), cB + hstep + kstep, voffB);
        PG8_WAIT_V(6); PG8_BAR;
    }
    for (;;) {
        const bool has_next = S.next(ui + 1, nxt);
        const char* nA = has_next ? (const char*)g.A + (size_t)nxt.pm * tstep + nxt.ks * ksb : cA; const char* nB = has_next ? (const char*)g.Bt + (size_t)nxt.pn * tstep + nxt.ks * ksb : cB;
        for (int t = 0; t < nt; t += 2) {
            const bool last = (t == nt - 2);
            const char* a1 = cA + (size_t)(t + 1) * kstep;
            const char* a2 = last ? nA : cA + (size_t)(t + 2) * kstep; const char* b2 = last ? nB : cB + (size_t)(t + 2) * kstep;
            const char* a3 = a2 + kstep; const char* b3 = b2 + kstep;
            if (last && has_next) S.a_ready(nxt);
            if constexpr (SP2) {
            PG8_LDB(B0, 0, 0); PG8_LDB(B1, 0, 1); PG8_SCHED; PG8_LDA(At, 0, 0); PG8_STAGE(PG8_SA(1, 1), a1 + hstep, voffA);
            PG8_WAIT_V(8); PG8_WAIT_L(0); PG8_BAR; PG8_MMA(0, 0, At, B0); PG8_MMA(0, 1, At, B1); PG8_BAR; PG8_SCHED;
            PG8_LDA(At, 0, 1); PG8_STAGE(PG8_SB(0, 0), b2, voffB); PG8_STAGE(PG8_SB(0, 1), b2 + hstep, voffB); PG8_STAGE(PG8_SA(0, 0), a2, voffA);
            PG8_WAIT_V(8); PG8_WAIT_L(0); PG8_BAR; PG8_MMA(1, 0, At, B0); PG8_MMA(1, 1, At, B1); PG8_BAR; PG8_SCHED;
            PG8_LDB(B0, 1, 0); PG8_LDB(B1, 1, 1); PG8_SCHED; PG8_LDA(At, 1, 0); PG8_STAGE(PG8_SA(0, 1), a2 + hstep, voffA);
            PG8_WAIT_V(8); PG8_WAIT_L(0); PG8_BAR; PG8_MMA(0, 0, At, B0); PG8_MMA(0, 1, At, B1); PG8_BAR; PG8_SCHED;
            PG8_LDA(At, 1, 1); PG8_STAGE(PG8_SB(1, 0), b3, voffB); PG8_STAGE(PG8_SB(1, 1), b3 + hstep, voffB); PG8_STAGE(PG8_SA(1, 0), a3, voffA);
            PG8_WAIT_V(8); PG8_WAIT_L(0); PG8_BAR; PG8_MMA(1, 0, At, B0); PG8_MMA(1, 1, At, B1); PG8_BAR; PG8_SCHED;
            } else {
            PG8_LDB(B0, 0, 0); PG8_SCHED; PG8_LDA(At, 0, 0); PG8_STAGE(PG8_SA(1, 1), a1 + hstep, voffA);
            PG8_WAIT_L(8); PG8_BAR; PG8_WAIT_L(0); PG8_MMA(0, 0, At, B0); PG8_BAR; PG8_SCHED;
            PG8_LDB(B1, 0, 1); PG8_STAGE(PG8_SB(0, 0), b2, voffB);
            PG8_BAR; PG8_WAIT_L(0); PG8_MMA(0, 1, At, B1); PG8_BAR;
            PG8_LDA(At, 0, 1); PG8_STAGE(PG8_SA(0, 0), a2, voffA);
            PG8_BAR; PG8_WAIT_L(0); PG8_MMA(1, 0, At, B0); PG8_BAR; PG8_SCHED;
            PG8_STAGE(PG8_SB(0, 1), b2 + hstep, voffB);
            PG8_WAIT_V(6); PG8_BAR; PG8_MMA(1, 1, At, B1); PG8_BAR;
            PG8_LDB(B0, 1, 0); PG8_SCHED; PG8_LDA(At, 1, 0); PG8_STAGE(PG8_SA(0, 1), a2 + hstep, voffA);
            PG8_WAIT_L(8); PG8_BAR; PG8_WAIT_L(0); PG8_MMA(0, 0, At, B0); PG8_BAR; PG8_SCHED;
            PG8_LDB(B1, 1, 1); PG8_STAGE(PG8_SB(1, 0), b3, voffB);
            PG8_BAR; PG8_WAIT_L(0); PG8_MMA(0, 1, At, B1); PG8_BAR;
            PG8_LDA(At, 1, 1); PG8_STAGE(PG8_SA(1, 0), a3, voffA);
            PG8_BAR; PG8_WAIT_L(0); PG8_MMA(1, 0, At, B0); PG8_BAR; PG8_SCHED;
            PG8_STAGE(PG8_SB(1, 1), b3 + hstep, voffB);
            PG8_WAIT_V(6); PG8_BAR; PG8_MMA(1, 1, At, B1); PG8_BAR;
            }
        }
        if constexpr (ALIGN_EPI) { if (wr == 0) PG8_BAR; }
        if constexpr (!Epi::AFTER_DRAIN) { E(acc, cur, wr, wc, fr, fq); S.done(cur); }
        if (!has_next) break;
#pragma unroll
        for (int a = 0; a < 2; ++a)
#pragma unroll
            for (int b = 0; b < 2; ++b)
#pragma unroll
                for (int m = 0; m < 4; ++m)
#pragma unroll
                    for (int n = 0; n < 2; ++n) acc[a][b][m][n] = (f32x4){0.f, 0.f, 0.f, 0.f};
        cur = nxt; cA = nA; cB = nB; ++ui;
        if constexpr (ALIGN_EPI) { if (wr == 1) PG8_BAR; }
    }
    PG8_WAIT_V(0);
    if constexpr (!ALIGN_EPI) { if (wr == 0) PG8_BAR; }
    PG8_BAR;
    if constexpr (Epi::AFTER_DRAIN) { E.fused(acc, cur, wr, wc, fr, fq, lds, wid, lane); S.done(cur); }
#undef PG8_SA
#undef PG8_SB
#undef PG8_STAGE
#undef PG8_LDA
#undef PG8_LDB
#undef PG8_MMA
#undef PG8_WAIT_V
#undef PG8_WAIT_L
#undef PG8_BAR
#undef PG8_SCHED
}
}

template <class Epi>
__device__ __forceinline__ void gemm_run(unsigned char* lds, const bf16_t* A, const bf16_t* Bt, int M, int N, int Ktot, int KS, const Epi& E) {
    pg8::StaticOrder S; S.init(M, N, KS, (int)gridDim.x, (int)blockIdx.x);
    pg8::Gemm g; g.A = A; g.Bt = Bt; g.M = M; g.N = N; g.K = Ktot / KS; g.ld = Ktot;
    __syncthreads();
    pg8::gemm_phase<Epi, pg8::StaticOrder, true, true>((PG8_LAS unsigned char*)lds, g, S, E);
    __syncthreads();
}

__device__ void phase_lca(const Params& p, int j) {
  const bf16_t* ZT = (const bf16_t*)(p.ws + WS_ZT); bf16_t* U = (bf16_t*)(p.ws + WS_U); bf16_t* X0 = (bf16_t*)(p.ws + WS_X0C);
  const float* cw = p.in[I_HCW] + (size_t)j * 3 * 3072; const float* cb = p.in[I_HCB] + (size_t)j * 3072;
  for (int i = blockIdx.x * 512 + tidx(); i < D * MTOK; i += gridDim.x * 512) {
    const int c = i >> 13, m = i & 8191;
    const int L = m < NPR ? 256 : 1024, t = m & (L - 1);
    float sc[3];
#pragma unroll
    for (int part = 0; part < 3; ++part) {
      const int ch = part * 1024 + c;
      const bf16_t* z = ZT + (size_t)ch * MTOK + m;
      const float zm = t > 0 ? bf2f(z[-1]) : 0.f, z0 = bf2f(z[0]), zp = t < L - 1 ? bf2f(z[1]) : 0.f;
      sc[part] = zm * cw[ch] + z0 * cw[3072 + ch] + zp * cw[2 * 3072 + ch] + cb[ch];
    }
    X0[i] = f2bf(sc[0]); U[i] = f2bf(sc[1] * sc[2]);
  }
}
__device__ void phase_lcb(const Params& p, int j) {
  const bf16_t* U = (const bf16_t*)(p.ws + WS_U); const bf16_t* X0 = (const bf16_t*)(p.ws + WS_X0C); bf16_t* YG = (bf16_t*)(p.ws + WS_YG);
  const float* RN = (const float*)(p.ws + WS_RNORM); const float* bias = p.in[I_HBIAS] + j * D;
  for (int i = blockIdx.x * 512 + tidx(); i < D * MTOK; i += gridDim.x * 512) {
    const int c = i >> 13, m = i & 8191;
    const int lsel = m < NPR ? 0 : 1, L = lsel ? 1024 : 256, t = m & (L - 1);
    const float* g2 = (const float*)(p.ws + WS_FILT) + (size_t)j * FILT_J + (lsel ? FILT_L1 : 0) + (size_t)c * (2 * L) + L + t;
    const bf16_t* u = U + (size_t)c * MTOK + (m - t);
    float acc = 0.f;
    for (int s = 0; s < L; ++s) acc += g2[-s] * bf2f(u[s]);
    const float uu = bf2f(u[t]);
    const float y = acc * RN[(j * 2 + lsel) * 1024 + c] + uu * bias[c];
    YG[(size_t)m * D + c] = f2bf(bf2f(X0[i]) * y);
  }
}

__device__ void phase_qkvpost(const Params& p, int j) {
  const int lane = tidx() & 63, wid = tidx() >> 6;
  const unsigned* QKV = (const unsigned*)(p.ws + WS_QKV);
  unsigned* Q = (unsigned*)(p.ws + WS_Q); unsigned* KP = (unsigned*)(p.ws + WS_KP); unsigned* VP = (unsigned*)(p.ws + WS_VP);
  unsigned* KS = (unsigned*)(p.ws + WS_KS) + (size_t)j * 4 * 1536 * 128; unsigned* VS = (unsigned*)(p.ws + WS_VS) + (size_t)j * 4 * 1536 * 128;
  const float* qn = p.in[I_QN] + j * 128; const float* kn = p.in[I_KN] + j * 128;
  float* newk = p.out + (size_t)2 * NPR * D; float* newv = newk + (size_t)16 * 2 * 256 * 256;
  const float qg0 = qn[2 * lane], qg1 = qn[2 * lane + 1], kg0 = kn[2 * lane], kg1 = kn[2 * lane + 1];
  const float freq = exp2f(-(float)(lane & 31) * 0.41524101186092029f);
  for (int m = blockIdx.x * 8 + wid; m < MTOK; m += gridDim.x * 8) {
    const bool smp = m >= NPR;
    float cs = 1.f, sn = 0.f;
    if (smp) { const int t = (m - NPR) & 1023; const float pos = (float)(lane < 32 ? (t >> 6) : (t & 63)); const float rev = (pos * freq) * INV_2PI; cs = cos_rev(rev); sn = sin_rev(rev); }
    for (int s = 0; s < 12; ++s) {
      const unsigned raw = QKV[(size_t)m * 768 + s * 64 + lane];
      float x0 = __uint_as_float(raw << 16), x1 = __uint_as_float(raw & 0xFFFF0000u);
      if (s < 10) {
        const float ss = wave_sum(x0 * x0 + x1 * x1);
        const float r = rsqrtf(ss * (1.f / 128.f) + EPS);
        x0 = x0 * r * (s < 8 ? qg0 : kg0); x1 = x1 * r * (s < 8 ? qg1 : kg1);
        if (smp) { const float a = x0, b = x1; x0 = a * cs - b * sn; x1 = a * sn + b * cs; }
      }
      const unsigned w = pack2(x0, x1);
      if (s < 8) Q[(size_t)m * 512 + s * 64 + lane] = w;
      else {
        const int kv = (s - 8) & 1; const bool isk = s < 10;
        if (!smp) {
          (isk ? KP : VP)[(size_t)m * 128 + kv * 64 + lane] = w;
          const int b = m >> 8, t = m & 255;
          float* o = (isk ? newk : newv) + ((((size_t)b * 2 + j) * 256 + t) * 2 + kv) * 128 + 2 * lane;
          o[0] = x0; o[1] = x1;
        } else {
          const int b = (m - NPR) >> 10, t = (m - NPR) & 1023;
          (isk ? KS : VS)[((size_t)b * 1536 + t) * 128 + kv * 64 + lane] = w;
        }
      }
    }
  }
}

__device__ void phase_att_naive(const Params& p, int j, unsigned char* lds) {
  const int lane = tidx() & 63, wid = tidx() >> 6;
  float* qs = (float*)lds + wid * 1664; float* sl = qs + 128;
  const bf16_t* Q = (const bf16_t*)(p.ws + WS_Q); bf16_t* O = (bf16_t*)(p.ws + WS_O);
  const bf16_t* KP = (const bf16_t*)(p.ws + WS_KP); const bf16_t* VP = (const bf16_t*)(p.ws + WS_VP);
  const bf16_t* KS = (const bf16_t*)(p.ws + WS_KS) + (size_t)j * 4 * 1536 * 256; const bf16_t* VS = (const bf16_t*)(p.ws + WS_VS) + (size_t)j * 4 * 1536 * 256;
  const float scale = 0.08838834764831845f;
  for (int u = blockIdx.x * 8 + wid; u < MTOK * 8; u += gridDim.x * 8) {
    const int m = u >> 3, h = u & 7, kv = h >> 2;
    const bool smp = m >= NPR;
    const int nk = smp ? 1536 : 256;
    const size_t kb = smp ? ((size_t)((m - NPR) >> 10) * 1536) * 256 : ((size_t)(m >> 8) * 256) * 256;
    const bf16_t* Kb = (smp ? KS : KP) + kb + kv * 128; const bf16_t* Vb = (smp ? VS : VP) + kb + kv * 128;
    { const unsigned raw = *(const unsigned*)(Q + (size_t)m * D + h * 128 + 2 * lane); qs[2 * lane] = __uint_as_float(raw << 16); qs[2 * lane + 1] = __uint_as_float(raw & 0xFFFF0000u); }
    float mx = -1e30f;
    for (int k = lane; k < nk; k += 64) {
      const bf16_t* kr = Kb + (size_t)k * 256;
      float acc = 0.f;
      for (int d0 = 0; d0 < 128; d0 += 8) {
        const u32x4 w = *(const u32x4*)(kr + d0);
        acc += qs[d0 + 0] * __uint_as_float(w.x << 16) + qs[d0 + 1] * __uint_as_float(w.x & 0xFFFF0000u)
             + qs[d0 + 2] * __uint_as_float(w.y << 16) + qs[d0 + 3] * __uint_as_float(w.y & 0xFFFF0000u)
             + qs[d0 + 4] * __uint_as_float(w.z << 16) + qs[d0 + 5] * __uint_as_float(w.z & 0xFFFF0000u)
             + qs[d0 + 6] * __uint_as_float(w.w << 16) + qs[d0 + 7] * __uint_as_float(w.w & 0xFFFF0000u);
      }
      acc *= scale; sl[k] = acc; mx = fmaxf(mx, acc);
    }
    mx = wave_max(mx);
    float sum = 0.f;
    for (int k = lane; k < nk; k += 64) { const float e = expf(sl[k] - mx); sl[k] = e; sum += e; }
    sum = wave_sum(sum);
    float a0 = 0.f, a1 = 0.f;
    for (int k = 0; k < nk; ++k) {
      const float pk = sl[k];
      const unsigned raw = *(const unsigned*)(Vb + (size_t)k * 256 + 2 * lane);
      a0 += pk * __uint_as_float(raw << 16); a1 += pk * __uint_as_float(raw & 0xFFFF0000u);
    }
    const float inv = 1.f / sum;
    *(unsigned*)(O + (size_t)m * D + h * 128 + 2 * lane) = pack2(a0 * inv, a1 * inv);
  }
}

__global__ void __launch_bounds__(512, 2) mega(Params p) {
  extern __shared__ __attribute__((aligned(16))) unsigned char lds[];
  cg::grid_group grid = cg::this_grid();
  int ph = 0;
#define RUN(stmt) do { if (ph >= p.ph_lo && ph < p.ph_hi) { stmt; if (ph + 1 < p.ph_hi) grid.sync(); } ++ph; } while (0)
  bf16_t* XN = (bf16_t*)(p.ws + WS_XN); float* Y = (float*)(p.ws + WS_Y); const float* MOD = (const float*)(p.ws + WS_MOD);
  RUN(phase_p0(p, lds));
  RUN(phase_p0b(p));
#pragma unroll 1
  for (int l = 0; l < 4; ++l) {
    const int j = l >> 1;
    RUN(phase_nm(p, l, 0));
    if ((l & 1) == 0) {
      RUN(gemm_run(lds, (const bf16_t*)(p.ws + WS_WIN) + (size_t)j * 3072 * D, XN, 3072, MTOK, D, 1, pg8::EpiBf16{(bf16_t*)(p.ws + WS_ZT), MTOK}));
      RUN(phase_lca(p, j));
      RUN(phase_lcb(p, j));
      RUN(gemm_run(lds, (const bf16_t*)(p.ws + WS_YG), (const bf16_t*)(p.ws + WS_WHO) + (size_t)j * D * D, MTOK, D, D, 2, pg8::EpiGate<true>{Y, MOD + (size_t)l * 5 * 6144 + 2048}));
    } else {
      RUN(gemm_run(lds, XN, (const bf16_t*)(p.ws + WS_WQKV) + (size_t)j * QKVD * D, MTOK, QKVD, D, 1, pg8::EpiBf16{(bf16_t*)(p.ws + WS_QKV), QKVD}));
      RUN(phase_qkvpost(p, j));
      RUN(phase_att_naive(p, j, lds));
      RUN(gemm_run(lds, (const bf16_t*)(p.ws + WS_O), (const bf16_t*)(p.ws + WS_WAO) + (size_t)j * D * D, MTOK, D, D, 2, pg8::EpiGate<true>{Y, MOD + (size_t)l * 5 * 6144 + 2048}));
    }
    RUN(phase_nm(p, l, 1));
    RUN(gemm_run(lds, XN, (const bf16_t*)(p.ws + WS_WGU) + (size_t)l * 2 * DFF * D, MTOK, 2 * DFF, D, 1, pg8::EpiSwiglu{(bf16_t*)(p.ws + WS_H)}));
    RUN(gemm_run(lds, (const bf16_t*)(p.ws + WS_H), (const bf16_t*)(p.ws + WS_WDN) + (size_t)l * D * DFF, MTOK, D, DFF, 2, pg8::EpiGate<true>{Y, MOD + (size_t)l * 5 * 6144 + 5 * 1024}));
  }
  RUN(phase_final(p));
#undef RUN
}
constexpr int N_PHASES = 2 + 4 * 8 + 1;

#ifndef MK_SPLIT
#define MK_SPLIT 0
#endif

extern "C" void kernel_launch(void* const* d_in, const int* in_sizes, int n_in, void* d_out, int out_size, void* d_ws, size_t ws_size, hipStream_t stream) {
  static int grid = 0;
  if (grid == 0) {
    if (n_in != 29 || ws_size < WS_END) { fprintf(stderr, "kernel_launch: n_in %d ws %zu (need 29, >= %zu)\n", n_in, ws_size, (size_t)WS_END); grid = -1; return; }
    int dev = 0, cus = 0, per_cu = 0;
    hipGetDevice(&dev);
    hipDeviceGetAttribute(&cus, hipDeviceAttributeMultiprocessorCount, dev);
    if (hipFuncSetAttribute((const void*)mega, hipFuncAttributeMaxDynamicSharedMemorySize, LDS_BYTES) != hipSuccess) { fprintf(stderr, "kernel_launch: hipFuncSetAttribute failed\n"); grid = -1; return; }
    hipOccupancyMaxActiveBlocksPerMultiprocessor(&per_cu, (const void*)mega, 512, LDS_BYTES);
    if (per_cu < 1) { fprintf(stderr, "kernel_launch: occupancy query says %d blocks per CU\n", per_cu); per_cu = 1; }
    grid = cus * per_cu;
  }
  if (grid < 0) return;
  Params p{};
  for (int i = 0; i < 29; ++i) p.in[i] = (const float*)d_in[i];
  p.out = (float*)d_out; p.ws = (unsigned char*)d_ws;
#if MK_SPLIT
  for (int ph = 0; ph < N_PHASES; ++ph) {
    p.ph_lo = ph; p.ph_hi = ph + 1;
    void* args[] = {&p};
    hipError_t e = hipLaunchCooperativeKernel((const void*)mega, dim3(grid), dim3(512), args, LDS_BYTES, stream);
    if (e != hipSuccess) { fprintf(stderr, "cooperative launch failed: %s (grid %d)\n", hipGetErrorString(e), grid); break; }
  }
#else
  p.ph_lo = 0; p.ph_hi = N_PHASES;
  void* args[] = {&p};
  hipError_t e = hipLaunchCooperativeKernel((const void*)mega, dim3(grid), dim3(512), args, LDS_BYTES, stream);
  if (e != hipSuccess) fprintf(stderr, "cooperative launch failed: %s (grid %d)\n", hipGetErrorString(e), grid);
#endif
}
```

```cpp
#include <hip/hip_runtime.h>
#include <hip/hip_cooperative_groups.h>
#include <cstdio>
#include <cstdint>
namespace cg = cooperative_groups;

typedef unsigned short bf16_t;
typedef short bf16x8 __attribute__((ext_vector_type(8)));
typedef float f32x4 __attribute__((ext_vector_type(4)));
typedef unsigned u32x4 __attribute__((ext_vector_type(4)));

constexpr int D = 1024, MTOK = 8192, NPR = 4096;
constexpr int DFF = 2816, QKVD = 1536;
constexpr float EPS = 1e-6f;
constexpr float MIN_DECAY = -3.0701134573253944f, MAX_DECAY = -15.350567286626972f;

constexpr size_t MiB = 1u << 20;
constexpr size_t WS_MOD = 1 * MiB, WS_MODP = 2 * MiB, WS_FSQP = 6 * MiB, WS_RNORM = 7 * MiB, WS_FILT = 8 * MiB;
constexpr size_t WS_WIN = 28 * MiB, WS_WHO = 40 * MiB, WS_WQKV = 44 * MiB, WS_WAO = 50 * MiB, WS_WGU = 54 * MiB, WS_WDN = 98 * MiB;
constexpr size_t WS_Y = 120 * MiB, WS_XN = 152 * MiB, WS_R = 168 * MiB;
constexpr size_t WS_ZT = WS_R, WS_U = WS_R + 48 * MiB, WS_X0C = WS_R + 64 * MiB, WS_YG = WS_R + 80 * MiB;
constexpr size_t WS_QKV = WS_R, WS_Q = WS_R + 24 * MiB, WS_KP = WS_R + 40 * MiB, WS_VP = WS_R + 42 * MiB, WS_O = WS_R + 44 * MiB;
constexpr size_t WS_H = WS_R;
constexpr size_t WS_KS = WS_R + 96 * MiB, WS_VS = WS_R + 102 * MiB, WS_END = WS_R + 108 * MiB;
constexpr size_t FILT_J = 10 * MiB / 4;
constexpr size_t FILT_L1 = 1024 * 512;

constexpr int LDS_BYTES = 147456;

struct Params {
  const float* in[29];
  float* out;
  unsigned char* ws;
  int ph_lo, ph_hi;
};
enum { I_XP = 0, I_XS, I_CK, I_CV, I_C, I_CCTX, I_MODW, I_MODB, I_NMIX, I_NFFN, I_HWIN, I_HCW, I_HCB, I_FW1, I_FB1, I_FFREQ, I_FW2, I_FB2, I_FW3,
       I_HBIAS, I_HWOUT, I_WQKV, I_QN, I_KN, I_WAO, I_WG, I_WU, I_WD, I_FN };

__device__ __forceinline__ bf16_t f2bf(float f) { unsigned u = __float_as_uint(f); u += 0x7FFFu + ((u >> 16) & 1u); return (bf16_t)(u >> 16); }
__device__ __forceinline__ float bf2f(bf16_t b) { return __uint_as_float(((unsigned)b) << 16); }
__device__ __forceinline__ unsigned pack2(float lo, float hi) { return (unsigned)f2bf(lo) | ((unsigned)f2bf(hi) << 16); }
__device__ __forceinline__ float wave_sum(float v) {
#pragma unroll
  for (int o = 32; o >= 1; o >>= 1) v += __shfl_xor(v, o);
  return v;
}
__device__ __forceinline__ float wave_max(float v) {
#pragma unroll
  for (int o = 32; o >= 1; o >>= 1) v = fmaxf(v, __shfl_xor(v, o));
  return v;
}
__device__ __forceinline__ int tidx() { int t = threadIdx.x; asm volatile("" : "+v"(t)); return t; }
__device__ __forceinline__ int cond_of(int m) { return m < NPR ? 4 : ((m - NPR) >> 10); }
__device__ __forceinline__ float silu_f(float x) { return x / (1.f + expf(-x)); }
__device__ __forceinline__ float sin_rev(float r) { return __builtin_amdgcn_sinf(r - rintf(r)); }
__device__ __forceinline__ float cos_rev(float r) { return __builtin_amdgcn_cosf(r - rintf(r)); }
constexpr float INV_2PI = 0.15915494309189535f;

__device__ __forceinline__ void cvt_tile(const float* __restrict__ src, int K, int N, int kt, int nt, bf16_t* __restrict__ dst, int mode, float* tile  ) {
  const int tid = tidx();
  const int k0 = kt * 64, n0 = nt * 64;
  {
    const int r = tid >> 4, c4 = (tid & 15) * 4;
#pragma unroll
    for (int h = 0; h < 2; ++h) {
      const int rr = r + 32 * h;
      const f32x4 v = *(const f32x4*)(src + (size_t)(k0 + rr) * N + n0 + c4);
      tile[rr * 65 + c4 + 0] = v[0]; tile[rr * 65 + c4 + 1] = v[1]; tile[rr * 65 + c4 + 2] = v[2]; tile[rr * 65 + c4 + 3] = v[3];
    }
  }
  __syncthreads();
  {
    const int n = tid >> 3, kc = (tid & 7) * 8;
    u32x4 w;
    w.x = pack2(tile[(kc + 0) * 65 + n], tile[(kc + 1) * 65 + n]);
    w.y = pack2(tile[(kc + 2) * 65 + n], tile[(kc + 3) * 65 + n]);
    w.z = pack2(tile[(kc + 4) * 65 + n], tile[(kc + 5) * 65 + n]);
    w.w = pack2(tile[(kc + 6) * 65 + n], tile[(kc + 7) * 65 + n]);
    const int ng = n0 + n;
    const int row = mode == 0 ? ng : ((ng >> 7) * 256 + (ng & 127) + (mode == 2 ? 128 : 0));
    *(u32x4*)(dst + (size_t)row * K + k0 + kc) = w;
  }
  __syncthreads();
}

constexpr int NT_FILT = 320, NT_MOD = 384;
constexpr int NT_WIN = 2 * 16 * 48, NT_WHO = 2 * 16 * 16, NT_WQKV = 2 * 16 * 24, NT_WAO = 2 * 16 * 16, NT_G = 4 * 16 * 44, NT_DN = 4 * 44 * 16;
constexpr int NT_CVT = NT_WIN + NT_WHO + NT_WQKV + NT_WAO + 2 * NT_G + NT_DN;

__device__ void task_cvt(const Params& p, int t, float* tile) {
  if (t < NT_WIN) { const int l = t / (16 * 48), r = t % (16 * 48); cvt_tile(p.in[I_HWIN] + (size_t)l * D * 3072, D, 3072, r / 48, r % 48, (bf16_t*)(p.ws + WS_WIN) + (size_t)l * 3072 * D, 0, tile); return; }
  t -= NT_WIN;
  if (t < NT_WHO) { const int l = t / 256, r = t % 256; cvt_tile(p.in[I_HWOUT] + (size_t)l * D * D, D, D, r / 16, r % 16, (bf16_t*)(p.ws + WS_WHO) + (size_t)l * D * D, 0, tile); return; }
  t -= NT_WHO;
  if (t < NT_WQKV) { const int l = t / (16 * 24), r = t % (16 * 24); cvt_tile(p.in[I_WQKV] + (size_t)l * D * QKVD, D, QKVD, r / 24, r % 24, (bf16_t*)(p.ws + WS_WQKV) + (size_t)l * QKVD * D, 0, tile); return; }
  t -= NT_WQKV;
  if (t < NT_WAO) { const int l = t / 256, r = t % 256; cvt_tile(p.in[I_WAO] + (size_t)l * D * D, D, D, r / 16, r % 16, (bf16_t*)(p.ws + WS_WAO) + (size_t)l * D * D, 0, tile); return; }
  t -= NT_WAO;
  if (t < NT_G) { const int l = t / (16 * 44), r = t % (16 * 44); cvt_tile(p.in[I_WG] + (size_t)l * D * DFF, D, DFF, r / 44, r % 44, (bf16_t*)(p.ws + WS_WGU) + (size_t)l * 2 * DFF * D, 1, tile); return; }
  t -= NT_G;
  if (t < NT_G) { const int l = t / (16 * 44), r = t % (16 * 44); cvt_tile(p.in[I_WU] + (size_t)l * D * DFF, D, DFF, r / 44, r % 44, (bf16_t*)(p.ws + WS_WGU) + (size_t)l * 2 * DFF * D, 2, tile); return; }
  t -= NT_G;
  { const int l = t / (44 * 16), r = t % (44 * 16); cvt_tile(p.in[I_WD] + (size_t)l * DFF * D, DFF, D, r / 16, r % 16, (bf16_t*)(p.ws + WS_WDN) + (size_t)l * D * DFF, 0, tile); }
}

__device__ void task_mod(const Params& p, int t, float* sl  ) {
  const int tid = tidx();
  const int l = t / 96, rem = t % 96, cb = rem / 8, kc = rem % 8;
  __syncthreads();
  for (int i = tid; i < 640; i += 512) {
    const int j = i >> 7, k = kc * 128 + (i & 127);
    const float x = j < 4 ? p.in[I_C][j * D + k] : p.in[I_CCTX][k];
    sl[i] = silu_f(x);
  }
  __syncthreads();
  const int n = cb * 512 + tid;
  const float* w = p.in[I_MODW] + ((size_t)l * D + kc * 128) * 6144 + n;
  float a0 = 0.f, a1 = 0.f, a2 = 0.f, a3 = 0.f, a4 = 0.f;
#pragma unroll 4
  for (int k = 0; k < 128; ++k) {
    const float wv = w[(size_t)k * 6144];
    a0 += sl[k] * wv; a1 += sl[128 + k] * wv; a2 += sl[256 + k] * wv; a3 += sl[384 + k] * wv; a4 += sl[512 + k] * wv;
  }
  float* o = (float*)(p.ws + WS_MODP) + ((size_t)(kc * 4 + l) * 5) * 6144 + n;
  o[0] = a0; o[6144] = a1; o[2 * 6144] = a2; o[3 * 6144] = a3; o[4 * 6144] = a4;
}

__device__ void task_filt(const Params& p, int t, float* h1  , float* h2  ) {
  const int tid = tidx(), lane = tid & 63, wid = tid >> 6;
  const int combo = t >> 3, nchunk = t & 7;
  const int j = combo / 20, r = combo % 20;
  const int lsel = r < 4 ? 0 : 1, tchunk = r < 4 ? r : r - 4, L = lsel ? 1024 : 256;
  const int tt = lane, tpos = tchunk * 64 + tt;
  const float tn = (float)tpos / (float)L;
  const float* w1 = p.in[I_FW1] + (size_t)j * 33 * 64;
  const float* b1 = p.in[I_FB1] + j * 64;
  const float* fr = p.in[I_FFREQ] + j * 128;
  const float* w2 = p.in[I_FW2] + (size_t)j * 64 * 64;
  const float* b2 = p.in[I_FB2] + j * 64;
  const float* w3 = p.in[I_FW3] + (size_t)j * 64 * 2048;
  __syncthreads();
  {
    const int u0 = wid * 8;
    float acc[8];
#pragma unroll
    for (int uu = 0; uu < 8; ++uu) acc[uu] = tn * w1[u0 + uu];
    for (int b = 1; b <= 16; ++b) {
      const float rev = tn * (float)b;
      const float cs = cos_rev(rev), sn = sin_rev(rev);
#pragma unroll
      for (int uu = 0; uu < 8; ++uu) acc[uu] += cs * w1[b * 64 + u0 + uu] + sn * w1[(16 + b) * 64 + u0 + uu];
    }
#pragma unroll
    for (int uu = 0; uu < 8; ++uu) h1[tt * 65 + u0 + uu] = sin_rev(INV_2PI * (fr[u0 + uu] * (acc[uu] + b1[u0 + uu])));
  }
  __syncthreads();
  {
    const int u0 = wid * 8;
    float acc[8];
#pragma unroll
    for (int uu = 0; uu < 8; ++uu) acc[uu] = 0.f;
    for (int v = 0; v < 64; ++v) {
      const float hv = h1[tt * 65 + v];
#pragma unroll
      for (int uu = 0; uu < 8; ++uu) acc[uu] += hv * w2[v * 64 + u0 + uu];
    }
#pragma unroll
    for (int uu = 0; uu < 8; ++uu) h2[tt * 65 + u0 + uu] = sin_rev(INV_2PI * (fr[64 + u0 + uu] * (acc[uu] + b2[u0 + uu])));
  }
  __syncthreads();
  float* G2 = (float*)(p.ws + WS_FILT) + (size_t)j * FILT_J + (lsel ? FILT_L1 : 0);
  float* fsq = (float*)(p.ws + WS_FSQP) + ((size_t)((j * 2 + lsel) * 16 + tchunk)) * 2048;
  for (int q = 0; q < 32; ++q) {
    const int n = nchunk * 256 + wid * 32 + q;
    float acc = 0.f;
    for (int v = 0; v < 64; ++v) acc += h2[tt * 65 + v] * w3[v * 2048 + n];
    const int c = n & 1023; const bool isb = n >= 1024;
    const float delta = fabsf(MIN_DECAY + (MAX_DECAY - MIN_DECAY) * ((float)c / 1023.f));
    float val = acc * expf(-tn * delta);
    if (isb && tpos == 0) val = 0.f;
    if (!(isb && tpos == 0)) G2[(size_t)c * (2 * L) + (isb ? (L - tpos) : (L + tpos))] = val;
    const float s = wave_sum(val * val);
    if (lane == 0) fsq[n] = s;
  }
}

__device__ void phase_p0(const Params& p, unsigned char* lds) {
  float* fl = (float*)lds;
  const int G = gridDim.x, b = blockIdx.x, tid = tidx();
  for (int t = b; t < NT_FILT + NT_MOD + NT_CVT; t += G) {
    __syncthreads();
    if (t < NT_FILT) task_filt(p, t, fl, fl + 64 * 65);
    else if (t < NT_FILT + NT_MOD) task_mod(p, t - NT_FILT, fl);
    else task_cvt(p, t - NT_FILT - NT_MOD, fl);
  }
  {
    f32x4* Y = (f32x4*)(p.ws + WS_Y);
    const f32x4* xp = (const f32x4*)p.in[I_XP]; const f32x4* xs = (const f32x4*)p.in[I_XS];
    const int half = NPR * D / 4;
    for (int i = b * 512 + tid; i < 2 * half; i += G * 512) Y[i] = i < half ? xp[i] : xs[i - half];
  }
  {
    bf16_t* KS = (bf16_t*)(p.ws + WS_KS); bf16_t* VS = (bf16_t*)(p.ws + WS_VS);
    const int n = 4 * 2 * 512 * 256;
    for (int i = b * 512 + tid; i < n; i += G * 512) {
      const int e = i & 255, pos = (i >> 8) & 511, j = (i >> 17) & 1, bb = i >> 18;
      const size_t o = ((size_t)(j * 4 + bb) * 1536 + 1024 + pos) * 256 + e;
      KS[o] = f2bf(p.in[I_CK][i]); VS[o] = f2bf(p.in[I_CV][i]);
    }
  }
}

__device__ void phase_p0b(const Params& p) {
  const int G = gridDim.x, b = blockIdx.x, tid = tidx();
  float* MOD = (float*)(p.ws + WS_MOD); const float* MP = (const float*)(p.ws + WS_MODP);
  for (int i = b * 512 + tid; i < 4 * 5 * 6144; i += G * 512) {
    const int n = i % 6144, l = i / (5 * 6144);
    float s = p.in[I_MODB][l * 6144 + n];
#pragma unroll
    for (int kc = 0; kc < 8; ++kc) s += MP[(size_t)kc * (4 * 5 * 6144) + i];
    MOD[i] = s;
  }
  float* RN = (float*)(p.ws + WS_RNORM); const float* FS = (const float*)(p.ws + WS_FSQP);
  for (int i = b * 512 + tid; i < 4096; i += G * 512) {
    const int c = i & 1023, jl = i >> 10, nch = (jl & 1) ? 16 : 4;
    float s = 0.f;
    for (int ch = 0; ch < nch; ++ch) s += FS[((size_t)jl * 16 + ch) * 2048 + c] + FS[((size_t)jl * 16 + ch) * 2048 + 1024 + c];
    RN[i] = 1.f / sqrtf(s + EPS);
  }
}

__device__ void phase_nm(const Params& p, int layer, int which) {
  const int lane = tidx() & 63, wid = tidx() >> 6;
  const float* Y = (const float*)(p.ws + WS_Y); bf16_t* XN = (bf16_t*)(p.ws + WS_XN);
  const float* g = p.in[which ? I_NFFN : I_NMIX] + layer * D;
  for (int m = blockIdx.x * 8 + wid; m < MTOK; m += gridDim.x * 8) {
    const float* y = Y + (size_t)m * D;
    f32x4 v[4]; float ss = 0.f;
#pragma unroll
    for (int i = 0; i < 4; ++i) { v[i] = *(const f32x4*)(y + i * 256 + lane * 4); ss += v[i][0] * v[i][0] + v[i][1] * v[i][1] + v[i][2] * v[i][2] + v[i][3] * v[i][3]; }
    ss = wave_sum(ss);
    const float r = rsqrtf(ss * (1.f / D) + EPS);
    const float* mod = (const float*)(p.ws + WS_MOD) + (size_t)(layer * 5 + cond_of(m)) * 6144 + which * 3072;
#pragma unroll
    for (int i = 0; i < 4; ++i) {
      const int k = i * 256 + lane * 4;
      const f32x4 gg = *(const f32x4*)(g + k), sh = *(const f32x4*)(mod + k), sc = *(const f32x4*)(mod + 1024 + k);
      float o[4];
#pragma unroll
      for (int e = 0; e < 4; ++e) o[e] = (v[i][e] * r * gg[e]) * (1.f + sc[e]) + sh[e];
      uint2 w; w.x = pack2(o[0], o[1]); w.y = pack2(o[2], o[3]);
      *(uint2*)(XN + (size_t)m * D + k) = w;
    }
  }
}

__device__ void phase_final(const Params& p) {
  const int lane = tidx() & 63, wid = tidx() >> 6;
  const float* Y = (const float*)(p.ws + WS_Y);
  const float* g = p.in[I_FN];
  for (int m = blockIdx.x * 8 + wid; m < MTOK; m += gridDim.x * 8) {
    const float* y = Y + (size_t)m * D;
    f32x4 v[4]; float ss = 0.f;
#pragma unroll
    for (int i = 0; i < 4; ++i) { v[i] = *(const f32x4*)(y + i * 256 + lane * 4); ss += v[i][0] * v[i][0] + v[i][1] * v[i][1] + v[i][2] * v[i][2] + v[i][3] * v[i][3]; }
    ss = wave_sum(ss);
    const float r = rsqrtf(ss * (1.f / D) + EPS);
#pragma unroll
    for (int i = 0; i < 4; ++i) {
      const int k = i * 256 + lane * 4;
      const f32x4 gg = *(const f32x4*)(g + k);
      f32x4 o; o[0] = v[i][0] * r * gg[0]; o[1] = v[i][1] * r * gg[1]; o[2] = v[i][2] * r * gg[2]; o[3] = v[i][3] * r * gg[3];
      *(f32x4*)(p.out + (size_t)m * D + k) = o;
    }
  }
}

struct EpiStoreBf16 { bf16_t* C; int ld; __device__ __forceinline__ void operator()(int m, int n, float v) const { C[(size_t)m * ld + n] = f2bf(v); } };
struct EpiGateRes { float* Y; const float* gate; __device__ __forceinline__ void operator()(int m, int n, float v) const { Y[(size_t)m * D + n] += gate[cond_of(m) * 6144 + n] * v; } };

template <bool SWIGLU, class Epi>
__device__ __forceinline__ void gemm_naive(const bf16_t* __restrict__ A, const bf16_t* __restrict__ Bt, int M, int N, int K, const Epi& epi, bf16_t* Hout) {
  const int lane = tidx() & 63, wid = tidx() >> 6, r16 = lane & 15, kg = lane >> 4;
  const int tilesN = SWIGLU ? N / 32 : N / 64, total = (M / 64) * tilesN;
  for (int tile = blockIdx.x * 8 + wid; tile < total; tile += gridDim.x * 8) {
    const int tm = tile / tilesN, tn = tile % tilesN, m0 = tm * 64;
    f32x4 acc[4][4];
#pragma unroll
    for (int i = 0; i < 4; ++i)
#pragma unroll
      for (int f = 0; f < 4; ++f) acc[i][f] = (f32x4){0.f, 0.f, 0.f, 0.f};
    const bf16_t* ap = A + (size_t)(m0 + r16) * K + kg * 8;
    int brow[4];
#pragma unroll
    for (int f = 0; f < 4; ++f) {
      if (SWIGLU) { const int hc = tn * 32 + 16 * (f & 1) + r16; brow[f] = (hc >> 7) * 256 + (hc & 127) + 128 * (f >> 1); }
      else brow[f] = tn * 64 + 16 * f + r16;
    }
    const bf16_t* bp0 = Bt + (size_t)brow[0] * K + kg * 8; const bf16_t* bp1 = Bt + (size_t)brow[1] * K + kg * 8;
    const bf16_t* bp2 = Bt + (size_t)brow[2] * K + kg * 8; const bf16_t* bp3 = Bt + (size_t)brow[3] * K + kg * 8;
    for (int k0 = 0; k0 < K; k0 += 32) {
      bf16x8 a[4], b[4];
#pragma unroll
      for (int i = 0; i < 4; ++i) a[i] = *(const bf16x8*)(ap + (size_t)(16 * i) * K + k0);
      b[0] = *(const bf16x8*)(bp0 + k0); b[1] = *(const bf16x8*)(bp1 + k0); b[2] = *(const bf16x8*)(bp2 + k0); b[3] = *(const bf16x8*)(bp3 + k0);
#pragma unroll
      for (int i = 0; i < 4; ++i)
#pragma unroll
        for (int f = 0; f < 4; ++f) acc[i][f] = __builtin_amdgcn_mfma_f32_16x16x32_bf16(a[i], b[f], acc[i][f], 0, 0, 0);
    }
    if (SWIGLU) {
#pragma unroll
      for (int i = 0; i < 4; ++i)
#pragma unroll
        for (int f = 0; f < 2; ++f)
#pragma unroll
          for (int e = 0; e < 4; ++e) {
            const int m = m0 + 16 * i + 4 * kg + e, hc = tn * 32 + 16 * f + r16;
            const float gv = acc[i][f][e], uv = acc[i][f + 2][e];
            Hout[(size_t)m * DFF + hc] = f2bf(silu_f(gv) * uv);
          }
    } else {
#pragma unroll
      for (int i = 0; i < 4; ++i)
#pragma unroll
        for (int f = 0; f < 4; ++f)
#pragma unroll
          for (int e = 0; e < 4; ++e) epi(m0 + 16 * i + 4 * kg + e, tn * 64 + 16 * f + r16, acc[i][f][e]);
    }
  }
}


namespace pg8 {
#define PG8_LAS __attribute__((address_space(3)))
constexpr int BM = 256, BK = 64, HALF = 128, HTB = HALF * BK * 2, STAGE_BYTES = 8 * HTB, NXCD = 8, WGM = 8;
__host__ __device__ __forceinline__ int lds_byte(int r, int c) { const int st = (r >> 4) * 2 + (c >> 5), rr = r & 15, cc = c & 31, ob = rr * 64 + cc * 2; return st * 1024 + (ob ^ (((ob >> 9) & 1) << 5)); }
__host__ __device__ __forceinline__ void stage_rc(int b, int& R, int& C) { const int st = b / 1024, sb = b % 1024, swz = sb ^ (((sb >> 9) & 1) << 5); R = (st >> 1) * 16 + swz / 64; C = (st & 1) * 32 + (swz % 64) / 2; }
__host__ __device__ __forceinline__ int perm32(int rho) { const int n = rho >> 4, i = rho & 15; return 8 * (i >> 2) + 4 * n + (i & 3); }
struct Unit { int pm, pn, ks; };
struct Gemm { const bf16_t* A; const bf16_t* Bt; int M, N, K, ld; };
struct StaticOrder {
    int nM, nN, nwg, G, c, KS;
    __device__ void init(int M, int N, int KS_, int G_, int c_) { nM = M / BM; KS = KS_; nN = (N / BM) * KS_; nwg = nM * nN; G = G_; c = c_; }
    __device__ bool next(int i, Unit& u) const {
        const long L = (long)i * G + c; if (L >= nwg) return false;
        int wgid = (int)L; { const int q = nwg / NXCD, r = nwg % NXCD, xcd = wgid % NXCD, off = wgid / NXCD; wgid = (xcd < r ? xcd * (q + 1) : r * (q + 1) + (xcd - r) * q) + off; }
        const int nig = WGM * nN, gid = wgid / nig, fm = gid * WGM, gsz = (nM - fm) < WGM ? (nM - fm) : WGM;
        u.pm = fm + ((wgid % nig) % gsz); const int pn2 = (wgid % nig) / gsz; u.pn = pn2 / KS; u.ks = pn2 % KS; return true;
    }
    __device__ __forceinline__ void a_ready(const Unit&) const {}
    __device__ __forceinline__ void done(const Unit&) const {}
};
__device__ __forceinline__ unsigned cvt_pk_bf16(float lo, float hi) { unsigned r; asm volatile("v_cvt_pk_bf16_f32 %0, %1, %2" : "=v"(r) : "v"(lo), "v"(hi)); return r; }
struct EpiBf16 {
    static constexpr bool PERM = true, AFTER_DRAIN = false;
    bf16_t* O; int ldc;
    __device__ __forceinline__ void operator()(const f32x4 (&acc)[2][2][4][2], const Unit& u, int wr, int wc, int fr, int fq) const {
        const int row0 = u.pm * BM + wr * 64 + fr, col0 = u.pn * BM + wc * 32 + 8 * fq;
#pragma unroll
        for (int ai = 0; ai < 2; ++ai)
#pragma unroll
            for (int m = 0; m < 4; ++m) { bf16_t* rowp = O + (size_t)(row0 + ai * HALF + m * 16) * ldc + col0;
#pragma unroll
                for (int bj = 0; bj < 2; ++bj) { const f32x4 v0 = acc[ai][bj][m][0], v1 = acc[ai][bj][m][1];
                    u32x4 w; w.x = cvt_pk_bf16(v0[0], v0[1]); w.y = cvt_pk_bf16(v0[2], v0[3]); w.z = cvt_pk_bf16(v1[0], v1[1]); w.w = cvt_pk_bf16(v1[2], v1[3]);
                    *(u32x4*)(rowp + bj * HALF) = w; } }
    }
};
struct EpiSwiglu {
    static constexpr bool PERM = true, AFTER_DRAIN = false;
    bf16_t* H;
    __device__ __forceinline__ void operator()(const f32x4 (&acc)[2][2][4][2], const Unit& u, int wr, int wc, int fr, int fq) const {
        const int row0 = u.pm * BM + wr * 64 + fr, col0 = u.pn * HALF + wc * 32 + 8 * fq;
#pragma unroll
        for (int ai = 0; ai < 2; ++ai)
#pragma unroll
            for (int m = 0; m < 4; ++m) {
                float h[8];
#pragma unroll
                for (int n = 0; n < 2; ++n)
#pragma unroll
                    for (int e = 0; e < 4; ++e) { const float gv = acc[ai][0][m][n][e], uv = acc[ai][1][m][n][e]; h[4 * n + e] = gv * __builtin_amdgcn_rcpf(1.f + __expf(-gv)) * uv; }
                u32x4 w; w.x = cvt_pk_bf16(h[0], h[1]); w.y = cvt_pk_bf16(h[2], h[3]); w.z = cvt_pk_bf16(h[4], h[5]); w.w = cvt_pk_bf16(h[6], h[7]);
                *(u32x4*)(H + (size_t)(row0 + ai * HALF + m * 16) * DFF + col0) = w; }
    }
};
template <bool ATOMIC> struct EpiGate {
    static constexpr bool PERM = false, AFTER_DRAIN = false;
    float* Y; const float* gate;
    __device__ __forceinline__ void operator()(const f32x4 (&acc)[2][2][4][2], const Unit& u, int wr, int wc, int fr, int fq) const {
        const int row0 = u.pm * BM + wr * 64 + fr, col0 = u.pn * BM + wc * 32 + 4 * fq;
#pragma unroll
        for (int ai = 0; ai < 2; ++ai)
#pragma unroll
            for (int m = 0; m < 4; ++m) { const int row = row0 + ai * HALF + m * 16; const float* gp = gate + cond_of(row) * 6144 + col0; float* yp = Y + (size_t)row * D + col0;
#pragma unroll
                for (int bj = 0; bj < 2; ++bj)
#pragma unroll
                    for (int n = 0; n < 2; ++n) { const int o = bj * HALF + n * 16; const f32x4 gv = *(const f32x4*)(gp + o); const f32x4 v = acc[ai][bj][m][n] * gv;
                        if (ATOMIC) { unsafeAtomicAdd(yp + o, v[0]); unsafeAtomicAdd(yp + o + 1, v[1]); unsafeAtomicAdd(yp + o + 2, v[2]); unsafeAtomicAdd(yp + o + 3, v[3]); }
                        else { *(f32x4*)(yp + o) = *(const f32x4*)(yp + o) + v; } } }
    }
};
template <class Epi, class Sched, bool ALIGN_EPI = false, bool SP2 = false>
__device__ __forceinline__ void gemm_phase(PG8_LAS unsigned char* lds, const Gemm g, const Sched& S, const Epi& E) {
    int tid_ = tidx();
    const int tid = tid_, wid = __builtin_amdgcn_readfirstlane(tid >> 6), lane = tid & 63, wr = wid >> 2, wc = wid & 3, fr = lane & 15, fq = lane >> 4;
    const int K = g.ld, nt = g.K / BK;
    unsigned voffA[2], voffB[2];
#pragma unroll
    for (int i = 0; i < 2; ++i) { int R, C; stage_rc(tid * 16 + i * 8192, R, C); const int Rb = Epi::PERM ? ((R & ~31) + perm32(R & 31)) : R;
        voffA[i] = (unsigned)(R * K + C) * 2u; voffB[i] = (unsigned)(Rb * K + C) * 2u; }
    const size_t kstep = (size_t)(BK * 2);
    const size_t hstep = (size_t)HALF * K * 2;
    const size_t tstep = 2 * hstep;
    const unsigned ldsw = (unsigned)wid * 1024u;
    const int aoff = lds_byte(wr * 64 + fr, fq * 8), boff = lds_byte(wc * 32 + fr, fq * 8);
#define PG8_SA(b, h) (((b) * 2 + (h)) * HTB)
#define PG8_SB(b, h) ((4 + (b) * 2 + (h)) * HTB)
#define PG8_STAGE(bufoff, gbase, voff) do { _Pragma("unroll") for (int _i = 0; _i < 2; ++_i) \
        __builtin_amdgcn_global_load_lds((const unsigned*)((const char*)(gbase) + (voff)[_i]), (PG8_LAS unsigned*)(lds + (bufoff) + ldsw + _i * 8192), 16, 0, 0); } while (0)
#define PG8_LDA(dst, b, h) do { _Pragma("unroll") for (int m = 0; m < 4; ++m) _Pragma("unroll") for (int k = 0; k < 2; ++k) dst[m][k] = *(const PG8_LAS bf16x8*)(lds + PG8_SA(b, h) + aoff + m * 2048 + k * 1024); } while (0)
#define PG8_LDB(dst, b, h) do { _Pragma("unroll") for (int n = 0; n < 2; ++n) _Pragma("unroll") for (int k = 0; k < 2; ++k) dst[n][k] = *(const PG8_LAS bf16x8*)(lds + PG8_SB(b, h) + boff + n * 2048 + k * 1024); } while (0)
#define PG8_MMA(ai, bj, At, Bt) do { __builtin_amdgcn_s_setprio(1); _Pragma("unroll") for (int m = 0; m < 4; ++m) _Pragma("unroll") for (int n = 0; n < 2; ++n) _Pragma("unroll") for (int k = 0; k < 2; ++k) \
        acc[ai][bj][m][n] = __builtin_amdgcn_mfma_f32_16x16x32_bf16(Bt[n][k], At[m][k], acc[ai][bj][m][n], 0, 0, 0); __builtin_amdgcn_s_setprio(0); } while (0)
#define PG8_WAIT_V(n) asm volatile("s_waitcnt vmcnt(" #n ")" ::: "memory")
#define PG8_WAIT_L(n) asm volatile("s_waitcnt lgkmcnt(" #n ")" ::: "memory")
#define PG8_BAR __builtin_amdgcn_s_barrier()
#define PG8_SCHED __builtin_amdgcn_sched_barrier(0)
    Unit cur, nxt; int ui = 0;
    if (!S.next(0, cur)) return;
    f32x4 acc[2][2][4][2];
#pragma unroll
    for (int a = 0; a < 2; ++a)
#pragma unroll
        for (int b = 0; b < 2; ++b)
#pragma unroll
            for (int m = 0; m < 4; ++m)
#pragma unroll
                for (int n = 0; n < 2; ++n) acc[a][b][m][n] = (f32x4){0.f, 0.f, 0.f, 0.f};
    bf16x8 At[4][2], B0[2][2], B1[2][2];
    const size_t ksb = (size_t)g.K * 2; const char* cA = (const char*)g.A + (size_t)cur.pm * tstep + cur.ks * ksb; const char* cB = (const char*)g.Bt + (size_t)cur.pn * tstep + cur.ks * ksb;
    S.a_ready(cur);
    if constexpr (SP2) {
        PG8_STAGE(PG8_SB(0, 0), cB, voffB); PG8_STAGE(PG8_SB(0, 1), cB + hstep, voffB); PG8_STAGE(PG8_SA(0, 0), cA, voffA); PG8_STAGE(PG8_SA(0, 1), cA + hstep, voffA);
        if (wr == 1) PG8_BAR;
        PG8_WAIT_V(2); PG8_BAR;
        PG8_STAGE(PG8_SB(1, 0), cB + kstep, voffB); PG8_STAGE(PG8_SA(1, 0), cA + kstep, voffA); PG8_STAGE(PG8_SB(1, 1), cB + hstep + kstep, voffB);
        PG8_WAIT_V(6); PG8_BAR;
    } else {
        PG8_STAGE(PG8_SB(0, 0), cB, voffB); PG8_STAGE(PG8_SA(0, 0), cA, voffA); PG8_STAGE(PG8_SB(0, 1), cB + hstep, voffB); PG8_STAGE(PG8_SA(0, 1), cA + hstep, voffA);
        if (wr == 1) PG8_BAR;
        PG8_WAIT_V(4); PG8_BAR;
        PG8_STAGE(PG8_SB(1, 0), cB + kstep, voffB); PG8_STAGE(PG8_SA(1, 0), cA + kstep, voffA); PG8_STAGE(PG8_SB(1, 1), cB + hstep + kstep, voffB);
        PG8_WAIT_V(6); PG8_BAR;
    }
    for (;;) {
        const bool has_next = S.next(ui + 1, nxt);
        const char* nA = has_next ? (const char*)g.A + (size_t)nxt.pm * tstep + nxt.ks * ksb : cA; const char* nB = has_next ? (const char*)g.Bt + (size_t)nxt.pn * tstep + nxt.ks * ksb : cB;
        for (int t = 0; t < nt; t += 2) {
            const bool last = (t == nt - 2);
            const char* a1 = cA + (size_t)(t + 1) * kstep;
            const char* a2 = last ? nA : cA + (size_t)(t + 2) * kstep; const char* b2 = last ? nB : cB + (size_t)(t + 2) * kstep;
            const char* a3 = a2 + kstep; const char* b3 = b2 + kstep;
            if (last && has_next) S.a_ready(nxt);
            if constexpr (SP2) {
            PG8_LDB(B0, 0, 0); PG8_LDB(B1, 0, 1); PG8_SCHED; PG8_LDA(At, 0, 0); PG8_STAGE(PG8_SA(1, 1), a1 + hstep, voffA);
            PG8_WAIT_V(8); PG8_WAIT_L(0); PG8_BAR; PG8_MMA(0, 0, At, B0); PG8_MMA(0, 1, At, B1); PG8_BAR; PG8_SCHED;
            PG8_LDA(At, 0, 1); PG8_STAGE(PG8_SB(0, 0), b2, voffB); PG8_STAGE(PG8_SB(0, 1), b2 + hstep, voffB); PG8_STAGE(PG8_SA(0, 0), a2, voffA);
            PG8_WAIT_V(8); PG8_WAIT_L(0); PG8_BAR; PG8_MMA(1, 0, At, B0); PG8_MMA(1, 1, At, B1); PG8_BAR; PG8_SCHED;
            PG8_LDB(B0, 1, 0); PG8_LDB(B1, 1, 1); PG8_SCHED; PG8_LDA(At, 1, 0); PG8_STAGE(PG8_SA(0, 1), a2 + hstep, voffA);
            PG8_WAIT_V(8); PG8_WAIT_L(0); PG8_BAR; PG8_MMA(0, 0, At, B0); PG8_MMA(0, 1, At, B1); PG8_BAR; PG8_SCHED;
            PG8_LDA(At, 1, 1); PG8_STAGE(PG8_SB(1, 0), b3, voffB); PG8_STAGE(PG8_SB(1, 1), b3 + hstep, voffB); PG8_STAGE(PG8_SA(1, 0), a3, voffA);
            PG8_WAIT_V(8); PG8_WAIT_L(0); PG8_BAR; PG8_MMA(1, 0, At, B0); PG8_MMA(1, 1, At, B1); PG8_BAR; PG8_SCHED;
            } else {
            PG8_LDB(B0, 0, 0); PG8_SCHED; PG8_LDA(At, 0, 0); PG8_STAGE(PG8_SA(1, 1), a1 + hstep, voffA);
            PG8_WAIT_L(8); PG8_BAR; PG8_WAIT_L(0); PG8_MMA(0, 0, At, B0); PG8_BAR; PG8_SCHED;
            PG8_LDB(B1, 0, 1); PG8_STAGE(PG8_SB(0, 0), b2, voffB);
            PG8_BAR; PG8_WAIT_L(0); PG8_MMA(0, 1, At, B1); PG8_BAR;
            PG8_LDA(At, 0, 1); PG8_STAGE(PG8_SA(0, 0), a2, voffA);
            PG8_BAR; PG8_WAIT_L(0); PG8_MMA(1, 0, At, B0); PG8_BAR; PG8_SCHED;
            PG8_STAGE(PG8_SB(0, 1), b2 + hstep, voffB);
            PG8_WAIT_V(6); PG8_BAR; PG8_MMA(1, 1, At, B1); PG8_BAR;
            PG8_LDB(B0, 1, 0); PG8_SCHED; PG8_LDA(At, 1, 0); PG8_STAGE(PG8_SA(0, 1), a2 + hstep, voffA);
            PG8_WAIT_L(8); PG8_BAR; PG8_WAIT_L(0); PG8_MMA(0, 0, At, B0); PG8_BAR; PG8_SCHED;
            PG8_LDB(B1, 1, 1); PG8_STAGE(PG8_SB(1, 0), b3, voffB);
            PG8_BAR; PG8_WAIT_L(0); PG8_MMA(0, 1, At, B1); PG8_BAR;
            PG8_LDA(At, 1, 1); PG8_STAGE(PG8_SA(1, 0), a3, voffA);
            PG8_BAR; PG8_WAIT_L(0); PG8_MMA(1, 0, At, B0); PG8_BAR; PG8_SCHED;
            PG8_STAGE(PG8_SB(1, 1), b3 + hstep, voffB);
            PG8_WAIT_V(6); PG8_BAR; PG8_MMA(1, 1, At, B1); PG8_BAR;
            }
        }
        if constexpr (ALIGN_EPI) { if (wr == 0) PG8_BAR; }
        if constexpr (!Epi::AFTER_DRAIN) { E(acc, cur, wr, wc, fr, fq); S.done(cur); }
        if (!has_next) break;
#pragma unroll
        for (int a = 0; a < 2; ++a)
#pragma unroll
            for (int b = 0; b < 2; ++b)
#pragma unroll
                for (int m = 0; m < 4; ++m)
#pragma unroll
                    for (int n = 0; n < 2; ++n) acc[a][b][m][n] = (f32x4){0.f, 0.f, 0.f, 0.f};
        cur = nxt; cA = nA; cB = nB; ++ui;
        if constexpr (ALIGN_EPI) { if (wr == 1) PG8_BAR; }
    }
    PG8_WAIT_V(0);
    if constexpr (!ALIGN_EPI) { if (wr == 0) PG8_BAR; }
    PG8_BAR;
    if constexpr (Epi::AFTER_DRAIN) { E.fused(acc, cur, wr, wc, fr, fq, lds, wid, lane); S.done(cur); }
#undef PG8_SA
#undef PG8_SB
#undef PG8_STAGE
#undef PG8_LDA
#undef PG8_LDB
#undef PG8_MMA
#undef PG8_WAIT_V
#undef PG8_WAIT_L
#undef PG8_BAR
#undef PG8_SCHED
}
}

template <class Epi>
__device__ __forceinline__ void gemm_run(unsigned char* lds, const bf16_t* A, const bf16_t* Bt, int M, int N, int Ktot, int KS, const Epi& E) {
    pg8::StaticOrder S; S.init(M, N, KS, (int)gridDim.x, (int)blockIdx.x);
    pg8::Gemm g; g.A = A; g.Bt = Bt; g.M = M; g.N = N; g.K = Ktot / KS; g.ld = Ktot;
    __syncthreads();
    pg8::gemm_phase<Epi, pg8::StaticOrder, true, true>((PG8_LAS unsigned char*)lds, g, S, E);
    __syncthreads();
}

__device__ void phase_lca(const Params& p, int j) {
  const bf16_t* ZT = (const bf16_t*)(p.ws + WS_ZT); bf16_t* U = (bf16_t*)(p.ws + WS_U); bf16_t* X0 = (bf16_t*)(p.ws + WS_X0C);
  const float* cw = p.in[I_HCW] + (size_t)j * 3 * 3072; const float* cb = p.in[I_HCB] + (size_t)j * 3072;
  for (int i = blockIdx.x * 512 + tidx(); i < D * MTOK; i += gridDim.x * 512) {
    const int c = i >> 13, m = i & 8191;
    const int L = m < NPR ? 256 : 1024, t = m & (L - 1);
    float sc[3];
#pragma unroll
    for (int part = 0; part < 3; ++part) {
      const int ch = part * 1024 + c;
      const bf16_t* z = ZT + (size_t)ch * MTOK + m;
      const float zm = t > 0 ? bf2f(z[-1]) : 0.f, z0 = bf2f(z[0]), zp = t < L - 1 ? bf2f(z[1]) : 0.f;
      sc[part] = zm * cw[ch] + z0 * cw[3072 + ch] + zp * cw[2 * 3072 + ch] + cb[ch];
    }
    X0[i] = f2bf(sc[0]); U[i] = f2bf(sc[1] * sc[2]);
  }
}
__device__ void phase_lcb(const Params& p, int j) {
  const bf16_t* U = (const bf16_t*)(p.ws + WS_U); const bf16_t* X0 = (const bf16_t*)(p.ws + WS_X0C); bf16_t* YG = (bf16_t*)(p.ws + WS_YG);
  const float* RN = (const float*)(p.ws + WS_RNORM); const float* bias = p.in[I_HBIAS] + j * D;
  for (int i = blockIdx.x * 512 + tidx(); i < D * MTOK; i += gridDim.x * 512) {
    const int c = i >> 13, m = i & 8191;
    const int lsel = m < NPR ? 0 : 1, L = lsel ? 1024 : 256, t = m & (L - 1);
    const float* g2 = (const float*)(p.ws + WS_FILT) + (size_t)j * FILT_J + (lsel ? FILT_L1 : 0) + (size_t)c * (2 * L) + L + t;
    const bf16_t* u = U + (size_t)c * MTOK + (m - t);
    float acc = 0.f;
    for (int s = 0; s < L; ++s) acc += g2[-s] * bf2f(u[s]);
    const float uu = bf2f(u[t]);
    const float y = acc * RN[(j * 2 + lsel) * 1024 + c] + uu * bias[c];
    YG[(size_t)m * D + c] = f2bf(bf2f(X0[i]) * y);
  }
}

__device__ void phase_qkvpost(const Params& p, int j) {
  const int lane = tidx() & 63, wid = tidx() >> 6;
  const unsigned* QKV = (const unsigned*)(p.ws + WS_QKV);
  unsigned* Q = (unsigned*)(p.ws + WS_Q); unsigned* KP = (unsigned*)(p.ws + WS_KP); unsigned* VP = (unsigned*)(p.ws + WS_VP);
  unsigned* KS = (unsigned*)(p.ws + WS_KS) + (size_t)j * 4 * 1536 * 128; unsigned* VS = (unsigned*)(p.ws + WS_VS) + (size_t)j * 4 * 1536 * 128;
  const float* qn = p.in[I_QN] + j * 128; const float* kn = p.in[I_KN] + j * 128;
  float* newk = p.out + (size_t)2 * NPR * D; float* newv = newk + (size_t)16 * 2 * 256 * 256;
  const float qg0 = qn[2 * lane], qg1 = qn[2 * lane + 1], kg0 = kn[2 * lane], kg1 = kn[2 * lane + 1];
  const float freq = exp2f(-(float)(lane & 31) * 0.41524101186092029f);
  for (int m = blockIdx.x * 8 + wid; m < MTOK; m += gridDim.x * 8) {
    const bool smp = m >= NPR;
    float cs = 1.f, sn = 0.f;
    if (smp) { const int t = (m - NPR) & 1023; const float pos = (float)(lane < 32 ? (t >> 6) : (t & 63)); const float rev = (pos * freq) * INV_2PI; cs = cos_rev(rev); sn = sin_rev(rev); }
    for (int s = 0; s < 12; ++s) {
      const unsigned raw = QKV[(size_t)m * 768 + s * 64 + lane];
      float x0 = __uint_as_float(raw << 16), x1 = __uint_as_float(raw & 0xFFFF0000u);
      if (s < 10) {
        const float ss = wave_sum(x0 * x0 + x1 * x1);
        const float r = rsqrtf(ss * (1.f / 128.f) + EPS);
        x0 = x0 * r * (s < 8 ? qg0 : kg0); x1 = x1 * r * (s < 8 ? qg1 : kg1);
        if (smp) { const float a = x0, b = x1; x0 = a * cs - b * sn; x1 = a * sn + b * cs; }
      }
      const unsigned w = pack2(x0, x1);
      if (s < 8) Q[(size_t)m * 512 + s * 64 + lane] = w;
      else {
        const int kv = (s - 8) & 1; const bool isk = s < 10;
        if (!smp) {
          (isk ? KP : VP)[(size_t)m * 128 + kv * 64 + lane] = w;
          const int b = m >> 8, t = m & 255;
          float* o = (isk ? newk : newv) + ((((size_t)b * 2 + j) * 256 + t) * 2 + kv) * 128 + 2 * lane;
          o[0] = x0; o[1] = x1;
        } else {
          const int b = (m - NPR) >> 10, t = (m - NPR) & 1023;
          (isk ? KS : VS)[((size_t)b * 1536 + t) * 128 + kv * 64 + lane] = w;
        }
      }
    }
  }
}

__device__ void phase_att_naive(const Params& p, int j, unsigned char* lds) {
  const int lane = tidx() & 63, wid = tidx() >> 6;
  float* qs = (float*)lds + wid * 1664; float* sl = qs + 128;
  const bf16_t* Q = (const bf16_t*)(p.ws + WS_Q); bf16_t* O = (bf16_t*)(p.ws + WS_O);
  const bf16_t* KP = (const bf16_t*)(p.ws + WS_KP); const bf16_t* VP = (const bf16_t*)(p.ws + WS_VP);
  const bf16_t* KS = (const bf16_t*)(p.ws + WS_KS) + (size_t)j * 4 * 1536 * 256; const bf16_t* VS = (const bf16_t*)(p.ws + WS_VS) + (size_t)j * 4 * 1536 * 256;
  const float scale = 0.08838834764831845f;
  for (int u = blockIdx.x * 8 + wid; u < MTOK * 8; u += gridDim.x * 8) {
    const int m = u >> 3, h = u & 7, kv = h >> 2;
    const bool smp = m >= NPR;
    const int nk = smp ? 1536 : 256;
    const size_t kb = smp ? ((size_t)((m - NPR) >> 10) * 1536) * 256 : ((size_t)(m >> 8) * 256) * 256;
    const bf16_t* Kb = (smp ? KS : KP) + kb + kv * 128; const bf16_t* Vb = (smp ? VS : VP) + kb + kv * 128;
    { const unsigned raw = *(const unsigned*)(Q + (size_t)m * D + h * 128 + 2 * lane); qs[2 * lane] = __uint_as_float(raw << 16); qs[2 * lane + 1] = __uint_as_float(raw & 0xFFFF0000u); }
    float mx = -1e30f;
    for (int k = lane; k < nk; k += 64) {
      const bf16_t* kr = Kb + (size_t)k * 256;
      float acc = 0.f;
      for (int d0 = 0; d0 < 128; d0 += 8) {
        const u32x4 w = *(const u32x4*)(kr + d0);
        acc += qs[d0 + 0] * __uint_as_float(w.x << 16) + qs[d0 + 1] * __uint_as_float(w.x & 0xFFFF0000u)
             + qs[d0 + 2] * __uint_as_float(w.y << 16) + qs[d0 + 3] * __uint_as_float(w.y & 0xFFFF0000u)
             + qs[d0 + 4] * __uint_as_float(w.z << 16) + qs[d0 + 5] * __uint_as_float(w.z & 0xFFFF0000u)
             + qs[d0 + 6] * __uint_as_float(w.w << 16) + qs[d0 + 7] * __uint_as_float(w.w & 0xFFFF0000u);
      }
      acc *= scale; sl[k] = acc; mx = fmaxf(mx, acc);
    }
    mx = wave_max(mx);
    float sum = 0.f;
    for (int k = lane; k < nk; k += 64) { const float e = expf(sl[k] - mx); sl[k] = e; sum += e; }
    sum = wave_sum(sum);
    float a0 = 0.f, a1 = 0.f;
    for (int k = 0; k < nk; ++k) {
      const float pk = sl[k];
      const unsigned raw = *(const unsigned*)(Vb + (size_t)k * 256 + 2 * lane);
      a0 += pk * __uint_as_float(raw << 16); a1 += pk * __uint_as_float(raw & 0xFFFF0000u);
    }
    const float inv = 1.f / sum;
    *(unsigned*)(O + (size_t)m * D + h * 128 + 2 * lane) = pack2(a0 * inv, a1 * inv);
  }
}


namespace att {
typedef unsigned short bf16;
constexpr int   D = 128, NW = 8, QBLK = 32, KVBLK = 64;
constexpr float SCALE = 0.088388347648318440f;
constexpr float THR = 8.f;
constexpr int SDEPTH = 2;
constexpr int LDQ = 1024, LDK = 256, LDO = 1024;
constexpr size_t SHM_V = KVBLK * D * 2, SHM_K = KVBLK * D * 2, SHM_ATTN = 2 * SHM_V + 2 * SHM_K + NW * 64 * 4;

using s16x4  = __attribute__((ext_vector_type(4))) short;
using f32x16 = __attribute__((ext_vector_type(16))) float;
using f32x8  = __attribute__((ext_vector_type(8))) float;

#define KSWZ(row, colB) ((row) * 256 + ((colB) ^ (((row) & 7) << 4)))
#define SBAR() __builtin_amdgcn_sched_barrier(0)
__device__ __forceinline__ int crow(int r, int hi) { return (r & 3) + 8 * (r >> 2) + 4 * hi; }
__device__ __forceinline__ unsigned cvtpk(float lo, float hi) {
  unsigned r; asm volatile("v_cvt_pk_bf16_f32 %0, %1, %2" : "=v"(r) : "v"(lo), "v"(hi)); return r;
}
template <typename TIn> struct Stage;
template <> struct Stage<bf16>  { using T = bf16x8;
  __device__ static __forceinline__ T ld8(const bf16* p) { return *reinterpret_cast<const bf16x8*>(p); }
  __device__ static __forceinline__ bf16x8 tobf(T x) { return x; } };
template <> struct Stage<float> { using T = f32x8;
  __device__ static __forceinline__ T ld8(const float* p) { return *reinterpret_cast<const f32x8*>(p); }
  __device__ static __forceinline__ bf16x8 tobf(T x) {
    u32x4 w = {cvtpk(x[0], x[1]), cvtpk(x[2], x[3]), cvtpk(x[4], x[5]), cvtpk(x[6], x[7])}; return *reinterpret_cast<bf16x8*>(&w); } };

__device__ __forceinline__ void partialSM(f32x16& p0, f32x16& p1, float& m_reg, float& mn, float& alpha) {
  constexpr float C = SCALE * 1.4426950408889634f;
  float pmax = p0[0]; for (int r = 1; r < 16; ++r) pmax = fmaxf(pmax, p0[r]); for (int r = 0; r < 16; ++r) pmax = fmaxf(pmax, p1[r]);
  { auto rr = __builtin_amdgcn_permlane32_swap(__float_as_uint(pmax), __float_as_uint(pmax), false, false);
    pmax = fmaxf(__uint_as_float(rr[0]), __uint_as_float(rr[1])); }
  if (__builtin_expect(__all(pmax - m_reg <= THR / SCALE), 1)) { mn = m_reg; alpha = 1.f; }
  else { mn = fmaxf(m_reg, pmax); alpha = __builtin_amdgcn_exp2f((m_reg - mn) * C); m_reg = mn; }
  float mnC = -mn * C;
  for (int r = 0; r < 16; ++r) p0[r] = fmaf(p0[r], C, mnC); for (int r = 0; r < 16; ++r) p1[r] = fmaf(p1[r], C, mnC);
  for (int r = 0; r < 16; ++r) p0[r] = __builtin_amdgcn_exp2f(p0[r]);
}
__device__ __forceinline__ void finishSM(f32x16& p0, f32x16& p1, float alpha, float& l_reg, bf16x8& pa0, bf16x8& pa1, bf16x8& pa2, bf16x8& pa3) {
  for (int r = 0; r < 16; ++r) p1[r] = __builtin_amdgcn_exp2f(p1[r]);
  float ps = 0; for (int r = 0; r < 16; ++r) ps += p0[r]; for (int r = 0; r < 16; ++r) ps += p1[r];
  { auto rr = __builtin_amdgcn_permlane32_swap(__float_as_uint(ps), __float_as_uint(ps), false, false);
    ps = __uint_as_float(rr[0]) + __uint_as_float(rr[1]); }
  l_reg = l_reg * alpha + ps;
#define PK4(P, BASE, OUT) do { unsigned a0 = cvtpk(P[BASE + 0], P[BASE + 1]), a1 = cvtpk(P[BASE + 2], P[BASE + 3]);   \
    unsigned b0 = cvtpk(P[BASE + 4], P[BASE + 5]), b1 = cvtpk(P[BASE + 6], P[BASE + 7]);                              \
    auto r0 = __builtin_amdgcn_permlane32_swap(a0, b0, false, false); auto r1 = __builtin_amdgcn_permlane32_swap(a1, b1, false, false); \
    u32x4 w = {r0[0], r1[0], r0[1], r1[1]}; OUT = *reinterpret_cast<bf16x8*>(&w); } while (0)
  PK4(p0, 0, pa0); PK4(p0, 8, pa1); PK4(p1, 0, pa2); PK4(p1, 8, pa3);
#undef PK4
}
__device__ __forceinline__ void qkt(f32x16& p0, f32x16& p1, const bf16* Ks, const bf16x8* qr, int r32, int hi) {
  p0 = f32x16{}; p1 = f32x16{};
  for (int d0 = 0; d0 < 8; ++d0) { int cb = (d0 * 16 + hi * 8) * 2;
    bf16x8 b0 = *reinterpret_cast<const bf16x8*>((const char*)Ks + KSWZ(r32, cb));
    bf16x8 b1 = *reinterpret_cast<const bf16x8*>((const char*)Ks + KSWZ(32 + r32, cb));
    p0 = __builtin_amdgcn_mfma_f32_32x32x16_bf16(b0, qr[d0], p0, 0, 0, 0);
    p1 = __builtin_amdgcn_mfma_f32_32x32x16_bf16(b1, qr[d0], p1, 0, 0, 0); }
}
__device__ __forceinline__ int v_st(int k, int c) { const int kk = (k & ~0xC) | ((k & 4) << 1) | ((k & 8) >> 1); return ((kk >> 3) * 4 + (c >> 5)) * 512 + ((kk & 7) * 32 + (c & 31)) * 2; }
__device__ __forceinline__ int v_rd_base(int lane) { return ((lane & 3) << 3) | (((lane >> 2) & 3) << 6) | (((lane >> 4) & 1) << 5) | (((lane >> 5) & 1) << 8); }
constexpr int v_rd_off(int d0, int ks, int half) { return d0 * 512 + ks * 4096 + half * 2048; }
template <int OFF> __device__ __forceinline__ s16x4 tr_read(int vb) {
  s16x4 r; asm volatile("ds_read_b64_tr_b16 %0, %1 offset:%2" : "=&v"(r) : "v"(vb), "i"(OFF) : "memory"); return r;
}
template <int D0> __device__ __forceinline__ void pv_one(f32x16& od, int vb, bf16x8 pa0, bf16x8 pa1, bf16x8 pa2, bf16x8 pa3) {
  const s16x4 l0 = tr_read<v_rd_off(D0, 0, 0)>(vb), h0 = tr_read<v_rd_off(D0, 0, 1)>(vb), l1 = tr_read<v_rd_off(D0, 1, 0)>(vb), h1 = tr_read<v_rd_off(D0, 1, 1)>(vb);
  const s16x4 l2 = tr_read<v_rd_off(D0, 2, 0)>(vb), h2 = tr_read<v_rd_off(D0, 2, 1)>(vb), l3 = tr_read<v_rd_off(D0, 3, 0)>(vb), h3 = tr_read<v_rd_off(D0, 3, 1)>(vb);
  asm volatile("s_waitcnt lgkmcnt(0)" ::: "memory"); SBAR();
#define PK(L, H) (bf16x8){L[0], L[1], L[2], L[3], H[0], H[1], H[2], H[3]}
  od = __builtin_amdgcn_mfma_f32_32x32x16_bf16(pa0, PK(l0, h0), od, 0, 0, 0);
  od = __builtin_amdgcn_mfma_f32_32x32x16_bf16(pa1, PK(l1, h1), od, 0, 0, 0);
  od = __builtin_amdgcn_mfma_f32_32x32x16_bf16(pa2, PK(l2, h2), od, 0, 0, 0);
  od = __builtin_amdgcn_mfma_f32_32x32x16_bf16(pa3, PK(l3, h3), od, 0, 0, 0);
#undef PK
}
__device__ __forceinline__ void pv_d0(f32x16* o, int vb, bf16x8 pa0, bf16x8 pa1, bf16x8 pa2, bf16x8 pa3) {
  pv_one<0>(o[0], vb, pa0, pa1, pa2, pa3); pv_one<1>(o[1], vb, pa0, pa1, pa2, pa3); pv_one<2>(o[2], vb, pa0, pa1, pa2, pa3); pv_one<3>(o[3], vb, pa0, pa1, pa2, pa3);
}

template <typename TQ>
__device__ __forceinline__ void attn_dense_body(const TQ* __restrict__ Qb, const bf16* __restrict__ Kh, const bf16* __restrict__ Vh,
                                                bf16* __restrict__ Ob, int seq, char* lds) {
  using St = Stage<bf16>; using SQ = Stage<TQ>;
  const int tid = tidx(), wid = tid >> 6, lane = tid & 63, r32 = lane & 31, hi = lane >> 5;
  bf16* V_lds = (bf16*)lds; bf16* K_lds = (bf16*)(lds + 2 * SHM_V);
  float* ws = (float*)(lds + 2 * SHM_V + 2 * SHM_K) + wid * 64; float* li_l = ws; float* al_l = ws + 32;
  float m_reg = -1e30f, l_reg = 0; f32x16 o[4] = {}; bf16x8 qr[8];
  const TQ* Qw = Qb + (long)(wid * QBLK + r32) * LDQ + hi * 8;
#pragma unroll
  for (int d0 = 0; d0 < 8; ++d0) qr[d0] = SQ::tobf(SQ::ld8(Qw + d0 * 16));
  const int sr = tid >> 4, sc = (tid & 15) * 8, vst0 = v_st(sr, sc), vst1 = v_st(32 + sr, sc);
  const int vb0 = (int)(uintptr_t)V_lds + v_rd_base(lane);
  struct { typename St::T vs0, vs1, ks0, ks1; } sr_[SDEPTH];
#define SLOAD(i, k0) do { sr_[i].vs0 = St::ld8(&Vh[(long)((k0) + sr) * LDK + sc]); sr_[i].vs1 = St::ld8(&Vh[(long)((k0) + 32 + sr) * LDK + sc]); \
    sr_[i].ks0 = St::ld8(&Kh[(long)((k0) + sr) * LDK + sc]); sr_[i].ks1 = St::ld8(&Kh[(long)((k0) + 32 + sr) * LDK + sc]); } while (0)
#define SWRITE(b, i) do { *(bf16x8*)((char*)V_lds + (b) * SHM_V + vst0) = St::tobf(sr_[i].vs0);          \
    *(bf16x8*)((char*)V_lds + (b) * SHM_V + vst1) = St::tobf(sr_[i].vs1); int kc = sc * 2;               \
    *(bf16x8*)((char*)K_lds + (b) * SHM_K + KSWZ(sr, kc)) = St::tobf(sr_[i].ks0);                       \
    *(bf16x8*)((char*)K_lds + (b) * SHM_K + KSWZ(32 + sr, kc)) = St::tobf(sr_[i].ks1); } while (0)
#define SWAIT() do { if constexpr (SDEPTH == 2) asm volatile("s_waitcnt vmcnt(4)" ::: "memory"); else asm volatile("s_waitcnt vmcnt(0)" ::: "memory"); } while (0)
#define RESC(a) do { if (__any((a) < 1.f)) { if (hi == 0) al_l[r32] = (a); asm volatile("s_waitcnt lgkmcnt(0)" ::: "memory"); \
    for (int d = 0; d < 4; ++d) for (int r = 0; r < 16; ++r) o[d][r] *= al_l[crow(r, hi)]; } } while (0)
  f32x16 pA0, pA1, pB0, pB1; float mnA, mnB, alA, alB; bf16x8 pa0, pa1, pa2, pa3; const int NT = seq / KVBLK;
  constexpr int SE = 0, SO = SDEPTH - 1;
  SLOAD(SE, 0); asm volatile("s_waitcnt vmcnt(0)" ::: "memory"); SWRITE(0, SE); __syncthreads();
  qkt(pA0, pA1, K_lds, qr, r32, hi); partialSM(pA0, pA1, m_reg, mnA, alA);
  SLOAD(SO, KVBLK); if constexpr (SDEPTH == 2) { if (2 < NT) SLOAD(SE, 2 * KVBLK); }
  SWAIT(); SWRITE(1, SO); __syncthreads();
  for (int j = 1; j + 1 < NT; j += 2) {
    SBAR(); qkt(pB0, pB1, (bf16*)((char*)K_lds + SHM_K), qr, r32, hi);
    finishSM(pA0, pA1, alA, l_reg, pa0, pa1, pa2, pa3); SBAR();
    SLOAD(SO, (j + SDEPTH) * KVBLK); SBAR();
    pv_d0(o, vb0, pa0, pa1, pa2, pa3); partialSM(pB0, pB1, m_reg, mnB, alB);
    __syncthreads(); SWAIT(); SWRITE(0, SE);
    RESC(alB); __syncthreads();
    SBAR(); qkt(pA0, pA1, K_lds, qr, r32, hi);
    finishSM(pB0, pB1, alB, l_reg, pa0, pa1, pa2, pa3); SBAR();
    if (SDEPTH == 1 || j + 3 < NT) SLOAD(SE, (j + 1 + SDEPTH) * KVBLK); SBAR();
    pv_d0(o, vb0 + (int)SHM_V, pa0, pa1, pa2, pa3); partialSM(pA0, pA1, m_reg, mnA, alA);
    __syncthreads(); SWAIT(); SWRITE(1, SO);
    RESC(alA); __syncthreads();
  }
  SBAR(); qkt(pB0, pB1, (bf16*)((char*)K_lds + SHM_K), qr, r32, hi);
  finishSM(pA0, pA1, alA, l_reg, pa0, pa1, pa2, pa3); SBAR();
  pv_d0(o, vb0, pa0, pa1, pa2, pa3); partialSM(pB0, pB1, m_reg, mnB, alB);
  __syncthreads(); RESC(alB);
  finishSM(pB0, pB1, alB, l_reg, pa0, pa1, pa2, pa3); SBAR();
  pv_d0(o, vb0 + (int)SHM_V, pa0, pa1, pa2, pa3);
  if (hi == 0) li_l[r32] = l_reg; asm volatile("s_waitcnt lgkmcnt(0)" ::: "memory");
  float rli[16];
#pragma unroll
  for (int r = 0; r < 16; ++r) rli[r] = __builtin_amdgcn_rcpf(li_l[crow(r, hi)]);
  bf16* Ow = Ob + (long)(wid * QBLK) * LDO;
#pragma unroll
  for (int r = 0; r < 16; ++r) { int orow = crow(r, hi);
    for (int d0 = 0; d0 < 4; ++d0) Ow[(long)orow * LDO + d0 * 32 + r32] = f2bf(o[d0][r] * rli[r]); }
#undef SLOAD
#undef SWRITE
#undef SWAIT
#undef RESC
}
}

__device__ void phase_att(const Params& p, int j, unsigned char* lds) {
  const bf16_t* Q = (const bf16_t*)(p.ws + WS_Q); bf16_t* O = (bf16_t*)(p.ws + WS_O);
  const bf16_t* KP = (const bf16_t*)(p.ws + WS_KP); const bf16_t* VP = (const bf16_t*)(p.ws + WS_VP);
  const bf16_t* KS = (const bf16_t*)(p.ws + WS_KS) + (size_t)j * 4 * 1536 * 256; const bf16_t* VS = (const bf16_t*)(p.ws + WS_VS) + (size_t)j * 4 * 1536 * 256;
  for (int u = blockIdx.x; u < 256; u += gridDim.x) {
    __syncthreads();
    if (u < 128) {
      const int qb = u & 3, h = (u >> 2) & 7, b = u >> 5, kv = h >> 2;
      const size_t row0 = (size_t)NPR + b * 1024 + qb * 256, kb = ((size_t)b * 1536) * 256 + kv * 128;
      att::attn_dense_body<att::bf16>(Q + row0 * D + h * 128, KS + kb, VS + kb, O + row0 * D + h * 128, 1536, (char*)lds);
    } else {
      const int h = (u - 128) & 7, b = (u - 128) >> 3, kv = h >> 2;
      const size_t row0 = (size_t)b * 256, kb = row0 * 256 + kv * 128;
      att::attn_dense_body<att::bf16>(Q + row0 * D + h * 128, KP + kb, VP + kb, O + row0 * D + h * 128, 256, (char*)lds);
    }
  }
  __syncthreads();
}

__global__ void __launch_bounds__(512, 2) mega(Params p) {
  extern __shared__ __attribute__((aligned(16))) unsigned char lds[];
  cg::grid_group grid = cg::this_grid();
  int ph = 0;
#define RUN(stmt) do { if (ph >= p.ph_lo && ph < p.ph_hi) { stmt; if (ph + 1 < p.ph_hi) grid.sync(); } ++ph; } while (0)
  bf16_t* XN = (bf16_t*)(p.ws + WS_XN); float* Y = (float*)(p.ws + WS_Y); const float* MOD = (const float*)(p.ws + WS_MOD);
  RUN(phase_p0(p, lds));
  RUN(phase_p0b(p));
#pragma unroll 1
  for (int l = 0; l < 4; ++l) {
    const int j = l >> 1;
    RUN(phase_nm(p, l, 0));
    if ((l & 1) == 0) {
      RUN(gemm_run(lds, (const bf16_t*)(p.ws + WS_WIN) + (size_t)j * 3072 * D, XN, 3072, MTOK, D, 1, pg8::EpiBf16{(bf16_t*)(p.ws + WS_ZT), MTOK}));
      RUN(phase_lca(p, j));
      RUN(phase_lcb(p, j));
      RUN(gemm_run(lds, (const bf16_t*)(p.ws + WS_YG), (const bf16_t*)(p.ws + WS_WHO) + (size_t)j * D * D, MTOK, D, D, 2, pg8::EpiGate<true>{Y, MOD + (size_t)l * 5 * 6144 + 2048}));
    } else {
      RUN(gemm_run(lds, XN, (const bf16_t*)(p.ws + WS_WQKV) + (size_t)j * QKVD * D, MTOK, QKVD, D, 1, pg8::EpiBf16{(bf16_t*)(p.ws + WS_QKV), QKVD}));
      RUN(phase_qkvpost(p, j));
      RUN(phase_att(p, j, lds));
      RUN(gemm_run(lds, (const bf16_t*)(p.ws + WS_O), (const bf16_t*)(p.ws + WS_WAO) + (size_t)j * D * D, MTOK, D, D, 2, pg8::EpiGate<true>{Y, MOD + (size_t)l * 5 * 6144 + 2048}));
    }
    RUN(phase_nm(p, l, 1));
    RUN(gemm_run(lds, XN, (const bf16_t*)(p.ws + WS_WGU) + (size_t)l * 2 * DFF * D, MTOK, 2 * DFF, D, 1, pg8::EpiSwiglu{(bf16_t*)(p.ws + WS_H)}));
    RUN(gemm_run(lds, (const bf16_t*)(p.ws + WS_H), (const bf16_t*)(p.ws + WS_WDN) + (size_t)l * D * DFF, MTOK, D, DFF, 2, pg8::EpiGate<true>{Y, MOD + (size_t)l * 5 * 6144 + 5 * 1024}));
  }
  RUN(phase_final(p));
#undef RUN
}
constexpr int N_PHASES = 2 + 4 * 8 + 1;

#ifndef MK_SPLIT
#define MK_SPLIT 0
#endif

extern "C" void kernel_launch(void* const* d_in, const int* in_sizes, int n_in, void* d_out, int out_size, void* d_ws, size_t ws_size, hipStream_t stream) {
  static int grid = 0;
  if (grid == 0) {
    if (n_in != 29 || ws_size < WS_END) { fprintf(stderr, "kernel_launch: n_in %d ws %zu (need 29, >= %zu)\n", n_in, ws_size, (size_t)WS_END); grid = -1; return; }
    int dev = 0, cus = 0, per_cu = 0;
    hipGetDevice(&dev);
    hipDeviceGetAttribute(&cus, hipDeviceAttributeMultiprocessorCount, dev);
    if (hipFuncSetAttribute((const void*)mega, hipFuncAttributeMaxDynamicSharedMemorySize, LDS_BYTES) != hipSuccess) { fprintf(stderr, "kernel_launch: hipFuncSetAttribute failed\n"); grid = -1; return; }
    hipOccupancyMaxActiveBlocksPerMultiprocessor(&per_cu, (const void*)mega, 512, LDS_BYTES);
    if (per_cu < 1) { fprintf(stderr, "kernel_launch: occupancy query says %d blocks per CU\n", per_cu); per_cu = 1; }
    grid = cus * per_cu;
  }
  if (grid < 0) return;
  Params p{};
  for (int i = 0; i < 29; ++i) p.in[i] = (const float*)d_in[i];
  p.out = (float*)d_out; p.ws = (unsigned char*)d_ws;
#if MK_SPLIT
  for (int ph = 0; ph < N_PHASES; ++ph) {
    p.ph_lo = ph; p.ph_hi = ph + 1;
    void* args[] = {&p};
    hipError_t e = hipLaunchCooperativeKernel((const void*)mega, dim3(grid), dim3(512), args, LDS_BYTES, stream);
    if (e != hipSuccess) { fprintf(stderr, "cooperative launch failed: %s (grid %d)\n", hipGetErrorString(e), grid); break; }
  }
#else
  p.ph_lo = 0; p.ph_hi = N_PHASES;
  void* args[] = {&p};
  hipError_t e = hipLaunchCooperativeKernel((const void*)mega, dim3(grid), dim3(512), args, LDS_BYTES, stream);
  if (e != hipSuccess) fprintf(stderr, "cooperative launch failed: %s (grid %d)\n", hipGetErrorString(e), grid);
#endif
}
```

```cpp
#include <hip/hip_runtime.h>
#include <hip/hip_cooperative_groups.h>
#include <cstdio>
#include <cstdint>
namespace cg = cooperative_groups;

typedef unsigned short bf16_t;
typedef short bf16x8 __attribute__((ext_vector_type(8)));
typedef float f32x4 __attribute__((ext_vector_type(4)));
typedef unsigned u32x4 __attribute__((ext_vector_type(4)));
typedef float f32x16 __attribute__((ext_vector_type(16)));

constexpr int D = 1024, MTOK = 8192, NPR = 4096;
constexpr int DFF = 2816, QKVD = 1536;
constexpr float EPS = 1e-6f;
constexpr float MIN_DECAY = -3.0701134573253944f, MAX_DECAY = -15.350567286626972f;

constexpr size_t MiB = 1u << 20;
constexpr size_t WS_MOD = 1 * MiB, WS_MODP = 2 * MiB, WS_FSQP = 6 * MiB, WS_RNORM = 7 * MiB, WS_FILT = 8 * MiB;
constexpr size_t WS_WIN = 28 * MiB, WS_WHO = 40 * MiB, WS_WQKV = 44 * MiB, WS_WAO = 50 * MiB, WS_WGU = 54 * MiB, WS_WDN = 98 * MiB;
constexpr size_t WS_Y = 120 * MiB, WS_XN = 152 * MiB, WS_R = 168 * MiB;
constexpr size_t WS_ZT = WS_R, WS_U = WS_R + 48 * MiB, WS_X0C = WS_R + 64 * MiB, WS_YG = WS_R + 80 * MiB;
constexpr size_t WS_QKV = WS_R, WS_Q = WS_R + 24 * MiB, WS_KP = WS_R + 40 * MiB, WS_VP = WS_R + 42 * MiB, WS_O = WS_R + 44 * MiB;
constexpr size_t WS_H = WS_R;
constexpr size_t WS_KS = WS_R + 96 * MiB, WS_VS = WS_R + 102 * MiB, WS_FRG = WS_R + 108 * MiB, WS_END = WS_R + 130 * MiB;
constexpr size_t FRG_J = 11 * MiB / 2, FRG_L1 = (size_t)1024 * (4 * 256 + 40);
constexpr size_t FILT_J = 10 * MiB / 4;
constexpr size_t FILT_L1 = 1024 * 512;

constexpr int LDS_BYTES = 147456;

struct Params {
  const float* in[29];
  float* out;
  unsigned char* ws;
  int ph_lo, ph_hi;
};
enum { I_XP = 0, I_XS, I_CK, I_CV, I_C, I_CCTX, I_MODW, I_MODB, I_NMIX, I_NFFN, I_HWIN, I_HCW, I_HCB, I_FW1, I_FB1, I_FFREQ, I_FW2, I_FB2, I_FW3,
       I_HBIAS, I_HWOUT, I_WQKV, I_QN, I_KN, I_WAO, I_WG, I_WU, I_WD, I_FN };

__device__ __forceinline__ bf16_t f2bf(float f) { unsigned u = __float_as_uint(f); u += 0x7FFFu + ((u >> 16) & 1u); return (bf16_t)(u >> 16); }
__device__ __forceinline__ float bf2f(bf16_t b) { return __uint_as_float(((unsigned)b) << 16); }
__device__ __forceinline__ unsigned pack2(float lo, float hi) { return (unsigned)f2bf(lo) | ((unsigned)f2bf(hi) << 16); }
__device__ __forceinline__ float wave_sum(float v) {
#pragma unroll
  for (int o = 32; o >= 1; o >>= 1) v += __shfl_xor(v, o);
  return v;
}
__device__ __forceinline__ float wave_max(float v) {
#pragma unroll
  for (int o = 32; o >= 1; o >>= 1) v = fmaxf(v, __shfl_xor(v, o));
  return v;
}
__device__ __forceinline__ int tidx() { int t = threadIdx.x; asm volatile("" : "+v"(t)); return t; }
__device__ __forceinline__ int cond_of(int m) { return m < NPR ? 4 : ((m - NPR) >> 10); }
__device__ __forceinline__ float silu_f(float x) { return x / (1.f + expf(-x)); }
__device__ __forceinline__ float sin_rev(float r) { return __builtin_amdgcn_sinf(r - rintf(r)); }
__device__ __forceinline__ float cos_rev(float r) { return __builtin_amdgcn_cosf(r - rintf(r)); }
constexpr float INV_2PI = 0.15915494309189535f;

__device__ __forceinline__ void cvt_tile(const float* __restrict__ src, int K, int N, int kt, int nt, bf16_t* __restrict__ dst, int mode, float* tile  ) {
  const int tid = tidx();
  const int k0 = kt * 64, n0 = nt * 64;
  {
    const int r = tid >> 4, c4 = (tid & 15) * 4;
#pragma unroll
    for (int h = 0; h < 2; ++h) {
      const int rr = r + 32 * h;
      const f32x4 v = *(const f32x4*)(src + (size_t)(k0 + rr) * N + n0 + c4);
      tile[rr * 65 + c4 + 0] = v[0]; tile[rr * 65 + c4 + 1] = v[1]; tile[rr * 65 + c4 + 2] = v[2]; tile[rr * 65 + c4 + 3] = v[3];
    }
  }
  __syncthreads();
  {
    const int n = tid >> 3, kc = (tid & 7) * 8;
    u32x4 w;
    w.x = pack2(tile[(kc + 0) * 65 + n], tile[(kc + 1) * 65 + n]);
    w.y = pack2(tile[(kc + 2) * 65 + n], tile[(kc + 3) * 65 + n]);
    w.z = pack2(tile[(kc + 4) * 65 + n], tile[(kc + 5) * 65 + n]);
    w.w = pack2(tile[(kc + 6) * 65 + n], tile[(kc + 7) * 65 + n]);
    const int ng = n0 + n;
    const int row = mode == 0 ? ng : ((ng >> 7) * 256 + (ng & 127) + (mode == 2 ? 128 : 0));
    *(u32x4*)(dst + (size_t)row * K + k0 + kc) = w;
  }
  __syncthreads();
}

constexpr int NT_FILT = 320, NT_MOD = 384;
constexpr int NT_WIN = 2 * 16 * 48, NT_WHO = 2 * 16 * 16, NT_WQKV = 2 * 16 * 24, NT_WAO = 2 * 16 * 16, NT_G = 4 * 16 * 44, NT_DN = 4 * 44 * 16;
constexpr int NT_CVT = NT_WIN + NT_WHO + NT_WQKV + NT_WAO + 2 * NT_G + NT_DN;

__device__ void task_cvt(const Params& p, int t, float* tile) {
  if (t < NT_WIN) { const int l = t / (16 * 48), r = t % (16 * 48); cvt_tile(p.in[I_HWIN] + (size_t)l * D * 3072, D, 3072, r / 48, r % 48, (bf16_t*)(p.ws + WS_WIN) + (size_t)l * 3072 * D, 0, tile); return; }
  t -= NT_WIN;
  if (t < NT_WHO) { const int l = t / 256, r = t % 256; cvt_tile(p.in[I_HWOUT] + (size_t)l * D * D, D, D, r / 16, r % 16, (bf16_t*)(p.ws + WS_WHO) + (size_t)l * D * D, 0, tile); return; }
  t -= NT_WHO;
  if (t < NT_WQKV) { const int l = t / (16 * 24), r = t % (16 * 24); cvt_tile(p.in[I_WQKV] + (size_t)l * D * QKVD, D, QKVD, r / 24, r % 24, (bf16_t*)(p.ws + WS_WQKV) + (size_t)l * QKVD * D, 0, tile); return; }
  t -= NT_WQKV;
  if (t < NT_WAO) { const int l = t / 256, r = t % 256; cvt_tile(p.in[I_WAO] + (size_t)l * D * D, D, D, r / 16, r % 16, (bf16_t*)(p.ws + WS_WAO) + (size_t)l * D * D, 0, tile); return; }
  t -= NT_WAO;
  if (t < NT_G) { const int l = t / (16 * 44), r = t % (16 * 44); cvt_tile(p.in[I_WG] + (size_t)l * D * DFF, D, DFF, r / 44, r % 44, (bf16_t*)(p.ws + WS_WGU) + (size_t)l * 2 * DFF * D, 1, tile); return; }
  t -= NT_G;
  if (t < NT_G) { const int l = t / (16 * 44), r = t % (16 * 44); cvt_tile(p.in[I_WU] + (size_t)l * D * DFF, D, DFF, r / 44, r % 44, (bf16_t*)(p.ws + WS_WGU) + (size_t)l * 2 * DFF * D, 2, tile); return; }
  t -= NT_G;
  { const int l = t / (44 * 16), r = t % (44 * 16); cvt_tile(p.in[I_WD] + (size_t)l * DFF * D, DFF, D, r / 16, r % 16, (bf16_t*)(p.ws + WS_WDN) + (size_t)l * D * DFF, 0, tile); }
}

__device__ void task_mod(const Params& p, int t, float* sl  ) {
  const int tid = tidx();
  const int l = t / 96, rem = t % 96, cb = rem / 8, kc = rem % 8;
  __syncthreads();
  for (int i = tid; i < 640; i += 512) {
    const int j = i >> 7, k = kc * 128 + (i & 127);
    const float x = j < 4 ? p.in[I_C][j * D + k] : p.in[I_CCTX][k];
    sl[i] = silu_f(x);
  }
  __syncthreads();
  const int n = cb * 512 + tid;
  const float* w = p.in[I_MODW] + ((size_t)l * D + kc * 128) * 6144 + n;
  float a0 = 0.f, a1 = 0.f, a2 = 0.f, a3 = 0.f, a4 = 0.f;
#pragma unroll 4
  for (int k = 0; k < 128; ++k) {
    const float wv = w[(size_t)k * 6144];
    a0 += sl[k] * wv; a1 += sl[128 + k] * wv; a2 += sl[256 + k] * wv; a3 += sl[384 + k] * wv; a4 += sl[512 + k] * wv;
  }
  float* o = (float*)(p.ws + WS_MODP) + ((size_t)(kc * 4 + l) * 5) * 6144 + n;
  o[0] = a0; o[6144] = a1; o[2 * 6144] = a2; o[3 * 6144] = a3; o[4 * 6144] = a4;
}

__device__ void task_filt(const Params& p, int t, float* h1  , float* h2  ) {
  const int tid = tidx(), lane = tid & 63, wid = tid >> 6;
  const int combo = t >> 3, nchunk = t & 7;
  const int j = combo / 20, r = combo % 20;
  const int lsel = r < 4 ? 0 : 1, tchunk = r < 4 ? r : r - 4, L = lsel ? 1024 : 256;
  const int tt = lane, tpos = tchunk * 64 + tt;
  const float tn = (float)tpos / (float)L;
  const float* w1 = p.in[I_FW1] + (size_t)j * 33 * 64;
  const float* b1 = p.in[I_FB1] + j * 64;
  const float* fr = p.in[I_FFREQ] + j * 128;
  const float* w2 = p.in[I_FW2] + (size_t)j * 64 * 64;
  const float* b2 = p.in[I_FB2] + j * 64;
  const float* w3 = p.in[I_FW3] + (size_t)j * 64 * 2048;
  __syncthreads();
  {
    const int u0 = wid * 8;
    float acc[8];
#pragma unroll
    for (int uu = 0; uu < 8; ++uu) acc[uu] = tn * w1[u0 + uu];
    for (int b = 1; b <= 16; ++b) {
      const float rev = tn * (float)b;
      const float cs = cos_rev(rev), sn = sin_rev(rev);
#pragma unroll
      for (int uu = 0; uu < 8; ++uu) acc[uu] += cs * w1[b * 64 + u0 + uu] + sn * w1[(16 + b) * 64 + u0 + uu];
    }
#pragma unroll
    for (int uu = 0; uu < 8; ++uu) h1[tt * 65 + u0 + uu] = sin_rev(INV_2PI * (fr[u0 + uu] * (acc[uu] + b1[u0 + uu])));
  }
  __syncthreads();
  {
    const int u0 = wid * 8;
    float acc[8];
#pragma unroll
    for (int uu = 0; uu < 8; ++uu) acc[uu] = 0.f;
    for (int v = 0; v < 64; ++v) {
      const float hv = h1[tt * 65 + v];
#pragma unroll
      for (int uu = 0; uu < 8; ++uu) acc[uu] += hv * w2[v * 64 + u0 + uu];
    }
#pragma unroll
    for (int uu = 0; uu < 8; ++uu) h2[tt * 65 + u0 + uu] = sin_rev(INV_2PI * (fr[64 + u0 + uu] * (acc[uu] + b2[u0 + uu])));
  }
  __syncthreads();
  float* G2 = (float*)(p.ws + WS_FILT) + (size_t)j * FILT_J + (lsel ? FILT_L1 : 0);
  float* fsq = (float*)(p.ws + WS_FSQP) + ((size_t)((j * 2 + lsel) * 16 + tchunk)) * 2048;
  for (int q = 0; q < 32; ++q) {
    const int n = nchunk * 256 + wid * 32 + q;
    float acc = 0.f;
    for (int v = 0; v < 64; ++v) acc += h2[tt * 65 + v] * w3[v * 2048 + n];
    const int c = n & 1023; const bool isb = n >= 1024;
    const float delta = fabsf(MIN_DECAY + (MAX_DECAY - MIN_DECAY) * ((float)c / 1023.f));
    float val = acc * expf(-tn * delta);
    if (isb && tpos == 0) val = 0.f;
    if (!(isb && tpos == 0)) G2[(size_t)c * (2 * L) + (isb ? (L - tpos) : (L + tpos))] = val;
    {
      bf16_t* rec = (bf16_t*)(p.ws + WS_FRG) + (size_t)j * FRG_J + (lsel ? FRG_L1 : 0) + (size_t)c * (4 * L + 40);
      if (isb && tpos == 0) rec[0] = 0;
      else { const int i = isb ? (L + tpos) : (L - tpos); const bf16_t v = f2bf(val); rec[i] = v; rec[2 * L + 40 + i - 1] = v; }
    }
    const float s = wave_sum(val * val);
    if (lane == 0) fsq[n] = s;
  }
}

__device__ void phase_p0(const Params& p, unsigned char* lds) {
  float* fl = (float*)lds;
  const int G = gridDim.x, b = blockIdx.x, tid = tidx();
  for (int t = b; t < NT_FILT + NT_MOD + NT_CVT; t += G) {
    __syncthreads();
    if (t < NT_FILT) task_filt(p, t, fl, fl + 64 * 65);
    else if (t < NT_FILT + NT_MOD) task_mod(p, t - NT_FILT, fl);
    else task_cvt(p, t - NT_FILT - NT_MOD, fl);
  }
  {
    f32x4* Y = (f32x4*)(p.ws + WS_Y);
    const f32x4* xp = (const f32x4*)p.in[I_XP]; const f32x4* xs = (const f32x4*)p.in[I_XS];
    const int half = NPR * D / 4;
    for (int i = b * 512 + tid; i < 2 * half; i += G * 512) Y[i] = i < half ? xp[i] : xs[i - half];
  }
  {
    bf16_t* KS = (bf16_t*)(p.ws + WS_KS); bf16_t* VS = (bf16_t*)(p.ws + WS_VS);
    const int n = 4 * 2 * 512 * 256;
    for (int i = b * 512 + tid; i < n; i += G * 512) {
      const int e = i & 255, pos = (i >> 8) & 511, j = (i >> 17) & 1, bb = i >> 18;
      const size_t o = ((size_t)(j * 4 + bb) * 1536 + 1024 + pos) * 256 + e;
      KS[o] = f2bf(p.in[I_CK][i]); VS[o] = f2bf(p.in[I_CV][i]);
    }
  }
}

__device__ void phase_p0b(const Params& p) {
  const int G = gridDim.x, b = blockIdx.x, tid = tidx();
  float* MOD = (float*)(p.ws + WS_MOD); const float* MP = (const float*)(p.ws + WS_MODP);
  for (int i = b * 512 + tid; i < 4 * 5 * 6144; i += G * 512) {
    const int n = i % 6144, l = i / (5 * 6144);
    float s = p.in[I_MODB][l * 6144 + n];
#pragma unroll
    for (int kc = 0; kc < 8; ++kc) s += MP[(size_t)kc * (4 * 5 * 6144) + i];
    MOD[i] = s;
  }
  float* RN = (float*)(p.ws + WS_RNORM); const float* FS = (const float*)(p.ws + WS_FSQP);
  for (int i = b * 512 + tid; i < 4096; i += G * 512) {
    const int c = i & 1023, jl = i >> 10, nch = (jl & 1) ? 16 : 4;
    float s = 0.f;
    for (int ch = 0; ch < nch; ++ch) s += FS[((size_t)jl * 16 + ch) * 2048 + c] + FS[((size_t)jl * 16 + ch) * 2048 + 1024 + c];
    RN[i] = 1.f / sqrtf(s + EPS);
  }
}

__device__ void phase_nm(const Params& p, int layer, int which) {
  const int lane = tidx() & 63, wid = tidx() >> 6;
  const float* Y = (const float*)(p.ws + WS_Y); bf16_t* XN = (bf16_t*)(p.ws + WS_XN);
  const float* g = p.in[which ? I_NFFN : I_NMIX] + layer * D;
  for (int m = blockIdx.x * 8 + wid; m < MTOK; m += gridDim.x * 8) {
    const float* y = Y + (size_t)m * D;
    f32x4 v[4]; float ss = 0.f;
#pragma unroll
    for (int i = 0; i < 4; ++i) { v[i] = *(const f32x4*)(y + i * 256 + lane * 4); ss += v[i][0] * v[i][0] + v[i][1] * v[i][1] + v[i][2] * v[i][2] + v[i][3] * v[i][3]; }
    ss = wave_sum(ss);
    const float r = rsqrtf(ss * (1.f / D) + EPS);
    const float* mod = (const float*)(p.ws + WS_MOD) + (size_t)(layer * 5 + cond_of(m)) * 6144 + which * 3072;
#pragma unroll
    for (int i = 0; i < 4; ++i) {
      const int k = i * 256 + lane * 4;
      const f32x4 gg = *(const f32x4*)(g + k), sh = *(const f32x4*)(mod + k), sc = *(const f32x4*)(mod + 1024 + k);
      float o[4];
#pragma unroll
      for (int e = 0; e < 4; ++e) o[e] = (v[i][e] * r * gg[e]) * (1.f + sc[e]) + sh[e];
      uint2 w; w.x = pack2(o[0], o[1]); w.y = pack2(o[2], o[3]);
      *(uint2*)(XN + (size_t)m * D + k) = w;
    }
  }
}

__device__ void phase_final(const Params& p) {
  const int lane = tidx() & 63, wid = tidx() >> 6;
  const float* Y = (const float*)(p.ws + WS_Y);
  const float* g = p.in[I_FN];
  for (int m = blockIdx.x * 8 + wid; m < MTOK; m += gridDim.x * 8) {
    const float* y = Y + (size_t)m * D;
    f32x4 v[4]; float ss = 0.f;
#pragma unroll
    for (int i = 0; i < 4; ++i) { v[i] = *(const f32x4*)(y + i * 256 + lane * 4); ss += v[i][0] * v[i][0] + v[i][1] * v[i][1] + v[i][2] * v[i][2] + v[i][3] * v[i][3]; }
    ss = wave_sum(ss);
    const float r = rsqrtf(ss * (1.f / D) + EPS);
#pragma unroll
    for (int i = 0; i < 4; ++i) {
      const int k = i * 256 + lane * 4;
      const f32x4 gg = *(const f32x4*)(g + k);
      f32x4 o; o[0] = v[i][0] * r * gg[0]; o[1] = v[i][1] * r * gg[1]; o[2] = v[i][2] * r * gg[2]; o[3] = v[i][3] * r * gg[3];
      *(f32x4*)(p.out + (size_t)m * D + k) = o;
    }
  }
}

struct EpiStoreBf16 { bf16_t* C; int ld; __device__ __forceinline__ void operator()(int m, int n, float v) const { C[(size_t)m * ld + n] = f2bf(v); } };
struct EpiGateRes { float* Y; const float* gate; __device__ __forceinline__ void operator()(int m, int n, float v) const { Y[(size_t)m * D + n] += gate[cond_of(m) * 6144 + n] * v; } };

template <bool SWIGLU, class Epi>
__device__ __forceinline__ void gemm_naive(const bf16_t* __restrict__ A, const bf16_t* __restrict__ Bt, int M, int N, int K, const Epi& epi, bf16_t* Hout) {
  const int lane = tidx() & 63, wid = tidx() >> 6, r16 = lane & 15, kg = lane >> 4;
  const int tilesN = SWIGLU ? N / 32 : N / 64, total = (M / 64) * tilesN;
  for (int tile = blockIdx.x * 8 + wid; tile < total; tile += gridDim.x * 8) {
    const int tm = tile / tilesN, tn = tile % tilesN, m0 = tm * 64;
    f32x4 acc[4][4];
#pragma unroll
    for (int i = 0; i < 4; ++i)
#pragma unroll
      for (int f = 0; f < 4; ++f) acc[i][f] = (f32x4){0.f, 0.f, 0.f, 0.f};
    const bf16_t* ap = A + (size_t)(m0 + r16) * K + kg * 8;
    int brow[4];
#pragma unroll
    for (int f = 0; f < 4; ++f) {
      if (SWIGLU) { const int hc = tn * 32 + 16 * (f & 1) + r16; brow[f] = (hc >> 7) * 256 + (hc & 127) + 128 * (f >> 1); }
      else brow[f] = tn * 64 + 16 * f + r16;
    }
    const bf16_t* bp0 = Bt + (size_t)brow[0] * K + kg * 8; const bf16_t* bp1 = Bt + (size_t)brow[1] * K + kg * 8;
    const bf16_t* bp2 = Bt + (size_t)brow[2] * K + kg * 8; const bf16_t* bp3 = Bt + (size_t)brow[3] * K + kg * 8;
    for (int k0 = 0; k0 < K; k0 += 32) {
      bf16x8 a[4], b[4];
#pragma unroll
      for (int i = 0; i < 4; ++i) a[i] = *(const bf16x8*)(ap + (size_t)(16 * i) * K + k0);
      b[0] = *(const bf16x8*)(bp0 + k0); b[1] = *(const bf16x8*)(bp1 + k0); b[2] = *(const bf16x8*)(bp2 + k0); b[3] = *(const bf16x8*)(bp3 + k0);
#pragma unroll
      for (int i = 0; i < 4; ++i)
#pragma unroll
        for (int f = 0; f < 4; ++f) acc[i][f] = __builtin_amdgcn_mfma_f32_16x16x32_bf16(a[i], b[f], acc[i][f], 0, 0, 0);
    }
    if (SWIGLU) {
#pragma unroll
      for (int i = 0; i < 4; ++i)
#pragma unroll
        for (int f = 0; f < 2; ++f)
#pragma unroll
          for (int e = 0; e < 4; ++e) {
            const int m = m0 + 16 * i + 4 * kg + e, hc = tn * 32 + 16 * f + r16;
            const float gv = acc[i][f][e], uv = acc[i][f + 2][e];
            Hout[(size_t)m * DFF + hc] = f2bf(silu_f(gv) * uv);
          }
    } else {
#pragma unroll
      for (int i = 0; i < 4; ++i)
#pragma unroll
        for (int f = 0; f < 4; ++f)
#pragma unroll
          for (int e = 0; e < 4; ++e) epi(m0 + 16 * i + 4 * kg + e, tn * 64 + 16 * f + r16, acc[i][f][e]);
    }
  }
}


namespace pg8 {
#define PG8_LAS __attribute__((address_space(3)))
constexpr int BM = 256, BK = 64, HALF = 128, HTB = HALF * BK * 2, STAGE_BYTES = 8 * HTB, NXCD = 8, WGM = 8;
__host__ __device__ __forceinline__ int lds_byte(int r, int c) { const int st = (r >> 4) * 2 + (c >> 5), rr = r & 15, cc = c & 31, ob = rr * 64 + cc * 2; return st * 1024 + (ob ^ (((ob >> 9) & 1) << 5)); }
__host__ __device__ __forceinline__ void stage_rc(int b, int& R, int& C) { const int st = b / 1024, sb = b % 1024, swz = sb ^ (((sb >> 9) & 1) << 5); R = (st >> 1) * 16 + swz / 64; C = (st & 1) * 32 + (swz % 64) / 2; }
__host__ __device__ __forceinline__ int perm32(int rho) { const int n = rho >> 4, i = rho & 15; return 8 * (i >> 2) + 4 * n + (i & 3); }
struct Unit { int pm, pn, ks; };
struct Gemm { const bf16_t* A; const bf16_t* Bt; int M, N, K, ld; };
struct StaticOrder {
    int nM, nN, nwg, G, c, KS;
    __device__ void init(int M, int N, int KS_, int G_, int c_) { nM = M / BM; KS = KS_; nN = (N / BM) * KS_; nwg = nM * nN; G = G_; c = c_; }
    __device__ bool next(int i, Unit& u) const {
        const long L = (long)i * G + c; if (L >= nwg) return false;
        int wgid = (int)L; { const int q = nwg / NXCD, r = nwg % NXCD, xcd = wgid % NXCD, off = wgid / NXCD; wgid = (xcd < r ? xcd * (q + 1) : r * (q + 1) + (xcd - r) * q) + off; }
        const int nig = WGM * nN, gid = wgid / nig, fm = gid * WGM, gsz = (nM - fm) < WGM ? (nM - fm) : WGM;
        u.pm = fm + ((wgid % nig) % gsz); const int pn2 = (wgid % nig) / gsz; u.pn = pn2 / KS; u.ks = pn2 % KS; return true;
    }
    __device__ __forceinline__ void a_ready(const Unit&) const {}
    __device__ __forceinline__ void done(const Unit&) const {}
};
__device__ __forceinline__ unsigned cvt_pk_bf16(float lo, float hi) { unsigned r; asm volatile("v_cvt_pk_bf16_f32 %0, %1, %2" : "=v"(r) : "v"(lo), "v"(hi)); return r; }
struct EpiBf16 {
    static constexpr bool PERM = true, AFTER_DRAIN = false;
    bf16_t* O; int ldc;
    __device__ __forceinline__ void operator()(const f32x4 (&acc)[2][2][4][2], const Unit& u, int wr, int wc, int fr, int fq) const {
        const int row0 = u.pm * BM + wr * 64 + fr, col0 = u.pn * BM + wc * 32 + 8 * fq;
#pragma unroll
        for (int ai = 0; ai < 2; ++ai)
#pragma unroll
            for (int m = 0; m < 4; ++m) { bf16_t* rowp = O + (size_t)(row0 + ai * HALF + m * 16) * ldc + col0;
#pragma unroll
                for (int bj = 0; bj < 2; ++bj) { const f32x4 v0 = acc[ai][bj][m][0], v1 = acc[ai][bj][m][1];
                    u32x4 w; w.x = cvt_pk_bf16(v0[0], v0[1]); w.y = cvt_pk_bf16(v0[2], v0[3]); w.z = cvt_pk_bf16(v1[0], v1[1]); w.w = cvt_pk_bf16(v1[2], v1[3]);
                    *(u32x4*)(rowp + bj * HALF) = w; } }
    }
};
struct EpiSwiglu {
    static constexpr bool PERM = true, AFTER_DRAIN = false;
    bf16_t* H;
    __device__ __forceinline__ void operator()(const f32x4 (&acc)[2][2][4][2], const Unit& u, int wr, int wc, int fr, int fq) const {
        const int row0 = u.pm * BM + wr * 64 + fr, col0 = u.pn * HALF + wc * 32 + 8 * fq;
#pragma unroll
        for (int ai = 0; ai < 2; ++ai)
#pragma unroll
            for (int m = 0; m < 4; ++m) {
                float h[8];
#pragma unroll
                for (int n = 0; n < 2; ++n)
#pragma unroll
                    for (int e = 0; e < 4; ++e) { const float gv = acc[ai][0][m][n][e], uv = acc[ai][1][m][n][e]; h[4 * n + e] = gv * __builtin_amdgcn_rcpf(1.f + __expf(-gv)) * uv; }
                u32x4 w; w.x = cvt_pk_bf16(h[0], h[1]); w.y = cvt_pk_bf16(h[2], h[3]); w.z = cvt_pk_bf16(h[4], h[5]); w.w = cvt_pk_bf16(h[6], h[7]);
                *(u32x4*)(H + (size_t)(row0 + ai * HALF + m * 16) * DFF + col0) = w; }
    }
};
template <bool ATOMIC> struct EpiGate {
    static constexpr bool PERM = false, AFTER_DRAIN = false;
    float* Y; const float* gate;
    __device__ __forceinline__ void operator()(const f32x4 (&acc)[2][2][4][2], const Unit& u, int wr, int wc, int fr, int fq) const {
        const int row0 = u.pm * BM + wr * 64 + fr, col0 = u.pn * BM + wc * 32 + 4 * fq;
#pragma unroll
        for (int ai = 0; ai < 2; ++ai)
#pragma unroll
            for (int m = 0; m < 4; ++m) { const int row = row0 + ai * HALF + m * 16; const float* gp = gate + cond_of(row) * 6144 + col0; float* yp = Y + (size_t)row * D + col0;
#pragma unroll
                for (int bj = 0; bj < 2; ++bj)
#pragma unroll
                    for (int n = 0; n < 2; ++n) { const int o = bj * HALF + n * 16; const f32x4 gv = *(const f32x4*)(gp + o); const f32x4 v = acc[ai][bj][m][n] * gv;
                        if (ATOMIC) { unsafeAtomicAdd(yp + o, v[0]); unsafeAtomicAdd(yp + o + 1, v[1]); unsafeAtomicAdd(yp + o + 2, v[2]); unsafeAtomicAdd(yp + o + 3, v[3]); }
                        else { *(f32x4*)(yp + o) = *(const f32x4*)(yp + o) + v; } } }
    }
};
template <class Epi, class Sched, bool ALIGN_EPI = false, bool SP2 = false>
__device__ __forceinline__ void gemm_phase(PG8_LAS unsigned char* lds, const Gemm g, const Sched& S, const Epi& E) {
    int tid_ = tidx();
    const int tid = tid_, wid = __builtin_amdgcn_readfirstlane(tid >> 6), lane = tid & 63, wr = wid >> 2, wc = wid & 3, fr = lane & 15, fq = lane >> 4;
    const int K = g.ld, nt = g.K / BK;
    unsigned voffA[2], voffB[2];
#pragma unroll
    for (int i = 0; i < 2; ++i) { int R, C; stage_rc(tid * 16 + i * 8192, R, C); const int Rb = Epi::PERM ? ((R & ~31) + perm32(R & 31)) : R;
        voffA[i] = (unsigned)(R * K + C) * 2u; voffB[i] = (unsigned)(Rb * K + C) * 2u; }
    const size_t kstep = (size_t)(BK * 2);
    const size_t hstep = (size_t)HALF * K * 2;
    const size_t tstep = 2 * hstep;
    const unsigned ldsw = (unsigned)wid * 1024u;
    const int aoff = lds_byte(wr * 64 + fr, fq * 8), boff = lds_byte(wc * 32 + fr, fq * 8);
#define PG8_SA(b, h) (((b) * 2 + (h)) * HTB)
#define PG8_SB(b, h) ((4 + (b) * 2 + (h)) * HTB)
#define PG8_STAGE(bufoff, gbase, voff) do { _Pragma("unroll") for (int _i = 0; _i < 2; ++_i) \
        __builtin_amdgcn_global_load_lds((const unsigned*)((const char*)(gbase) + (voff)[_i]), (PG8_LAS unsigned*)(lds + (bufoff) + ldsw + _i * 8192), 16, 0, 0); } while (0)
#define PG8_LDA(dst, b, h) do { _Pragma("unroll") for (int m = 0; m < 4; ++m) _Pragma("unroll") for (int k = 0; k < 2; ++k) dst[m][k] = *(const PG8_LAS bf16x8*)(lds + PG8_SA(b, h) + aoff + m * 2048 + k * 1024); } while (0)
#define PG8_LDB(dst, b, h) do { _Pragma("unroll") for (int n = 0; n < 2; ++n) _Pragma("unroll") for (int k = 0; k < 2; ++k) dst[n][k] = *(const PG8_LAS bf16x8*)(lds + PG8_SB(b, h) + boff + n * 2048 + k * 1024); } while (0)
#define PG8_MMA(ai, bj, At, Bt) do { __builtin_amdgcn_s_setprio(1); _Pragma("unroll") for (int m = 0; m < 4; ++m) _Pragma("unroll") for (int n = 0; n < 2; ++n) _Pragma("unroll") for (int k = 0; k < 2; ++k) \
        acc[ai][bj][m][n] = __builtin_amdgcn_mfma_f32_16x16x32_bf16(Bt[n][k], At[m][k], acc[ai][bj][m][n], 0, 0, 0); __builtin_amdgcn_s_setprio(0); } while (0)
#define PG8_WAIT_V(n) asm volatile("s_waitcnt vmcnt(" #n ")" ::: "memory")
#define PG8_WAIT_L(n) asm volatile("s_waitcnt lgkmcnt(" #n ")" ::: "memory")
#define PG8_BAR __builtin_amdgcn_s_barrier()
#define PG8_SCHED __builtin_amdgcn_sched_barrier(0)
    Unit cur, nxt; int ui = 0;
    if (!S.next(0, cur)) return;
    f32x4 acc[2][2][4][2];
#pragma unroll
    for (int a = 0; a < 2; ++a)
#pragma unroll
        for (int b = 0; b < 2; ++b)
#pragma unroll
            for (int m = 0; m < 4; ++m)
#pragma unroll
                for (int n = 0; n < 2; ++n) acc[a][b][m][n] = (f32x4){0.f, 0.f, 0.f, 0.f};
    bf16x8 At[4][2], B0[2][2], B1[2][2];
    const size_t ksb = (size_t)g.K * 2; const char* cA = (const char*)g.A + (size_t)cur.pm * tstep + cur.ks * ksb; const char* cB = (const char*)g.Bt + (size_t)cur.pn * tstep + cur.ks * ksb;
    S.a_ready(cur);
    if constexpr (SP2) {
        PG8_STAGE(PG8_SB(0, 0), cB, voffB); PG8_STAGE(PG8_SB(0, 1), cB + hstep, voffB); PG8_STAGE(PG8_SA(0, 0), cA, voffA); PG8_STAGE(PG8_SA(0, 1), cA + hstep, voffA);
        if (wr == 1) PG8_BAR;
        PG8_WAIT_V(2); PG8_BAR;
        PG8_STAGE(PG8_SB(1, 0), cB + kstep, voffB); PG8_STAGE(PG8_SA(1, 0), cA + kstep, voffA); PG8_STAGE(PG8_SB(1, 1), cB + hstep + kstep, voffB);
        PG8_WAIT_V(6); PG8_BAR;
    } else {
        PG8_STAGE(PG8_SB(0, 0), cB, voffB); PG8_STAGE(PG8_SA(0, 0), cA, voffA); PG8_STAGE(PG8_SB(0, 1), cB + hstep, voffB); PG8_STAGE(PG8_SA(0, 1), cA + hstep, voffA);
        if (wr == 1) PG8_BAR;
        PG8_WAIT_V(4); PG8_BAR;
        PG8_STAGE(PG8_SB(1, 0), cB + kstep, voffB); PG8_STAGE(PG8_SA(1, 0), cA + kstep, voffA); PG8_STAGE(PG8_SB(1, 1), cB + hstep + kstep, voffB);
        PG8_WAIT_V(6); PG8_BAR;
    }
    for (;;) {
        const bool has_next = S.next(ui + 1, nxt);
        const char* nA = has_next ? (const char*)g.A + (size_t)nxt.pm * tstep + nxt.ks * ksb : cA; const char* nB = has_next ? (const char*)g.Bt + (size_t)nxt.pn * tstep + nxt.ks * ksb : cB;
        for (int t = 0; t < nt; t += 2) {
            const bool last = (t == nt - 2);
            const char* a1 = cA + (size_t)(t + 1) * kstep;
            const char* a2 = last ? nA : cA + (size_t)(t + 2) * kstep; const char* b2 = last ? nB : cB + (size_t)(t + 2) * kstep;
            const char* a3 = a2 + kstep; const char* b3 = b2 + kstep;
            if (last && has_next) S.a_ready(nxt);
            if constexpr (SP2) {
            PG8_LDB(B0, 0, 0); PG8_LDB(B1, 0, 1); PG8_SCHED; PG8_LDA(At, 0, 0); PG8_STAGE(PG8_SA(1, 1), a1 + hstep, voffA);
            PG8_WAIT_V(8); PG8_WAIT_L(0); PG8_BAR; PG8_MMA(0, 0, At, B0); PG8_MMA(0, 1, At, B1); PG8_BAR; PG8_SCHED;
            PG8_LDA(At, 0, 1); PG8_STAGE(PG8_SB(0, 0), b2, voffB); PG8_STAGE(PG8_SB(0, 1), b2 + hstep, voffB); PG8_STAGE(PG8_SA(0, 0), a2, voffA);
            PG8_WAIT_V(8); PG8_WAIT_L(0); PG8_BAR; PG8_MMA(1, 0, At, B0); PG8_MMA(1, 1, At, B1); PG8_BAR; PG8_SCHED;
            PG8_LDB(B0, 1, 0); PG8_LDB(B1, 1, 1); PG8_SCHED; PG8_LDA(At, 1, 0); PG8_STAGE(PG8_SA(0, 1), a2 + hstep, voffA);
            PG8_WAIT_V(8); PG8_WAIT_L(0); PG8_BAR; PG8_MMA(0, 0, At, B0); PG8_MMA(0, 1, At, B1); PG8_BAR; PG8_SCHED;
            PG8_LDA(At, 1, 1); PG8_STAGE(PG8_SB(1, 0), b3, voffB); PG8_STAGE(PG8_SB(1, 1), b3 + hstep, voffB); PG8_STAGE(PG8_SA(1, 0), a3, voffA);
            PG8_WAIT_V(8); PG8_WAIT_L(0); PG8_BAR; PG8_MMA(1, 0, At, B0); PG8_MMA(1, 1, At, B1); PG8_BAR; PG8_SCHED;
            } else {
            PG8_LDB(B0, 0, 0); PG8_SCHED; PG8_LDA(At, 0, 0); PG8_STAGE(PG8_SA(1, 1), a1 + hstep, voffA);
            PG8_WAIT_L(8); PG8_BAR; PG8_WAIT_L(0); PG8_MMA(0, 0, At, B0); PG8_BAR; PG8_SCHED;
            PG8_LDB(B1, 0, 1); PG8_STAGE(PG8_SB(0, 0), b2, voffB);
            PG8_BAR; PG8_WAIT_L(0); PG8_MMA(0, 1, At, B1); PG8_BAR;
            PG8_LDA(At, 0, 1); PG8_STAGE(PG8_SA(0, 0), a2, voffA);
            PG8_BAR; PG8_WAIT_L(0); PG8_MMA(1, 0, At, B0); PG8_BAR; PG8_SCHED;
            PG8_STAGE(PG8_SB(0, 1), b2 + hstep, voffB);
            PG8_WAIT_V(6); PG8_BAR; PG8_MMA(1, 1, At, B1); PG8_BAR;
            PG8_LDB(B0, 1, 0); PG8_SCHED; PG8_LDA(At, 1, 0); PG8_STAGE(PG8_SA(0, 1), a2 + hstep, voffA);
            PG8_WAIT_L(8); PG8_BAR; PG8_WAIT_L(0); PG8_MMA(0, 0, At, B0); PG8_BAR; PG8_SCHED;
            PG8_LDB(B1, 1, 1); PG8_STAGE(PG8_SB(1, 0), b3, voffB);
            PG8_BAR; PG8_WAIT_L(0); PG8_MMA(0, 1, At, B1); PG8_BAR;
            PG8_LDA(At, 1, 1); PG8_STAGE(PG8_SA(1, 0), a3, voffA);
            PG8_BAR; PG8_WAIT_L(0); PG8_MMA(1, 0, At, B0); PG8_BAR; PG8_SCHED;
            PG8_STAGE(PG8_SB(1, 1), b3 + hstep, voffB);
            PG8_WAIT_V(6); PG8_BAR; PG8_MMA(1, 1, At, B1); PG8_BAR;
            }
        }
        if constexpr (ALIGN_EPI) { if (wr == 0) PG8_BAR; }
        if constexpr (!Epi::AFTER_DRAIN) { E(acc, cur, wr, wc, fr, fq); S.done(cur); }
        if (!has_next) break;
#pragma unroll
        for (int a = 0; a < 2; ++a)
#pragma unroll
            for (int b = 0; b < 2; ++b)
#pragma unroll
                for (int m = 0; m < 4; ++m)
#pragma unroll
                    for (int n = 0; n < 2; ++n) acc[a][b][m][n] = (f32x4){0.f, 0.f, 0.f, 0.f};
        cur = nxt; cA = nA; cB = nB; ++ui;
        if constexpr (ALIGN_EPI) { if (wr == 1) PG8_BAR; }
    }
    PG8_WAIT_V(0);
    if constexpr (!ALIGN_EPI) { if (wr == 0) PG8_BAR; }
    PG8_BAR;
    if constexpr (Epi::AFTER_DRAIN) { E.fused(acc, cur, wr, wc, fr, fq, lds, wid, lane); S.done(cur); }
#undef PG8_SA
#undef PG8_SB
#undef PG8_STAGE
#undef PG8_LDA
#undef PG8_LDB
#undef PG8_MMA
#undef PG8_WAIT_V
#undef PG8_WAIT_L
#undef PG8_BAR
#undef PG8_SCHED
}
}

template <class Epi>
__device__ __forceinline__ void gemm_run(unsigned char* lds, const bf16_t* A, const bf16_t* Bt, int M, int N, int Ktot, int KS, const Epi& E) {
    pg8::StaticOrder S; S.init(M, N, KS, (int)gridDim.x, (int)blockIdx.x);
    pg8::Gemm g; g.A = A; g.Bt = Bt; g.M = M; g.N = N; g.K = Ktot / KS; g.ld = Ktot;
    __syncthreads();
    pg8::gemm_phase<Epi, pg8::StaticOrder, true, true>((PG8_LAS unsigned char*)lds, g, S, E);
    __syncthreads();
}

__device__ void phase_lca(const Params& p, int j) {
  const bf16_t* ZT = (const bf16_t*)(p.ws + WS_ZT); bf16_t* U = (bf16_t*)(p.ws + WS_U); bf16_t* X0 = (bf16_t*)(p.ws + WS_X0C);
  const float* cw = p.in[I_HCW] + (size_t)j * 3 * 3072; const float* cb = p.in[I_HCB] + (size_t)j * 3072;
  for (int i = blockIdx.x * 512 + tidx(); i < D * MTOK; i += gridDim.x * 512) {
    const int c = i >> 13, m = i & 8191;
    const int L = m < NPR ? 256 : 1024, t = m & (L - 1);
    float sc[3];
#pragma unroll
    for (int part = 0; part < 3; ++part) {
      const int ch = part * 1024 + c;
      const bf16_t* z = ZT + (size_t)ch * MTOK + m;
      const float zm = t > 0 ? bf2f(z[-1]) : 0.f, z0 = bf2f(z[0]), zp = t < L - 1 ? bf2f(z[1]) : 0.f;
      sc[part] = zm * cw[ch] + z0 * cw[3072 + ch] + zp * cw[2 * 3072 + ch] + cb[ch];
    }
    X0[i] = f2bf(sc[0]); U[i] = f2bf(sc[1] * sc[2]);
  }
}
__device__ void phase_lcb(const Params& p, int j) {
  const bf16_t* U = (const bf16_t*)(p.ws + WS_U); const bf16_t* X0 = (const bf16_t*)(p.ws + WS_X0C); bf16_t* YG = (bf16_t*)(p.ws + WS_YG);
  const float* RN = (const float*)(p.ws + WS_RNORM); const float* bias = p.in[I_HBIAS] + j * D;
  for (int i = blockIdx.x * 512 + tidx(); i < D * MTOK; i += gridDim.x * 512) {
    const int c = i >> 13, m = i & 8191;
    const int lsel = m < NPR ? 0 : 1, L = lsel ? 1024 : 256, t = m & (L - 1);
    const float* g2 = (const float*)(p.ws + WS_FILT) + (size_t)j * FILT_J + (lsel ? FILT_L1 : 0) + (size_t)c * (2 * L) + L + t;
    const bf16_t* u = U + (size_t)c * MTOK + (m - t);
    float acc = 0.f;
    for (int s = 0; s < L; ++s) acc += g2[-s] * bf2f(u[s]);
    const float uu = bf2f(u[t]);
    const float y = acc * RN[(j * 2 + lsel) * 1024 + c] + uu * bias[c];
    YG[(size_t)m * D + c] = f2bf(bf2f(X0[i]) * y);
  }
}


#define LDSP __attribute__((address_space(3)))
constexpr int LC_FR = 0, LC_U = 66176, LC_X0 = LC_U + 20480, LC_S = LC_X0 + 20480, LC_Z = LC_S + 17408;
__device__ void phase_lc(const Params& p, int j, unsigned char* lds_) {
  LDSP unsigned char* lds = (LDSP unsigned char*)lds_;
  const int tid = tidx(), lane = tid & 63, wid = tid >> 6, n = lane & 31, hi = lane >> 5;
  const bf16_t* ZT = (const bf16_t*)(p.ws + WS_ZT); bf16_t* YG = (bf16_t*)(p.ws + WS_YG);
  const float* cw = p.in[I_HCW] + (size_t)j * 3 * 3072; const float* cb = p.in[I_HCB] + (size_t)j * 3072;
  for (int q = blockIdx.x; q < 1024; q += gridDim.x) {
    const int lsel = q < 512 ? 1 : 0, qq = q & 511, cg = qq >> 2, tb = (lsel ? 4 : 0) + (qq & 3);
    const int L = lsel ? 1024 : 256, P = L >> 5, REC = 4 * L + 40, c0 = cg * 8;
    const size_t m0 = (size_t)tb * 1024;
    __syncthreads();
    {
      const u32x4* src = (const u32x4*)((const bf16_t*)(p.ws + WS_FRG) + (size_t)j * FRG_J + (lsel ? FRG_L1 : 0) + (size_t)c0 * REC);
      LDSP u32x4* dst = (LDSP u32x4*)(lds + LC_FR);
      for (int i = tid; i < REC; i += 512) dst[i] = src[i];
    }
    for (int task = tid; task < 1024; task += 512) {
      const int ch = task >> 7, tok0 = (task & 127) * 8;
      const bool first = (tok0 & (L - 1)) == 0, last = ((tok0 + 8) & (L - 1)) == 0;
      float sc[3][8];
#pragma unroll
      for (int part = 0; part < 3; ++part) {
        const int chn = part * 1024 + c0 + ch;
        const bf16_t* z = ZT + (size_t)chn * MTOK + m0 + tok0;
        const u32x4 w = *(const u32x4*)z;
        float zv[10];
        zv[0] = first ? 0.f : bf2f(z[-1]); zv[9] = last ? 0.f : bf2f(z[8]);
        zv[1] = __uint_as_float(w.x << 16); zv[2] = __uint_as_float(w.x & 0xFFFF0000u); zv[3] = __uint_as_float(w.y << 16); zv[4] = __uint_as_float(w.y & 0xFFFF0000u);
        zv[5] = __uint_as_float(w.z << 16); zv[6] = __uint_as_float(w.z & 0xFFFF0000u); zv[7] = __uint_as_float(w.w << 16); zv[8] = __uint_as_float(w.w & 0xFFFF0000u);
        const float w0 = cw[chn], w1 = cw[3072 + chn], w2 = cw[2 * 3072 + chn], bb = cb[chn];
#pragma unroll
        for (int i = 0; i < 8; ++i) sc[part][i] = zv[i] * w0 + zv[i + 1] * w1 + zv[i + 2] * w2 + bb;
      }
      u32x4 xo, uo;
      xo.x = pack2(sc[0][0], sc[0][1]); xo.y = pack2(sc[0][2], sc[0][3]); xo.z = pack2(sc[0][4], sc[0][5]); xo.w = pack2(sc[0][6], sc[0][7]);
      uo.x = pack2(sc[1][0] * sc[2][0], sc[1][1] * sc[2][1]); uo.y = pack2(sc[1][2] * sc[2][2], sc[1][3] * sc[2][3]);
      uo.z = pack2(sc[1][4] * sc[2][4], sc[1][5] * sc[2][5]); uo.w = pack2(sc[1][6] * sc[2][6], sc[1][7] * sc[2][7]);
      const int po = (ch * 1280 + tok0 + 8 * (tok0 >> 5)) * 2;
      *(LDSP u32x4*)(lds + LC_U + po) = uo; *(LDSP u32x4*)(lds + LC_X0 + po) = xo;
    }
    if (tid < 4) ((LDSP unsigned*)(lds + LC_Z))[tid] = 0u;
    __syncthreads();
    f32x16 acc;
#pragma unroll
    for (int r = 0; r < 16; ++r) acc[r] = 0.f;
    {
      const int par = n & 1;
      LDSP const unsigned char* fa = lds + LC_FR + wid * (REC * 2) + (par ? (2 * L + 40) * 2 : 0) + 2 * (L - n - par + 8 * hi);
      LDSP const unsigned char* ub = lds + LC_U + wid * 2560 + (40 * n + 8 * hi) * 2;
      const int ti = n & (P - 1);
      for (int dl = -(P - 1); dl <= P - 1; ++dl) {
        const bool valid = (unsigned)(ti - dl) < (unsigned)P;
#pragma unroll
        for (int ks = 0; ks < 2; ++ks) {
          LDSP const volatile unsigned* ap = (LDSP const volatile unsigned*)(fa + 2 * (-32 * dl + 16 * ks));
          u32x4 aw; aw.x = ap[0]; aw.y = ap[1]; aw.z = ap[2]; aw.w = ap[3];
          LDSP const unsigned char* bp = valid ? (ub + (-40 * dl + 16 * ks) * 2) : (lds + LC_Z);
          const bf16x8 bfrag = *(LDSP const bf16x8*)bp;
          acc = __builtin_amdgcn_mfma_f32_32x32x16_bf16(__builtin_bit_cast(bf16x8, aw), bfrag, acc, 0, 0, 0);
        }
      }
    }
    {
      const float rn = ((const float*)(p.ws + WS_RNORM))[(j * 2 + lsel) * 1024 + c0 + wid], bs = p.in[I_HBIAS][j * D + c0 + wid];
      LDSP const bf16_t* uu = (LDSP const bf16_t*)(lds + LC_U) + wid * 1280 + 40 * n;
      LDSP const bf16_t* xx = (LDSP const bf16_t*)(lds + LC_X0) + wid * 1280 + 40 * n;
      LDSP bf16_t* so = (LDSP bf16_t*)(lds + LC_S) + wid * 1088 + 34 * n;
#pragma unroll
      for (int r = 0; r < 16; ++r) {
        const int row = (r & 3) + 8 * (r >> 2) + 4 * hi;
        const float y = acc[r] * rn + bf2f(uu[row]) * bs;
        so[row] = f2bf(bf2f(xx[row]) * y);
      }
    }
    __syncthreads();
    for (int tok = tid; tok < 1024; tok += 512) {
      LDSP const bf16_t* so = (LDSP const bf16_t*)(lds + LC_S) + tok + 2 * (tok >> 5);
      u32x4 w;
      w.x = (unsigned)so[0] | ((unsigned)so[1088] << 16); w.y = (unsigned)so[2 * 1088] | ((unsigned)so[3 * 1088] << 16);
      w.z = (unsigned)so[4 * 1088] | ((unsigned)so[5 * 1088] << 16); w.w = (unsigned)so[6 * 1088] | ((unsigned)so[7 * 1088] << 16);
      *(u32x4*)(YG + (m0 + tok) * D + c0) = w;
    }
  }
  __syncthreads();
}

__device__ void phase_qkvpost(const Params& p, int j) {
  const int lane = tidx() & 63, wid = tidx() >> 6;
  const unsigned* QKV = (const unsigned*)(p.ws + WS_QKV);
  unsigned* Q = (unsigned*)(p.ws + WS_Q); unsigned* KP = (unsigned*)(p.ws + WS_KP); unsigned* VP = (unsigned*)(p.ws + WS_VP);
  unsigned* KS = (unsigned*)(p.ws + WS_KS) + (size_t)j * 4 * 1536 * 128; unsigned* VS = (unsigned*)(p.ws + WS_VS) + (size_t)j * 4 * 1536 * 128;
  const float* qn = p.in[I_QN] + j * 128; const float* kn = p.in[I_KN] + j * 128;
  float* newk = p.out + (size_t)2 * NPR * D; float* newv = newk + (size_t)16 * 2 * 256 * 256;
  const float qg0 = qn[2 * lane], qg1 = qn[2 * lane + 1], kg0 = kn[2 * lane], kg1 = kn[2 * lane + 1];
  const float freq = exp2f(-(float)(lane & 31) * 0.41524101186092029f);
  for (int m = blockIdx.x * 8 + wid; m < MTOK; m += gridDim.x * 8) {
    const bool smp = m >= NPR;
    float cs = 1.f, sn = 0.f;
    if (smp) { const int t = (m - NPR) & 1023; const float pos = (float)(lane < 32 ? (t >> 6) : (t & 63)); const float rev = (pos * freq) * INV_2PI; cs = cos_rev(rev); sn = sin_rev(rev); }
    for (int s = 0; s < 12; ++s) {
      const unsigned raw = QKV[(size_t)m * 768 + s * 64 + lane];
      float x0 = __uint_as_float(raw << 16), x1 = __uint_as_float(raw & 0xFFFF0000u);
      if (s < 10) {
        const float ss = wave_sum(x0 * x0 + x1 * x1);
        const float r = rsqrtf(ss * (1.f / 128.f) + EPS);
        x0 = x0 * r * (s < 8 ? qg0 : kg0); x1 = x1 * r * (s < 8 ? qg1 : kg1);
        if (smp) { const float a = x0, b = x1; x0 = a * cs - b * sn; x1 = a * sn + b * cs; }
      }
      const unsigned w = pack2(x0, x1);
      if (s < 8) Q[(size_t)m * 512 + s * 64 + lane] = w;
      else {
        const int kv = (s - 8) & 1; const bool isk = s < 10;
        if (!smp) {
          (isk ? KP : VP)[(size_t)m * 128 + kv * 64 + lane] = w;
          const int b = m >> 8, t = m & 255;
          float* o = (isk ? newk : newv) + ((((size_t)b * 2 + j) * 256 + t) * 2 + kv) * 128 + 2 * lane;
          o[0] = x0; o[1] = x1;
        } else {
          const int b = (m - NPR) >> 10, t = (m - NPR) & 1023;
          (isk ? KS : VS)[((size_t)b * 1536 + t) * 128 + kv * 64 + lane] = w;
        }
      }
    }
  }
}

__device__ void phase_att_naive(const Params& p, int j, unsigned char* lds) {
  const int lane = tidx() & 63, wid = tidx() >> 6;
  float* qs = (float*)lds + wid * 1664; float* sl = qs + 128;
  const bf16_t* Q = (const bf16_t*)(p.ws + WS_Q); bf16_t* O = (bf16_t*)(p.ws + WS_O);
  const bf16_t* KP = (const bf16_t*)(p.ws + WS_KP); const bf16_t* VP = (const bf16_t*)(p.ws + WS_VP);
  const bf16_t* KS = (const bf16_t*)(p.ws + WS_KS) + (size_t)j * 4 * 1536 * 256; const bf16_t* VS = (const bf16_t*)(p.ws + WS_VS) + (size_t)j * 4 * 1536 * 256;
  const float scale = 0.08838834764831845f;
  for (int u = blockIdx.x * 8 + wid; u < MTOK * 8; u += gridDim.x * 8) {
    const int m = u >> 3, h = u & 7, kv = h >> 2;
    const bool smp = m >= NPR;
    const int nk = smp ? 1536 : 256;
    const size_t kb = smp ? ((size_t)((m - NPR) >> 10) * 1536) * 256 : ((size_t)(m >> 8) * 256) * 256;
    const bf16_t* Kb = (smp ? KS : KP) + kb + kv * 128; const bf16_t* Vb = (smp ? VS : VP) + kb + kv * 128;
    { const unsigned raw = *(const unsigned*)(Q + (size_t)m * D + h * 128 + 2 * lane); qs[2 * lane] = __uint_as_float(raw << 16); qs[2 * lane + 1] = __uint_as_float(raw & 0xFFFF0000u); }
    float mx = -1e30f;
    for (int k = lane; k < nk; k += 64) {
      const bf16_t* kr = Kb + (size_t)k * 256;
      float acc = 0.f;
      for (int d0 = 0; d0 < 128; d0 += 8) {
        const u32x4 w = *(const u32x4*)(kr + d0);
        acc += qs[d0 + 0] * __uint_as_float(w.x << 16) + qs[d0 + 1] * __uint_as_float(w.x & 0xFFFF0000u)
             + qs[d0 + 2] * __uint_as_float(w.y << 16) + qs[d0 + 3] * __uint_as_float(w.y & 0xFFFF0000u)
             + qs[d0 + 4] * __uint_as_float(w.z << 16) + qs[d0 + 5] * __uint_as_float(w.z & 0xFFFF0000u)
             + qs[d0 + 6] * __uint_as_float(w.w << 16) + qs[d0 + 7] * __uint_as_float(w.w & 0xFFFF0000u);
      }
      acc *= scale; sl[k] = acc; mx = fmaxf(mx, acc);
    }
    mx = wave_max(mx);
    float sum = 0.f;
    for (int k = lane; k < nk; k += 64) { const float e = expf(sl[k] - mx); sl[k] = e; sum += e; }
    sum = wave_sum(sum);
    float a0 = 0.f, a1 = 0.f;
    for (int k = 0; k < nk; ++k) {
      const float pk = sl[k];
      const unsigned raw = *(const unsigned*)(Vb + (size_t)k * 256 + 2 * lane);
      a0 += pk * __uint_as_float(raw << 16); a1 += pk * __uint_as_float(raw & 0xFFFF0000u);
    }
    const float inv = 1.f / sum;
    *(unsigned*)(O + (size_t)m * D + h * 128 + 2 * lane) = pack2(a0 * inv, a1 * inv);
  }
}


namespace att {
typedef unsigned short bf16;
constexpr int   D = 128, NW = 8, QBLK = 32, KVBLK = 64;
constexpr float SCALE = 0.088388347648318440f;
constexpr float THR = 8.f;
constexpr int SDEPTH = 2;
constexpr int LDQ = 1024, LDK = 256, LDO = 1024;
constexpr size_t SHM_V = KVBLK * D * 2, SHM_K = KVBLK * D * 2, SHM_ATTN = 2 * SHM_V + 2 * SHM_K + NW * 64 * 4;

using s16x4  = __attribute__((ext_vector_type(4))) short;
using f32x16 = __attribute__((ext_vector_type(16))) float;
using f32x8  = __attribute__((ext_vector_type(8))) float;

#define KSWZ(row, colB) ((row) * 256 + ((colB) ^ (((row) & 7) << 4)))
#define SBAR() __builtin_amdgcn_sched_barrier(0)
__device__ __forceinline__ int crow(int r, int hi) { return (r & 3) + 8 * (r >> 2) + 4 * hi; }
__device__ __forceinline__ unsigned cvtpk(float lo, float hi) {
  unsigned r; asm volatile("v_cvt_pk_bf16_f32 %0, %1, %2" : "=v"(r) : "v"(lo), "v"(hi)); return r;
}
template <typename TIn> struct Stage;
template <> struct Stage<bf16>  { using T = bf16x8;
  __device__ static __forceinline__ T ld8(const bf16* p) { return *reinterpret_cast<const bf16x8*>(p); }
  __device__ static __forceinline__ bf16x8 tobf(T x) { return x; } };
template <> struct Stage<float> { using T = f32x8;
  __device__ static __forceinline__ T ld8(const float* p) { return *reinterpret_cast<const f32x8*>(p); }
  __device__ static __forceinline__ bf16x8 tobf(T x) {
    u32x4 w = {cvtpk(x[0], x[1]), cvtpk(x[2], x[3]), cvtpk(x[4], x[5]), cvtpk(x[6], x[7])}; return *reinterpret_cast<bf16x8*>(&w); } };

__device__ __forceinline__ void partialSM(f32x16& p0, f32x16& p1, float& m_reg, float& mn, float& alpha) {
  constexpr float C = SCALE * 1.4426950408889634f;
  float pmax = p0[0]; for (int r = 1; r < 16; ++r) pmax = fmaxf(pmax, p0[r]); for (int r = 0; r < 16; ++r) pmax = fmaxf(pmax, p1[r]);
  { auto rr = __builtin_amdgcn_permlane32_swap(__float_as_uint(pmax), __float_as_uint(pmax), false, false);
    pmax = fmaxf(__uint_as_float(rr[0]), __uint_as_float(rr[1])); }
  if (__builtin_expect(__all(pmax - m_reg <= THR / SCALE), 1)) { mn = m_reg; alpha = 1.f; }
  else { mn = fmaxf(m_reg, pmax); alpha = __builtin_amdgcn_exp2f((m_reg - mn) * C); m_reg = mn; }
  float mnC = -mn * C;
  for (int r = 0; r < 16; ++r) p0[r] = fmaf(p0[r], C, mnC); for (int r = 0; r < 16; ++r) p1[r] = fmaf(p1[r], C, mnC);
  for (int r = 0; r < 16; ++r) p0[r] = __builtin_amdgcn_exp2f(p0[r]);
}
__device__ __forceinline__ void finishSM(f32x16& p0, f32x16& p1, float alpha, float& l_reg, bf16x8& pa0, bf16x8& pa1, bf16x8& pa2, bf16x8& pa3) {
  for (int r = 0; r < 16; ++r) p1[r] = __builtin_amdgcn_exp2f(p1[r]);
  float ps = 0; for (int r = 0; r < 16; ++r) ps += p0[r]; for (int r = 0; r < 16; ++r) ps += p1[r];
  { auto rr = __builtin_amdgcn_permlane32_swap(__float_as_uint(ps), __float_as_uint(ps), false, false);
    ps = __uint_as_float(rr[0]) + __uint_as_float(rr[1]); }
  l_reg = l_reg * alpha + ps;
#define PK4(P, BASE, OUT) do { unsigned a0 = cvtpk(P[BASE + 0], P[BASE + 1]), a1 = cvtpk(P[BASE + 2], P[BASE + 3]);   \
    unsigned b0 = cvtpk(P[BASE + 4], P[BASE + 5]), b1 = cvtpk(P[BASE + 6], P[BASE + 7]);                              \
    auto r0 = __builtin_amdgcn_permlane32_swap(a0, b0, false, false); auto r1 = __builtin_amdgcn_permlane32_swap(a1, b1, false, false); \
    u32x4 w = {r0[0], r1[0], r0[1], r1[1]}; OUT = *reinterpret_cast<bf16x8*>(&w); } while (0)
  PK4(p0, 0, pa0); PK4(p0, 8, pa1); PK4(p1, 0, pa2); PK4(p1, 8, pa3);
#undef PK4
}
__device__ __forceinline__ void qkt(f32x16& p0, f32x16& p1, const bf16* Ks, const bf16x8* qr, int r32, int hi) {
  p0 = f32x16{}; p1 = f32x16{};
  for (int d0 = 0; d0 < 8; ++d0) { int cb = (d0 * 16 + hi * 8) * 2;
    bf16x8 b0 = *reinterpret_cast<const bf16x8*>((const char*)Ks + KSWZ(r32, cb));
    bf16x8 b1 = *reinterpret_cast<const bf16x8*>((const char*)Ks + KSWZ(32 + r32, cb));
    p0 = __builtin_amdgcn_mfma_f32_32x32x16_bf16(b0, qr[d0], p0, 0, 0, 0);
    p1 = __builtin_amdgcn_mfma_f32_32x32x16_bf16(b1, qr[d0], p1, 0, 0, 0); }
}
__device__ __forceinline__ int v_st(int k, int c) { const int kk = (k & ~0xC) | ((k & 4) << 1) | ((k & 8) >> 1); return ((kk >> 3) * 4 + (c >> 5)) * 512 + ((kk & 7) * 32 + (c & 31)) * 2; }
__device__ __forceinline__ int v_rd_base(int lane) { return ((lane & 3) << 3) | (((lane >> 2) & 3) << 6) | (((lane >> 4) & 1) << 5) | (((lane >> 5) & 1) << 8); }
constexpr int v_rd_off(int d0, int ks, int half) { return d0 * 512 + ks * 4096 + half * 2048; }
template <int OFF> __device__ __forceinline__ s16x4 tr_read(int vb) {
  s16x4 r; asm volatile("ds_read_b64_tr_b16 %0, %1 offset:%2" : "=&v"(r) : "v"(vb), "i"(OFF) : "memory"); return r;
}
template <int D0> __device__ __forceinline__ void pv_one(f32x16& od, int vb, bf16x8 pa0, bf16x8 pa1, bf16x8 pa2, bf16x8 pa3) {
  const s16x4 l0 = tr_read<v_rd_off(D0, 0, 0)>(vb), h0 = tr_read<v_rd_off(D0, 0, 1)>(vb), l1 = tr_read<v_rd_off(D0, 1, 0)>(vb), h1 = tr_read<v_rd_off(D0, 1, 1)>(vb);
  const s16x4 l2 = tr_read<v_rd_off(D0, 2, 0)>(vb), h2 = tr_read<v_rd_off(D0, 2, 1)>(vb), l3 = tr_read<v_rd_off(D0, 3, 0)>(vb), h3 = tr_read<v_rd_off(D0, 3, 1)>(vb);
  asm volatile("s_waitcnt lgkmcnt(0)" ::: "memory"); SBAR();
#define PK(L, H) (bf16x8){L[0], L[1], L[2], L[3], H[0], H[1], H[2], H[3]}
  od = __builtin_amdgcn_mfma_f32_32x32x16_bf16(pa0, PK(l0, h0), od, 0, 0, 0);
  od = __builtin_amdgcn_mfma_f32_32x32x16_bf16(pa1, PK(l1, h1), od, 0, 0, 0);
  od = __builtin_amdgcn_mfma_f32_32x32x16_bf16(pa2, PK(l2, h2), od, 0, 0, 0);
  od = __builtin_amdgcn_mfma_f32_32x32x16_bf16(pa3, PK(l3, h3), od, 0, 0, 0);
#undef PK
}
__device__ __forceinline__ void pv_d0(f32x16* o, int vb, bf16x8 pa0, bf16x8 pa1, bf16x8 pa2, bf16x8 pa3) {
  pv_one<0>(o[0], vb, pa0, pa1, pa2, pa3); pv_one<1>(o[1], vb, pa0, pa1, pa2, pa3); pv_one<2>(o[2], vb, pa0, pa1, pa2, pa3); pv_one<3>(o[3], vb, pa0, pa1, pa2, pa3);
}

template <typename TQ>
__device__ __forceinline__ void attn_dense_body(const TQ* __restrict__ Qb, const bf16* __restrict__ Kh, const bf16* __restrict__ Vh,
                                                bf16* __restrict__ Ob, int seq, char* lds) {
  using St = Stage<bf16>; using SQ = Stage<TQ>;
  const int tid = tidx(), wid = tid >> 6, lane = tid & 63, r32 = lane & 31, hi = lane >> 5;
  bf16* V_lds = (bf16*)lds; bf16* K_lds = (bf16*)(lds + 2 * SHM_V);
  float* ws = (float*)(lds + 2 * SHM_V + 2 * SHM_K) + wid * 64; float* li_l = ws; float* al_l = ws + 32;
  float m_reg = -1e30f, l_reg = 0; f32x16 o[4] = {}; bf16x8 qr[8];
  const TQ* Qw = Qb + (long)(wid * QBLK + r32) * LDQ + hi * 8;
#pragma unroll
  for (int d0 = 0; d0 < 8; ++d0) qr[d0] = SQ::tobf(SQ::ld8(Qw + d0 * 16));
  const int sr = tid >> 4, sc = (tid & 15) * 8, vst0 = v_st(sr, sc), vst1 = v_st(32 + sr, sc);
  const int vb0 = (int)(uintptr_t)V_lds + v_rd_base(lane);
  struct { typename St::T vs0, vs1, ks0, ks1; } sr_[SDEPTH];
#define SLOAD(i, k0) do { sr_[i].vs0 = St::ld8(&Vh[(long)((k0) + sr) * LDK + sc]); sr_[i].vs1 = St::ld8(&Vh[(long)((k0) + 32 + sr) * LDK + sc]); \
    sr_[i].ks0 = St::ld8(&Kh[(long)((k0) + sr) * LDK + sc]); sr_[i].ks1 = St::ld8(&Kh[(long)((k0) + 32 + sr) * LDK + sc]); } while (0)
#define SWRITE(b, i) do { *(bf16x8*)((char*)V_lds + (b) * SHM_V + vst0) = St::tobf(sr_[i].vs0);          \
    *(bf16x8*)((char*)V_lds + (b) * SHM_V + vst1) = St::tobf(sr_[i].vs1); int kc = sc * 2;               \
    *(bf16x8*)((char*)K_lds + (b) * SHM_K + KSWZ(sr, kc)) = St::tobf(sr_[i].ks0);                       \
    *(bf16x8*)((char*)K_lds + (b) * SHM_K + KSWZ(32 + sr, kc)) = St::tobf(sr_[i].ks1); } while (0)
#define SWAIT() do { if constexpr (SDEPTH == 2) asm volatile("s_waitcnt vmcnt(4)" ::: "memory"); else asm volatile("s_waitcnt vmcnt(0)" ::: "memory"); } while (0)
#define RESC(a) do { if (__any((a) < 1.f)) { if (hi == 0) al_l[r32] = (a); asm volatile("s_waitcnt lgkmcnt(0)" ::: "memory"); \
    for (int d = 0; d < 4; ++d) for (int r = 0; r < 16; ++r) o[d][r] *= al_l[crow(r, hi)]; } } while (0)
  f32x16 pA0, pA1, pB0, pB1; float mnA, mnB, alA, alB; bf16x8 pa0, pa1, pa2, pa3; const int NT = seq / KVBLK;
  constexpr int SE = 0, SO = SDEPTH - 1;
  SLOAD(SE, 0); asm volatile("s_waitcnt vmcnt(0)" ::: "memory"); SWRITE(0, SE); __syncthreads();
  qkt(pA0, pA1, K_lds, qr, r32, hi); partialSM(pA0, pA1, m_reg, mnA, alA);
  SLOAD(SO, KVBLK); if constexpr (SDEPTH == 2) { if (2 < NT) SLOAD(SE, 2 * KVBLK); }
  SWAIT(); SWRITE(1, SO); __syncthreads();
  for (int j = 1; j + 1 < NT; j += 2) {
    SBAR(); qkt(pB0, pB1, (bf16*)((char*)K_lds + SHM_K), qr, r32, hi);
    finishSM(pA0, pA1, alA, l_reg, pa0, pa1, pa2, pa3); SBAR();
    SLOAD(SO, (j + SDEPTH) * KVBLK); SBAR();
    pv_d0(o, vb0, pa0, pa1, pa2, pa3); partialSM(pB0, pB1, m_reg, mnB, alB);
    __syncthreads(); SWAIT(); SWRITE(0, SE);
    RESC(alB); __syncthreads();
    SBAR(); qkt(pA0, pA1, K_lds, qr, r32, hi);
    finishSM(pB0, pB1, alB, l_reg, pa0, pa1, pa2, pa3); SBAR();
    if (SDEPTH == 1 || j + 3 < NT) SLOAD(SE, (j + 1 + SDEPTH) * KVBLK); SBAR();
    pv_d0(o, vb0 + (int)SHM_V, pa0, pa1, pa2, pa3); partialSM(pA0, pA1, m_reg, mnA, alA);
    __syncthreads(); SWAIT(); SWRITE(1, SO);
    RESC(alA); __syncthreads();
  }
  SBAR(); qkt(pB0, pB1, (bf16*)((char*)K_lds + SHM_K), qr, r32, hi);
  finishSM(pA0, pA1, alA, l_reg, pa0, pa1, pa2, pa3); SBAR();
  pv_d0(o, vb0, pa0, pa1, pa2, pa3); partialSM(pB0, pB1, m_reg, mnB, alB);
  __syncthreads(); RESC(alB);
  finishSM(pB0, pB1, alB, l_reg, pa0, pa1, pa2, pa3); SBAR();
  pv_d0(o, vb0 + (int)SHM_V, pa0, pa1, pa2, pa3);
  if (hi == 0) li_l[r32] = l_reg; asm volatile("s_waitcnt lgkmcnt(0)" ::: "memory");
  float rli[16];
#pragma unroll
  for (int r = 0; r < 16; ++r) rli[r] = __builtin_amdgcn_rcpf(li_l[crow(r, hi)]);
  bf16* Ow = Ob + (long)(wid * QBLK) * LDO;
#pragma unroll
  for (int r = 0; r < 16; ++r) { int orow = crow(r, hi);
    for (int d0 = 0; d0 < 4; ++d0) Ow[(long)orow * LDO + d0 * 32 + r32] = f2bf(o[d0][r] * rli[r]); }
#undef SLOAD
#undef SWRITE
#undef SWAIT
#undef RESC
}
}

__device__ void phase_att(const Params& p, int j, unsigned char* lds) {
  const bf16_t* Q = (const bf16_t*)(p.ws + WS_Q); bf16_t* O = (bf16_t*)(p.ws + WS_O);
  const bf16_t* KP = (const bf16_t*)(p.ws + WS_KP); const bf16_t* VP = (const bf16_t*)(p.ws + WS_VP);
  const bf16_t* KS = (const bf16_t*)(p.ws + WS_KS) + (size_t)j * 4 * 1536 * 256; const bf16_t* VS = (const bf16_t*)(p.ws + WS_VS) + (size_t)j * 4 * 1536 * 256;
  for (int u = blockIdx.x; u < 256; u += gridDim.x) {
    __syncthreads();
    if (u < 128) {
      const int qb = u & 3, h = (u >> 2) & 7, b = u >> 5, kv = h >> 2;
      const size_t row0 = (size_t)NPR + b * 1024 + qb * 256, kb = ((size_t)b * 1536) * 256 + kv * 128;
      att::attn_dense_body<att::bf16>(Q + row0 * D + h * 128, KS + kb, VS + kb, O + row0 * D + h * 128, 1536, (char*)lds);
    } else {
      const int h = (u - 128) & 7, b = (u - 128) >> 3, kv = h >> 2;
      const size_t row0 = (size_t)b * 256, kb = row0 * 256 + kv * 128;
      att::attn_dense_body<att::bf16>(Q + row0 * D + h * 128, KP + kb, VP + kb, O + row0 * D + h * 128, 256, (char*)lds);
    }
  }
  __syncthreads();
}

__global__ void __launch_bounds__(512, 2) mega(Params p) {
  extern __shared__ __attribute__((aligned(16))) unsigned char lds[];
  cg::grid_group grid = cg::this_grid();
  int ph = 0;
#define RUN(stmt) do { if (ph >= p.ph_lo && ph < p.ph_hi) { stmt; if (ph + 1 < p.ph_hi) grid.sync(); } ++ph; } while (0)
  bf16_t* XN = (bf16_t*)(p.ws + WS_XN); float* Y = (float*)(p.ws + WS_Y); const float* MOD = (const float*)(p.ws + WS_MOD);
  RUN(phase_p0(p, lds));
  RUN(phase_p0b(p));
#pragma unroll 1
  for (int l = 0; l < 4; ++l) {
    const int j = l >> 1;
    RUN(phase_nm(p, l, 0));
    if ((l & 1) == 0) {
      RUN(gemm_run(lds, (const bf16_t*)(p.ws + WS_WIN) + (size_t)j * 3072 * D, XN, 3072, MTOK, D, 1, pg8::EpiBf16{(bf16_t*)(p.ws + WS_ZT), MTOK}));
      RUN(phase_lc(p, j, lds));
      RUN(gemm_run(lds, (const bf16_t*)(p.ws + WS_YG), (const bf16_t*)(p.ws + WS_WHO) + (size_t)j * D * D, MTOK, D, D, 2, pg8::EpiGate<true>{Y, MOD + (size_t)l * 5 * 6144 + 2048}));
    } else {
      RUN(gemm_run(lds, XN, (const bf16_t*)(p.ws + WS_WQKV) + (size_t)j * QKVD * D, MTOK, QKVD, D, 1, pg8::EpiBf16{(bf16_t*)(p.ws + WS_QKV), QKVD}));
      RUN(phase_qkvpost(p, j));
      RUN(phase_att(p, j, lds));
      RUN(gemm_run(lds, (const bf16_t*)(p.ws + WS_O), (const bf16_t*)(p.ws + WS_WAO) + (size_t)j * D * D, MTOK, D, D, 2, pg8::EpiGate<true>{Y, MOD + (size_t)l * 5 * 6144 + 2048}));
    }
    RUN(phase_nm(p, l, 1));
    RUN(gemm_run(lds, XN, (const bf16_t*)(p.ws + WS_WGU) + (size_t)l * 2 * DFF * D, MTOK, 2 * DFF, D, 1, pg8::EpiSwiglu{(bf16_t*)(p.ws + WS_H)}));
    RUN(gemm_run(lds, (const bf16_t*)(p.ws + WS_H), (const bf16_t*)(p.ws + WS_WDN) + (size_t)l * D * DFF, MTOK, D, DFF, 2, pg8::EpiGate<true>{Y, MOD + (size_t)l * 5 * 6144 + 5 * 1024}));
  }
  RUN(phase_final(p));
#undef RUN
}
constexpr int N_PHASES = 2 + 2 * 7 + 2 * 8 + 1;

#ifndef MK_SPLIT
#define MK_SPLIT 0
#endif

extern "C" void kernel_launch(void* const* d_in, const int* in_sizes, int n_in, void* d_out, int out_size, void* d_ws, size_t ws_size, hipStream_t stream) {
  static int grid = 0;
  if (grid == 0) {
    if (n_in != 29 || ws_size < WS_END) { fprintf(stderr, "kernel_launch: n_in %d ws %zu (need 29, >= %zu)\n", n_in, ws_size, (size_t)WS_END); grid = -1; return; }
    int dev = 0, cus = 0, per_cu = 0;
    hipGetDevice(&dev);
    hipDeviceGetAttribute(&cus, hipDeviceAttributeMultiprocessorCount, dev);
    if (hipFuncSetAttribute((const void*)mega, hipFuncAttributeMaxDynamicSharedMemorySize, LDS_BYTES) != hipSuccess) { fprintf(stderr, "kernel_launch: hipFuncSetAttribute failed\n"); grid = -1; return; }
    hipOccupancyMaxActiveBlocksPerMultiprocessor(&per_cu, (const void*)mega, 512, LDS_BYTES);
    if (per_cu < 1) { fprintf(stderr, "kernel_launch: occupancy query says %d blocks per CU\n", per_cu); per_cu = 1; }
    grid = cus * per_cu;
  }
  if (grid < 0) return;
  Params p{};
  for (int i = 0; i < 29; ++i) p.in[i] = (const float*)d_in[i];
  p.out = (float*)d_out; p.ws = (unsigned char*)d_ws;
#if MK_SPLIT
  for (int ph = 0; ph < N_PHASES; ++ph) {
    p.ph_lo = ph; p.ph_hi = ph + 1;
    void* args[] = {&p};
    hipError_t e = hipLaunchCooperativeKernel((const void*)mega, dim3(grid), dim3(512), args, LDS_BYTES, stream);
    if (e != hipSuccess) { fprintf(stderr, "cooperative launch failed: %s (grid %d)\n", hipGetErrorString(e), grid); break; }
  }
#else
  p.ph_lo = 0; p.ph_hi = N_PHASES;
  void* args[] = {&p};
  hipError_t e = hipLaunchCooperativeKernel((const void*)mega, dim3(grid), dim3(512), args, LDS_BYTES, stream);
  if (e != hipSuccess) fprintf(stderr, "cooperative launch failed: %s (grid %d)\n", hipGetErrorString(e), grid);
#endif
}
```

```cpp
#include <hip/hip_runtime.h>
#include <hip/hip_cooperative_groups.h>
#include <cstdio>
#include <cstdint>
namespace cg = cooperative_groups;

typedef unsigned short bf16_t;
typedef short bf16x8 __attribute__((ext_vector_type(8)));
typedef float f32x4 __attribute__((ext_vector_type(4)));
typedef unsigned u32x4 __attribute__((ext_vector_type(4)));
typedef float f32x16 __attribute__((ext_vector_type(16)));

constexpr int D = 1024, MTOK = 8192, NPR = 4096;
constexpr int DFF = 2816, QKVD = 1536;
constexpr float EPS = 1e-6f;
constexpr float MIN_DECAY = -3.0701134573253944f, MAX_DECAY = -15.350567286626972f;

constexpr size_t MiB = 1u << 20;
constexpr size_t WS_MOD = 1 * MiB, WS_MODP = 2 * MiB, WS_FSQP = 6 * MiB, WS_RNORM = 7 * MiB, WS_FILT = 8 * MiB;
constexpr size_t WS_WIN = 28 * MiB, WS_WHO = 40 * MiB, WS_WQKV = 44 * MiB, WS_WAO = 50 * MiB, WS_WGU = 54 * MiB, WS_WDN = 98 * MiB;
constexpr size_t WS_Y = 120 * MiB, WS_XN = 152 * MiB, WS_R = 168 * MiB;
constexpr size_t WS_ZT = WS_R, WS_U = WS_R + 48 * MiB, WS_X0C = WS_R + 64 * MiB, WS_YG = WS_R + 80 * MiB;
constexpr size_t WS_QKV = WS_R, WS_Q = WS_R + 24 * MiB, WS_KP = WS_R + 40 * MiB, WS_VP = WS_R + 42 * MiB, WS_O = WS_R + 44 * MiB;
constexpr size_t WS_H = WS_R;
constexpr size_t WS_KS = WS_R + 96 * MiB, WS_VS = WS_R + 102 * MiB, WS_FRG = WS_R + 108 * MiB, WS_END = WS_R + 130 * MiB;
constexpr size_t FRG_J = 11 * MiB / 2, FRG_L1 = (size_t)1024 * (4 * 256 + 40);
constexpr size_t FILT_J = 10 * MiB / 4;
constexpr size_t FILT_L1 = 1024 * 512;

constexpr int LDS_BYTES = 147456;

struct Params {
  const float* in[29];
  float* out;
  unsigned char* ws;
  int ph_lo, ph_hi;
};
enum { I_XP = 0, I_XS, I_CK, I_CV, I_C, I_CCTX, I_MODW, I_MODB, I_NMIX, I_NFFN, I_HWIN, I_HCW, I_HCB, I_FW1, I_FB1, I_FFREQ, I_FW2, I_FB2, I_FW3,
       I_HBIAS, I_HWOUT, I_WQKV, I_QN, I_KN, I_WAO, I_WG, I_WU, I_WD, I_FN };

__device__ __forceinline__ bf16_t f2bf(float f) { unsigned u = __float_as_uint(f); u += 0x7FFFu + ((u >> 16) & 1u); return (bf16_t)(u >> 16); }
__device__ __forceinline__ float bf2f(bf16_t b) { return __uint_as_float(((unsigned)b) << 16); }
__device__ __forceinline__ unsigned pack2(float lo, float hi) { return (unsigned)f2bf(lo) | ((unsigned)f2bf(hi) << 16); }
__device__ __forceinline__ float wave_sum(float v) {
#pragma unroll
  for (int o = 32; o >= 1; o >>= 1) v += __shfl_xor(v, o);
  return v;
}
__device__ __forceinline__ float wave_max(float v) {
#pragma unroll
  for (int o = 32; o >= 1; o >>= 1) v = fmaxf(v, __shfl_xor(v, o));
  return v;
}
__device__ __forceinline__ int tidx() { int t = threadIdx.x; asm volatile("" : "+v"(t)); return t; }
__device__ __forceinline__ int cond_of(int m) { return m < NPR ? 4 : ((m - NPR) >> 10); }
__device__ __forceinline__ float silu_f(float x) { return x / (1.f + expf(-x)); }
__device__ __forceinline__ float sin_rev(float r) { return __builtin_amdgcn_sinf(r - rintf(r)); }
__device__ __forceinline__ float cos_rev(float r) { return __builtin_amdgcn_cosf(r - rintf(r)); }
constexpr float INV_2PI = 0.15915494309189535f;

__device__ __forceinline__ void cvt_tile(const float* __restrict__ src, int K, int N, int kt, int nt, bf16_t* __restrict__ dst, int mode, float* tile  ) {
  const int tid = tidx();
  const int k0 = kt * 64, n0 = nt * 64;
  {
    const int r = tid >> 4, c4 = (tid & 15) * 4;
#pragma unroll
    for (int h = 0; h < 2; ++h) {
      const int rr = r + 32 * h;
      const f32x4 v = *(const f32x4*)(src + (size_t)(k0 + rr) * N + n0 + c4);
      tile[rr * 65 + c4 + 0] = v[0]; tile[rr * 65 + c4 + 1] = v[1]; tile[rr * 65 + c4 + 2] = v[2]; tile[rr * 65 + c4 + 3] = v[3];
    }
  }
  __syncthreads();
  {
    const int n = tid >> 3, kc = (tid & 7) * 8;
    u32x4 w;
    w.x = pack2(tile[(kc + 0) * 65 + n], tile[(kc + 1) * 65 + n]);
    w.y = pack2(tile[(kc + 2) * 65 + n], tile[(kc + 3) * 65 + n]);
    w.z = pack2(tile[(kc + 4) * 65 + n], tile[(kc + 5) * 65 + n]);
    w.w = pack2(tile[(kc + 6) * 65 + n], tile[(kc + 7) * 65 + n]);
    const int ng = n0 + n;
    const int row = mode == 0 ? ng : ((ng >> 7) * 256 + (ng & 127) + (mode == 2 ? 128 : 0));
    *(u32x4*)(dst + (size_t)row * K + k0 + kc) = w;
  }
  __syncthreads();
}

constexpr int NT_FILT = 320, NT_MOD = 384;
constexpr int NT_WIN = 2 * 16 * 48, NT_WHO = 2 * 16 * 16, NT_WQKV = 2 * 16 * 24, NT_WAO = 2 * 16 * 16, NT_G = 4 * 16 * 44, NT_DN = 4 * 44 * 16;
constexpr int NT_CVT = NT_WIN + NT_WHO + NT_WQKV + NT_WAO + 2 * NT_G + NT_DN;

__device__ void task_cvt(const Params& p, int t, float* tile) {
  if (t < NT_WIN) { const int l = t / (16 * 48), r = t % (16 * 48); cvt_tile(p.in[I_HWIN] + (size_t)l * D * 3072, D, 3072, r / 48, r % 48, (bf16_t*)(p.ws + WS_WIN) + (size_t)l * 3072 * D, 0, tile); return; }
  t -= NT_WIN;
  if (t < NT_WHO) { const int l = t / 256, r = t % 256; cvt_tile(p.in[I_HWOUT] + (size_t)l * D * D, D, D, r / 16, r % 16, (bf16_t*)(p.ws + WS_WHO) + (size_t)l * D * D, 0, tile); return; }
  t -= NT_WHO;
  if (t < NT_WQKV) { const int l = t / (16 * 24), r = t % (16 * 24); cvt_tile(p.in[I_WQKV] + (size_t)l * D * QKVD, D, QKVD, r / 24, r % 24, (bf16_t*)(p.ws + WS_WQKV) + (size_t)l * QKVD * D, 0, tile); return; }
  t -= NT_WQKV;
  if (t < NT_WAO) { const int l = t / 256, r = t % 256; cvt_tile(p.in[I_WAO] + (size_t)l * D * D, D, D, r / 16, r % 16, (bf16_t*)(p.ws + WS_WAO) + (size_t)l * D * D, 0, tile); return; }
  t -= NT_WAO;
  if (t < NT_G) { const int l = t / (16 * 44), r = t % (16 * 44); cvt_tile(p.in[I_WG] + (size_t)l * D * DFF, D, DFF, r / 44, r % 44, (bf16_t*)(p.ws + WS_WGU) + (size_t)l * 2 * DFF * D, 1, tile); return; }
  t -= NT_G;
  if (t < NT_G) { const int l = t / (16 * 44), r = t % (16 * 44); cvt_tile(p.in[I_WU] + (size_t)l * D * DFF, D, DFF, r / 44, r % 44, (bf16_t*)(p.ws + WS_WGU) + (size_t)l * 2 * DFF * D, 2, tile); return; }
  t -= NT_G;
  { const int l = t / (44 * 16), r = t % (44 * 16); cvt_tile(p.in[I_WD] + (size_t)l * DFF * D, DFF, D, r / 16, r % 16, (bf16_t*)(p.ws + WS_WDN) + (size_t)l * D * DFF, 0, tile); }
}

__device__ void task_mod(const Params& p, int t, float* sl  ) {
  const int tid = tidx();
  const int l = t / 96, rem = t % 96, cb = rem / 8, kc = rem % 8;
  __syncthreads();
  for (int i = tid; i < 640; i += 512) {
    const int j = i >> 7, k = kc * 128 + (i & 127);
    const float x = j < 4 ? p.in[I_C][j * D + k] : p.in[I_CCTX][k];
    sl[i] = silu_f(x);
  }
  __syncthreads();
  const int n = cb * 512 + tid;
  const float* w = p.in[I_MODW] + ((size_t)l * D + kc * 128) * 6144 + n;
  float a0 = 0.f, a1 = 0.f, a2 = 0.f, a3 = 0.f, a4 = 0.f;
#pragma unroll 4
  for (int k = 0; k < 128; ++k) {
    const float wv = w[(size_t)k * 6144];
    a0 += sl[k] * wv; a1 += sl[128 + k] * wv; a2 += sl[256 + k] * wv; a3 += sl[384 + k] * wv; a4 += sl[512 + k] * wv;
  }
  float* o = (float*)(p.ws + WS_MODP) + ((size_t)(kc * 4 + l) * 5) * 6144 + n;
  o[0] = a0; o[6144] = a1; o[2 * 6144] = a2; o[3 * 6144] = a3; o[4 * 6144] = a4;
}

__device__ void task_filt(const Params& p, int t, float* h1  , float* h2  ) {
  const int tid = tidx(), lane = tid & 63, wid = tid >> 6;
  const int combo = t >> 3, nchunk = t & 7;
  const int j = combo / 20, r = combo % 20;
  const int lsel = r < 4 ? 0 : 1, tchunk = r < 4 ? r : r - 4, L = lsel ? 1024 : 256;
  const int tt = lane, tpos = tchunk * 64 + tt;
  const float tn = (float)tpos / (float)L;
  const float* w1 = p.in[I_FW1] + (size_t)j * 33 * 64;
  const float* b1 = p.in[I_FB1] + j * 64;
  const float* fr = p.in[I_FFREQ] + j * 128;
  const float* w2 = p.in[I_FW2] + (size_t)j * 64 * 64;
  const float* b2 = p.in[I_FB2] + j * 64;
  const float* w3 = p.in[I_FW3] + (size_t)j * 64 * 2048;
  __syncthreads();
  {
    const int u0 = wid * 8;
    float acc[8];
#pragma unroll
    for (int uu = 0; uu < 8; ++uu) acc[uu] = tn * w1[u0 + uu];
    for (int b = 1; b <= 16; ++b) {
      const float rev = tn * (float)b;
      const float cs = cos_rev(rev), sn = sin_rev(rev);
#pragma unroll
      for (int uu = 0; uu < 8; ++uu) acc[uu] += cs * w1[b * 64 + u0 + uu] + sn * w1[(16 + b) * 64 + u0 + uu];
    }
#pragma unroll
    for (int uu = 0; uu < 8; ++uu) h1[tt * 65 + u0 + uu] = sin_rev(INV_2PI * (fr[u0 + uu] * (acc[uu] + b1[u0 + uu])));
  }
  __syncthreads();
  {
    const int u0 = wid * 8;
    float acc[8];
#pragma unroll
    for (int uu = 0; uu < 8; ++uu) acc[uu] = 0.f;
    for (int v = 0; v < 64; ++v) {
      const float hv = h1[tt * 65 + v];
#pragma unroll
      for (int uu = 0; uu < 8; ++uu) acc[uu] += hv * w2[v * 64 + u0 + uu];
    }
#pragma unroll
    for (int uu = 0; uu < 8; ++uu) h2[tt * 65 + u0 + uu] = sin_rev(INV_2PI * (fr[64 + u0 + uu] * (acc[uu] + b2[u0 + uu])));
  }
  __syncthreads();
  float* G2 = (float*)(p.ws + WS_FILT) + (size_t)j * FILT_J + (lsel ? FILT_L1 : 0);
  float* fsq = (float*)(p.ws + WS_FSQP) + ((size_t)((j * 2 + lsel) * 16 + tchunk)) * 2048;
  for (int q = 0; q < 32; ++q) {
    const int n = nchunk * 256 + wid * 32 + q;
    float acc = 0.f;
    for (int v = 0; v < 64; ++v) acc += h2[tt * 65 + v] * w3[v * 2048 + n];
    const int c = n & 1023; const bool isb = n >= 1024;
    const float delta = fabsf(MIN_DECAY + (MAX_DECAY - MIN_DECAY) * ((float)c / 1023.f));
    float val = acc * expf(-tn * delta);
    if (isb && tpos == 0) val = 0.f;
    if (!(isb && tpos == 0)) G2[(size_t)c * (2 * L) + (isb ? (L - tpos) : (L + tpos))] = val;
    {
      bf16_t* rec = (bf16_t*)(p.ws + WS_FRG) + (size_t)j * FRG_J + (lsel ? FRG_L1 : 0) + (size_t)c * (4 * L + 40);
      if (isb && tpos == 0) rec[0] = 0;
      else { const int i = isb ? (L + tpos) : (L - tpos); const bf16_t v = f2bf(val); rec[i] = v; rec[2 * L + 40 + i - 1] = v; }
    }
    const float s = wave_sum(val * val);
    if (lane == 0) fsq[n] = s;
  }
}

__device__ void phase_p0(const Params& p, unsigned char* lds) {
  float* fl = (float*)lds;
  const int G = gridDim.x, b = blockIdx.x, tid = tidx();
  for (int t = b; t < NT_FILT + NT_MOD + NT_CVT; t += G) {
    __syncthreads();
    if (t < NT_FILT) task_filt(p, t, fl, fl + 64 * 65);
    else if (t < NT_FILT + NT_MOD) task_mod(p, t - NT_FILT, fl);
    else task_cvt(p, t - NT_FILT - NT_MOD, fl);
  }
  {
    f32x4* Y = (f32x4*)(p.ws + WS_Y);
    const f32x4* xp = (const f32x4*)p.in[I_XP]; const f32x4* xs = (const f32x4*)p.in[I_XS];
    const int half = NPR * D / 4;
    for (int i = b * 512 + tid; i < 2 * half; i += G * 512) Y[i] = i < half ? xp[i] : xs[i - half];
  }
  {
    bf16_t* KS = (bf16_t*)(p.ws + WS_KS); bf16_t* VS = (bf16_t*)(p.ws + WS_VS);
    const int n = 4 * 2 * 512 * 256;
    for (int i = b * 512 + tid; i < n; i += G * 512) {
      const int e = i & 255, pos = (i >> 8) & 511, j = (i >> 17) & 1, bb = i >> 18;
      const size_t o = ((size_t)(j * 4 + bb) * 1536 + 1024 + pos) * 256 + e;
      KS[o] = f2bf(p.in[I_CK][i]); VS[o] = f2bf(p.in[I_CV][i]);
    }
  }
}

__device__ void phase_p0b(const Params& p) {
  const int G = gridDim.x, b = blockIdx.x, tid = tidx();
  float* MOD = (float*)(p.ws + WS_MOD); const float* MP = (const float*)(p.ws + WS_MODP);
  for (int i = b * 512 + tid; i < 4 * 5 * 6144; i += G * 512) {
    const int n = i % 6144, l = i / (5 * 6144);
    float s = p.in[I_MODB][l * 6144 + n];
#pragma unroll
    for (int kc = 0; kc < 8; ++kc) s += MP[(size_t)kc * (4 * 5 * 6144) + i];
    MOD[i] = s;
  }
  float* RN = (float*)(p.ws + WS_RNORM); const float* FS = (const float*)(p.ws + WS_FSQP);
  for (int i = b * 512 + tid; i < 4096; i += G * 512) {
    const int c = i & 1023, jl = i >> 10, nch = (jl & 1) ? 16 : 4;
    float s = 0.f;
    for (int ch = 0; ch < nch; ++ch) s += FS[((size_t)jl * 16 + ch) * 2048 + c] + FS[((size_t)jl * 16 + ch) * 2048 + 1024 + c];
    RN[i] = 1.f / sqrtf(s + EPS);
  }
}

__device__ void phase_nm(const Params& p, int layer, int which) {
  const int lane = tidx() & 63, wid = tidx() >> 6;
  const float* Y = (const float*)(p.ws + WS_Y); bf16_t* XN = (bf16_t*)(p.ws + WS_XN);
  const float* g = p.in[which ? I_NFFN : I_NMIX] + layer * D;
  for (int m = blockIdx.x * 8 + wid; m < MTOK; m += gridDim.x * 8) {
    const float* y = Y + (size_t)m * D;
    f32x4 v[4]; float ss = 0.f;
#pragma unroll
    for (int i = 0; i < 4; ++i) { v[i] = *(const f32x4*)(y + i * 256 + lane * 4); ss += v[i][0] * v[i][0] + v[i][1] * v[i][1] + v[i][2] * v[i][2] + v[i][3] * v[i][3]; }
    ss = wave_sum(ss);
    const float r = rsqrtf(ss * (1.f / D) + EPS);
    const float* mod = (const float*)(p.ws + WS_MOD) + (size_t)(layer * 5 + cond_of(m)) * 6144 + which * 3072;
#pragma unroll
    for (int i = 0; i < 4; ++i) {
      const int k = i * 256 + lane * 4;
      const f32x4 gg = *(const f32x4*)(g + k), sh = *(const f32x4*)(mod + k), sc = *(const f32x4*)(mod + 1024 + k);
      float o[4];
#pragma unroll
      for (int e = 0; e < 4; ++e) o[e] = (v[i][e] * r * gg[e]) * (1.f + sc[e]) + sh[e];
      uint2 w; w.x = pack2(o[0], o[1]); w.y = pack2(o[2], o[3]);
      *(uint2*)(XN + (size_t)m * D + k) = w;
    }
  }
}

__device__ void phase_final(const Params& p) {
  const int lane = tidx() & 63, wid = tidx() >> 6;
  const float* Y = (const float*)(p.ws + WS_Y);
  const float* g = p.in[I_FN];
  for (int m = blockIdx.x * 8 + wid; m < MTOK; m += gridDim.x * 8) {
    const float* y = Y + (size_t)m * D;
    f32x4 v[4]; float ss = 0.f;
#pragma unroll
    for (int i = 0; i < 4; ++i) { v[i] = *(const f32x4*)(y + i * 256 + lane * 4); ss += v[i][0] * v[i][0] + v[i][1] * v[i][1] + v[i][2] * v[i][2] + v[i][3] * v[i][3]; }
    ss = wave_sum(ss);
    const float r = rsqrtf(ss * (1.f / D) + EPS);
#pragma unroll
    for (int i = 0; i < 4; ++i) {
      const int k = i * 256 + lane * 4;
      const f32x4 gg = *(const f32x4*)(g + k);
      f32x4 o; o[0] = v[i][0] * r * gg[0]; o[1] = v[i][1] * r * gg[1]; o[2] = v[i][2] * r * gg[2]; o[3] = v[i][3] * r * gg[3];
      *(f32x4*)(p.out + (size_t)m * D + k) = o;
    }
  }
}

struct EpiStoreBf16 { bf16_t* C; int ld; __device__ __forceinline__ void operator()(int m, int n, float v) const { C[(size_t)m * ld + n] = f2bf(v); } };
struct EpiGateRes { float* Y; const float* gate; __device__ __forceinline__ void operator()(int m, int n, float v) const { Y[(size_t)m * D + n] += gate[cond_of(m) * 6144 + n] * v; } };

template <bool SWIGLU, class Epi>
__device__ __forceinline__ void gemm_naive(const bf16_t* __restrict__ A, const bf16_t* __restrict__ Bt, int M, int N, int K, const Epi& epi, bf16_t* Hout) {
  const int lane = tidx() & 63, wid = tidx() >> 6, r16 = lane & 15, kg = lane >> 4;
  const int tilesN = SWIGLU ? N / 32 : N / 64, total = (M / 64) * tilesN;
  for (int tile = blockIdx.x * 8 + wid; tile < total; tile += gridDim.x * 8) {
    const int tm = tile / tilesN, tn = tile % tilesN, m0 = tm * 64;
    f32x4 acc[4][4];
#pragma unroll
    for (int i = 0; i < 4; ++i)
#pragma unroll
      for (int f = 0; f < 4; ++f) acc[i][f] = (f32x4){0.f, 0.f, 0.f, 0.f};
    const bf16_t* ap = A + (size_t)(m0 + r16) * K + kg * 8;
    int brow[4];
#pragma unroll
    for (int f = 0; f < 4; ++f) {
      if (SWIGLU) { const int hc = tn * 32 + 16 * (f & 1) + r16; brow[f] = (hc >> 7) * 256 + (hc & 127) + 128 * (f >> 1); }
      else brow[f] = tn * 64 + 16 * f + r16;
    }
    const bf16_t* bp0 = Bt + (size_t)brow[0] * K + kg * 8; const bf16_t* bp1 = Bt + (size_t)brow[1] * K + kg * 8;
    const bf16_t* bp2 = Bt + (size_t)brow[2] * K + kg * 8; const bf16_t* bp3 = Bt + (size_t)brow[3] * K + kg * 8;
    for (int k0 = 0; k0 < K; k0 += 32) {
      bf16x8 a[4], b[4];
#pragma unroll
      for (int i = 0; i < 4; ++i) a[i] = *(const bf16x8*)(ap + (size_t)(16 * i) * K + k0);
      b[0] = *(const bf16x8*)(bp0 + k0); b[1] = *(const bf16x8*)(bp1 + k0); b[2] = *(const bf16x8*)(bp2 + k0); b[3] = *(const bf16x8*)(bp3 + k0);
#pragma unroll
      for (int i = 0; i < 4; ++i)
#pragma unroll
        for (int f = 0; f < 4; ++f) acc[i][f] = __builtin_amdgcn_mfma_f32_16x16x32_bf16(a[i], b[f], acc[i][f], 0, 0, 0);
    }
    if (SWIGLU) {
#pragma unroll
      for (int i = 0; i < 4; ++i)
#pragma unroll
        for (int f = 0; f < 2; ++f)
#pragma unroll
          for (int e = 0; e < 4; ++e) {
            const int m = m0 + 16 * i + 4 * kg + e, hc = tn * 32 + 16 * f + r16;
            const float gv = acc[i][f][e], uv = acc[i][f + 2][e];
            Hout[(size_t)m * DFF + hc] = f2bf(silu_f(gv) * uv);
          }
    } else {
#pragma unroll
      for (int i = 0; i < 4; ++i)
#pragma unroll
        for (int f = 0; f < 4; ++f)
#pragma unroll
          for (int e = 0; e < 4; ++e) epi(m0 + 16 * i + 4 * kg + e, tn * 64 + 16 * f + r16, acc[i][f][e]);
    }
  }
}


namespace pg8 {
#define PG8_LAS __attribute__((address_space(3)))
constexpr int BM = 256, BK = 64, HALF = 128, HTB = HALF * BK * 2, STAGE_BYTES = 8 * HTB, NXCD = 8, WGM = 8;
__host__ __device__ __forceinline__ int lds_byte(int r, int c) { const int st = (r >> 4) * 2 + (c >> 5), rr = r & 15, cc = c & 31, ob = rr * 64 + cc * 2; return st * 1024 + (ob ^ (((ob >> 9) & 1) << 5)); }
__host__ __device__ __forceinline__ void stage_rc(int b, int& R, int& C) { const int st = b / 1024, sb = b % 1024, swz = sb ^ (((sb >> 9) & 1) << 5); R = (st >> 1) * 16 + swz / 64; C = (st & 1) * 32 + (swz % 64) / 2; }
__host__ __device__ __forceinline__ int perm32(int rho) { const int n = rho >> 4, i = rho & 15; return 8 * (i >> 2) + 4 * n + (i & 3); }
struct Unit { int pm, pn, ks; };
struct Gemm { const bf16_t* A; const bf16_t* Bt; int M, N, K, ld; };
struct StaticOrder {
    int nM, nN, nwg, G, c, KS;
    __device__ void init(int M, int N, int KS_, int G_, int c_) { nM = M / BM; KS = KS_; nN = (N / BM) * KS_; nwg = nM * nN; G = G_; c = c_; }
    __device__ bool next(int i, Unit& u) const {
        const long L = (long)i * G + c; if (L >= nwg) return false;
        int wgid = (int)L; { const int q = nwg / NXCD, r = nwg % NXCD, xcd = wgid % NXCD, off = wgid / NXCD; wgid = (xcd < r ? xcd * (q + 1) : r * (q + 1) + (xcd - r) * q) + off; }
        const int nig = WGM * nN, gid = wgid / nig, fm = gid * WGM, gsz = (nM - fm) < WGM ? (nM - fm) : WGM;
        u.pm = fm + ((wgid % nig) % gsz); const int pn2 = (wgid % nig) / gsz; u.pn = pn2 / KS; u.ks = pn2 % KS; return true;
    }
    __device__ __forceinline__ void a_ready(const Unit&) const {}
    __device__ __forceinline__ void done(const Unit&) const {}
};
__device__ __forceinline__ unsigned cvt_pk_bf16(float lo, float hi) { unsigned r; asm volatile("v_cvt_pk_bf16_f32 %0, %1, %2" : "=v"(r) : "v"(lo), "v"(hi)); return r; }
struct EpiBf16 {
    static constexpr bool PERM = true, AFTER_DRAIN = false;
    bf16_t* O; int ldc;
    __device__ __forceinline__ void operator()(const f32x4 (&acc)[2][2][4][2], const Unit& u, int wr, int wc, int fr, int fq) const {
        const int row0 = u.pm * BM + wr * 64 + fr, col0 = u.pn * BM + wc * 32 + 8 * fq;
#pragma unroll
        for (int ai = 0; ai < 2; ++ai)
#pragma unroll
            for (int m = 0; m < 4; ++m) { bf16_t* rowp = O + (size_t)(row0 + ai * HALF + m * 16) * ldc + col0;
#pragma unroll
                for (int bj = 0; bj < 2; ++bj) { const f32x4 v0 = acc[ai][bj][m][0], v1 = acc[ai][bj][m][1];
                    u32x4 w; w.x = cvt_pk_bf16(v0[0], v0[1]); w.y = cvt_pk_bf16(v0[2], v0[3]); w.z = cvt_pk_bf16(v1[0], v1[1]); w.w = cvt_pk_bf16(v1[2], v1[3]);
                    *(u32x4*)(rowp + bj * HALF) = w; } }
    }
};
struct EpiSwiglu {
    static constexpr bool PERM = true, AFTER_DRAIN = false;
    bf16_t* H;
    __device__ __forceinline__ void operator()(const f32x4 (&acc)[2][2][4][2], const Unit& u, int wr, int wc, int fr, int fq) const {
        const int row0 = u.pm * BM + wr * 64 + fr, col0 = u.pn * HALF + wc * 32 + 8 * fq;
#pragma unroll
        for (int ai = 0; ai < 2; ++ai)
#pragma unroll
            for (int m = 0; m < 4; ++m) {
                float h[8];
#pragma unroll
                for (int n = 0; n < 2; ++n)
#pragma unroll
                    for (int e = 0; e < 4; ++e) { const float gv = acc[ai][0][m][n][e], uv = acc[ai][1][m][n][e]; h[4 * n + e] = gv * __builtin_amdgcn_rcpf(1.f + __expf(-gv)) * uv; }
                u32x4 w; w.x = cvt_pk_bf16(h[0], h[1]); w.y = cvt_pk_bf16(h[2], h[3]); w.z = cvt_pk_bf16(h[4], h[5]); w.w = cvt_pk_bf16(h[6], h[7]);
                *(u32x4*)(H + (size_t)(row0 + ai * HALF + m * 16) * DFF + col0) = w; }
    }
};
template <bool ATOMIC> struct EpiGate {
    static constexpr bool PERM = false, AFTER_DRAIN = false;
    float* Y; const float* gate;
    __device__ __forceinline__ void operator()(const f32x4 (&acc)[2][2][4][2], const Unit& u, int wr, int wc, int fr, int fq) const {
        const int row0 = u.pm * BM + wr * 64 + fr, col0 = u.pn * BM + wc * 32 + 4 * fq;
#pragma unroll
        for (int ai = 0; ai < 2; ++ai)
#pragma unroll
            for (int m = 0; m < 4; ++m) { const int row = row0 + ai * HALF + m * 16; const float* gp = gate + cond_of(row) * 6144 + col0; float* yp = Y + (size_t)row * D + col0;
#pragma unroll
                for (int bj = 0; bj < 2; ++bj)
#pragma unroll
                    for (int n = 0; n < 2; ++n) { const int o = bj * HALF + n * 16; const f32x4 gv = *(const f32x4*)(gp + o); const f32x4 v = acc[ai][bj][m][n] * gv;
                        if (ATOMIC) { unsafeAtomicAdd(yp + o, v[0]); unsafeAtomicAdd(yp + o + 1, v[1]); unsafeAtomicAdd(yp + o + 2, v[2]); unsafeAtomicAdd(yp + o + 3, v[3]); }
                        else { *(f32x4*)(yp + o) = *(const f32x4*)(yp + o) + v; } } }
    }
};
template <class Epi, class Sched, bool ALIGN_EPI = false, bool SP2 = false>
__device__ __forceinline__ void gemm_phase(PG8_LAS unsigned char* lds, const Gemm g, const Sched& S, const Epi& E) {
    int tid_ = tidx();
    const int tid = tid_, wid = __builtin_amdgcn_readfirstlane(tid >> 6), lane = tid & 63, wr = wid >> 2, wc = wid & 3, fr = lane & 15, fq = lane >> 4;
    const int K = g.ld, nt = g.K / BK;
    unsigned voffA[2], voffB[2];
#pragma unroll
    for (int i = 0; i < 2; ++i) { int R, C; stage_rc(tid * 16 + i * 8192, R, C); const int Rb = Epi::PERM ? ((R & ~31) + perm32(R & 31)) : R;
        voffA[i] = (unsigned)(R * K + C) * 2u; voffB[i] = (unsigned)(Rb * K + C) * 2u; }
    const size_t kstep = (size_t)(BK * 2);
    const size_t hstep = (size_t)HALF * K * 2;
    const size_t tstep = 2 * hstep;
    const unsigned ldsw = (unsigned)wid * 1024u;
    const int aoff = lds_byte(wr * 64 + fr, fq * 8), boff = lds_byte(wc * 32 + fr, fq * 8);
#define PG8_SA(b, h) (((b) * 2 + (h)) * HTB)
#define PG8_SB(b, h) ((4 + (b) * 2 + (h)) * HTB)
#define PG8_STAGE(bufoff, gbase, voff) do { _Pragma("unroll") for (int _i = 0; _i < 2; ++_i) \
        __builtin_amdgcn_global_load_lds((const unsigned*)((const char*)(gbase) + (voff)[_i]), (PG8_LAS unsigned*)(lds + (bufoff) + ldsw + _i * 8192), 16, 0, 0); } while (0)
#define PG8_LDA(dst, b, h) do { _Pragma("unroll") for (int m = 0; m < 4; ++m) _Pragma("unroll") for (int k = 0; k < 2; ++k) dst[m][k] = *(const PG8_LAS bf16x8*)(lds + PG8_SA(b, h) + aoff + m * 2048 + k * 1024); } while (0)
#define PG8_LDB(dst, b, h) do { _Pragma("unroll") for (int n = 0; n < 2; ++n) _Pragma("unroll") for (int k = 0; k < 2; ++k) dst[n][k] = *(const PG8_LAS bf16x8*)(lds + PG8_SB(b, h) + boff + n * 2048 + k * 1024); } while (0)
#define PG8_MMA(ai, bj, At, Bt) do { __builtin_amdgcn_s_setprio(1); _Pragma("unroll") for (int m = 0; m < 4; ++m) _Pragma("unroll") for (int n = 0; n < 2; ++n) _Pragma("unroll") for (int k = 0; k < 2; ++k) \
        acc[ai][bj][m][n] = __builtin_amdgcn_mfma_f32_16x16x32_bf16(Bt[n][k], At[m][k], acc[ai][bj][m][n], 0, 0, 0); __builtin_amdgcn_s_setprio(0); } while (0)
#define PG8_WAIT_V(n) asm volatile("s_waitcnt vmcnt(" #n ")" ::: "memory")
#define PG8_WAIT_L(n) asm volatile("s_waitcnt lgkmcnt(" #n ")" ::: "memory")
#define PG8_BAR __builtin_amdgcn_s_barrier()
#define PG8_SCHED __builtin_amdgcn_sched_barrier(0)
    Unit cur, nxt; int ui = 0;
    if (!S.next(0, cur)) return;
    f32x4 acc[2][2][4][2];
#pragma unroll
    for (int a = 0; a < 2; ++a)
#pragma unroll
        for (int b = 0; b < 2; ++b)
#pragma unroll
            for (int m = 0; m < 4; ++m)
#pragma unroll
                for (int n = 0; n < 2; ++n) acc[a][b][m][n] = (f32x4){0.f, 0.f, 0.f, 0.f};
    bf16x8 At[4][2], B0[2][2], B1[2][2];
    const size_t ksb = (size_t)g.K * 2; const char* cA = (const char*)g.A + (size_t)cur.pm * tstep + cur.ks * ksb; const char* cB = (const char*)g.Bt + (size_t)cur.pn * tstep + cur.ks * ksb;
    S.a_ready(cur);
    if constexpr (SP2) {
        PG8_STAGE(PG8_SB(0, 0), cB, voffB); PG8_STAGE(PG8_SB(0, 1), cB + hstep, voffB); PG8_STAGE(PG8_SA(0, 0), cA, voffA); PG8_STAGE(PG8_SA(0, 1), cA + hstep, voffA);
        if (wr == 1) PG8_BAR;
        PG8_WAIT_V(2); PG8_BAR;
        PG8_STAGE(PG8_SB(1, 0), cB + kstep, voffB); PG8_STAGE(PG8_SA(1, 0), cA + kstep, voffA); PG8_STAGE(PG8_SB(1, 1), cB + hstep + kstep, voffB);
        PG8_WAIT_V(6); PG8_BAR;
    } else {
        PG8_STAGE(PG8_SB(0, 0), cB, voffB); PG8_STAGE(PG8_SA(0, 0), cA, voffA); PG8_STAGE(PG8_SB(0, 1), cB + hstep, voffB); PG8_STAGE(PG8_SA(0, 1), cA + hstep, voffA);
        if (wr == 1) PG8_BAR;
        PG8_WAIT_V(4); PG8_BAR;
        PG8_STAGE(PG8_SB(1, 0), cB + kstep, voffB); PG8_STAGE(PG8_SA(1, 0), cA + kstep, voffA); PG8_STAGE(PG8_SB(1, 1), cB + hstep + kstep, voffB);
        PG8_WAIT_V(6); PG8_BAR;
    }
    for (;;) {
        const bool has_next = S.next(ui + 1, nxt);
        const char* nA = has_next ? (const char*)g.A + (size_t)nxt.pm * tstep + nxt.ks * ksb : cA; const char* nB = has_next ? (const char*)g.Bt + (size_t)nxt.pn * tstep + nxt.ks * ksb : cB;
        for (int t = 0; t < nt; t += 2) {
            const bool last = (t == nt - 2);
            const char* a1 = cA + (size_t)(t + 1) * kstep;
            const char* a2 = last ? nA : cA + (size_t)(t + 2) * kstep; const char* b2 = last ? nB : cB + (size_t)(t + 2) * kstep;
            const char* a3 = a2 + kstep; const char* b3 = b2 + kstep;
            if (last && has_next) S.a_ready(nxt);
            if constexpr (SP2) {
            PG8_LDB(B0, 0, 0); PG8_LDB(B1, 0, 1); PG8_SCHED; PG8_LDA(At, 0, 0); PG8_STAGE(PG8_SA(1, 1), a1 + hstep, voffA);
            PG8_WAIT_V(8); PG8_WAIT_L(0); PG8_BAR; PG8_MMA(0, 0, At, B0); PG8_MMA(0, 1, At, B1); PG8_BAR; PG8_SCHED;
            PG8_LDA(At, 0, 1); PG8_STAGE(PG8_SB(0, 0), b2, voffB); PG8_STAGE(PG8_SB(0, 1), b2 + hstep, voffB); PG8_STAGE(PG8_SA(0, 0), a2, voffA);
            PG8_WAIT_V(8); PG8_WAIT_L(0); PG8_BAR; PG8_MMA(1, 0, At, B0); PG8_MMA(1, 1, At, B1); PG8_BAR; PG8_SCHED;
            PG8_LDB(B0, 1, 0); PG8_LDB(B1, 1, 1); PG8_SCHED; PG8_LDA(At, 1, 0); PG8_STAGE(PG8_SA(0, 1), a2 + hstep, voffA);
            PG8_WAIT_V(8); PG8_WAIT_L(0); PG8_BAR; PG8_MMA(0, 0, At, B0); PG8_MMA(0, 1, At, B1); PG8_BAR; PG8_SCHED;
            PG8_LDA(At, 1, 1); PG8_STAGE(PG8_SB(1, 0), b3, voffB); PG8_STAGE(PG8_SB(1, 1), b3 + hstep, voffB); PG8_STAGE(PG8_SA(1, 0), a3, voffA);
            PG8_WAIT_V(8); PG8_WAIT_L(0); PG8_BAR; PG8_MMA(1, 0, At, B0); PG8_MMA(1, 1, At, B1); PG8_BAR; PG8_SCHED;
            } else {
            PG8_LDB(B0, 0, 0); PG8_SCHED; PG8_LDA(At, 0, 0); PG8_STAGE(PG8_SA(1, 1), a1 + hstep, voffA);
            PG8_WAIT_L(8); PG8_BAR; PG8_WAIT_L(0); PG8_MMA(0, 0, At, B0); PG8_BAR; PG8_SCHED;
            PG8_LDB(B1, 0, 1); PG8_STAGE(PG8_SB(0, 0), b2, voffB);
            PG8_BAR; PG8_WAIT_L(0); PG8_MMA(0, 1, At, B1); PG8_BAR;
            PG8_LDA(At, 0, 1); PG8_STAGE(PG8_SA(0, 0), a2, voffA);
            PG8_BAR; PG8_WAIT_L(0); PG8_MMA(1, 0, At, B0); PG8_BAR; PG8_SCHED;
            PG8_STAGE(PG8_SB(0, 1), b2 + hstep, voffB);
            PG8_WAIT_V(6); PG8_BAR; PG8_MMA(1, 1, At, B1); PG8_BAR;
            PG8_LDB(B0, 1, 0); PG8_SCHED; PG8_LDA(At, 1, 0); PG8_STAGE(PG8_SA(0, 1), a2 + hstep, voffA);
            PG8_WAIT_L(8); PG8_BAR; PG8_WAIT_L(0); PG8_MMA(0, 0, At, B0); PG8_BAR; PG8_SCHED;
            PG8_LDB(B1, 1, 1); PG8_STAGE(PG8_SB(1, 0), b3, voffB);
            PG8_BAR; PG8_WAIT_L(0); PG8_MMA(0, 1, At, B1); PG8_BAR;
            PG8_LDA(At, 1, 1); PG8_STAGE(PG8_SA(1, 0), a3, voffA);
            PG8_BAR; PG8_WAIT_L(0); PG8_MMA(1, 0, At, B0); PG8_BAR; PG8_SCHED;
            PG8_STAGE(PG8_SB(1, 1), b3 + hstep, voffB);
            PG8_WAIT_V(6); PG8_BAR; PG8_MMA(1, 1, At, B1); PG8_BAR;
            }
        }
        if constexpr (ALIGN_EPI) { if (wr == 0) PG8_BAR; }
        if constexpr (!Epi::AFTER_DRAIN) { E(acc, cur, wr, wc, fr, fq); S.done(cur); }
        if (!has_next) break;
#pragma unroll
        for (int a = 0; a < 2; ++a)
#pragma unroll
            for (int b = 0; b < 2; ++b)
#pragma unroll
                for (int m = 0; m < 4; ++m)
#pragma unroll
                    for (int n = 0; n < 2; ++n) acc[a][b][m][n] = (f32x4){0.f, 0.f, 0.f, 0.f};
        cur = nxt; cA = nA; cB = nB; ++ui;
        if constexpr (ALIGN_EPI) { if (wr == 1) PG8_BAR; }
    }
    PG8_WAIT_V(0);
    if constexpr (!ALIGN_EPI) { if (wr == 0) PG8_BAR; }
    PG8_BAR;
    if constexpr (Epi::AFTER_DRAIN) { E.fused(acc, cur, wr, wc, fr, fq, lds, wid, lane); S.done(cur); }
#undef PG8_SA
#undef PG8_SB
#undef PG8_STAGE
#undef PG8_LDA
#undef PG8_LDB
#undef PG8_MMA
#undef PG8_WAIT_V
#undef PG8_WAIT_L
#undef PG8_BAR
#undef PG8_SCHED
}
}

template <class Epi>
__device__ __forceinline__ void gemm_run(unsigned char* lds, const bf16_t* A, const bf16_t* Bt, int M, int N, int Ktot, int KS, const Epi& E) {
    pg8::StaticOrder S; S.init(M, N, KS, (int)gridDim.x, (int)blockIdx.x);
    pg8::Gemm g; g.A = A; g.Bt = Bt; g.M = M; g.N = N; g.K = Ktot / KS; g.ld = Ktot;
    __syncthreads();
    pg8::gemm_phase<Epi, pg8::StaticOrder, true, true>((PG8_LAS unsigned char*)lds, g, S, E);
    __syncthreads();
}

__device__ void phase_lca(const Params& p, int j) {
  const bf16_t* ZT = (const bf16_t*)(p.ws + WS_ZT); bf16_t* U = (bf16_t*)(p.ws + WS_U); bf16_t* X0 = (bf16_t*)(p.ws + WS_X0C);
  const float* cw = p.in[I_HCW] + (size_t)j * 3 * 3072; const float* cb = p.in[I_HCB] + (size_t)j * 3072;
  for (int i = blockIdx.x * 512 + tidx(); i < D * MTOK; i += gridDim.x * 512) {
    const int c = i >> 13, m = i & 8191;
    const int L = m < NPR ? 256 : 1024, t = m & (L - 1);
    float sc[3];
#pragma unroll
    for (int part = 0; part < 3; ++part) {
      const int ch = part * 1024 + c;
      const bf16_t* z = ZT + (size_t)ch * MTOK + m;
      const float zm = t > 0 ? bf2f(z[-1]) : 0.f, z0 = bf2f(z[0]), zp = t < L - 1 ? bf2f(z[1]) : 0.f;
      sc[part] = zm * cw[ch] + z0 * cw[3072 + ch] + zp * cw[2 * 3072 + ch] + cb[ch];
    }
    X0[i] = f2bf(sc[0]); U[i] = f2bf(sc[1] * sc[2]);
  }
}
__device__ void phase_lcb(const Params& p, int j) {
  const bf16_t* U = (const bf16_t*)(p.ws + WS_U); const bf16_t* X0 = (const bf16_t*)(p.ws + WS_X0C); bf16_t* YG = (bf16_t*)(p.ws + WS_YG);
  const float* RN = (const float*)(p.ws + WS_RNORM); const float* bias = p.in[I_HBIAS] + j * D;
  for (int i = blockIdx.x * 512 + tidx(); i < D * MTOK; i += gridDim.x * 512) {
    const int c = i >> 13, m = i & 8191;
    const int lsel = m < NPR ? 0 : 1, L = lsel ? 1024 : 256, t = m & (L - 1);
    const float* g2 = (const float*)(p.ws + WS_FILT) + (size_t)j * FILT_J + (lsel ? FILT_L1 : 0) + (size_t)c * (2 * L) + L + t;
    const bf16_t* u = U + (size_t)c * MTOK + (m - t);
    float acc = 0.f;
    for (int s = 0; s < L; ++s) acc += g2[-s] * bf2f(u[s]);
    const float uu = bf2f(u[t]);
    const float y = acc * RN[(j * 2 + lsel) * 1024 + c] + uu * bias[c];
    YG[(size_t)m * D + c] = f2bf(bf2f(X0[i]) * y);
  }
}


#define LDSP __attribute__((address_space(3)))
constexpr int LC_FR = 0, LC_U = 66176, LC_X0 = LC_U + 20480, LC_S = LC_X0 + 20480, LC_Z = LC_S + 17408;
__device__ void phase_lc(const Params& p, int j, unsigned char* lds_) {
  LDSP unsigned char* lds = (LDSP unsigned char*)lds_;
  const int tid = tidx(), lane = tid & 63, wid = tid >> 6, n = lane & 31, hi = lane >> 5;
  const bf16_t* ZT = (const bf16_t*)(p.ws + WS_ZT); bf16_t* YG = (bf16_t*)(p.ws + WS_YG);
  const float* cw = p.in[I_HCW] + (size_t)j * 3 * 3072; const float* cb = p.in[I_HCB] + (size_t)j * 3072;
  for (int q = blockIdx.x; q < 1024; q += gridDim.x) {
    const int lsel = q < 512 ? 1 : 0, qq = q & 511, cg = qq >> 2, tb = (lsel ? 4 : 0) + (qq & 3);
    const int L = lsel ? 1024 : 256, P = L >> 5, REC = 4 * L + 40, c0 = cg * 8;
    const size_t m0 = (size_t)tb * 1024;
    __syncthreads();
    {
      const u32x4* src = (const u32x4*)((const bf16_t*)(p.ws + WS_FRG) + (size_t)j * FRG_J + (lsel ? FRG_L1 : 0) + (size_t)c0 * REC);
      LDSP u32x4* dst = (LDSP u32x4*)(lds + LC_FR);
      for (int i = tid; i < REC; i += 512) dst[i] = src[i];
    }
    for (int task = tid; task < 1024; task += 512) {
      const int ch = task >> 7, tok0 = (task & 127) * 8;
      const bool first = (tok0 & (L - 1)) == 0, last = ((tok0 + 8) & (L - 1)) == 0;
      float sc[3][8];
#pragma unroll
      for (int part = 0; part < 3; ++part) {
        const int chn = part * 1024 + c0 + ch;
        const bf16_t* z = ZT + (size_t)chn * MTOK + m0 + tok0;
        const u32x4 w = *(const u32x4*)z;
        float zv[10];
        zv[0] = first ? 0.f : bf2f(z[-1]); zv[9] = last ? 0.f : bf2f(z[8]);
        zv[1] = __uint_as_float(w.x << 16); zv[2] = __uint_as_float(w.x & 0xFFFF0000u); zv[3] = __uint_as_float(w.y << 16); zv[4] = __uint_as_float(w.y & 0xFFFF0000u);
        zv[5] = __uint_as_float(w.z << 16); zv[6] = __uint_as_float(w.z & 0xFFFF0000u); zv[7] = __uint_as_float(w.w << 16); zv[8] = __uint_as_float(w.w & 0xFFFF0000u);
        const float w0 = cw[chn], w1 = cw[3072 + chn], w2 = cw[2 * 3072 + chn], bb = cb[chn];
#pragma unroll
        for (int i = 0; i < 8; ++i) sc[part][i] = zv[i] * w0 + zv[i + 1] * w1 + zv[i + 2] * w2 + bb;
      }
      u32x4 xo, uo;
      xo.x = pack2(sc[0][0], sc[0][1]); xo.y = pack2(sc[0][2], sc[0][3]); xo.z = pack2(sc[0][4], sc[0][5]); xo.w = pack2(sc[0][6], sc[0][7]);
      uo.x = pack2(sc[1][0] * sc[2][0], sc[1][1] * sc[2][1]); uo.y = pack2(sc[1][2] * sc[2][2], sc[1][3] * sc[2][3]);
      uo.z = pack2(sc[1][4] * sc[2][4], sc[1][5] * sc[2][5]); uo.w = pack2(sc[1][6] * sc[2][6], sc[1][7] * sc[2][7]);
      const int po = (ch * 1280 + tok0 + 8 * (tok0 >> 5)) * 2;
      *(LDSP u32x4*)(lds + LC_U + po) = uo; *(LDSP u32x4*)(lds + LC_X0 + po) = xo;
    }
    if (tid < 4) ((LDSP unsigned*)(lds + LC_Z))[tid] = 0u;
    __syncthreads();
    f32x16 acc;
#pragma unroll
    for (int r = 0; r < 16; ++r) acc[r] = 0.f;
    {
      const int par = n & 1;
      LDSP const unsigned char* fa = lds + LC_FR + wid * (REC * 2) + (par ? (2 * L + 40) * 2 : 0) + 2 * (L - n - par + 8 * hi);
      LDSP const unsigned char* ub = lds + LC_U + wid * 2560 + (40 * n + 8 * hi) * 2;
      const int ti = n & (P - 1);
      for (int dl = -(P - 1); dl <= P - 1; ++dl) {
        const bool valid = (unsigned)(ti - dl) < (unsigned)P;
#pragma unroll
        for (int ks = 0; ks < 2; ++ks) {
          LDSP const volatile unsigned* ap = (LDSP const volatile unsigned*)(fa + 2 * (-32 * dl + 16 * ks));
          u32x4 aw; aw.x = ap[0]; aw.y = ap[1]; aw.z = ap[2]; aw.w = ap[3];
          LDSP const unsigned char* bp = valid ? (ub + (-40 * dl + 16 * ks) * 2) : (lds + LC_Z);
          const bf16x8 bfrag = *(LDSP const bf16x8*)bp;
          acc = __builtin_amdgcn_mfma_f32_32x32x16_bf16(__builtin_bit_cast(bf16x8, aw), bfrag, acc, 0, 0, 0);
        }
      }
    }
    {
      const float rn = ((const float*)(p.ws + WS_RNORM))[(j * 2 + lsel) * 1024 + c0 + wid], bs = p.in[I_HBIAS][j * D + c0 + wid];
      LDSP const bf16_t* uu = (LDSP const bf16_t*)(lds + LC_U) + wid * 1280 + 40 * n;
      LDSP const bf16_t* xx = (LDSP const bf16_t*)(lds + LC_X0) + wid * 1280 + 40 * n;
      LDSP bf16_t* so = (LDSP bf16_t*)(lds + LC_S) + wid * 1088 + 34 * n;
#pragma unroll
      for (int r = 0; r < 16; ++r) {
        const int row = (r & 3) + 8 * (r >> 2) + 4 * hi;
        const float y = acc[r] * rn + bf2f(uu[row]) * bs;
        so[row] = f2bf(bf2f(xx[row]) * y);
      }
    }
    __syncthreads();
    for (int tok = tid; tok < 1024; tok += 512) {
      LDSP const bf16_t* so = (LDSP const bf16_t*)(lds + LC_S) + tok + 2 * (tok >> 5);
      u32x4 w;
      w.x = (unsigned)so[0] | ((unsigned)so[1088] << 16); w.y = (unsigned)so[2 * 1088] | ((unsigned)so[3 * 1088] << 16);
      w.z = (unsigned)so[4 * 1088] | ((unsigned)so[5 * 1088] << 16); w.w = (unsigned)so[6 * 1088] | ((unsigned)so[7 * 1088] << 16);
      *(u32x4*)(YG + (m0 + tok) * D + c0) = w;
    }
  }
  __syncthreads();
}

__device__ void phase_qkvpost(const Params& p, int j) {
  const int lane = tidx() & 63, wid = tidx() >> 6;
  const unsigned* QKV = (const unsigned*)(p.ws + WS_QKV);
  unsigned* Q = (unsigned*)(p.ws + WS_Q); unsigned* KP = (unsigned*)(p.ws + WS_KP); unsigned* VP = (unsigned*)(p.ws + WS_VP);
  unsigned* KS = (unsigned*)(p.ws + WS_KS) + (size_t)j * 4 * 1536 * 128; unsigned* VS = (unsigned*)(p.ws + WS_VS) + (size_t)j * 4 * 1536 * 128;
  const float* qn = p.in[I_QN] + j * 128; const float* kn = p.in[I_KN] + j * 128;
  float* newk = p.out + (size_t)2 * NPR * D; float* newv = newk + (size_t)16 * 2 * 256 * 256;
  const float qg0 = qn[2 * lane], qg1 = qn[2 * lane + 1], kg0 = kn[2 * lane], kg1 = kn[2 * lane + 1];
  const float freq = exp2f(-(float)(lane & 31) * 0.41524101186092029f);
  for (int m = blockIdx.x * 8 + wid; m < MTOK; m += gridDim.x * 8) {
    const bool smp = m >= NPR;
    float cs = 1.f, sn = 0.f;
    if (smp) { const int t = (m - NPR) & 1023; const float pos = (float)(lane < 32 ? (t >> 6) : (t & 63)); const float rev = (pos * freq) * INV_2PI; cs = cos_rev(rev); sn = sin_rev(rev); }
    for (int s = 0; s < 12; ++s) {
      const unsigned raw = QKV[(size_t)m * 768 + s * 64 + lane];
      float x0 = __uint_as_float(raw << 16), x1 = __uint_as_float(raw & 0xFFFF0000u);
      if (s < 10) {
        const float ss = wave_sum(x0 * x0 + x1 * x1);
        const float r = rsqrtf(ss * (1.f / 128.f) + EPS);
        x0 = x0 * r * (s < 8 ? qg0 : kg0); x1 = x1 * r * (s < 8 ? qg1 : kg1);
        if (smp) { const float a = x0, b = x1; x0 = a * cs - b * sn; x1 = a * sn + b * cs; }
      }
      const unsigned w = pack2(x0, x1);
      if (s < 8) Q[(size_t)m * 512 + s * 64 + lane] = w;
      else {
        const int kv = (s - 8) & 1; const bool isk = s < 10;
        if (!smp) {
          (isk ? KP : VP)[(size_t)m * 128 + kv * 64 + lane] = w;
          const int b = m >> 8, t = m & 255;
          float* o = (isk ? newk : newv) + ((((size_t)b * 2 + j) * 256 + t) * 2 + kv) * 128 + 2 * lane;
          o[0] = x0; o[1] = x1;
        } else {
          const int b = (m - NPR) >> 10, t = (m - NPR) & 1023;
          (isk ? KS : VS)[((size_t)b * 1536 + t) * 128 + kv * 64 + lane] = w;
        }
      }
    }
  }
}

__device__ void phase_att_naive(const Params& p, int j, unsigned char* lds) {
  const int lane = tidx() & 63, wid = tidx() >> 6;
  float* qs = (float*)lds + wid * 1664; float* sl = qs + 128;
  const bf16_t* Q = (const bf16_t*)(p.ws + WS_Q); bf16_t* O = (bf16_t*)(p.ws + WS_O);
  const bf16_t* KP = (const bf16_t*)(p.ws + WS_KP); const bf16_t* VP = (const bf16_t*)(p.ws + WS_VP);
  const bf16_t* KS = (const bf16_t*)(p.ws + WS_KS) + (size_t)j * 4 * 1536 * 256; const bf16_t* VS = (const bf16_t*)(p.ws + WS_VS) + (size_t)j * 4 * 1536 * 256;
  const float scale = 0.08838834764831845f;
  for (int u = blockIdx.x * 8 + wid; u < MTOK * 8; u += gridDim.x * 8) {
    const int m = u >> 3, h = u & 7, kv = h >> 2;
    const bool smp = m >= NPR;
    const int nk = smp ? 1536 : 256;
    const size_t kb = smp ? ((size_t)((m - NPR) >> 10) * 1536) * 256 : ((size_t)(m >> 8) * 256) * 256;
    const bf16_t* Kb = (smp ? KS : KP) + kb + kv * 128; const bf16_t* Vb = (smp ? VS : VP) + kb + kv * 128;
    { const unsigned raw = *(const unsigned*)(Q + (size_t)m * D + h * 128 + 2 * lane); qs[2 * lane] = __uint_as_float(raw << 16); qs[2 * lane + 1] = __uint_as_float(raw & 0xFFFF0000u); }
    float mx = -1e30f;
    for (int k = lane; k < nk; k += 64) {
      const bf16_t* kr = Kb + (size_t)k * 256;
      float acc = 0.f;
      for (int d0 = 0; d0 < 128; d0 += 8) {
        const u32x4 w = *(const u32x4*)(kr + d0);
        acc += qs[d0 + 0] * __uint_as_float(w.x << 16) + qs[d0 + 1] * __uint_as_float(w.x & 0xFFFF0000u)
             + qs[d0 + 2] * __uint_as_float(w.y << 16) + qs[d0 + 3] * __uint_as_float(w.y & 0xFFFF0000u)
             + qs[d0 + 4] * __uint_as_float(w.z << 16) + qs[d0 + 5] * __uint_as_float(w.z & 0xFFFF0000u)
             + qs[d0 + 6] * __uint_as_float(w.w << 16) + qs[d0 + 7] * __uint_as_float(w.w & 0xFFFF0000u);
      }
      acc *= scale; sl[k] = acc; mx = fmaxf(mx, acc);
    }
    mx = wave_max(mx);
    float sum = 0.f;
    for (int k = lane; k < nk; k += 64) { const float e = expf(sl[k] - mx); sl[k] = e; sum += e; }
    sum = wave_sum(sum);
    float a0 = 0.f, a1 = 0.f;
    for (int k = 0; k < nk; ++k) {
      const float pk = sl[k];
      const unsigned raw = *(const unsigned*)(Vb + (size_t)k * 256 + 2 * lane);
      a0 += pk * __uint_as_float(raw << 16); a1 += pk * __uint_as_float(raw & 0xFFFF0000u);
    }
    const float inv = 1.f / sum;
    *(unsigned*)(O + (size_t)m * D + h * 128 + 2 * lane) = pack2(a0 * inv, a1 * inv);
  }
}


namespace att {
typedef unsigned short bf16;
constexpr int   D = 128, NW = 8, QBLK = 32, KVBLK = 64;
constexpr float SCALE = 0.088388347648318440f;
constexpr float THR = 8.f;
constexpr int SDEPTH = 2;
constexpr int LDQ = 1024, LDK = 256, LDO = 1024;
constexpr size_t SHM_V = KVBLK * D * 2, SHM_K = KVBLK * D * 2, SHM_ATTN = 2 * SHM_V + 2 * SHM_K + NW * 64 * 4;

using s16x4  = __attribute__((ext_vector_type(4))) short;
using f32x16 = __attribute__((ext_vector_type(16))) float;
using f32x8  = __attribute__((ext_vector_type(8))) float;

#define KSWZ(row, colB) ((row) * 256 + ((colB) ^ (((row) & 7) << 4)))
#define SBAR() __builtin_amdgcn_sched_barrier(0)
__device__ __forceinline__ int crow(int r, int hi) { return (r & 3) + 8 * (r >> 2) + 4 * hi; }
__device__ __forceinline__ unsigned cvtpk(float lo, float hi) {
  unsigned r; asm volatile("v_cvt_pk_bf16_f32 %0, %1, %2" : "=v"(r) : "v"(lo), "v"(hi)); return r;
}
template <typename TIn> struct Stage;
template <> struct Stage<bf16>  { using T = bf16x8;
  __device__ static __forceinline__ T ld8(const bf16* p) { return *reinterpret_cast<const bf16x8*>(p); }
  __device__ static __forceinline__ bf16x8 tobf(T x) { return x; } };
template <> struct Stage<float> { using T = f32x8;
  __device__ static __forceinline__ T ld8(const float* p) { return *reinterpret_cast<const f32x8*>(p); }
  __device__ static __forceinline__ bf16x8 tobf(T x) {
    u32x4 w = {cvtpk(x[0], x[1]), cvtpk(x[2], x[3]), cvtpk(x[4], x[5]), cvtpk(x[6], x[7])}; return *reinterpret_cast<bf16x8*>(&w); } };

__device__ __forceinline__ void partialSM(f32x16& p0, f32x16& p1, float& m_reg, float& mn, float& alpha) {
  constexpr float C = SCALE * 1.4426950408889634f;
  float pmax = p0[0]; for (int r = 1; r < 16; ++r) pmax = fmaxf(pmax, p0[r]); for (int r = 0; r < 16; ++r) pmax = fmaxf(pmax, p1[r]);
  { auto rr = __builtin_amdgcn_permlane32_swap(__float_as_uint(pmax), __float_as_uint(pmax), false, false);
    pmax = fmaxf(__uint_as_float(rr[0]), __uint_as_float(rr[1])); }
  if (__builtin_expect(__all(pmax - m_reg <= THR / SCALE), 1)) { mn = m_reg; alpha = 1.f; }
  else { mn = fmaxf(m_reg, pmax); alpha = __builtin_amdgcn_exp2f((m_reg - mn) * C); m_reg = mn; }
  float mnC = -mn * C;
  for (int r = 0; r < 16; ++r) p0[r] = fmaf(p0[r], C, mnC); for (int r = 0; r < 16; ++r) p1[r] = fmaf(p1[r], C, mnC);
  for (int r = 0; r < 16; ++r) p0[r] = __builtin_amdgcn_exp2f(p0[r]);
}
__device__ __forceinline__ void finishSM(f32x16& p0, f32x16& p1, float alpha, float& l_reg, bf16x8& pa0, bf16x8& pa1, bf16x8& pa2, bf16x8& pa3) {
  for (int r = 0; r < 16; ++r) p1[r] = __builtin_amdgcn_exp2f(p1[r]);
  float ps = 0; for (int r = 0; r < 16; ++r) ps += p0[r]; for (int r = 0; r < 16; ++r) ps += p1[r];
  { auto rr = __builtin_amdgcn_permlane32_swap(__float_as_uint(ps), __float_as_uint(ps), false, false);
    ps = __uint_as_float(rr[0]) + __uint_as_float(rr[1]); }
  l_reg = l_reg * alpha + ps;
#define PK4(P, BASE, OUT) do { unsigned a0 = cvtpk(P[BASE + 0], P[BASE + 1]), a1 = cvtpk(P[BASE + 2], P[BASE + 3]);   \
    unsigned b0 = cvtpk(P[BASE + 4], P[BASE + 5]), b1 = cvtpk(P[BASE + 6], P[BASE + 7]);                              \
    auto r0 = __builtin_amdgcn_permlane32_swap(a0, b0, false, false); auto r1 = __builtin_amdgcn_permlane32_swap(a1, b1, false, false); \
    u32x4 w = {r0[0], r1[0], r0[1], r1[1]}; OUT = *reinterpret_cast<bf16x8*>(&w); } while (0)
  PK4(p0, 0, pa0); PK4(p0, 8, pa1); PK4(p1, 0, pa2); PK4(p1, 8, pa3);
#undef PK4
}
__device__ __forceinline__ void qkt(f32x16& p0, f32x16& p1, const bf16* Ks, const bf16x8* qr, int r32, int hi) {
  p0 = f32x16{}; p1 = f32x16{};
  for (int d0 = 0; d0 < 8; ++d0) { int cb = (d0 * 16 + hi * 8) * 2;
    bf16x8 b0 = *reinterpret_cast<const bf16x8*>((const char*)Ks + KSWZ(r32, cb));
    bf16x8 b1 = *reinterpret_cast<const bf16x8*>((const char*)Ks + KSWZ(32 + r32, cb));
    p0 = __builtin_amdgcn_mfma_f32_32x32x16_bf16(b0, qr[d0], p0, 0, 0, 0);
    p1 = __builtin_amdgcn_mfma_f32_32x32x16_bf16(b1, qr[d0], p1, 0, 0, 0); }
}
__device__ __forceinline__ int v_st(int k, int c) { const int kk = (k & ~0xC) | ((k & 4) << 1) | ((k & 8) >> 1); return ((kk >> 3) * 4 + (c >> 5)) * 512 + ((kk & 7) * 32 + (c & 31)) * 2; }
__device__ __forceinline__ int v_rd_base(int lane) { return ((lane & 3) << 3) | (((lane >> 2) & 3) << 6) | (((lane >> 4) & 1) << 5) | (((lane >> 5) & 1) << 8); }
constexpr int v_rd_off(int d0, int ks, int half) { return d0 * 512 + ks * 4096 + half * 2048; }
template <int OFF> __device__ __forceinline__ s16x4 tr_read(int vb) {
  s16x4 r; asm volatile("ds_read_b64_tr_b16 %0, %1 offset:%2" : "=&v"(r) : "v"(vb), "i"(OFF) : "memory"); return r;
}
template <int D0> __device__ __forceinline__ void pv_one(f32x16& od, int vb, bf16x8 pa0, bf16x8 pa1, bf16x8 pa2, bf16x8 pa3) {
  const s16x4 l0 = tr_read<v_rd_off(D0, 0, 0)>(vb), h0 = tr_read<v_rd_off(D0, 0, 1)>(vb), l1 = tr_read<v_rd_off(D0, 1, 0)>(vb), h1 = tr_read<v_rd_off(D0, 1, 1)>(vb);
  const s16x4 l2 = tr_read<v_rd_off(D0, 2, 0)>(vb), h2 = tr_read<v_rd_off(D0, 2, 1)>(vb), l3 = tr_read<v_rd_off(D0, 3, 0)>(vb), h3 = tr_read<v_rd_off(D0, 3, 1)>(vb);
  asm volatile("s_waitcnt lgkmcnt(0)" ::: "memory"); SBAR();
#define PK(L, H) (bf16x8){L[0], L[1], L[2], L[3], H[0], H[1], H[2], H[3]}
  od = __builtin_amdgcn_mfma_f32_32x32x16_bf16(pa0, PK(l0, h0), od, 0, 0, 0);
  od = __builtin_amdgcn_mfma_f32_32x32x16_bf16(pa1, PK(l1, h1), od, 0, 0, 0);
  od = __builtin_amdgcn_mfma_f32_32x32x16_bf16(pa2, PK(l2, h2), od, 0, 0, 0);
  od = __builtin_amdgcn_mfma_f32_32x32x16_bf16(pa3, PK(l3, h3), od, 0, 0, 0);
#undef PK
}
__device__ __forceinline__ void pv_d0(f32x16* o, int vb, bf16x8 pa0, bf16x8 pa1, bf16x8 pa2, bf16x8 pa3) {
  pv_one<0>(o[0], vb, pa0, pa1, pa2, pa3); pv_one<1>(o[1], vb, pa0, pa1, pa2, pa3); pv_one<2>(o[2], vb, pa0, pa1, pa2, pa3); pv_one<3>(o[3], vb, pa0, pa1, pa2, pa3);
}

template <typename TQ>
__device__ __forceinline__ void attn_dense_body(const TQ* __restrict__ Qb, const bf16* __restrict__ Kh, const bf16* __restrict__ Vh,
                                                bf16* __restrict__ Ob, int seq, char* lds) {
  using St = Stage<bf16>; using SQ = Stage<TQ>;
  const int tid = tidx(), wid = tid >> 6, lane = tid & 63, r32 = lane & 31, hi = lane >> 5;
  bf16* V_lds = (bf16*)lds; bf16* K_lds = (bf16*)(lds + 2 * SHM_V);
  float* ws = (float*)(lds + 2 * SHM_V + 2 * SHM_K) + wid * 64; float* li_l = ws; float* al_l = ws + 32;
  float m_reg = -1e30f, l_reg = 0; f32x16 o[4] = {}; bf16x8 qr[8];
  const TQ* Qw = Qb + (long)(wid * QBLK + r32) * LDQ + hi * 8;
#pragma unroll
  for (int d0 = 0; d0 < 8; ++d0) qr[d0] = SQ::tobf(SQ::ld8(Qw + d0 * 16));
  const int sr = tid >> 4, sc = (tid & 15) * 8, vst0 = v_st(sr, sc), vst1 = v_st(32 + sr, sc);
  const int vb0 = (int)(uintptr_t)V_lds + v_rd_base(lane);
  struct { typename St::T vs0, vs1, ks0, ks1; } sr_[SDEPTH];
#define SLOAD(i, k0) do { sr_[i].vs0 = St::ld8(&Vh[(long)((k0) + sr) * LDK + sc]); sr_[i].vs1 = St::ld8(&Vh[(long)((k0) + 32 + sr) * LDK + sc]); \
    sr_[i].ks0 = St::ld8(&Kh[(long)((k0) + sr) * LDK + sc]); sr_[i].ks1 = St::ld8(&Kh[(long)((k0) + 32 + sr) * LDK + sc]); } while (0)
#define SWRITE(b, i) do { *(bf16x8*)((char*)V_lds + (b) * SHM_V + vst0) = St::tobf(sr_[i].vs0);          \
    *(bf16x8*)((char*)V_lds + (b) * SHM_V + vst1) = St::tobf(sr_[i].vs1); int kc = sc * 2;               \
    *(bf16x8*)((char*)K_lds + (b) * SHM_K + KSWZ(sr, kc)) = St::tobf(sr_[i].ks0);                       \
    *(bf16x8*)((char*)K_lds + (b) * SHM_K + KSWZ(32 + sr, kc)) = St::tobf(sr_[i].ks1); } while (0)
#define SWAIT() do { if constexpr (SDEPTH == 2) asm volatile("s_waitcnt vmcnt(4)" ::: "memory"); else asm volatile("s_waitcnt vmcnt(0)" ::: "memory"); } while (0)
#define RESC(a) do { if (__any((a) < 1.f)) { if (hi == 0) al_l[r32] = (a); asm volatile("s_waitcnt lgkmcnt(0)" ::: "memory"); \
    for (int d = 0; d < 4; ++d) for (int r = 0; r < 16; ++r) o[d][r] *= al_l[crow(r, hi)]; } } while (0)
  f32x16 pA0, pA1, pB0, pB1; float mnA, mnB, alA, alB; bf16x8 pa0, pa1, pa2, pa3; const int NT = seq / KVBLK;
  constexpr int SE = 0, SO = SDEPTH - 1;
  SLOAD(SE, 0); asm volatile("s_waitcnt vmcnt(0)" ::: "memory"); SWRITE(0, SE); __syncthreads();
  qkt(pA0, pA1, K_lds, qr, r32, hi); partialSM(pA0, pA1, m_reg, mnA, alA);
  SLOAD(SO, KVBLK); if constexpr (SDEPTH == 2) { if (2 < NT) SLOAD(SE, 2 * KVBLK); }
  SWAIT(); SWRITE(1, SO); __syncthreads();
  for (int j = 1; j + 1 < NT; j += 2) {
    SBAR(); qkt(pB0, pB1, (bf16*)((char*)K_lds + SHM_K), qr, r32, hi);
    finishSM(pA0, pA1, alA, l_reg, pa0, pa1, pa2, pa3); SBAR();
    SLOAD(SO, (j + SDEPTH) * KVBLK); SBAR();
    pv_d0(o, vb0, pa0, pa1, pa2, pa3); partialSM(pB0, pB1, m_reg, mnB, alB);
    __syncthreads(); SWAIT(); SWRITE(0, SE);
    RESC(alB); __syncthreads();
    SBAR(); qkt(pA0, pA1, K_lds, qr, r32, hi);
    finishSM(pB0, pB1, alB, l_reg, pa0, pa1, pa2, pa3); SBAR();
    if (SDEPTH == 1 || j + 3 < NT) SLOAD(SE, (j + 1 + SDEPTH) * KVBLK); SBAR();
    pv_d0(o, vb0 + (int)SHM_V, pa0, pa1, pa2, pa3); partialSM(pA0, pA1, m_reg, mnA, alA);
    __syncthreads(); SWAIT(); SWRITE(1, SO);
    RESC(alA); __syncthreads();
  }
  SBAR(); qkt(pB0, pB1, (bf16*)((char*)K_lds + SHM_K), qr, r32, hi);
  finishSM(pA0, pA1, alA, l_reg, pa0, pa1, pa2, pa3); SBAR();
  pv_d0(o, vb0, pa0, pa1, pa2, pa3); partialSM(pB0, pB1, m_reg, mnB, alB);
  __syncthreads(); RESC(alB);
  finishSM(pB0, pB1, alB, l_reg, pa0, pa1, pa2, pa3); SBAR();
  pv_d0(o, vb0 + (int)SHM_V, pa0, pa1, pa2, pa3);
  if (hi == 0) li_l[r32] = l_reg; asm volatile("s_waitcnt lgkmcnt(0)" ::: "memory");
  float rli[16];
#pragma unroll
  for (int r = 0; r < 16; ++r) rli[r] = __builtin_amdgcn_rcpf(li_l[crow(r, hi)]);
  bf16* Ow = Ob + (long)(wid * QBLK) * LDO;
#pragma unroll
  for (int r = 0; r < 16; ++r) { int orow = crow(r, hi);
    for (int d0 = 0; d0 < 4; ++d0) Ow[(long)orow * LDO + d0 * 32 + r32] = f2bf(o[d0][r] * rli[r]); }
#undef SLOAD
#undef SWRITE
#undef SWAIT
#undef RESC
}
}

__device__ void phase_att(const Params& p, int j, unsigned char* lds) {
  const bf16_t* Q = (const bf16_t*)(p.ws + WS_Q); bf16_t* O = (bf16_t*)(p.ws + WS_O);
  const bf16_t* KP = (const bf16_t*)(p.ws + WS_KP); const bf16_t* VP = (const bf16_t*)(p.ws + WS_VP);
  const bf16_t* KS = (const bf16_t*)(p.ws + WS_KS) + (size_t)j * 4 * 1536 * 256; const bf16_t* VS = (const bf16_t*)(p.ws + WS_VS) + (size_t)j * 4 * 1536 * 256;
  for (int u = blockIdx.x; u < 256; u += gridDim.x) {
    __syncthreads();
    if (u < 128) {
      const int qb = u & 3, h = (u >> 2) & 7, b = u >> 5, kv = h >> 2;
      const size_t row0 = (size_t)NPR + b * 1024 + qb * 256, kb = ((size_t)b * 1536) * 256 + kv * 128;
      att::attn_dense_body<att::bf16>(Q + row0 * D + h * 128, KS + kb, VS + kb, O + row0 * D + h * 128, 1536, (char*)lds);
    } else {
      const int h = (u - 128) & 7, b = (u - 128) >> 3, kv = h >> 2;
      const size_t row0 = (size_t)b * 256, kb = row0 * 256 + kv * 128;
      att::attn_dense_body<att::bf16>(Q + row0 * D + h * 128, KP + kb, VP + kb, O + row0 * D + h * 128, 256, (char*)lds);
    }
  }
  __syncthreads();
}

#define XB_TMO      128
#define XB_XCNT(j)  (256  + 64 * (j))
#define XB_XSUB(j)  (1280 + 64 * (j))
#define XB_XGEN(j)  (2304 + 64 * (j))
#define XB_TOP      3328
#define XB_TOPGEN   3392
#define XCD_BAR_WORDS 3456
#define XB_SPIN_CAP (1u << 18)
#define LAS __attribute__((address_space(3)))

__device__ __forceinline__ unsigned xb_ld(unsigned* p)              { return __hip_atomic_load(p, __ATOMIC_RELAXED, __HIP_MEMORY_SCOPE_AGENT); }
__device__ __forceinline__ unsigned xb_add(unsigned* p, unsigned v) { return __hip_atomic_fetch_add(p, v, __ATOMIC_RELAXED, __HIP_MEMORY_SCOPE_AGENT); }
__device__ __forceinline__ unsigned xb_xcc_id() { return (unsigned)__builtin_amdgcn_s_getreg((3 << 11) | 20) & 0xFu; }
#define XB_SPIN(cond, bar) do { unsigned _sp = 0; while (cond) { __builtin_amdgcn_s_sleep(1); \
    if ((++_sp & 255u) == 0u) { if (xb_ld(&(bar)[XB_TMO])) break; if (_sp > XB_SPIN_CAP) { atomicAdd(&(bar)[XB_TMO], 1u); break; } } } } while (0)

struct XcdBarrier {
    unsigned* bar; unsigned x;
    volatile LAS unsigned* st;
};

__device__ __forceinline__ XcdBarrier xcd_barrier_post(unsigned* bar, volatile LAS unsigned* st) {
    XcdBarrier b; b.bar = bar; b.x = xb_xcc_id(); b.st = st;
    if (threadIdx.x == 0) (void)xb_add(&bar[XB_XCNT(b.x)], 1u);
    return b;
}
__device__ __forceinline__ void xcd_barrier_complete(unsigned* bar, unsigned x, unsigned& nloc, unsigned& nx) {
    const unsigned G = gridDim.x * gridDim.y * gridDim.z;
    unsigned sum, cnt, mine, sp = 0u;
    for (;;) {
        sum = 0u; cnt = 0u; mine = 0u;
#pragma unroll
        for (unsigned j = 0; j < 16; ++j) { const unsigned c = xb_ld(&bar[XB_XCNT(j)]); sum += c; cnt += (c > 0u) ? 1u : 0u; mine = (j == x) ? c : mine; }
        if (sum == G) break;
        __builtin_amdgcn_s_sleep(1);
        if ((++sp & 255u) == 0u) { if (xb_ld(&bar[XB_TMO])) break; if (sp > XB_SPIN_CAP) { atomicAdd(&bar[XB_TMO], 1u); break; } }
    }
    nloc = mine > 0u ? mine : 1u; nx = cnt > 0u ? cnt : 1u;
}

__device__ __forceinline__ void xcd_barrier(const XcdBarrier& b) {
    asm volatile("s_waitcnt vmcnt(0)" ::: "memory");
    __syncthreads();
    if (threadIdx.x == 0) {
        unsigned* bar = b.bar;
        __builtin_amdgcn_s_waitcnt(0);
        unsigned nloc = b.st[0], nx = b.st[1];
        if (nloc == 0u) { xcd_barrier_complete(bar, b.x, nloc, nx); b.st[0] = nloc; b.st[1] = nx; }
        const unsigned old = xb_add(&bar[XB_XSUB(b.x)], 1u);
        const unsigned gen = old / nloc;
        if (old + 1u == (gen + 1u) * nloc) {
            __builtin_amdgcn_fence(__ATOMIC_RELEASE, "agent");
            asm volatile("s_waitcnt vmcnt(0)" ::: "memory");
            const unsigned og = xb_add(&bar[XB_TOP], 1u);
            const unsigned tg = og / nx;
            if (og + 1u == (tg + 1u) * nx) xb_add(&bar[XB_TOPGEN], 1u);
            else XB_SPIN(xb_ld(&bar[XB_TOPGEN]) == tg, bar);
            __builtin_amdgcn_fence(__ATOMIC_ACQUIRE, "agent");
            xb_add(&bar[XB_XGEN(b.x)], 1u);
            asm volatile("s_waitcnt vmcnt(0)" ::: "memory");
        } else {
            XB_SPIN(xb_ld(&bar[XB_XGEN(b.x)]) == gen, bar);
            __builtin_amdgcn_fence(__ATOMIC_ACQUIRE, "agent");
            asm volatile("s_waitcnt vmcnt(0)" ::: "memory");
        }
    }
    __syncthreads();
}

__global__ void __launch_bounds__(512, 2) mega(Params p) {
  extern __shared__ __attribute__((aligned(16))) unsigned char lds[];
  cg::grid_group grid = cg::this_grid();
  volatile LAS unsigned* xst = (volatile LAS unsigned*)((LAS unsigned char*)lds + (LDS_BYTES - 16));
  if (threadIdx.x < 4) xst[threadIdx.x] = 0u;
  __syncthreads();
  const XcdBarrier xbar = xcd_barrier_post((unsigned*)p.ws, xst);
  int ph = 0;
#define RUN(stmt) do { if (ph >= p.ph_lo && ph < p.ph_hi) { stmt; if (ph + 1 < p.ph_hi) { if (ph == 0) grid.sync(); else xcd_barrier(xbar); } } ++ph; } while (0)
  bf16_t* XN = (bf16_t*)(p.ws + WS_XN); float* Y = (float*)(p.ws + WS_Y); const float* MOD = (const float*)(p.ws + WS_MOD);
  RUN(phase_p0(p, lds));
  RUN(phase_p0b(p));
#pragma unroll 1
  for (int l = 0; l < 4; ++l) {
    const int j = l >> 1;
    RUN(phase_nm(p, l, 0));
    if ((l & 1) == 0) {
      RUN(gemm_run(lds, (const bf16_t*)(p.ws + WS_WIN) + (size_t)j * 3072 * D, XN, 3072, MTOK, D, 1, pg8::EpiBf16{(bf16_t*)(p.ws + WS_ZT), MTOK}));
      RUN(phase_lc(p, j, lds));
      RUN(gemm_run(lds, (const bf16_t*)(p.ws + WS_YG), (const bf16_t*)(p.ws + WS_WHO) + (size_t)j * D * D, MTOK, D, D, 2, pg8::EpiGate<true>{Y, MOD + (size_t)l * 5 * 6144 + 2048}));
    } else {
      RUN(gemm_run(lds, XN, (const bf16_t*)(p.ws + WS_WQKV) + (size_t)j * QKVD * D, MTOK, QKVD, D, 1, pg8::EpiBf16{(bf16_t*)(p.ws + WS_QKV), QKVD}));
      RUN(phase_qkvpost(p, j));
      RUN(phase_att(p, j, lds));
      RUN(gemm_run(lds, (const bf16_t*)(p.ws + WS_O), (const bf16_t*)(p.ws + WS_WAO) + (size_t)j * D * D, MTOK, D, D, 2, pg8::EpiGate<true>{Y, MOD + (size_t)l * 5 * 6144 + 2048}));
    }
    RUN(phase_nm(p, l, 1));
    RUN(gemm_run(lds, XN, (const bf16_t*)(p.ws + WS_WGU) + (size_t)l * 2 * DFF * D, MTOK, 2 * DFF, D, 1, pg8::EpiSwiglu{(bf16_t*)(p.ws + WS_H)}));
    RUN(gemm_run(lds, (const bf16_t*)(p.ws + WS_H), (const bf16_t*)(p.ws + WS_WDN) + (size_t)l * D * DFF, MTOK, D, DFF, 2, pg8::EpiGate<true>{Y, MOD + (size_t)l * 5 * 6144 + 5 * 1024}));
  }
  RUN(phase_final(p));
#undef RUN
}
constexpr int N_PHASES = 2 + 2 * 7 + 2 * 8 + 1;


extern "C" void kernel_launch(void* const* d_in, const int* in_sizes, int n_in, void* d_out, int out_size, void* d_ws, size_t ws_size, hipStream_t stream) {
  static int grid = 0;
  if (grid == 0) {
    if (n_in != 29 || ws_size < WS_END) { fprintf(stderr, "kernel_launch: n_in %d ws %zu (need 29, >= %zu)\n", n_in, ws_size, (size_t)WS_END); grid = -1; return; }
    int dev = 0, cus = 0, per_cu = 0;
    hipGetDevice(&dev);
    hipDeviceGetAttribute(&cus, hipDeviceAttributeMultiprocessorCount, dev);
    if (hipFuncSetAttribute((const void*)mega, hipFuncAttributeMaxDynamicSharedMemorySize, LDS_BYTES) != hipSuccess) { fprintf(stderr, "kernel_launch: hipFuncSetAttribute failed\n"); grid = -1; return; }
    hipOccupancyMaxActiveBlocksPerMultiprocessor(&per_cu, (const void*)mega, 512, LDS_BYTES);
    if (per_cu < 1) { fprintf(stderr, "kernel_launch: occupancy query says %d blocks per CU\n", per_cu); per_cu = 1; }
    grid = cus * per_cu;
  }
  if (grid < 0) return;
  Params p{};
  for (int i = 0; i < 29; ++i) p.in[i] = (const float*)d_in[i];
  p.out = (float*)d_out; p.ws = (unsigned char*)d_ws;

  if (hipMemsetAsync(d_ws, 0, 16384, stream) != hipSuccess) { fprintf(stderr, "kernel_launch: memset of the barrier words failed\n"); return; }
  p.ph_lo = 0; p.ph_hi = N_PHASES;
  void* args[] = {&p};
  hipError_t e = hipLaunchCooperativeKernel((const void*)mega, dim3(grid), dim3(512), args, LDS_BYTES, stream);
  if (e != hipSuccess) fprintf(stderr, "cooperative launch failed: %s (grid %d)\n", hipGetErrorString(e), grid);

}
```

```cpp
#include <hip/hip_runtime.h>
#include <hip/hip_cooperative_groups.h>
#include <cstdio>
#include <cstdint>
namespace cg = cooperative_groups;

typedef unsigned short bf16_t;
typedef short bf16x8 __attribute__((ext_vector_type(8)));
typedef float f32x4 __attribute__((ext_vector_type(4)));
typedef unsigned u32x4 __attribute__((ext_vector_type(4)));
typedef float f32x16 __attribute__((ext_vector_type(16)));

constexpr int D = 1024, MTOK = 8192, NPR = 4096;
constexpr int DFF = 2816, QKVD = 1536;
constexpr float EPS = 1e-6f;
constexpr float MIN_DECAY = -3.0701134573253944f, MAX_DECAY = -15.350567286626972f;

constexpr size_t MiB = 1u << 20;
constexpr size_t WS_MOD = 1 * MiB, WS_MODP = 2 * MiB, WS_FSQP = 6 * MiB, WS_RNORM = 7 * MiB, WS_FILT = 8 * MiB;
constexpr size_t WS_WIN = 28 * MiB, WS_WHO = 40 * MiB, WS_WQKV = 44 * MiB, WS_WAO = 50 * MiB, WS_WGU = 54 * MiB, WS_WDN = 98 * MiB;
constexpr size_t WS_Y = 120 * MiB, WS_XN = 152 * MiB, WS_R = 168 * MiB;
constexpr size_t WS_ZT = WS_R, WS_U = WS_R + 48 * MiB, WS_X0C = WS_R + 64 * MiB, WS_YG = WS_R + 80 * MiB;
constexpr size_t WS_QKV = WS_R, WS_Q = WS_R + 24 * MiB, WS_KP = WS_R + 40 * MiB, WS_VP = WS_R + 42 * MiB, WS_O = WS_R + 44 * MiB;
constexpr size_t WS_H = WS_R;
constexpr size_t WS_KS = WS_R + 96 * MiB, WS_VS = WS_R + 102 * MiB, WS_FRG = WS_R + 108 * MiB, WS_END = WS_R + 130 * MiB;
constexpr size_t FRG_J = 11 * MiB / 2, FRG_L1 = (size_t)1024 * (4 * 256 + 40);
constexpr size_t FILT_J = 10 * MiB / 4;
constexpr size_t FILT_L1 = 1024 * 512;

constexpr int LDS_BYTES = 147456;

struct Params {
  const float* in[29];
  float* out;
  unsigned char* ws;
  int ph_lo, ph_hi;
};
enum { I_XP = 0, I_XS, I_CK, I_CV, I_C, I_CCTX, I_MODW, I_MODB, I_NMIX, I_NFFN, I_HWIN, I_HCW, I_HCB, I_FW1, I_FB1, I_FFREQ, I_FW2, I_FB2, I_FW3,
       I_HBIAS, I_HWOUT, I_WQKV, I_QN, I_KN, I_WAO, I_WG, I_WU, I_WD, I_FN };

__device__ __forceinline__ bf16_t f2bf(float f) { unsigned u = __float_as_uint(f); u += 0x7FFFu + ((u >> 16) & 1u); return (bf16_t)(u >> 16); }
__device__ __forceinline__ float bf2f(bf16_t b) { return __uint_as_float(((unsigned)b) << 16); }
__device__ __forceinline__ unsigned pack2(float lo, float hi) { return (unsigned)f2bf(lo) | ((unsigned)f2bf(hi) << 16); }
__device__ __forceinline__ float wave_sum(float v) {
#pragma unroll
  for (int o = 32; o >= 1; o >>= 1) v += __shfl_xor(v, o);
  return v;
}
__device__ __forceinline__ float wave_max(float v) {
#pragma unroll
  for (int o = 32; o >= 1; o >>= 1) v = fmaxf(v, __shfl_xor(v, o));
  return v;
}
__device__ __forceinline__ int tidx() { int t = threadIdx.x; asm volatile("" : "+v"(t)); return t; }
__device__ __forceinline__ int cond_of(int m) { return m < NPR ? 4 : ((m - NPR) >> 10); }
__device__ __forceinline__ float silu_f(float x) { return x / (1.f + expf(-x)); }
__device__ __forceinline__ float sin_rev(float r) { return __builtin_amdgcn_sinf(r - rintf(r)); }
__device__ __forceinline__ float cos_rev(float r) { return __builtin_amdgcn_cosf(r - rintf(r)); }
constexpr float INV_2PI = 0.15915494309189535f;

struct TileDesc { const float* src; bf16_t* dst; int K, N, k0, n0, mode; };
constexpr int NT_WIN = 2 * 16 * 24, NT_WHO = 2 * 16 * 8, NT_WQKV = 2 * 16 * 12, NT_WAO = 2 * 16 * 8, NT_G = 4 * 16 * 22, NT_DN = 4 * 44 * 8;
constexpr int NT_CVT = NT_WIN + NT_WHO + NT_WQKV + NT_WAO + 2 * NT_G + NT_DN;
__device__ __forceinline__ TileDesc cvt_decode(const Params& p, int t) {
  TileDesc d;
  if (t < NT_WIN) { const int l = t / (16 * 24), r = t % (16 * 24); d.src = p.in[I_HWIN] + (size_t)l * D * 3072; d.dst = (bf16_t*)(p.ws + WS_WIN) + (size_t)l * 3072 * D; d.K = D; d.N = 3072; d.k0 = (r / 24) * 64; d.n0 = (r % 24) * 128; d.mode = 0; return d; }
  t -= NT_WIN;
  if (t < NT_WHO) { const int l = t / 128, r = t % 128; d.src = p.in[I_HWOUT] + (size_t)l * D * D; d.dst = (bf16_t*)(p.ws + WS_WHO) + (size_t)l * D * D; d.K = D; d.N = D; d.k0 = (r / 8) * 64; d.n0 = (r % 8) * 128; d.mode = 0; return d; }
  t -= NT_WHO;
  if (t < NT_WQKV) { const int l = t / (16 * 12), r = t % (16 * 12); d.src = p.in[I_WQKV] + (size_t)l * D * QKVD; d.dst = (bf16_t*)(p.ws + WS_WQKV) + (size_t)l * QKVD * D; d.K = D; d.N = QKVD; d.k0 = (r / 12) * 64; d.n0 = (r % 12) * 128; d.mode = 0; return d; }
  t -= NT_WQKV;
  if (t < NT_WAO) { const int l = t / 128, r = t % 128; d.src = p.in[I_WAO] + (size_t)l * D * D; d.dst = (bf16_t*)(p.ws + WS_WAO) + (size_t)l * D * D; d.K = D; d.N = D; d.k0 = (r / 8) * 64; d.n0 = (r % 8) * 128; d.mode = 0; return d; }
  t -= NT_WAO;
  if (t < 2 * NT_G) { const int up = t >= NT_G ? 1 : 0; t -= up * NT_G; const int l = t / (16 * 22), r = t % (16 * 22);
    d.src = p.in[up ? I_WU : I_WG] + (size_t)l * D * DFF; d.dst = (bf16_t*)(p.ws + WS_WGU) + (size_t)l * 2 * DFF * D; d.K = D; d.N = DFF; d.k0 = (r / 22) * 64; d.n0 = (r % 22) * 128; d.mode = 1 + up; return d; }
  t -= 2 * NT_G;
  { const int l = t / (44 * 8), r = t % (44 * 8); d.src = p.in[I_WD] + (size_t)l * DFF * D; d.dst = (bf16_t*)(p.ws + WS_WDN) + (size_t)l * D * DFF; d.K = DFF; d.N = D; d.k0 = (r / 8) * 64; d.n0 = (r % 8) * 128; d.mode = 0; return d; }
}
__device__ __forceinline__ void cvt_load(const TileDesc& d, int tid, f32x4 (&v)[4]) {
  const int r = tid >> 5, c4 = (tid & 31) * 4;
#pragma unroll
  for (int h = 0; h < 4; ++h) v[h] = *(const f32x4*)(d.src + (size_t)(d.k0 + r + 16 * h) * d.N + d.n0 + c4);
}
__device__ void cvt_all(const Params& p, float* tile  ) {
  const int tid = tidx(), G = gridDim.x;
  int t = blockIdx.x;
  if (t >= NT_CVT) return;
  TileDesc cur = cvt_decode(p, t);
  f32x4 v[4];
  cvt_load(cur, tid, v);
  for (;;) {
    __syncthreads();
    {
      const int r = tid >> 5, c4 = (tid & 31) * 4;
#pragma unroll
      for (int h = 0; h < 4; ++h) { float* q = tile + (r + 16 * h) * 129 + c4; q[0] = v[h][0]; q[1] = v[h][1]; q[2] = v[h][2]; q[3] = v[h][3]; }
    }
    const int tn = t + G; const bool has = tn < NT_CVT;
    TileDesc nx = cur;
    if (has) { nx = cvt_decode(p, tn); cvt_load(nx, tid, v); }
    __syncthreads();
    {
      const int n = tid >> 2, kc = (tid & 3) * 16;
      u32x4 w0, w1;
      w0.x = pack2(tile[(kc + 0) * 129 + n], tile[(kc + 1) * 129 + n]); w0.y = pack2(tile[(kc + 2) * 129 + n], tile[(kc + 3) * 129 + n]);
      w0.z = pack2(tile[(kc + 4) * 129 + n], tile[(kc + 5) * 129 + n]); w0.w = pack2(tile[(kc + 6) * 129 + n], tile[(kc + 7) * 129 + n]);
      w1.x = pack2(tile[(kc + 8) * 129 + n], tile[(kc + 9) * 129 + n]); w1.y = pack2(tile[(kc + 10) * 129 + n], tile[(kc + 11) * 129 + n]);
      w1.z = pack2(tile[(kc + 12) * 129 + n], tile[(kc + 13) * 129 + n]); w1.w = pack2(tile[(kc + 14) * 129 + n], tile[(kc + 15) * 129 + n]);
      const int ng = cur.n0 + n;
      const int row = cur.mode == 0 ? ng : ((ng >> 7) * 256 + (ng & 127) + (cur.mode == 2 ? 128 : 0));
      bf16_t* o = cur.dst + (size_t)row * cur.K + cur.k0 + kc;
      *(u32x4*)o = w0; *(u32x4*)(o + 8) = w1;
    }
    if (!has) break;
    cur = nx; t = tn;
  }
  __syncthreads();
}

constexpr int NT_MOD = 4 * 3 * 16;
__device__ void task_mod(const Params& p, int t, float* sl  ) {
  const int tid = tidx();
  const int l = t / 48, rem = t % 48, cb = rem / 16, kc = rem % 16;
  __syncthreads();
  if (tid < 320) {
    const int j = tid >> 6, k = kc * 64 + (tid & 63);
    const float x = j < 4 ? p.in[I_C][j * D + k] : p.in[I_CCTX][k];
    sl[tid] = silu_f(x);
  }
  __syncthreads();
  const int n = cb * 2048 + tid * 4;
  const float* w = p.in[I_MODW] + ((size_t)l * D + kc * 64) * 6144 + n;
  f32x4 a0 = {0.f, 0.f, 0.f, 0.f}, a1 = a0, a2 = a0, a3 = a0, a4 = a0;
#pragma unroll 8
  for (int k = 0; k < 64; ++k) {
    const f32x4 wv = *(const f32x4*)(w + (size_t)k * 6144);
    a0 += wv * sl[k]; a1 += wv * sl[64 + k]; a2 += wv * sl[128 + k]; a3 += wv * sl[192 + k]; a4 += wv * sl[256 + k];
  }
  float* o = (float*)(p.ws + WS_ZT) + ((size_t)(kc * 4 + l) * 5) * 6144 + n;
  *(f32x4*)o = a0; *(f32x4*)(o + 6144) = a1; *(f32x4*)(o + 2 * 6144) = a2; *(f32x4*)(o + 3 * 6144) = a3; *(f32x4*)(o + 4 * 6144) = a4;
}

constexpr int NT_FILT = 320;
__device__ void task_filt(const Params& p, int t, float* h1  , float* h2  ) {
  const int tid = tidx(), lane = tid & 63, wid = __builtin_amdgcn_readfirstlane(tid >> 6);
  const int combo = t >> 3, nchunk = t & 7;
  const int j = combo / 20, r = combo % 20;
  const int lsel = r < 4 ? 0 : 1, tchunk = r < 4 ? r : r - 4, L = lsel ? 1024 : 256;
  const int tt = lane, tpos = tchunk * 64 + tt;
  const float tn = (float)tpos / (float)L;
  const float* __restrict__ w1 = p.in[I_FW1] + (size_t)j * 33 * 64;
  const float* __restrict__ b1 = p.in[I_FB1] + j * 64;
  const float* __restrict__ fr = p.in[I_FFREQ] + j * 128;
  const float* __restrict__ w2 = p.in[I_FW2] + (size_t)j * 64 * 64;
  const float* __restrict__ b2 = p.in[I_FB2] + j * 64;
  const float* __restrict__ w3 = p.in[I_FW3] + (size_t)j * 64 * 2048;
  __syncthreads();
  {
    const int u0 = wid * 8;
    float acc[8];
#pragma unroll
    for (int uu = 0; uu < 8; ++uu) acc[uu] = tn * w1[u0 + uu];
    for (int b = 1; b <= 16; ++b) {
      const float rev = tn * (float)b;
      const float cs = cos_rev(rev), sn = sin_rev(rev);
#pragma unroll
      for (int uu = 0; uu < 8; ++uu) acc[uu] += cs * w1[b * 64 + u0 + uu] + sn * w1[(16 + b) * 64 + u0 + uu];
    }
#pragma unroll
    for (int uu = 0; uu < 8; ++uu) h1[tt * 65 + u0 + uu] = sin_rev(INV_2PI * (fr[u0 + uu] * (acc[uu] + b1[u0 + uu])));
  }
  __syncthreads();
  {
    const int u0 = wid * 8;
    float acc[8];
#pragma unroll
    for (int uu = 0; uu < 8; ++uu) acc[uu] = 0.f;
    for (int v = 0; v < 64; ++v) {
      const float hv = h1[tt * 65 + v];
#pragma unroll
      for (int uu = 0; uu < 8; ++uu) acc[uu] += hv * w2[v * 64 + u0 + uu];
    }
#pragma unroll
    for (int uu = 0; uu < 8; ++uu) h2[tt * 65 + u0 + uu] = sin_rev(INV_2PI * (fr[64 + u0 + uu] * (acc[uu] + b2[u0 + uu])));
  }
  __syncthreads();
  float* fsq = (float*)(p.ws + WS_FSQP) + ((size_t)((j * 2 + lsel) * 16 + tchunk)) * 2048;
  const int nb = nchunk * 256 + wid * 32;
  float acc[32];
#pragma unroll
  for (int q = 0; q < 32; ++q) acc[q] = 0.f;
  for (int v = 0; v < 64; ++v) {
    const float hv = h2[tt * 65 + v];
    const float* __restrict__ wr = w3 + v * 2048 + nb;
#pragma unroll
    for (int q = 0; q < 32; ++q) acc[q] += hv * wr[q];
  }
#pragma unroll
  for (int q = 0; q < 32; ++q) {
    const int n = nb + q, c = n & 1023; const bool isb = n >= 1024;
    const float delta = fabsf(MIN_DECAY + (MAX_DECAY - MIN_DECAY) * ((float)c / 1023.f));
    float val = acc[q] * expf(-tn * delta);
    if (isb && tpos == 0) val = 0.f;
    bf16_t* rec = (bf16_t*)(p.ws + WS_FRG) + (size_t)j * FRG_J + (lsel ? FRG_L1 : 0) + (size_t)c * (4 * L + 40);
    if (isb && tpos == 0) rec[0] = 0;
    else { const int i = isb ? (L + tpos) : (L - tpos); const bf16_t bv = f2bf(val); rec[i] = bv; rec[2 * L + 40 + i - 1] = bv; }
    const float s = wave_sum(val * val);
    if (lane == 0) fsq[n] = s;
  }
}

__device__ void phase_p0(const Params& p, unsigned char* lds) {
  float* fl = (float*)lds;
  const int G = gridDim.x, b = blockIdx.x, tid = tidx();
  for (int t = b; t < NT_FILT + NT_MOD; t += G) {
    __syncthreads();
    if (t < NT_FILT) task_filt(p, t, fl, fl + 64 * 65);
    else task_mod(p, t - NT_FILT, fl);
  }
  cvt_all(p, fl);
  {
    f32x4* Y = (f32x4*)(p.ws + WS_Y);
    const f32x4* xp = (const f32x4*)p.in[I_XP]; const f32x4* xs = (const f32x4*)p.in[I_XS];
    const int half = NPR * D / 4;
    for (int i = b * 512 + tid; i < 2 * half; i += G * 512) Y[i] = i < half ? xp[i] : xs[i - half];
  }
  {
    bf16_t* KS = (bf16_t*)(p.ws + WS_KS); bf16_t* VS = (bf16_t*)(p.ws + WS_VS);
    const int n = 4 * 2 * 512 * 256;
    for (int i = b * 512 + tid; i < n; i += G * 512) {
      const int e = i & 255, pos = (i >> 8) & 511, j = (i >> 17) & 1, bb = i >> 18;
      const size_t o = ((size_t)(j * 4 + bb) * 1536 + 1024 + pos) * 256 + e;
      KS[o] = f2bf(p.in[I_CK][i]); VS[o] = f2bf(p.in[I_CV][i]);
    }
  }
}

__device__ void phase_p0b(const Params& p) {
  const int G = gridDim.x, b = blockIdx.x, tid = tidx();
  float* MOD = (float*)(p.ws + WS_MOD); const float* MP = (const float*)(p.ws + WS_ZT);
  for (int i = b * 512 + tid; i < 4 * 5 * 6144; i += G * 512) {
    const int n = i % 6144, l = i / (5 * 6144);
    float s = p.in[I_MODB][l * 6144 + n];
#pragma unroll
    for (int kc = 0; kc < 16; ++kc) s += MP[(size_t)kc * (4 * 5 * 6144) + i];
    MOD[i] = s;
  }
  float* RN = (float*)(p.ws + WS_RNORM); const float* FS = (const float*)(p.ws + WS_FSQP);
  for (int i = b * 512 + tid; i < 4096; i += G * 512) {
    const int c = i & 1023, jl = i >> 10, nch = (jl & 1) ? 16 : 4;
    float s = 0.f;
    for (int ch = 0; ch < nch; ++ch) s += FS[((size_t)jl * 16 + ch) * 2048 + c] + FS[((size_t)jl * 16 + ch) * 2048 + 1024 + c];
    RN[i] = 1.f / sqrtf(s + EPS);
  }
}

__device__ void phase_nm(const Params& p, int layer, int which) {
  const int lane = tidx() & 63, wid = tidx() >> 6;
  const float* Y = (const float*)(p.ws + WS_Y); bf16_t* XN = (bf16_t*)(p.ws + WS_XN);
  const float* g = p.in[which ? I_NFFN : I_NMIX] + layer * D;
  for (int m = blockIdx.x * 8 + wid; m < MTOK; m += gridDim.x * 8) {
    const float* y = Y + (size_t)m * D;
    f32x4 v[4]; float ss = 0.f;
#pragma unroll
    for (int i = 0; i < 4; ++i) { v[i] = *(const f32x4*)(y + i * 256 + lane * 4); ss += v[i][0] * v[i][0] + v[i][1] * v[i][1] + v[i][2] * v[i][2] + v[i][3] * v[i][3]; }
    ss = wave_sum(ss);
    const float r = rsqrtf(ss * (1.f / D) + EPS);
    const float* mod = (const float*)(p.ws + WS_MOD) + (size_t)(layer * 5 + cond_of(m)) * 6144 + which * 3072;
#pragma unroll
    for (int i = 0; i < 4; ++i) {
      const int k = i * 256 + lane * 4;
      const f32x4 gg = *(const f32x4*)(g + k), sh = *(const f32x4*)(mod + k), sc = *(const f32x4*)(mod + 1024 + k);
      float o[4];
#pragma unroll
      for (int e = 0; e < 4; ++e) o[e] = (v[i][e] * r * gg[e]) * (1.f + sc[e]) + sh[e];
      uint2 w; w.x = pack2(o[0], o[1]); w.y = pack2(o[2], o[3]);
      *(uint2*)(XN + (size_t)m * D + k) = w;
    }
  }
}

__device__ void phase_final(const Params& p) {
  const int lane = tidx() & 63, wid = tidx() >> 6;
  const float* Y = (const float*)(p.ws + WS_Y);
  const float* g = p.in[I_FN];
  for (int m = blockIdx.x * 8 + wid; m < MTOK; m += gridDim.x * 8) {
    const float* y = Y + (size_t)m * D;
    f32x4 v[4]; float ss = 0.f;
#pragma unroll
    for (int i = 0; i < 4; ++i) { v[i] = *(const f32x4*)(y + i * 256 + lane * 4); ss += v[i][0] * v[i][0] + v[i][1] * v[i][1] + v[i][2] * v[i][2] + v[i][3] * v[i][3]; }
    ss = wave_sum(ss);
    const float r = rsqrtf(ss * (1.f / D) + EPS);
#pragma unroll
    for (int i = 0; i < 4; ++i) {
      const int k = i * 256 + lane * 4;
      const f32x4 gg = *(const f32x4*)(g + k);
      f32x4 o; o[0] = v[i][0] * r * gg[0]; o[1] = v[i][1] * r * gg[1]; o[2] = v[i][2] * r * gg[2]; o[3] = v[i][3] * r * gg[3];
      *(f32x4*)(p.out + (size_t)m * D + k) = o;
    }
  }
}


namespace pg8 {
#define PG8_LAS __attribute__((address_space(3)))
constexpr int BM = 256, BK = 64, HALF = 128, HTB = HALF * BK * 2, STAGE_BYTES = 8 * HTB, NXCD = 8, WGM = 8;
__host__ __device__ __forceinline__ int lds_byte(int r, int c) { const int st = (r >> 4) * 2 + (c >> 5), rr = r & 15, cc = c & 31, ob = rr * 64 + cc * 2; return st * 1024 + (ob ^ (((ob >> 9) & 1) << 5)); }
__host__ __device__ __forceinline__ void stage_rc(int b, int& R, int& C) { const int st = b / 1024, sb = b % 1024, swz = sb ^ (((sb >> 9) & 1) << 5); R = (st >> 1) * 16 + swz / 64; C = (st & 1) * 32 + (swz % 64) / 2; }
__host__ __device__ __forceinline__ int perm32(int rho) { const int n = rho >> 4, i = rho & 15; return 8 * (i >> 2) + 4 * n + (i & 3); }
struct Unit { int pm, pn, ks; };
struct Gemm { const bf16_t* A; const bf16_t* Bt; int M, N, K, ld; };
struct StaticOrder {
    int nM, nN, nwg, G, c, KS;
    __device__ void init(int M, int N, int KS_, int G_, int c_) { nM = M / BM; KS = KS_; nN = (N / BM) * KS_; nwg = nM * nN; G = G_; c = c_; }
    __device__ bool next(int i, Unit& u) const {
        const long L = (long)i * G + c; if (L >= nwg) return false;
        int wgid = (int)L; { const int q = nwg / NXCD, r = nwg % NXCD, xcd = wgid % NXCD, off = wgid / NXCD; wgid = (xcd < r ? xcd * (q + 1) : r * (q + 1) + (xcd - r) * q) + off; }
        const int nig = WGM * nN, gid = wgid / nig, fm = gid * WGM, gsz = (nM - fm) < WGM ? (nM - fm) : WGM;
        u.pm = fm + ((wgid % nig) % gsz); const int pn2 = (wgid % nig) / gsz; u.pn = pn2 / KS; u.ks = pn2 % KS; return true;
    }
    __device__ __forceinline__ void a_ready(const Unit&) const {}
    __device__ __forceinline__ void done(const Unit&) const {}
};
__device__ __forceinline__ unsigned cvt_pk_bf16(float lo, float hi) { unsigned r; asm volatile("v_cvt_pk_bf16_f32 %0, %1, %2" : "=v"(r) : "v"(lo), "v"(hi)); return r; }
struct EpiBf16 {
    static constexpr bool PERM = true, AFTER_DRAIN = false;
    bf16_t* O; int ldc;
    __device__ __forceinline__ void operator()(const f32x4 (&acc)[2][2][4][2], const Unit& u, int wr, int wc, int fr, int fq) const {
        const int row0 = u.pm * BM + wr * 64 + fr, col0 = u.pn * BM + wc * 32 + 8 * fq;
#pragma unroll
        for (int ai = 0; ai < 2; ++ai)
#pragma unroll
            for (int m = 0; m < 4; ++m) { bf16_t* rowp = O + (size_t)(row0 + ai * HALF + m * 16) * ldc + col0;
#pragma unroll
                for (int bj = 0; bj < 2; ++bj) { const f32x4 v0 = acc[ai][bj][m][0], v1 = acc[ai][bj][m][1];
                    u32x4 w; w.x = cvt_pk_bf16(v0[0], v0[1]); w.y = cvt_pk_bf16(v0[2], v0[3]); w.z = cvt_pk_bf16(v1[0], v1[1]); w.w = cvt_pk_bf16(v1[2], v1[3]);
                    *(u32x4*)(rowp + bj * HALF) = w; } }
    }
};
struct EpiSwiglu {
    static constexpr bool PERM = true, AFTER_DRAIN = false;
    bf16_t* H;
    __device__ __forceinline__ void operator()(const f32x4 (&acc)[2][2][4][2], const Unit& u, int wr, int wc, int fr, int fq) const {
        const int row0 = u.pm * BM + wr * 64 + fr, col0 = u.pn * HALF + wc * 32 + 8 * fq;
#pragma unroll
        for (int ai = 0; ai < 2; ++ai)
#pragma unroll
            for (int m = 0; m < 4; ++m) {
                float h[8];
#pragma unroll
                for (int n = 0; n < 2; ++n)
#pragma unroll
                    for (int e = 0; e < 4; ++e) { const float gv = acc[ai][0][m][n][e], uv = acc[ai][1][m][n][e]; h[4 * n + e] = gv * __builtin_amdgcn_rcpf(1.f + __expf(-gv)) * uv; }
                u32x4 w; w.x = cvt_pk_bf16(h[0], h[1]); w.y = cvt_pk_bf16(h[2], h[3]); w.z = cvt_pk_bf16(h[4], h[5]); w.w = cvt_pk_bf16(h[6], h[7]);
                *(u32x4*)(H + (size_t)(row0 + ai * HALF + m * 16) * DFF + col0) = w; }
    }
};
template <bool ATOMIC> struct EpiGate {
    static constexpr bool PERM = false, AFTER_DRAIN = false;
    float* Y; const float* gate;
    __device__ __forceinline__ void operator()(const f32x4 (&acc)[2][2][4][2], const Unit& u, int wr, int wc, int fr, int fq) const {
        const int row0 = u.pm * BM + wr * 64 + fr, col0 = u.pn * BM + wc * 32 + 4 * fq;
#pragma unroll
        for (int ai = 0; ai < 2; ++ai)
#pragma unroll
            for (int m = 0; m < 4; ++m) { const int row = row0 + ai * HALF + m * 16; const float* gp = gate + cond_of(row) * 6144 + col0; float* yp = Y + (size_t)row * D + col0;
#pragma unroll
                for (int bj = 0; bj < 2; ++bj)
#pragma unroll
                    for (int n = 0; n < 2; ++n) { const int o = bj * HALF + n * 16; const f32x4 gv = *(const f32x4*)(gp + o); const f32x4 v = acc[ai][bj][m][n] * gv;
                        if (ATOMIC) { unsafeAtomicAdd(yp + o, v[0]); unsafeAtomicAdd(yp + o + 1, v[1]); unsafeAtomicAdd(yp + o + 2, v[2]); unsafeAtomicAdd(yp + o + 3, v[3]); }
                        else { *(f32x4*)(yp + o) = *(const f32x4*)(yp + o) + v; } } }
    }
};
template <class Epi, class Sched, bool ALIGN_EPI = false, bool SP2 = false>
__device__ __forceinline__ void gemm_phase(PG8_LAS unsigned char* lds, const Gemm g, const Sched& S, const Epi& E) {
    int tid_ = tidx();
    const int tid = tid_, wid = __builtin_amdgcn_readfirstlane(tid >> 6), lane = tid & 63, wr = wid >> 2, wc = wid & 3, fr = lane & 15, fq = lane >> 4;
    const int K = g.ld, nt = g.K / BK;
    unsigned voffA[2], voffB[2];
#pragma unroll
    for (int i = 0; i < 2; ++i) { int R, C; stage_rc(tid * 16 + i * 8192, R, C); const int Rb = Epi::PERM ? ((R & ~31) + perm32(R & 31)) : R;
        voffA[i] = (unsigned)(R * K + C) * 2u; voffB[i] = (unsigned)(Rb * K + C) * 2u; }
    const size_t kstep = (size_t)(BK * 2);
    const size_t hstep = (size_t)HALF * K * 2;
    const size_t tstep = 2 * hstep;
    const unsigned ldsw = (unsigned)wid * 1024u;
    const int aoff = lds_byte(wr * 64 + fr, fq * 8), boff = lds_byte(wc * 32 + fr, fq * 8);
#define PG8_SA(b, h) (((b) * 2 + (h)) * HTB)
#define PG8_SB(b, h) ((4 + (b) * 2 + (h)) * HTB)
#define PG8_STAGE(bufoff, gbase, voff) do { _Pragma("unroll") for (int _i = 0; _i < 2; ++_i) \
        __builtin_amdgcn_global_load_lds((const unsigned*)((const char*)(gbase) + (voff)[_i]), (PG8_LAS unsigned*)(lds + (bufoff) + ldsw + _i * 8192), 16, 0, 0); } while (0)
#define PG8_LDA(dst, b, h) do { _Pragma("unroll") for (int m = 0; m < 4; ++m) _Pragma("unroll") for (int k = 0; k < 2; ++k) dst[m][k] = *(const PG8_LAS bf16x8*)(lds + PG8_SA(b, h) + aoff + m * 2048 + k * 1024); } while (0)
#define PG8_LDB(dst, b, h) do { _Pragma("unroll") for (int n = 0; n < 2; ++n) _Pragma("unroll") for (int k = 0; k < 2; ++k) dst[n][k] = *(const PG8_LAS bf16x8*)(lds + PG8_SB(b, h) + boff + n * 2048 + k * 1024); } while (0)
#define PG8_MMA(ai, bj, At, Bt) do { __builtin_amdgcn_s_setprio(1); _Pragma("unroll") for (int m = 0; m < 4; ++m) _Pragma("unroll") for (int n = 0; n < 2; ++n) _Pragma("unroll") for (int k = 0; k < 2; ++k) \
        acc[ai][bj][m][n] = __builtin_amdgcn_mfma_f32_16x16x32_bf16(Bt[n][k], At[m][k], acc[ai][bj][m][n], 0, 0, 0); __builtin_amdgcn_s_setprio(0); } while (0)
#define PG8_WAIT_V(n) asm volatile("s_waitcnt vmcnt(" #n ")" ::: "memory")
#define PG8_WAIT_L(n) asm volatile("s_waitcnt lgkmcnt(" #n ")" ::: "memory")
#define PG8_BAR __builtin_amdgcn_s_barrier()
#define PG8_SCHED __builtin_amdgcn_sched_barrier(0)
    Unit cur, nxt; int ui = 0;
    if (!S.next(0, cur)) return;
    f32x4 acc[2][2][4][2];
#pragma unroll
    for (int a = 0; a < 2; ++a)
#pragma unroll
        for (int b = 0; b < 2; ++b)
#pragma unroll
            for (int m = 0; m < 4; ++m)
#pragma unroll
                for (int n = 0; n < 2; ++n) acc[a][b][m][n] = (f32x4){0.f, 0.f, 0.f, 0.f};
    bf16x8 At[4][2], B0[2][2], B1[2][2];
    const size_t ksb = (size_t)g.K * 2; const char* cA = (const char*)g.A + (size_t)cur.pm * tstep + cur.ks * ksb; const char* cB = (const char*)g.Bt + (size_t)cur.pn * tstep + cur.ks * ksb;
    S.a_ready(cur);
    if constexpr (SP2) {
        PG8_STAGE(PG8_SB(0, 0), cB, voffB); PG8_STAGE(PG8_SB(0, 1), cB + hstep, voffB); PG8_STAGE(PG8_SA(0, 0), cA, voffA); PG8_STAGE(PG8_SA(0, 1), cA + hstep, voffA);
        if (wr == 1) PG8_BAR;
        PG8_WAIT_V(2); PG8_BAR;
        PG8_STAGE(PG8_SB(1, 0), cB + kstep, voffB); PG8_STAGE(PG8_SA(1, 0), cA + kstep, voffA); PG8_STAGE(PG8_SB(1, 1), cB + hstep + kstep, voffB);
        PG8_WAIT_V(6); PG8_BAR;
    } else {
        PG8_STAGE(PG8_SB(0, 0), cB, voffB); PG8_STAGE(PG8_SA(0, 0), cA, voffA); PG8_STAGE(PG8_SB(0, 1), cB + hstep, voffB); PG8_STAGE(PG8_SA(0, 1), cA + hstep, voffA);
        if (wr == 1) PG8_BAR;
        PG8_WAIT_V(4); PG8_BAR;
        PG8_STAGE(PG8_SB(1, 0), cB + kstep, voffB); PG8_STAGE(PG8_SA(1, 0), cA + kstep, voffA); PG8_STAGE(PG8_SB(1, 1), cB + hstep + kstep, voffB);
        PG8_WAIT_V(6); PG8_BAR;
    }
    for (;;) {
        const bool has_next = S.next(ui + 1, nxt);
        const char* nA = has_next ? (const char*)g.A + (size_t)nxt.pm * tstep + nxt.ks * ksb : cA; const char* nB = has_next ? (const char*)g.Bt + (size_t)nxt.pn * tstep + nxt.ks * ksb : cB;
        for (int t = 0; t < nt; t += 2) {
            const bool last = (t == nt - 2);
            const char* a1 = cA + (size_t)(t + 1) * kstep;
            const char* a2 = last ? nA : cA + (size_t)(t + 2) * kstep; const char* b2 = last ? nB : cB + (size_t)(t + 2) * kstep;
            const char* a3 = a2 + kstep; const char* b3 = b2 + kstep;
            if (last && has_next) S.a_ready(nxt);
            if constexpr (SP2) {
            PG8_LDB(B0, 0, 0); PG8_LDB(B1, 0, 1); PG8_SCHED; PG8_LDA(At, 0, 0); PG8_STAGE(PG8_SA(1, 1), a1 + hstep, voffA);
            PG8_WAIT_V(8); PG8_WAIT_L(0); PG8_BAR; PG8_MMA(0, 0, At, B0); PG8_MMA(0, 1, At, B1); PG8_BAR; PG8_SCHED;
            PG8_LDA(At, 0, 1); PG8_STAGE(PG8_SB(0, 0), b2, voffB); PG8_STAGE(PG8_SB(0, 1), b2 + hstep, voffB); PG8_STAGE(PG8_SA(0, 0), a2, voffA);
            PG8_WAIT_V(8); PG8_WAIT_L(0); PG8_BAR; PG8_MMA(1, 0, At, B0); PG8_MMA(1, 1, At, B1); PG8_BAR; PG8_SCHED;
            PG8_LDB(B0, 1, 0); PG8_LDB(B1, 1, 1); PG8_SCHED; PG8_LDA(At, 1, 0); PG8_STAGE(PG8_SA(0, 1), a2 + hstep, voffA);
            PG8_WAIT_V(8); PG8_WAIT_L(0); PG8_BAR; PG8_MMA(0, 0, At, B0); PG8_MMA(0, 1, At, B1); PG8_BAR; PG8_SCHED;
            PG8_LDA(At, 1, 1); PG8_STAGE(PG8_SB(1, 0), b3, voffB); PG8_STAGE(PG8_SB(1, 1), b3 + hstep, voffB); PG8_STAGE(PG8_SA(1, 0), a3, voffA);
            PG8_WAIT_V(8); PG8_WAIT_L(0); PG8_BAR; PG8_MMA(1, 0, At, B0); PG8_MMA(1, 1, At, B1); PG8_BAR; PG8_SCHED;
            } else {
            PG8_LDB(B0, 0, 0); PG8_SCHED; PG8_LDA(At, 0, 0); PG8_STAGE(PG8_SA(1, 1), a1 + hstep, voffA);
            PG8_WAIT_L(8); PG8_BAR; PG8_WAIT_L(0); PG8_MMA(0, 0, At, B0); PG8_BAR; PG8_SCHED;
            PG8_LDB(B1, 0, 1); PG8_STAGE(PG8_SB(0, 0), b2, voffB);
            PG8_BAR; PG8_WAIT_L(0); PG8_MMA(0, 1, At, B1); PG8_BAR;
            PG8_LDA(At, 0, 1); PG8_STAGE(PG8_SA(0, 0), a2, voffA);
            PG8_BAR; PG8_WAIT_L(0); PG8_MMA(1, 0, At, B0); PG8_BAR; PG8_SCHED;
            PG8_STAGE(PG8_SB(0, 1), b2 + hstep, voffB);
            PG8_WAIT_V(6); PG8_BAR; PG8_MMA(1, 1, At, B1); PG8_BAR;
            PG8_LDB(B0, 1, 0); PG8_SCHED; PG8_LDA(At, 1, 0); PG8_STAGE(PG8_SA(0, 1), a2 + hstep, voffA);
            PG8_WAIT_L(8); PG8_BAR; PG8_WAIT_L(0); PG8_MMA(0, 0, At, B0); PG8_BAR; PG8_SCHED;
            PG8_LDB(B1, 1, 1); PG8_STAGE(PG8_SB(1, 0), b3, voffB);
            PG8_BAR; PG8_WAIT_L(0); PG8_MMA(0, 1, At, B1); PG8_BAR;
            PG8_LDA(At, 1, 1); PG8_STAGE(PG8_SA(1, 0), a3, voffA);
            PG8_BAR; PG8_WAIT_L(0); PG8_MMA(1, 0, At, B0); PG8_BAR; PG8_SCHED;
            PG8_STAGE(PG8_SB(1, 1), b3 + hstep, voffB);
            PG8_WAIT_V(6); PG8_BAR; PG8_MMA(1, 1, At, B1); PG8_BAR;
            }
        }
        if constexpr (ALIGN_EPI) { if (wr == 0) PG8_BAR; }
        if constexpr (!Epi::AFTER_DRAIN) { E(acc, cur, wr, wc, fr, fq); S.done(cur); }
        if (!has_next) break;
#pragma unroll
        for (int a = 0; a < 2; ++a)
#pragma unroll
            for (int b = 0; b < 2; ++b)
#pragma unroll
                for (int m = 0; m < 4; ++m)
#pragma unroll
                    for (int n = 0; n < 2; ++n) acc[a][b][m][n] = (f32x4){0.f, 0.f, 0.f, 0.f};
        cur = nxt; cA = nA; cB = nB; ++ui;
        if constexpr (ALIGN_EPI) { if (wr == 1) PG8_BAR; }
    }
    PG8_WAIT_V(0);
    if constexpr (!ALIGN_EPI) { if (wr == 0) PG8_BAR; }
    PG8_BAR;
    if constexpr (Epi::AFTER_DRAIN) { E.fused(acc, cur, wr, wc, fr, fq, lds, wid, lane); S.done(cur); }
#undef PG8_SA
#undef PG8_SB
#undef PG8_STAGE
#undef PG8_LDA
#undef PG8_LDB
#undef PG8_MMA
#undef PG8_WAIT_V
#undef PG8_WAIT_L
#undef PG8_BAR
#undef PG8_SCHED
}
}

template <class Epi>
__device__ __forceinline__ void gemm_run(unsigned char* lds, const bf16_t* A, const bf16_t* Bt, int M, int N, int Ktot, int KS, const Epi& E) {
    pg8::StaticOrder S; S.init(M, N, KS, (int)gridDim.x, (int)blockIdx.x);
    pg8::Gemm g; g.A = A; g.Bt = Bt; g.M = M; g.N = N; g.K = Ktot / KS; g.ld = Ktot;
    __syncthreads();
    pg8::gemm_phase<Epi, pg8::StaticOrder, true, true>((PG8_LAS unsigned char*)lds, g, S, E);
    __syncthreads();
}


#define LDSP __attribute__((address_space(3)))
constexpr int LC_FR = 0, LC_U = 66176, LC_X0 = LC_U + 20480, LC_S = LC_X0 + 20480, LC_Z = LC_S + 17408;
__device__ void phase_lc(const Params& p, int j, unsigned char* lds_) {
  LDSP unsigned char* lds = (LDSP unsigned char*)lds_;
  const int tid = tidx(), lane = tid & 63, wid = tid >> 6, n = lane & 31, hi = lane >> 5;
  const bf16_t* ZT = (const bf16_t*)(p.ws + WS_ZT); bf16_t* YG = (bf16_t*)(p.ws + WS_YG);
  const float* cw = p.in[I_HCW] + (size_t)j * 3 * 3072; const float* cb = p.in[I_HCB] + (size_t)j * 3072;
  for (int q = blockIdx.x; q < 1024; q += gridDim.x) {
    const int lsel = q < 512 ? 1 : 0, qq = q & 511, cg = qq >> 2, tb = (lsel ? 4 : 0) + (qq & 3);
    const int L = lsel ? 1024 : 256, P = L >> 5, REC = 4 * L + 40, c0 = cg * 8;
    const size_t m0 = (size_t)tb * 1024;
    __syncthreads();
    {
      const u32x4* src = (const u32x4*)((const bf16_t*)(p.ws + WS_FRG) + (size_t)j * FRG_J + (lsel ? FRG_L1 : 0) + (size_t)c0 * REC);
      LDSP u32x4* dst = (LDSP u32x4*)(lds + LC_FR);
      for (int i = tid; i < REC; i += 512) dst[i] = src[i];
    }
    for (int task = tid; task < 1024; task += 512) {
      const int ch = task >> 7, tok0 = (task & 127) * 8;
      const bool first = (tok0 & (L - 1)) == 0, last = ((tok0 + 8) & (L - 1)) == 0;
      float sc[3][8];
#pragma unroll
      for (int part = 0; part < 3; ++part) {
        const int chn = part * 1024 + c0 + ch;
        const bf16_t* z = ZT + (size_t)chn * MTOK + m0 + tok0;
        const u32x4 w = *(const u32x4*)z;
        float zv[10];
        zv[0] = first ? 0.f : bf2f(z[-1]); zv[9] = last ? 0.f : bf2f(z[8]);
        zv[1] = __uint_as_float(w.x << 16); zv[2] = __uint_as_float(w.x & 0xFFFF0000u); zv[3] = __uint_as_float(w.y << 16); zv[4] = __uint_as_float(w.y & 0xFFFF0000u);
        zv[5] = __uint_as_float(w.z << 16); zv[6] = __uint_as_float(w.z & 0xFFFF0000u); zv[7] = __uint_as_float(w.w << 16); zv[8] = __uint_as_float(w.w & 0xFFFF0000u);
        const float w0 = cw[chn], w1 = cw[3072 + chn], w2 = cw[2 * 3072 + chn], bb = cb[chn];
#pragma unroll
        for (int i = 0; i < 8; ++i) sc[part][i] = zv[i] * w0 + zv[i + 1] * w1 + zv[i + 2] * w2 + bb;
      }
      u32x4 xo, uo;
      xo.x = pack2(sc[0][0], sc[0][1]); xo.y = pack2(sc[0][2], sc[0][3]); xo.z = pack2(sc[0][4], sc[0][5]); xo.w = pack2(sc[0][6], sc[0][7]);
      uo.x = pack2(sc[1][0] * sc[2][0], sc[1][1] * sc[2][1]); uo.y = pack2(sc[1][2] * sc[2][2], sc[1][3] * sc[2][3]);
      uo.z = pack2(sc[1][4] * sc[2][4], sc[1][5] * sc[2][5]); uo.w = pack2(sc[1][6] * sc[2][6], sc[1][7] * sc[2][7]);
      const int po = (ch * 1280 + tok0 + 8 * (tok0 >> 5)) * 2;
      *(LDSP u32x4*)(lds + LC_U + po) = uo; *(LDSP u32x4*)(lds + LC_X0 + po) = xo;
    }
    if (tid < 4) ((LDSP unsigned*)(lds + LC_Z))[tid] = 0u;
    __syncthreads();
    f32x16 acc;
#pragma unroll
    for (int r = 0; r < 16; ++r) acc[r] = 0.f;
    {
      const int par = n & 1;
      LDSP const unsigned char* fa = lds + LC_FR + wid * (REC * 2) + (par ? (2 * L + 40) * 2 : 0) + 2 * (L - n - par + 8 * hi);
      LDSP const unsigned char* ub = lds + LC_U + wid * 2560 + (40 * n + 8 * hi) * 2;
      const int ti = n & (P - 1);
      for (int dl = -(P - 1); dl <= P - 1; ++dl) {
        const bool valid = (unsigned)(ti - dl) < (unsigned)P;
#pragma unroll
        for (int ks = 0; ks < 2; ++ks) {
          LDSP const volatile unsigned* ap = (LDSP const volatile unsigned*)(fa + 2 * (-32 * dl + 16 * ks));
          u32x4 aw; aw.x = ap[0]; aw.y = ap[1]; aw.z = ap[2]; aw.w = ap[3];
          LDSP const unsigned char* bp = valid ? (ub + (-40 * dl + 16 * ks) * 2) : (lds + LC_Z);
          const bf16x8 bfrag = *(LDSP const bf16x8*)bp;
          acc = __builtin_amdgcn_mfma_f32_32x32x16_bf16(__builtin_bit_cast(bf16x8, aw), bfrag, acc, 0, 0, 0);
        }
      }
    }
    {
      const float rn = ((const float*)(p.ws + WS_RNORM))[(j * 2 + lsel) * 1024 + c0 + wid], bs = p.in[I_HBIAS][j * D + c0 + wid];
      LDSP const bf16_t* uu = (LDSP const bf16_t*)(lds + LC_U) + wid * 1280 + 40 * n;
      LDSP const bf16_t* xx = (LDSP const bf16_t*)(lds + LC_X0) + wid * 1280 + 40 * n;
      LDSP bf16_t* so = (LDSP bf16_t*)(lds + LC_S) + wid * 1088 + 34 * n;
#pragma unroll
      for (int r = 0; r < 16; ++r) {
        const int row = (r & 3) + 8 * (r >> 2) + 4 * hi;
        const float y = acc[r] * rn + bf2f(uu[row]) * bs;
        so[row] = f2bf(bf2f(xx[row]) * y);
      }
    }
    __syncthreads();
    for (int tok = tid; tok < 1024; tok += 512) {
      LDSP const bf16_t* so = (LDSP const bf16_t*)(lds + LC_S) + tok + 2 * (tok >> 5);
      u32x4 w;
      w.x = (unsigned)so[0] | ((unsigned)so[1088] << 16); w.y = (unsigned)so[2 * 1088] | ((unsigned)so[3 * 1088] << 16);
      w.z = (unsigned)so[4 * 1088] | ((unsigned)so[5 * 1088] << 16); w.w = (unsigned)so[6 * 1088] | ((unsigned)so[7 * 1088] << 16);
      *(u32x4*)(YG + (m0 + tok) * D + c0) = w;
    }
  }
  __syncthreads();
}

__device__ void phase_qkvpost(const Params& p, int j) {
  const int lane = tidx() & 63, wid = tidx() >> 6;
  const unsigned* QKV = (const unsigned*)(p.ws + WS_QKV);
  unsigned* Q = (unsigned*)(p.ws + WS_Q); unsigned* KP = (unsigned*)(p.ws + WS_KP); unsigned* VP = (unsigned*)(p.ws + WS_VP);
  unsigned* KS = (unsigned*)(p.ws + WS_KS) + (size_t)j * 4 * 1536 * 128; unsigned* VS = (unsigned*)(p.ws + WS_VS) + (size_t)j * 4 * 1536 * 128;
  const float* qn = p.in[I_QN] + j * 128; const float* kn = p.in[I_KN] + j * 128;
  float* newk = p.out + (size_t)2 * NPR * D; float* newv = newk + (size_t)16 * 2 * 256 * 256;
  const float qg0 = qn[2 * lane], qg1 = qn[2 * lane + 1], kg0 = kn[2 * lane], kg1 = kn[2 * lane + 1];
  const float freq = exp2f(-(float)(lane & 31) * 0.41524101186092029f);
  for (int m = blockIdx.x * 8 + wid; m < MTOK; m += gridDim.x * 8) {
    const bool smp = m >= NPR;
    float cs = 1.f, sn = 0.f;
    if (smp) { const int t = (m - NPR) & 1023; const float pos = (float)(lane < 32 ? (t >> 6) : (t & 63)); const float rev = (pos * freq) * INV_2PI; cs = cos_rev(rev); sn = sin_rev(rev); }
    for (int s = 0; s < 12; ++s) {
      const unsigned raw = QKV[(size_t)m * 768 + s * 64 + lane];
      float x0 = __uint_as_float(raw << 16), x1 = __uint_as_float(raw & 0xFFFF0000u);
      if (s < 10) {
        const float ss = wave_sum(x0 * x0 + x1 * x1);
        const float r = rsqrtf(ss * (1.f / 128.f) + EPS);
        x0 = x0 * r * (s < 8 ? qg0 : kg0); x1 = x1 * r * (s < 8 ? qg1 : kg1);
        if (smp) { const float a = x0, b = x1; x0 = a * cs - b * sn; x1 = a * sn + b * cs; }
      }
      const unsigned w = pack2(x0, x1);
      if (s < 8) Q[(size_t)m * 512 + s * 64 + lane] = w;
      else {
        const int kv = (s - 8) & 1; const bool isk = s < 10;
        if (!smp) {
          (isk ? KP : VP)[(size_t)m * 128 + kv * 64 + lane] = w;
          const int b = m >> 8, t = m & 255;
          float* o = (isk ? newk : newv) + ((((size_t)b * 2 + j) * 256 + t) * 2 + kv) * 128 + 2 * lane;
          o[0] = x0; o[1] = x1;
        } else {
          const int b = (m - NPR) >> 10, t = (m - NPR) & 1023;
          (isk ? KS : VS)[((size_t)b * 1536 + t) * 128 + kv * 64 + lane] = w;
        }
      }
    }
  }
}


namespace att {
typedef unsigned short bf16;
constexpr int   D = 128, NW = 8, QBLK = 32, KVBLK = 64;
constexpr float SCALE = 0.088388347648318440f;
constexpr float THR = 8.f;
constexpr int SDEPTH = 2;
constexpr int LDQ = 1024, LDK = 256, LDO = 1024;
constexpr size_t SHM_V = KVBLK * D * 2, SHM_K = KVBLK * D * 2, SHM_ATTN = 2 * SHM_V + 2 * SHM_K + NW * 64 * 4;

using s16x4  = __attribute__((ext_vector_type(4))) short;
using f32x16 = __attribute__((ext_vector_type(16))) float;
using f32x8  = __attribute__((ext_vector_type(8))) float;

#define KSWZ(row, colB) ((row) * 256 + ((colB) ^ (((row) & 7) << 4)))
#define SBAR() __builtin_amdgcn_sched_barrier(0)
__device__ __forceinline__ int crow(int r, int hi) { return (r & 3) + 8 * (r >> 2) + 4 * hi; }
__device__ __forceinline__ unsigned cvtpk(float lo, float hi) {
  unsigned r; asm volatile("v_cvt_pk_bf16_f32 %0, %1, %2" : "=v"(r) : "v"(lo), "v"(hi)); return r;
}
template <typename TIn> struct Stage;
template <> struct Stage<bf16>  { using T = bf16x8;
  __device__ static __forceinline__ T ld8(const bf16* p) { return *reinterpret_cast<const bf16x8*>(p); }
  __device__ static __forceinline__ bf16x8 tobf(T x) { return x; } };
template <> struct Stage<float> { using T = f32x8;
  __device__ static __forceinline__ T ld8(const float* p) { return *reinterpret_cast<const f32x8*>(p); }
  __device__ static __forceinline__ bf16x8 tobf(T x) {
    u32x4 w = {cvtpk(x[0], x[1]), cvtpk(x[2], x[3]), cvtpk(x[4], x[5]), cvtpk(x[6], x[7])}; return *reinterpret_cast<bf16x8*>(&w); } };

__device__ __forceinline__ void partialSM(f32x16& p0, f32x16& p1, float& m_reg, float& mn, float& alpha) {
  constexpr float C = SCALE * 1.4426950408889634f;
  float pmax = p0[0]; for (int r = 1; r < 16; ++r) pmax = fmaxf(pmax, p0[r]); for (int r = 0; r < 16; ++r) pmax = fmaxf(pmax, p1[r]);
  { auto rr = __builtin_amdgcn_permlane32_swap(__float_as_uint(pmax), __float_as_uint(pmax), false, false);
    pmax = fmaxf(__uint_as_float(rr[0]), __uint_as_float(rr[1])); }
  if (__builtin_expect(__all(pmax - m_reg <= THR / SCALE), 1)) { mn = m_reg; alpha = 1.f; }
  else { mn = fmaxf(m_reg, pmax); alpha = __builtin_amdgcn_exp2f((m_reg - mn) * C); m_reg = mn; }
  float mnC = -mn * C;
  for (int r = 0; r < 16; ++r) p0[r] = fmaf(p0[r], C, mnC); for (int r = 0; r < 16; ++r) p1[r] = fmaf(p1[r], C, mnC);
  for (int r = 0; r < 16; ++r) p0[r] = __builtin_amdgcn_exp2f(p0[r]);
}
__device__ __forceinline__ void finishSM(f32x16& p0, f32x16& p1, float alpha, float& l_reg, bf16x8& pa0, bf16x8& pa1, bf16x8& pa2, bf16x8& pa3) {
  for (int r = 0; r < 16; ++r) p1[r] = __builtin_amdgcn_exp2f(p1[r]);
  float ps = 0; for (int r = 0; r < 16; ++r) ps += p0[r]; for (int r = 0; r < 16; ++r) ps += p1[r];
  { auto rr = __builtin_amdgcn_permlane32_swap(__float_as_uint(ps), __float_as_uint(ps), false, false);
    ps = __uint_as_float(rr[0]) + __uint_as_float(rr[1]); }
  l_reg = l_reg * alpha + ps;
#define PK4(P, BASE, OUT) do { unsigned a0 = cvtpk(P[BASE + 0], P[BASE + 1]), a1 = cvtpk(P[BASE + 2], P[BASE + 3]);   \
    unsigned b0 = cvtpk(P[BASE + 4], P[BASE + 5]), b1 = cvtpk(P[BASE + 6], P[BASE + 7]);                              \
    auto r0 = __builtin_amdgcn_permlane32_swap(a0, b0, false, false); auto r1 = __builtin_amdgcn_permlane32_swap(a1, b1, false, false); \
    u32x4 w = {r0[0], r1[0], r0[1], r1[1]}; OUT = *reinterpret_cast<bf16x8*>(&w); } while (0)
  PK4(p0, 0, pa0); PK4(p0, 8, pa1); PK4(p1, 0, pa2); PK4(p1, 8, pa3);
#undef PK4
}
__device__ __forceinline__ void qkt(f32x16& p0, f32x16& p1, const bf16* Ks, const bf16x8* qr, int r32, int hi) {
  p0 = f32x16{}; p1 = f32x16{};
  for (int d0 = 0; d0 < 8; ++d0) { int cb = (d0 * 16 + hi * 8) * 2;
    bf16x8 b0 = *reinterpret_cast<const bf16x8*>((const char*)Ks + KSWZ(r32, cb));
    bf16x8 b1 = *reinterpret_cast<const bf16x8*>((const char*)Ks + KSWZ(32 + r32, cb));
    p0 = __builtin_amdgcn_mfma_f32_32x32x16_bf16(b0, qr[d0], p0, 0, 0, 0);
    p1 = __builtin_amdgcn_mfma_f32_32x32x16_bf16(b1, qr[d0], p1, 0, 0, 0); }
}
__device__ __forceinline__ int v_st(int k, int c) { const int kk = (k & ~0xC) | ((k & 4) << 1) | ((k & 8) >> 1); return ((kk >> 3) * 4 + (c >> 5)) * 512 + ((kk & 7) * 32 + (c & 31)) * 2; }
__device__ __forceinline__ int v_rd_base(int lane) { return ((lane & 3) << 3) | (((lane >> 2) & 3) << 6) | (((lane >> 4) & 1) << 5) | (((lane >> 5) & 1) << 8); }
constexpr int v_rd_off(int d0, int ks, int half) { return d0 * 512 + ks * 4096 + half * 2048; }
template <int OFF> __device__ __forceinline__ s16x4 tr_read(int vb) {
  s16x4 r; asm volatile("ds_read_b64_tr_b16 %0, %1 offset:%2" : "=&v"(r) : "v"(vb), "i"(OFF) : "memory"); return r;
}
template <int D0> __device__ __forceinline__ void pv_one(f32x16& od, int vb, bf16x8 pa0, bf16x8 pa1, bf16x8 pa2, bf16x8 pa3) {
  const s16x4 l0 = tr_read<v_rd_off(D0, 0, 0)>(vb), h0 = tr_read<v_rd_off(D0, 0, 1)>(vb), l1 = tr_read<v_rd_off(D0, 1, 0)>(vb), h1 = tr_read<v_rd_off(D0, 1, 1)>(vb);
  const s16x4 l2 = tr_read<v_rd_off(D0, 2, 0)>(vb), h2 = tr_read<v_rd_off(D0, 2, 1)>(vb), l3 = tr_read<v_rd_off(D0, 3, 0)>(vb), h3 = tr_read<v_rd_off(D0, 3, 1)>(vb);
  asm volatile("s_waitcnt lgkmcnt(0)" ::: "memory"); SBAR();
#define PK(L, H) (bf16x8){L[0], L[1], L[2], L[3], H[0], H[1], H[2], H[3]}
  od = __builtin_amdgcn_mfma_f32_32x32x16_bf16(pa0, PK(l0, h0), od, 0, 0, 0);
  od = __builtin_amdgcn_mfma_f32_32x32x16_bf16(pa1, PK(l1, h1), od, 0, 0, 0);
  od = __builtin_amdgcn_mfma_f32_32x32x16_bf16(pa2, PK(l2, h2), od, 0, 0, 0);
  od = __builtin_amdgcn_mfma_f32_32x32x16_bf16(pa3, PK(l3, h3), od, 0, 0, 0);
#undef PK
}
__device__ __forceinline__ void pv_d0(f32x16* o, int vb, bf16x8 pa0, bf16x8 pa1, bf16x8 pa2, bf16x8 pa3) {
  pv_one<0>(o[0], vb, pa0, pa1, pa2, pa3); pv_one<1>(o[1], vb, pa0, pa1, pa2, pa3); pv_one<2>(o[2], vb, pa0, pa1, pa2, pa3); pv_one<3>(o[3], vb, pa0, pa1, pa2, pa3);
}

template <typename TQ>
__device__ __forceinline__ void attn_dense_body(const TQ* __restrict__ Qb, const bf16* __restrict__ Kh, const bf16* __restrict__ Vh,
                                                bf16* __restrict__ Ob, int seq, char* lds) {
  using St = Stage<bf16>; using SQ = Stage<TQ>;
  const int tid = tidx(), wid = tid >> 6, lane = tid & 63, r32 = lane & 31, hi = lane >> 5;
  bf16* V_lds = (bf16*)lds; bf16* K_lds = (bf16*)(lds + 2 * SHM_V);
  float* ws = (float*)(lds + 2 * SHM_V + 2 * SHM_K) + wid * 64; float* li_l = ws; float* al_l = ws + 32;
  float m_reg = -1e30f, l_reg = 0; f32x16 o[4] = {}; bf16x8 qr[8];
  const TQ* Qw = Qb + (long)(wid * QBLK + r32) * LDQ + hi * 8;
#pragma unroll
  for (int d0 = 0; d0 < 8; ++d0) qr[d0] = SQ::tobf(SQ::ld8(Qw + d0 * 16));
  const int sr = tid >> 4, sc = (tid & 15) * 8, vst0 = v_st(sr, sc), vst1 = v_st(32 + sr, sc);
  const int vb0 = (int)(uintptr_t)V_lds + v_rd_base(lane);
  struct { typename St::T vs0, vs1, ks0, ks1; } sr_[SDEPTH];
#define SLOAD(i, k0) do { sr_[i].vs0 = St::ld8(&Vh[(long)((k0) + sr) * LDK + sc]); sr_[i].vs1 = St::ld8(&Vh[(long)((k0) + 32 + sr) * LDK + sc]); \
    sr_[i].ks0 = St::ld8(&Kh[(long)((k0) + sr) * LDK + sc]); sr_[i].ks1 = St::ld8(&Kh[(long)((k0) + 32 + sr) * LDK + sc]); } while (0)
#define SWRITE(b, i) do { *(bf16x8*)((char*)V_lds + (b) * SHM_V + vst0) = St::tobf(sr_[i].vs0);          \
    *(bf16x8*)((char*)V_lds + (b) * SHM_V + vst1) = St::tobf(sr_[i].vs1); int kc = sc * 2;               \
    *(bf16x8*)((char*)K_lds + (b) * SHM_K + KSWZ(sr, kc)) = St::tobf(sr_[i].ks0);                       \
    *(bf16x8*)((char*)K_lds + (b) * SHM_K + KSWZ(32 + sr, kc)) = St::tobf(sr_[i].ks1); } while (0)
#define SWAIT() do { if constexpr (SDEPTH == 2) asm volatile("s_waitcnt vmcnt(4)" ::: "memory"); else asm volatile("s_waitcnt vmcnt(0)" ::: "memory"); } while (0)
#define RESC(a) do { if (__any((a) < 1.f)) { if (hi == 0) al_l[r32] = (a); asm volatile("s_waitcnt lgkmcnt(0)" ::: "memory"); \
    for (int d = 0; d < 4; ++d) for (int r = 0; r < 16; ++r) o[d][r] *= al_l[crow(r, hi)]; } } while (0)
  f32x16 pA0, pA1, pB0, pB1; float mnA, mnB, alA, alB; bf16x8 pa0, pa1, pa2, pa3; const int NT = seq / KVBLK;
  constexpr int SE = 0, SO = SDEPTH - 1;
  SLOAD(SE, 0); asm volatile("s_waitcnt vmcnt(0)" ::: "memory"); SWRITE(0, SE); __syncthreads();
  qkt(pA0, pA1, K_lds, qr, r32, hi); partialSM(pA0, pA1, m_reg, mnA, alA);
  SLOAD(SO, KVBLK); if constexpr (SDEPTH == 2) { if (2 < NT) SLOAD(SE, 2 * KVBLK); }
  SWAIT(); SWRITE(1, SO); __syncthreads();
  for (int j = 1; j + 1 < NT; j += 2) {
    SBAR(); qkt(pB0, pB1, (bf16*)((char*)K_lds + SHM_K), qr, r32, hi);
    finishSM(pA0, pA1, alA, l_reg, pa0, pa1, pa2, pa3); SBAR();
    SLOAD(SO, (j + SDEPTH) * KVBLK); SBAR();
    pv_d0(o, vb0, pa0, pa1, pa2, pa3); partialSM(pB0, pB1, m_reg, mnB, alB);
    __syncthreads(); SWAIT(); SWRITE(0, SE);
    RESC(alB); __syncthreads();
    SBAR(); qkt(pA0, pA1, K_lds, qr, r32, hi);
    finishSM(pB0, pB1, alB, l_reg, pa0, pa1, pa2, pa3); SBAR();
    if (SDEPTH == 1 || j + 3 < NT) SLOAD(SE, (j + 1 + SDEPTH) * KVBLK); SBAR();
    pv_d0(o, vb0 + (int)SHM_V, pa0, pa1, pa2, pa3); partialSM(pA0, pA1, m_reg, mnA, alA);
    __syncthreads(); SWAIT(); SWRITE(1, SO);
    RESC(alA); __syncthreads();
  }
  SBAR(); qkt(pB0, pB1, (bf16*)((char*)K_lds + SHM_K), qr, r32, hi);
  finishSM(pA0, pA1, alA, l_reg, pa0, pa1, pa2, pa3); SBAR();
  pv_d0(o, vb0, pa0, pa1, pa2, pa3); partialSM(pB0, pB1, m_reg, mnB, alB);
  __syncthreads(); RESC(alB);
  finishSM(pB0, pB1, alB, l_reg, pa0, pa1, pa2, pa3); SBAR();
  pv_d0(o, vb0 + (int)SHM_V, pa0, pa1, pa2, pa3);
  if (hi == 0) li_l[r32] = l_reg; asm volatile("s_waitcnt lgkmcnt(0)" ::: "memory");
  float rli[16];
#pragma unroll
  for (int r = 0; r < 16; ++r) rli[r] = __builtin_amdgcn_rcpf(li_l[crow(r, hi)]);
  bf16* Ow = Ob + (long)(wid * QBLK) * LDO;
#pragma unroll
  for (int r = 0; r < 16; ++r) { int orow = crow(r, hi);
    for (int d0 = 0; d0 < 4; ++d0) Ow[(long)orow * LDO + d0 * 32 + r32] = f2bf(o[d0][r] * rli[r]); }
#undef SLOAD
#undef SWRITE
#undef SWAIT
#undef RESC
}
}

__device__ void phase_att(const Params& p, int j, unsigned char* lds) {
  const bf16_t* Q = (const bf16_t*)(p.ws + WS_Q); bf16_t* O = (bf16_t*)(p.ws + WS_O);
  const bf16_t* KP = (const bf16_t*)(p.ws + WS_KP); const bf16_t* VP = (const bf16_t*)(p.ws + WS_VP);
  const bf16_t* KS = (const bf16_t*)(p.ws + WS_KS) + (size_t)j * 4 * 1536 * 256; const bf16_t* VS = (const bf16_t*)(p.ws + WS_VS) + (size_t)j * 4 * 1536 * 256;
  for (int u = blockIdx.x; u < 256; u += gridDim.x) {
    __syncthreads();
    if (u < 128) {
      const int qb = u & 3, h = (u >> 2) & 7, b = u >> 5, kv = h >> 2;
      const size_t row0 = (size_t)NPR + b * 1024 + qb * 256, kb = ((size_t)b * 1536) * 256 + kv * 128;
      att::attn_dense_body<att::bf16>(Q + row0 * D + h * 128, KS + kb, VS + kb, O + row0 * D + h * 128, 1536, (char*)lds);
    } else {
      const int h = (u - 128) & 7, b = (u - 128) >> 3, kv = h >> 2;
      const size_t row0 = (size_t)b * 256, kb = row0 * 256 + kv * 128;
      att::attn_dense_body<att::bf16>(Q + row0 * D + h * 128, KP + kb, VP + kb, O + row0 * D + h * 128, 256, (char*)lds);
    }
  }
  __syncthreads();
}

#define XB_TMO      128
#define XB_XCNT(j)  (256  + 64 * (j))
#define XB_XSUB(j)  (1280 + 64 * (j))
#define XB_XGEN(j)  (2304 + 64 * (j))
#define XB_TOP      3328
#define XB_TOPGEN   3392
#define XCD_BAR_WORDS 3456
#define XB_SPIN_CAP (1u << 18)
#define LAS __attribute__((address_space(3)))

__device__ __forceinline__ unsigned xb_ld(unsigned* p)              { return __hip_atomic_load(p, __ATOMIC_RELAXED, __HIP_MEMORY_SCOPE_AGENT); }
__device__ __forceinline__ unsigned xb_add(unsigned* p, unsigned v) { return __hip_atomic_fetch_add(p, v, __ATOMIC_RELAXED, __HIP_MEMORY_SCOPE_AGENT); }
__device__ __forceinline__ unsigned xb_xcc_id() { return (unsigned)__builtin_amdgcn_s_getreg((3 << 11) | 20) & 0xFu; }
#define XB_SPIN(cond, bar) do { unsigned _sp = 0; while (cond) { __builtin_amdgcn_s_sleep(1); \
    if ((++_sp & 255u) == 0u) { if (xb_ld(&(bar)[XB_TMO])) break; if (_sp > XB_SPIN_CAP) { atomicAdd(&(bar)[XB_TMO], 1u); break; } } } } while (0)

struct XcdBarrier {
    unsigned* bar; unsigned x;
    volatile LAS unsigned* st;
};

__device__ __forceinline__ XcdBarrier xcd_barrier_post(unsigned* bar, volatile LAS unsigned* st) {
    XcdBarrier b; b.bar = bar; b.x = xb_xcc_id(); b.st = st;
    if (threadIdx.x == 0) (void)xb_add(&bar[XB_XCNT(b.x)], 1u);
    return b;
}
__device__ __forceinline__ void xcd_barrier_complete(unsigned* bar, unsigned x, unsigned& nloc, unsigned& nx) {
    const unsigned G = gridDim.x * gridDim.y * gridDim.z;
    unsigned sum, cnt, mine, sp = 0u;
    for (;;) {
        sum = 0u; cnt = 0u; mine = 0u;
#pragma unroll
        for (unsigned j = 0; j < 16; ++j) { const unsigned c = xb_ld(&bar[XB_XCNT(j)]); sum += c; cnt += (c > 0u) ? 1u : 0u; mine = (j == x) ? c : mine; }
        if (sum == G) break;
        __builtin_amdgcn_s_sleep(1);
        if ((++sp & 255u) == 0u) { if (xb_ld(&bar[XB_TMO])) break; if (sp > XB_SPIN_CAP) { atomicAdd(&bar[XB_TMO], 1u); break; } }
    }
    nloc = mine > 0u ? mine : 1u; nx = cnt > 0u ? cnt : 1u;
}

__device__ __forceinline__ void xcd_barrier(const XcdBarrier& b) {
    asm volatile("s_waitcnt vmcnt(0)" ::: "memory");
    __syncthreads();
    if (threadIdx.x == 0) {
        unsigned* bar = b.bar;
        __builtin_amdgcn_s_waitcnt(0);
        unsigned nloc = b.st[0], nx = b.st[1];
        if (nloc == 0u) { xcd_barrier_complete(bar, b.x, nloc, nx); b.st[0] = nloc; b.st[1] = nx; }
        const unsigned old = xb_add(&bar[XB_XSUB(b.x)], 1u);
        const unsigned gen = old / nloc;
        if (old + 1u == (gen + 1u) * nloc) {
            __builtin_amdgcn_fence(__ATOMIC_RELEASE, "agent");
            asm volatile("s_waitcnt vmcnt(0)" ::: "memory");
            const unsigned og = xb_add(&bar[XB_TOP], 1u);
            const unsigned tg = og / nx;
            if (og + 1u == (tg + 1u) * nx) xb_add(&bar[XB_TOPGEN], 1u);
            else XB_SPIN(xb_ld(&bar[XB_TOPGEN]) == tg, bar);
            __builtin_amdgcn_fence(__ATOMIC_ACQUIRE, "agent");
            xb_add(&bar[XB_XGEN(b.x)], 1u);
            asm volatile("s_waitcnt vmcnt(0)" ::: "memory");
        } else {
            XB_SPIN(xb_ld(&bar[XB_XGEN(b.x)]) == gen, bar);
            __builtin_amdgcn_fence(__ATOMIC_ACQUIRE, "agent");
            asm volatile("s_waitcnt vmcnt(0)" ::: "memory");
        }
    }
    __syncthreads();
}

__global__ void __launch_bounds__(512, 2) mega(Params p) {
  extern __shared__ __attribute__((aligned(16))) unsigned char lds[];
  cg::grid_group grid = cg::this_grid();
  volatile LAS unsigned* xst = (volatile LAS unsigned*)((LAS unsigned char*)lds + (LDS_BYTES - 16));
  if (threadIdx.x < 4) xst[threadIdx.x] = 0u;
  __syncthreads();
  const XcdBarrier xbar = xcd_barrier_post((unsigned*)p.ws, xst);
  int ph = 0;
#define RUN(stmt) do { if (ph >= p.ph_lo && ph < p.ph_hi) { stmt; if (ph + 1 < p.ph_hi) { if (ph == 0) grid.sync(); else xcd_barrier(xbar); } } ++ph; } while (0)
  bf16_t* XN = (bf16_t*)(p.ws + WS_XN); float* Y = (float*)(p.ws + WS_Y); const float* MOD = (const float*)(p.ws + WS_MOD);
  RUN(phase_p0(p, lds));
  RUN(phase_p0b(p));
#pragma unroll 1
  for (int l = 0; l < 4; ++l) {
    const int j = l >> 1;
    RUN(phase_nm(p, l, 0));
    if ((l & 1) == 0) {
      RUN(gemm_run(lds, (const bf16_t*)(p.ws + WS_WIN) + (size_t)j * 3072 * D, XN, 3072, MTOK, D, 1, pg8::EpiBf16{(bf16_t*)(p.ws + WS_ZT), MTOK}));
      RUN(phase_lc(p, j, lds));
      RUN(gemm_run(lds, (const bf16_t*)(p.ws + WS_YG), (const bf16_t*)(p.ws + WS_WHO) + (size_t)j * D * D, MTOK, D, D, 2, pg8::EpiGate<true>{Y, MOD + (size_t)l * 5 * 6144 + 2048}));
    } else {
      RUN(gemm_run(lds, XN, (const bf16_t*)(p.ws + WS_WQKV) + (size_t)j * QKVD * D, MTOK, QKVD, D, 1, pg8::EpiBf16{(bf16_t*)(p.ws + WS_QKV), QKVD}));
      RUN(phase_qkvpost(p, j));
      RUN(phase_att(p, j, lds));
      RUN(gemm_run(lds, (const bf16_t*)(p.ws + WS_O), (const bf16_t*)(p.ws + WS_WAO) + (size_t)j * D * D, MTOK, D, D, 2, pg8::EpiGate<true>{Y, MOD + (size_t)l * 5 * 6144 + 2048}));
    }
    RUN(phase_nm(p, l, 1));
    RUN(gemm_run(lds, XN, (const bf16_t*)(p.ws + WS_WGU) + (size_t)l * 2 * DFF * D, MTOK, 2 * DFF, D, 1, pg8::EpiSwiglu{(bf16_t*)(p.ws + WS_H)}));
    RUN(gemm_run(lds, (const bf16_t*)(p.ws + WS_H), (const bf16_t*)(p.ws + WS_WDN) + (size_t)l * D * DFF, MTOK, D, DFF, 2, pg8::EpiGate<true>{Y, MOD + (size_t)l * 5 * 6144 + 5 * 1024}));
  }
  RUN(phase_final(p));
#undef RUN
}
constexpr int N_PHASES = 2 + 2 * 7 + 2 * 8 + 1;


extern "C" void kernel_launch(void* const* d_in, const int* in_sizes, int n_in, void* d_out, int out_size, void* d_ws, size_t ws_size, hipStream_t stream) {
  static int grid = 0;
  if (grid == 0) {
    if (n_in != 29 || ws_size < WS_END) { fprintf(stderr, "kernel_launch: n_in %d ws %zu (need 29, >= %zu)\n", n_in, ws_size, (size_t)WS_END); grid = -1; return; }
    int dev = 0, cus = 0, per_cu = 0;
    hipGetDevice(&dev);
    hipDeviceGetAttribute(&cus, hipDeviceAttributeMultiprocessorCount, dev);
    if (hipFuncSetAttribute((const void*)mega, hipFuncAttributeMaxDynamicSharedMemorySize, LDS_BYTES) != hipSuccess) { fprintf(stderr, "kernel_launch: hipFuncSetAttribute failed\n"); grid = -1; return; }
    hipOccupancyMaxActiveBlocksPerMultiprocessor(&per_cu, (const void*)mega, 512, LDS_BYTES);
    if (per_cu < 1) { fprintf(stderr, "kernel_launch: occupancy query says %d blocks per CU\n", per_cu); per_cu = 1; }
    grid = cus * per_cu;
  }
  if (grid < 0) return;
  Params p{};
  for (int i = 0; i < 29; ++i) p.in[i] = (const float*)d_in[i];
  p.out = (float*)d_out; p.ws = (unsigned char*)d_ws;

  if (hipMemsetAsync(d_ws, 0, 16384, stream) != hipSuccess) { fprintf(stderr, "kernel_launch: memset of the barrier words failed\n"); return; }
  p.ph_lo = 0; p.ph_hi = N_PHASES;
  void* args[] = {&p};
  hipError_t e = hipLaunchCooperativeKernel((const void*)mega, dim3(grid), dim3(512), args, LDS_BYTES, stream);
  if (e != hipSuccess) fprintf(stderr, "cooperative launch failed: %s (grid %d)\n", hipGetErrorString(e), grid);

}
```

```cpp
#include <hip/hip_runtime.h>
#include <hip/hip_cooperative_groups.h>
#include <cstdio>
#include <cstdint>
namespace cg = cooperative_groups;

typedef unsigned short bf16_t;
typedef short bf16x8 __attribute__((ext_vector_type(8)));
typedef float f32x4 __attribute__((ext_vector_type(4)));
typedef unsigned u32x4 __attribute__((ext_vector_type(4)));
typedef float f32x16 __attribute__((ext_vector_type(16)));

constexpr int D = 1024, MTOK = 8192, NPR = 4096;
constexpr int DFF = 2816, QKVD = 1536;
constexpr float EPS = 1e-6f;
constexpr float MIN_DECAY = -3.0701134573253944f, MAX_DECAY = -15.350567286626972f;

constexpr size_t MiB = 1u << 20;
constexpr size_t WS_MOD = 1 * MiB, WS_MODP = 2 * MiB, WS_FSQP = 6 * MiB, WS_RNORM = 7 * MiB, WS_FILT = 8 * MiB;
constexpr size_t WS_WIN = 28 * MiB, WS_WHO = 40 * MiB, WS_WQKV = 44 * MiB, WS_WAO = 50 * MiB, WS_WGU = 54 * MiB, WS_WDN = 98 * MiB;
constexpr size_t WS_Y = 120 * MiB, WS_XN = 152 * MiB, WS_R = 168 * MiB;
constexpr size_t WS_ZT = WS_R, WS_YG = WS_R + 48 * MiB, WS_P1 = WS_R + 64 * MiB;
constexpr size_t WS_QKV = WS_R, WS_Q = WS_R + 24 * MiB, WS_KP = WS_R + 40 * MiB, WS_VP = WS_R + 42 * MiB, WS_O = WS_R + 44 * MiB;
constexpr size_t WS_H = WS_R;
constexpr size_t WS_KS = WS_R + 96 * MiB, WS_VS = WS_R + 102 * MiB, WS_FRG = WS_R + 108 * MiB, WS_END = WS_R + 130 * MiB;
constexpr size_t FRG_J = 11 * MiB / 2, FRG_L1 = (size_t)1024 * (4 * 256 + 40);
constexpr size_t FILT_J = 10 * MiB / 4;
constexpr size_t FILT_L1 = 1024 * 512;

constexpr int LDS_BYTES = 147456;

struct Params {
  const float* in[29];
  float* out;
  unsigned char* ws;
  int ph_lo, ph_hi;
};
enum { I_XP = 0, I_XS, I_CK, I_CV, I_C, I_CCTX, I_MODW, I_MODB, I_NMIX, I_NFFN, I_HWIN, I_HCW, I_HCB, I_FW1, I_FB1, I_FFREQ, I_FW2, I_FB2, I_FW3,
       I_HBIAS, I_HWOUT, I_WQKV, I_QN, I_KN, I_WAO, I_WG, I_WU, I_WD, I_FN };

__device__ __forceinline__ bf16_t f2bf(float f) { unsigned u = __float_as_uint(f); u += 0x7FFFu + ((u >> 16) & 1u); return (bf16_t)(u >> 16); }
__device__ __forceinline__ float bf2f(bf16_t b) { return __uint_as_float(((unsigned)b) << 16); }
__device__ __forceinline__ unsigned pack2(float lo, float hi) { return (unsigned)f2bf(lo) | ((unsigned)f2bf(hi) << 16); }
__device__ __forceinline__ float wave_sum(float v) {
#pragma unroll
  for (int o = 32; o >= 1; o >>= 1) v += __shfl_xor(v, o);
  return v;
}
__device__ __forceinline__ float wave_max(float v) {
#pragma unroll
  for (int o = 32; o >= 1; o >>= 1) v = fmaxf(v, __shfl_xor(v, o));
  return v;
}
__device__ __forceinline__ int tidx() { int t = threadIdx.x; asm volatile("" : "+v"(t)); return t; }
__device__ __forceinline__ int cond_of(int m) { return m < NPR ? 4 : ((m - NPR) >> 10); }
__device__ __forceinline__ float silu_f(float x) { return x / (1.f + expf(-x)); }
__device__ __forceinline__ float sin_rev(float r) { return __builtin_amdgcn_sinf(r - rintf(r)); }
__device__ __forceinline__ float cos_rev(float r) { return __builtin_amdgcn_cosf(r - rintf(r)); }
constexpr float INV_2PI = 0.15915494309189535f;

struct TileDesc { const float* src; bf16_t* dst; int K, N, k0, n0, mode; };
constexpr int NT_WIN = 2 * 16 * 24, NT_WHO = 2 * 16 * 8, NT_WQKV = 2 * 16 * 12, NT_WAO = 2 * 16 * 8, NT_G = 4 * 16 * 22, NT_DN = 4 * 44 * 8;
constexpr int NT_CVT = NT_WIN + NT_WHO + NT_WQKV + NT_WAO + 2 * NT_G + NT_DN;
__device__ __forceinline__ TileDesc cvt_decode(const Params& p, int t) {
  TileDesc d;
  if (t < NT_WIN) { const int l = t / (16 * 24), r = t % (16 * 24); d.src = p.in[I_HWIN] + (size_t)l * D * 3072; d.dst = (bf16_t*)(p.ws + WS_WIN) + (size_t)l * 3072 * D; d.K = D; d.N = 3072; d.k0 = (r / 24) * 64; d.n0 = (r % 24) * 128; d.mode = 0; return d; }
  t -= NT_WIN;
  if (t < NT_WHO) { const int l = t / 128, r = t % 128; d.src = p.in[I_HWOUT] + (size_t)l * D * D; d.dst = (bf16_t*)(p.ws + WS_WHO) + (size_t)l * D * D; d.K = D; d.N = D; d.k0 = (r / 8) * 64; d.n0 = (r % 8) * 128; d.mode = 0; return d; }
  t -= NT_WHO;
  if (t < NT_WQKV) { const int l = t / (16 * 12), r = t % (16 * 12); d.src = p.in[I_WQKV] + (size_t)l * D * QKVD; d.dst = (bf16_t*)(p.ws + WS_WQKV) + (size_t)l * QKVD * D; d.K = D; d.N = QKVD; d.k0 = (r / 12) * 64; d.n0 = (r % 12) * 128; d.mode = 0; return d; }
  t -= NT_WQKV;
  if (t < NT_WAO) { const int l = t / 128, r = t % 128; d.src = p.in[I_WAO] + (size_t)l * D * D; d.dst = (bf16_t*)(p.ws + WS_WAO) + (size_t)l * D * D; d.K = D; d.N = D; d.k0 = (r / 8) * 64; d.n0 = (r % 8) * 128; d.mode = 0; return d; }
  t -= NT_WAO;
  if (t < 2 * NT_G) { const int up = t >= NT_G ? 1 : 0; t -= up * NT_G; const int l = t / (16 * 22), r = t % (16 * 22);
    d.src = p.in[up ? I_WU : I_WG] + (size_t)l * D * DFF; d.dst = (bf16_t*)(p.ws + WS_WGU) + (size_t)l * 2 * DFF * D; d.K = D; d.N = DFF; d.k0 = (r / 22) * 64; d.n0 = (r % 22) * 128; d.mode = 1 + up; return d; }
  t -= 2 * NT_G;
  { const int l = t / (44 * 8), r = t % (44 * 8); d.src = p.in[I_WD] + (size_t)l * DFF * D; d.dst = (bf16_t*)(p.ws + WS_WDN) + (size_t)l * D * DFF; d.K = DFF; d.N = D; d.k0 = (r / 8) * 64; d.n0 = (r % 8) * 128; d.mode = 0; return d; }
}
__device__ __forceinline__ void cvt_load(const TileDesc& d, int tid, f32x4 (&v)[4]) {
  const int r = tid >> 5, c4 = (tid & 31) * 4;
#pragma unroll
  for (int h = 0; h < 4; ++h) v[h] = *(const f32x4*)(d.src + (size_t)(d.k0 + r + 16 * h) * d.N + d.n0 + c4);
}
__device__ void cvt_all(const Params& p, float* tile  ) {
  const int tid = tidx(), G = gridDim.x;
  int t = blockIdx.x;
  if (t >= NT_CVT) return;
  TileDesc cur = cvt_decode(p, t);
  f32x4 v[4];
  cvt_load(cur, tid, v);
  for (;;) {
    __syncthreads();
    {
      const int r = tid >> 5, c4 = (tid & 31) * 4;
#pragma unroll
      for (int h = 0; h < 4; ++h) { float* q = tile + (r + 16 * h) * 129 + c4; q[0] = v[h][0]; q[1] = v[h][1]; q[2] = v[h][2]; q[3] = v[h][3]; }
    }
    const int tn = t + G; const bool has = tn < NT_CVT;
    TileDesc nx = cur;
    if (has) { nx = cvt_decode(p, tn); cvt_load(nx, tid, v); }
    __syncthreads();
    {
      const int n = tid >> 2, kc = (tid & 3) * 16;
      u32x4 w0, w1;
      w0.x = pack2(tile[(kc + 0) * 129 + n], tile[(kc + 1) * 129 + n]); w0.y = pack2(tile[(kc + 2) * 129 + n], tile[(kc + 3) * 129 + n]);
      w0.z = pack2(tile[(kc + 4) * 129 + n], tile[(kc + 5) * 129 + n]); w0.w = pack2(tile[(kc + 6) * 129 + n], tile[(kc + 7) * 129 + n]);
      w1.x = pack2(tile[(kc + 8) * 129 + n], tile[(kc + 9) * 129 + n]); w1.y = pack2(tile[(kc + 10) * 129 + n], tile[(kc + 11) * 129 + n]);
      w1.z = pack2(tile[(kc + 12) * 129 + n], tile[(kc + 13) * 129 + n]); w1.w = pack2(tile[(kc + 14) * 129 + n], tile[(kc + 15) * 129 + n]);
      const int ng = cur.n0 + n;
      const int row = cur.mode == 0 ? ng : ((ng >> 7) * 256 + (ng & 127) + (cur.mode == 2 ? 128 : 0));
      bf16_t* o = cur.dst + (size_t)row * cur.K + cur.k0 + kc;
      *(u32x4*)o = w0; *(u32x4*)(o + 8) = w1;
    }
    if (!has) break;
    cur = nx; t = tn;
  }
  __syncthreads();
}

constexpr int NT_MOD = 4 * 3 * 16;
__device__ void task_mod(const Params& p, int t, float* sl  ) {
  const int tid = tidx();
  const int l = t / 48, rem = t % 48, cb = rem / 16, kc = rem % 16;
  __syncthreads();
  if (tid < 320) {
    const int j = tid >> 6, k = kc * 64 + (tid & 63);
    const float x = j < 4 ? p.in[I_C][j * D + k] : p.in[I_CCTX][k];
    sl[tid] = silu_f(x);
  }
  __syncthreads();
  const int n = cb * 2048 + tid * 4;
  const float* w = p.in[I_MODW] + ((size_t)l * D + kc * 64) * 6144 + n;
  f32x4 a0 = {0.f, 0.f, 0.f, 0.f}, a1 = a0, a2 = a0, a3 = a0, a4 = a0;
#pragma unroll 8
  for (int k = 0; k < 64; ++k) {
    const f32x4 wv = *(const f32x4*)(w + (size_t)k * 6144);
    a0 += wv * sl[k]; a1 += wv * sl[64 + k]; a2 += wv * sl[128 + k]; a3 += wv * sl[192 + k]; a4 += wv * sl[256 + k];
  }
  float* o = (float*)(p.ws + WS_ZT) + ((size_t)(kc * 4 + l) * 5) * 6144 + n;
  *(f32x4*)o = a0; *(f32x4*)(o + 6144) = a1; *(f32x4*)(o + 2 * 6144) = a2; *(f32x4*)(o + 3 * 6144) = a3; *(f32x4*)(o + 4 * 6144) = a4;
}

constexpr int NT_FILT = 320;
__device__ void task_filt(const Params& p, int t, float* h1  , float* h2  ) {
  const int tid = tidx(), lane = tid & 63, wid = __builtin_amdgcn_readfirstlane(tid >> 6);
  const int combo = t >> 3, nchunk = t & 7;
  const int j = combo / 20, r = combo % 20;
  const int lsel = r < 4 ? 0 : 1, tchunk = r < 4 ? r : r - 4, L = lsel ? 1024 : 256;
  const int tt = lane, tpos = tchunk * 64 + tt;
  const float tn = (float)tpos / (float)L;
  const float* __restrict__ w1 = p.in[I_FW1] + (size_t)j * 33 * 64;
  const float* __restrict__ b1 = p.in[I_FB1] + j * 64;
  const float* __restrict__ fr = p.in[I_FFREQ] + j * 128;
  const float* __restrict__ w2 = p.in[I_FW2] + (size_t)j * 64 * 64;
  const float* __restrict__ b2 = p.in[I_FB2] + j * 64;
  const float* __restrict__ w3 = p.in[I_FW3] + (size_t)j * 64 * 2048;
  __syncthreads();
  {
    const int u0 = wid * 8;
    float acc[8];
#pragma unroll
    for (int uu = 0; uu < 8; ++uu) acc[uu] = tn * w1[u0 + uu];
    for (int b = 1; b <= 16; ++b) {
      const float rev = tn * (float)b;
      const float cs = cos_rev(rev), sn = sin_rev(rev);
#pragma unroll
      for (int uu = 0; uu < 8; ++uu) acc[uu] += cs * w1[b * 64 + u0 + uu] + sn * w1[(16 + b) * 64 + u0 + uu];
    }
#pragma unroll
    for (int uu = 0; uu < 8; ++uu) h1[tt * 65 + u0 + uu] = sin_rev(INV_2PI * (fr[u0 + uu] * (acc[uu] + b1[u0 + uu])));
  }
  __syncthreads();
  {
    const int u0 = wid * 8;
    float acc[8];
#pragma unroll
    for (int uu = 0; uu < 8; ++uu) acc[uu] = 0.f;
    for (int v = 0; v < 64; ++v) {
      const float hv = h1[tt * 65 + v];
#pragma unroll
      for (int uu = 0; uu < 8; ++uu) acc[uu] += hv * w2[v * 64 + u0 + uu];
    }
#pragma unroll
    for (int uu = 0; uu < 8; ++uu) h2[tt * 65 + u0 + uu] = sin_rev(INV_2PI * (fr[64 + u0 + uu] * (acc[uu] + b2[u0 + uu])));
  }
  __syncthreads();
  float* fsq = (float*)(p.ws + WS_FSQP) + ((size_t)((j * 2 + lsel) * 16 + tchunk)) * 2048;
  const int nb = nchunk * 256 + wid * 32;
  float acc[32];
#pragma unroll
  for (int q = 0; q < 32; ++q) acc[q] = 0.f;
  for (int v = 0; v < 64; ++v) {
    const float hv = h2[tt * 65 + v];
    const float* __restrict__ wr = w3 + v * 2048 + nb;
#pragma unroll
    for (int q = 0; q < 32; ++q) acc[q] += hv * wr[q];
  }
#pragma unroll
  for (int q = 0; q < 32; ++q) {
    const int n = nb + q, c = n & 1023; const bool isb = n >= 1024;
    const float delta = fabsf(MIN_DECAY + (MAX_DECAY - MIN_DECAY) * ((float)c / 1023.f));
    float val = acc[q] * expf(-tn * delta);
    if (isb && tpos == 0) val = 0.f;
    bf16_t* rec = (bf16_t*)(p.ws + WS_FRG) + (size_t)j * FRG_J + (lsel ? FRG_L1 : 0) + (size_t)c * (4 * L + 40);
    if (isb && tpos == 0) rec[0] = 0;
    else { const int i = isb ? (L + tpos) : (L - tpos); const bf16_t bv = f2bf(val); rec[i] = bv; rec[2 * L + 40 + i - 1] = bv; }
    const float s = wave_sum(val * val);
    if (lane == 0) fsq[n] = s;
  }
}

__device__ void phase_p0(const Params& p, unsigned char* lds) {
  float* fl = (float*)lds;
  const int G = gridDim.x, b = blockIdx.x, tid = tidx();
  for (int t = b; t < NT_FILT + NT_MOD; t += G) {
    __syncthreads();
    if (t < NT_FILT) task_filt(p, t, fl, fl + 64 * 65);
    else task_mod(p, t - NT_FILT, fl);
  }
  cvt_all(p, fl);
  {
    f32x4* Y = (f32x4*)(p.ws + WS_Y);
    const f32x4* xp = (const f32x4*)p.in[I_XP]; const f32x4* xs = (const f32x4*)p.in[I_XS];
    const int half = NPR * D / 4;
    for (int i = b * 512 + tid; i < 2 * half; i += G * 512) Y[i] = i < half ? xp[i] : xs[i - half];
  }
  {
    bf16_t* KS = (bf16_t*)(p.ws + WS_KS); bf16_t* VS = (bf16_t*)(p.ws + WS_VS);
    const int n = 4 * 2 * 512 * 256;
    for (int i = b * 512 + tid; i < n; i += G * 512) {
      const int e = i & 255, pos = (i >> 8) & 511, j = (i >> 17) & 1, bb = i >> 18;
      const size_t o = ((size_t)(j * 4 + bb) * 1536 + 1024 + pos) * 256 + e;
      KS[o] = f2bf(p.in[I_CK][i]); VS[o] = f2bf(p.in[I_CV][i]);
    }
  }
}

__device__ void phase_p0b(const Params& p) {
  const int G = gridDim.x, b = blockIdx.x, tid = tidx();
  float* MOD = (float*)(p.ws + WS_MOD); const float* MP = (const float*)(p.ws + WS_ZT);
  for (int i = b * 512 + tid; i < 4 * 5 * 6144; i += G * 512) {
    const int n = i % 6144, l = i / (5 * 6144);
    float s = p.in[I_MODB][l * 6144 + n];
#pragma unroll
    for (int kc = 0; kc < 16; ++kc) s += MP[(size_t)kc * (4 * 5 * 6144) + i];
    MOD[i] = s;
  }
  float* RN = (float*)(p.ws + WS_RNORM); const float* FS = (const float*)(p.ws + WS_FSQP);
  for (int i = b * 512 + tid; i < 4096; i += G * 512) {
    const int c = i & 1023, jl = i >> 10, nch = (jl & 1) ? 16 : 4;
    float s = 0.f;
    for (int ch = 0; ch < nch; ++ch) s += FS[((size_t)jl * 16 + ch) * 2048 + c] + FS[((size_t)jl * 16 + ch) * 2048 + 1024 + c];
    RN[i] = 1.f / sqrtf(s + EPS);
  }
}

__device__ void phase_nm(const Params& p, int layer, int which, bool addp) {
  const int lane = tidx() & 63, wid = tidx() >> 6;
  float* Y = (float*)(p.ws + WS_Y); const float* P1 = (const float*)(p.ws + WS_P1); bf16_t* XN = (bf16_t*)(p.ws + WS_XN);
  const float* g = p.in[which ? I_NFFN : I_NMIX] + layer * D;
  for (int m = blockIdx.x * 8 + wid; m < MTOK; m += gridDim.x * 8) {
    float* y = Y + (size_t)m * D;
    f32x4 v[4]; float ss = 0.f;
#pragma unroll
    for (int i = 0; i < 4; ++i) { v[i] = *(const f32x4*)(y + i * 256 + lane * 4);
      if (addp) { v[i] += *(const f32x4*)(P1 + (size_t)m * D + i * 256 + lane * 4); *(f32x4*)(y + i * 256 + lane * 4) = v[i]; }
      ss += v[i][0] * v[i][0] + v[i][1] * v[i][1] + v[i][2] * v[i][2] + v[i][3] * v[i][3]; }
    ss = wave_sum(ss);
    const float r = rsqrtf(ss * (1.f / D) + EPS);
    const float* mod = (const float*)(p.ws + WS_MOD) + (size_t)(layer * 5 + cond_of(m)) * 6144 + which * 3072;
#pragma unroll
    for (int i = 0; i < 4; ++i) {
      const int k = i * 256 + lane * 4;
      const f32x4 gg = *(const f32x4*)(g + k), sh = *(const f32x4*)(mod + k), sc = *(const f32x4*)(mod + 1024 + k);
      float o[4];
#pragma unroll
      for (int e = 0; e < 4; ++e) o[e] = (v[i][e] * r * gg[e]) * (1.f + sc[e]) + sh[e];
      uint2 w; w.x = pack2(o[0], o[1]); w.y = pack2(o[2], o[3]);
      *(uint2*)(XN + (size_t)m * D + k) = w;
    }
  }
}

__device__ void phase_final(const Params& p) {
  const int lane = tidx() & 63, wid = tidx() >> 6;
  const float* Y = (const float*)(p.ws + WS_Y);
  const float* g = p.in[I_FN];
  for (int m = blockIdx.x * 8 + wid; m < MTOK; m += gridDim.x * 8) {
    const float* y = Y + (size_t)m * D;
    f32x4 v[4]; float ss = 0.f;
#pragma unroll
    for (int i = 0; i < 4; ++i) { v[i] = *(const f32x4*)(y + i * 256 + lane * 4) + *(const f32x4*)((const float*)(p.ws + WS_P1) + (size_t)m * D + i * 256 + lane * 4);
      ss += v[i][0] * v[i][0] + v[i][1] * v[i][1] + v[i][2] * v[i][2] + v[i][3] * v[i][3]; }
    ss = wave_sum(ss);
    const float r = rsqrtf(ss * (1.f / D) + EPS);
#pragma unroll
    for (int i = 0; i < 4; ++i) {
      const int k = i * 256 + lane * 4;
      const f32x4 gg = *(const f32x4*)(g + k);
      f32x4 o; o[0] = v[i][0] * r * gg[0]; o[1] = v[i][1] * r * gg[1]; o[2] = v[i][2] * r * gg[2]; o[3] = v[i][3] * r * gg[3];
      *(f32x4*)(p.out + (size_t)m * D + k) = o;
    }
  }
}


namespace pg8 {
#define PG8_LAS __attribute__((address_space(3)))
constexpr int BM = 256, BK = 64, HALF = 128, HTB = HALF * BK * 2, STAGE_BYTES = 8 * HTB, NXCD = 8, WGM = 8;
__host__ __device__ __forceinline__ int lds_byte(int r, int c) { const int st = (r >> 4) * 2 + (c >> 5), rr = r & 15, cc = c & 31, ob = rr * 64 + cc * 2; return st * 1024 + (ob ^ (((ob >> 9) & 1) << 5)); }
__host__ __device__ __forceinline__ void stage_rc(int b, int& R, int& C) { const int st = b / 1024, sb = b % 1024, swz = sb ^ (((sb >> 9) & 1) << 5); R = (st >> 1) * 16 + swz / 64; C = (st & 1) * 32 + (swz % 64) / 2; }
__host__ __device__ __forceinline__ int perm32(int rho) { const int n = rho >> 4, i = rho & 15; return 8 * (i >> 2) + 4 * n + (i & 3); }
struct Unit { int pm, pn, ks; };
struct Gemm { const bf16_t* A; const bf16_t* Bt; int M, N, K, ld; };
struct StaticOrder {
    int nM, nN, nwg, G, c, KS;
    __device__ void init(int M, int N, int KS_, int G_, int c_) { nM = M / BM; KS = KS_; nN = (N / BM) * KS_; nwg = nM * nN; G = G_; c = c_; }
    __device__ bool next(int i, Unit& u) const {
        const long L = (long)i * G + c; if (L >= nwg) return false;
        int wgid = (int)L; { const int q = nwg / NXCD, r = nwg % NXCD, xcd = wgid % NXCD, off = wgid / NXCD; wgid = (xcd < r ? xcd * (q + 1) : r * (q + 1) + (xcd - r) * q) + off; }
        const int nig = WGM * nN, gid = wgid / nig, fm = gid * WGM, gsz = (nM - fm) < WGM ? (nM - fm) : WGM;
        u.pm = fm + ((wgid % nig) % gsz); const int pn2 = (wgid % nig) / gsz; u.pn = pn2 / KS; u.ks = pn2 % KS; return true;
    }
    __device__ __forceinline__ void a_ready(const Unit&) const {}
    __device__ __forceinline__ void done(const Unit&) const {}
};
__device__ __forceinline__ unsigned cvt_pk_bf16(float lo, float hi) { unsigned r; asm volatile("v_cvt_pk_bf16_f32 %0, %1, %2" : "=v"(r) : "v"(lo), "v"(hi)); return r; }
struct EpiBf16 {
    static constexpr bool PERM = true, AFTER_DRAIN = false;
    bf16_t* O; int ldc;
    __device__ __forceinline__ void operator()(const f32x4 (&acc)[2][2][4][2], const Unit& u, int wr, int wc, int fr, int fq) const {
        const int row0 = u.pm * BM + wr * 64 + fr, col0 = u.pn * BM + wc * 32 + 8 * fq;
#pragma unroll
        for (int ai = 0; ai < 2; ++ai)
#pragma unroll
            for (int m = 0; m < 4; ++m) { bf16_t* rowp = O + (size_t)(row0 + ai * HALF + m * 16) * ldc + col0;
#pragma unroll
                for (int bj = 0; bj < 2; ++bj) { const f32x4 v0 = acc[ai][bj][m][0], v1 = acc[ai][bj][m][1];
                    u32x4 w; w.x = cvt_pk_bf16(v0[0], v0[1]); w.y = cvt_pk_bf16(v0[2], v0[3]); w.z = cvt_pk_bf16(v1[0], v1[1]); w.w = cvt_pk_bf16(v1[2], v1[3]);
                    *(u32x4*)(rowp + bj * HALF) = w; } }
    }
};
struct EpiSwiglu {
    static constexpr bool PERM = true, AFTER_DRAIN = false;
    bf16_t* H;
    __device__ __forceinline__ void operator()(const f32x4 (&acc)[2][2][4][2], const Unit& u, int wr, int wc, int fr, int fq) const {
        const int row0 = u.pm * BM + wr * 64 + fr, col0 = u.pn * HALF + wc * 32 + 8 * fq;
#pragma unroll
        for (int ai = 0; ai < 2; ++ai)
#pragma unroll
            for (int m = 0; m < 4; ++m) {
                float h[8];
#pragma unroll
                for (int n = 0; n < 2; ++n)
#pragma unroll
                    for (int e = 0; e < 4; ++e) { const float gv = acc[ai][0][m][n][e], uv = acc[ai][1][m][n][e]; h[4 * n + e] = gv * __builtin_amdgcn_rcpf(1.f + __expf(-gv)) * uv; }
                u32x4 w; w.x = cvt_pk_bf16(h[0], h[1]); w.y = cvt_pk_bf16(h[2], h[3]); w.z = cvt_pk_bf16(h[4], h[5]); w.w = cvt_pk_bf16(h[6], h[7]);
                *(u32x4*)(H + (size_t)(row0 + ai * HALF + m * 16) * DFF + col0) = w; }
    }
};
struct EpiGate {
    static constexpr bool PERM = false, AFTER_DRAIN = false;
    float* Y; float* P1; const float* gate;
    __device__ __forceinline__ void operator()(const f32x4 (&acc)[2][2][4][2], const Unit& u, int wr, int wc, int fr, int fq) const {
        const int row0 = u.pm * BM + wr * 64 + fr, col0 = u.pn * BM + wc * 32 + 4 * fq;
        const bool rmw = u.ks == 0;
        float* const dstb = rmw ? Y : P1;
#pragma unroll
        for (int ai = 0; ai < 2; ++ai)
#pragma unroll
            for (int m = 0; m < 4; ++m) { const int row = row0 + ai * HALF + m * 16; const float* gp = gate + cond_of(row) * 6144 + col0; float* yp = dstb + (size_t)row * D + col0;
                f32x4 v[4];
#pragma unroll
                for (int q = 0; q < 4; ++q) { const int o = (q >> 1) * HALF + (q & 1) * 16; v[q] = acc[ai][q >> 1][m][q & 1] * *(const f32x4*)(gp + o); }
                if (rmw) {
#pragma unroll
                    for (int q = 0; q < 4; ++q) { const int o = (q >> 1) * HALF + (q & 1) * 16; v[q] += *(const f32x4*)(yp + o); }
                }
#pragma unroll
                for (int q = 0; q < 4; ++q) { const int o = (q >> 1) * HALF + (q & 1) * 16; *(f32x4*)(yp + o) = v[q]; }
                asm volatile("" ::: "memory");
            }
    }
};
template <class Epi, class Sched, bool ALIGN_EPI = false, bool SP2 = false>
__device__ __forceinline__ void gemm_phase(PG8_LAS unsigned char* lds, const Gemm g, const Sched& S, const Epi& E) {
    int tid_ = tidx();
    const int tid = tid_, wid = __builtin_amdgcn_readfirstlane(tid >> 6), lane = tid & 63, wr = wid >> 2, wc = wid & 3, fr = lane & 15, fq = lane >> 4;
    const int K = g.ld, nt = g.K / BK;
    unsigned voffA[2], voffB[2];
#pragma unroll
    for (int i = 0; i < 2; ++i) { int R, C; stage_rc(tid * 16 + i * 8192, R, C); const int Rb = Epi::PERM ? ((R & ~31) + perm32(R & 31)) : R;
        voffA[i] = (unsigned)(R * K + C) * 2u; voffB[i] = (unsigned)(Rb * K + C) * 2u; }
    const size_t kstep = (size_t)(BK * 2);
    const size_t hstep = (size_t)HALF * K * 2;
    const size_t tstep = 2 * hstep;
    const unsigned ldsw = (unsigned)wid * 1024u;
    const int aoff = lds_byte(wr * 64 + fr, fq * 8), boff = lds_byte(wc * 32 + fr, fq * 8);
#define PG8_SA(b, h) (((b) * 2 + (h)) * HTB)
#define PG8_SB(b, h) ((4 + (b) * 2 + (h)) * HTB)
#define PG8_STAGE(bufoff, gbase, voff) do { _Pragma("unroll") for (int _i = 0; _i < 2; ++_i) \
        __builtin_amdgcn_global_load_lds((const unsigned*)((const char*)(gbase) + (voff)[_i]), (PG8_LAS unsigned*)(lds + (bufoff) + ldsw + _i * 8192), 16, 0, 0); } while (0)
#define PG8_LDA(dst, b, h) do { _Pragma("unroll") for (int m = 0; m < 4; ++m) _Pragma("unroll") for (int k = 0; k < 2; ++k) dst[m][k] = *(const PG8_LAS bf16x8*)(lds + PG8_SA(b, h) + aoff + m * 2048 + k * 1024); } while (0)
#define PG8_LDB(dst, b, h) do { _Pragma("unroll") for (int n = 0; n < 2; ++n) _Pragma("unroll") for (int k = 0; k < 2; ++k) dst[n][k] = *(const PG8_LAS bf16x8*)(lds + PG8_SB(b, h) + boff + n * 2048 + k * 1024); } while (0)
#define PG8_MMA(ai, bj, At, Bt) do { __builtin_amdgcn_s_setprio(1); _Pragma("unroll") for (int m = 0; m < 4; ++m) _Pragma("unroll") for (int n = 0; n < 2; ++n) _Pragma("unroll") for (int k = 0; k < 2; ++k) \
        acc[ai][bj][m][n] = __builtin_amdgcn_mfma_f32_16x16x32_bf16(Bt[n][k], At[m][k], acc[ai][bj][m][n], 0, 0, 0); __builtin_amdgcn_s_setprio(0); } while (0)
#define PG8_WAIT_V(n) asm volatile("s_waitcnt vmcnt(" #n ")" ::: "memory")
#define PG8_WAIT_L(n) asm volatile("s_waitcnt lgkmcnt(" #n ")" ::: "memory")
#define PG8_BAR __builtin_amdgcn_s_barrier()
#define PG8_SCHED __builtin_amdgcn_sched_barrier(0)
    Unit cur, nxt; int ui = 0;
    if (!S.next(0, cur)) return;
    f32x4 acc[2][2][4][2];
#pragma unroll
    for (int a = 0; a < 2; ++a)
#pragma unroll
        for (int b = 0; b < 2; ++b)
#pragma unroll
            for (int m = 0; m < 4; ++m)
#pragma unroll
                for (int n = 0; n < 2; ++n) acc[a][b][m][n] = (f32x4){0.f, 0.f, 0.f, 0.f};
    bf16x8 At[4][2], B0[2][2], B1[2][2];
    const size_t ksb = (size_t)g.K * 2; const char* cA = (const char*)g.A + (size_t)cur.pm * tstep + cur.ks * ksb; const char* cB = (const char*)g.Bt + (size_t)cur.pn * tstep + cur.ks * ksb;
    S.a_ready(cur);
    if constexpr (SP2) {
        PG8_STAGE(PG8_SB(0, 0), cB, voffB); PG8_STAGE(PG8_SB(0, 1), cB + hstep, voffB); PG8_STAGE(PG8_SA(0, 0), cA, voffA); PG8_STAGE(PG8_SA(0, 1), cA + hstep, voffA);
        if (wr == 1) PG8_BAR;
        PG8_WAIT_V(2); PG8_BAR;
        PG8_STAGE(PG8_SB(1, 0), cB + kstep, voffB); PG8_STAGE(PG8_SA(1, 0), cA + kstep, voffA); PG8_STAGE(PG8_SB(1, 1), cB + hstep + kstep, voffB);
        PG8_WAIT_V(6); PG8_BAR;
    } else {
        PG8_STAGE(PG8_SB(0, 0), cB, voffB); PG8_STAGE(PG8_SA(0, 0), cA, voffA); PG8_STAGE(PG8_SB(0, 1), cB + hstep, voffB); PG8_STAGE(PG8_SA(0, 1), cA + hstep, voffA);
        if (wr == 1) PG8_BAR;
        PG8_WAIT_V(4); PG8_BAR;
        PG8_STAGE(PG8_SB(1, 0), cB + kstep, voffB); PG8_STAGE(PG8_SA(1, 0), cA + kstep, voffA); PG8_STAGE(PG8_SB(1, 1), cB + hstep + kstep, voffB);
        PG8_WAIT_V(6); PG8_BAR;
    }
    for (;;) {
        const bool has_next = S.next(ui + 1, nxt);
        const char* nA = has_next ? (const char*)g.A + (size_t)nxt.pm * tstep + nxt.ks * ksb : cA; const char* nB = has_next ? (const char*)g.Bt + (size_t)nxt.pn * tstep + nxt.ks * ksb : cB;
        for (int t = 0; t < nt; t += 2) {
            const bool last = (t == nt - 2);
            const char* a1 = cA + (size_t)(t + 1) * kstep;
            const char* a2 = last ? nA : cA + (size_t)(t + 2) * kstep; const char* b2 = last ? nB : cB + (size_t)(t + 2) * kstep;
            const char* a3 = a2 + kstep; const char* b3 = b2 + kstep;
            if (last && has_next) S.a_ready(nxt);
            if constexpr (SP2) {
            PG8_LDB(B0, 0, 0); PG8_LDB(B1, 0, 1); PG8_SCHED; PG8_LDA(At, 0, 0); PG8_STAGE(PG8_SA(1, 1), a1 + hstep, voffA);
            PG8_WAIT_V(8); PG8_WAIT_L(0); PG8_BAR; PG8_MMA(0, 0, At, B0); PG8_MMA(0, 1, At, B1); PG8_BAR; PG8_SCHED;
            PG8_LDA(At, 0, 1); PG8_STAGE(PG8_SB(0, 0), b2, voffB); PG8_STAGE(PG8_SB(0, 1), b2 + hstep, voffB); PG8_STAGE(PG8_SA(0, 0), a2, voffA);
            PG8_WAIT_V(8); PG8_WAIT_L(0); PG8_BAR; PG8_MMA(1, 0, At, B0); PG8_MMA(1, 1, At, B1); PG8_BAR; PG8_SCHED;
            PG8_LDB(B0, 1, 0); PG8_LDB(B1, 1, 1); PG8_SCHED; PG8_LDA(At, 1, 0); PG8_STAGE(PG8_SA(0, 1), a2 + hstep, voffA);
            PG8_WAIT_V(8); PG8_WAIT_L(0); PG8_BAR; PG8_MMA(0, 0, At, B0); PG8_MMA(0, 1, At, B1); PG8_BAR; PG8_SCHED;
            PG8_LDA(At, 1, 1); PG8_STAGE(PG8_SB(1, 0), b3, voffB); PG8_STAGE(PG8_SB(1, 1), b3 + hstep, voffB); PG8_STAGE(PG8_SA(1, 0), a3, voffA);
            PG8_WAIT_V(8); PG8_WAIT_L(0); PG8_BAR; PG8_MMA(1, 0, At, B0); PG8_MMA(1, 1, At, B1); PG8_BAR; PG8_SCHED;
            } else {
            PG8_LDB(B0, 0, 0); PG8_SCHED; PG8_LDA(At, 0, 0); PG8_STAGE(PG8_SA(1, 1), a1 + hstep, voffA);
            PG8_WAIT_L(8); PG8_BAR; PG8_WAIT_L(0); PG8_MMA(0, 0, At, B0); PG8_BAR; PG8_SCHED;
            PG8_LDB(B1, 0, 1); PG8_STAGE(PG8_SB(0, 0), b2, voffB);
            PG8_BAR; PG8_WAIT_L(0); PG8_MMA(0, 1, At, B1); PG8_BAR;
            PG8_LDA(At, 0, 1); PG8_STAGE(PG8_SA(0, 0), a2, voffA);
            PG8_BAR; PG8_WAIT_L(0); PG8_MMA(1, 0, At, B0); PG8_BAR; PG8_SCHED;
            PG8_STAGE(PG8_SB(0, 1), b2 + hstep, voffB);
            PG8_WAIT_V(6); PG8_BAR; PG8_MMA(1, 1, At, B1); PG8_BAR;
            PG8_LDB(B0, 1, 0); PG8_SCHED; PG8_LDA(At, 1, 0); PG8_STAGE(PG8_SA(0, 1), a2 + hstep, voffA);
            PG8_WAIT_L(8); PG8_BAR; PG8_WAIT_L(0); PG8_MMA(0, 0, At, B0); PG8_BAR; PG8_SCHED;
            PG8_LDB(B1, 1, 1); PG8_STAGE(PG8_SB(1, 0), b3, voffB);
            PG8_BAR; PG8_WAIT_L(0); PG8_MMA(0, 1, At, B1); PG8_BAR;
            PG8_LDA(At, 1, 1); PG8_STAGE(PG8_SA(1, 0), a3, voffA);
            PG8_BAR; PG8_WAIT_L(0); PG8_MMA(1, 0, At, B0); PG8_BAR; PG8_SCHED;
            PG8_STAGE(PG8_SB(1, 1), b3 + hstep, voffB);
            PG8_WAIT_V(6); PG8_BAR; PG8_MMA(1, 1, At, B1); PG8_BAR;
            }
        }
        if constexpr (ALIGN_EPI) { if (wr == 0) PG8_BAR; }
        if constexpr (!Epi::AFTER_DRAIN) { E(acc, cur, wr, wc, fr, fq); S.done(cur); }
        if (!has_next) break;
#pragma unroll
        for (int a = 0; a < 2; ++a)
#pragma unroll
            for (int b = 0; b < 2; ++b)
#pragma unroll
                for (int m = 0; m < 4; ++m)
#pragma unroll
                    for (int n = 0; n < 2; ++n) acc[a][b][m][n] = (f32x4){0.f, 0.f, 0.f, 0.f};
        cur = nxt; cA = nA; cB = nB; ++ui;
        if constexpr (ALIGN_EPI) { if (wr == 1) PG8_BAR; }
    }
    PG8_WAIT_V(0);
    if constexpr (!ALIGN_EPI) { if (wr == 0) PG8_BAR; }
    PG8_BAR;
    if constexpr (Epi::AFTER_DRAIN) { E.fused(acc, cur, wr, wc, fr, fq, lds, wid, lane); S.done(cur); }
#undef PG8_SA
#undef PG8_SB
#undef PG8_STAGE
#undef PG8_LDA
#undef PG8_LDB
#undef PG8_MMA
#undef PG8_WAIT_V
#undef PG8_WAIT_L
#undef PG8_BAR
#undef PG8_SCHED
}
}

template <class Epi>
__device__ __forceinline__ void gemm_run(unsigned char* lds, const bf16_t* A, const bf16_t* Bt, int M, int N, int Ktot, int KS, const Epi& E) {
    pg8::StaticOrder S; S.init(M, N, KS, (int)gridDim.x, (int)blockIdx.x);
    pg8::Gemm g; g.A = A; g.Bt = Bt; g.M = M; g.N = N; g.K = Ktot / KS; g.ld = Ktot;
    __syncthreads();
    pg8::gemm_phase<Epi, pg8::StaticOrder, true, true>((PG8_LAS unsigned char*)lds, g, S, E);
    __syncthreads();
}


#define LDSP __attribute__((address_space(3)))
constexpr int LC_FR = 0, LC_U = 66176, LC_X0 = LC_U + 20480, LC_S = LC_X0 + 20480, LC_Z = LC_S + 17408;
__device__ void phase_lc(const Params& p, int j, unsigned char* lds_) {
  LDSP unsigned char* lds = (LDSP unsigned char*)lds_;
  const int tid = tidx(), lane = tid & 63, wid = tid >> 6, n = lane & 31, hi = lane >> 5;
  const bf16_t* ZT = (const bf16_t*)(p.ws + WS_ZT); bf16_t* YG = (bf16_t*)(p.ws + WS_YG);
  const float* cw = p.in[I_HCW] + (size_t)j * 3 * 3072; const float* cb = p.in[I_HCB] + (size_t)j * 3072;
  for (int q = blockIdx.x; q < 1024; q += gridDim.x) {
    const int lsel = q < 512 ? 1 : 0, qq = q & 511, cg = qq >> 2, tb = (lsel ? 4 : 0) + (qq & 3);
    const int L = lsel ? 1024 : 256, P = L >> 5, REC = 4 * L + 40, c0 = cg * 8;
    const size_t m0 = (size_t)tb * 1024;
    __syncthreads();
    {
      const u32x4* src = (const u32x4*)((const bf16_t*)(p.ws + WS_FRG) + (size_t)j * FRG_J + (lsel ? FRG_L1 : 0) + (size_t)c0 * REC);
      LDSP u32x4* dst = (LDSP u32x4*)(lds + LC_FR);
      for (int i = tid; i < REC; i += 512) dst[i] = src[i];
    }
    for (int task = tid; task < 1024; task += 512) {
      const int ch = task >> 7, tok0 = (task & 127) * 8;
      const bool first = (tok0 & (L - 1)) == 0, last = ((tok0 + 8) & (L - 1)) == 0;
      float sc[3][8];
#pragma unroll
      for (int part = 0; part < 3; ++part) {
        const int chn = part * 1024 + c0 + ch;
        const bf16_t* z = ZT + (size_t)chn * MTOK + m0 + tok0;
        const u32x4 w = *(const u32x4*)z;
        float zv[10];
        zv[0] = first ? 0.f : bf2f(z[-1]); zv[9] = last ? 0.f : bf2f(z[8]);
        zv[1] = __uint_as_float(w.x << 16); zv[2] = __uint_as_float(w.x & 0xFFFF0000u); zv[3] = __uint_as_float(w.y << 16); zv[4] = __uint_as_float(w.y & 0xFFFF0000u);
        zv[5] = __uint_as_float(w.z << 16); zv[6] = __uint_as_float(w.z & 0xFFFF0000u); zv[7] = __uint_as_float(w.w << 16); zv[8] = __uint_as_float(w.w & 0xFFFF0000u);
        const float w0 = cw[chn], w1 = cw[3072 + chn], w2 = cw[2 * 3072 + chn], bb = cb[chn];
#pragma unroll
        for (int i = 0; i < 8; ++i) sc[part][i] = zv[i] * w0 + zv[i + 1] * w1 + zv[i + 2] * w2 + bb;
      }
      u32x4 xo, uo;
      xo.x = pack2(sc[0][0], sc[0][1]); xo.y = pack2(sc[0][2], sc[0][3]); xo.z = pack2(sc[0][4], sc[0][5]); xo.w = pack2(sc[0][6], sc[0][7]);
      uo.x = pack2(sc[1][0] * sc[2][0], sc[1][1] * sc[2][1]); uo.y = pack2(sc[1][2] * sc[2][2], sc[1][3] * sc[2][3]);
      uo.z = pack2(sc[1][4] * sc[2][4], sc[1][5] * sc[2][5]); uo.w = pack2(sc[1][6] * sc[2][6], sc[1][7] * sc[2][7]);
      const int po = (ch * 1280 + tok0 + 8 * (tok0 >> 5)) * 2;
      *(LDSP u32x4*)(lds + LC_U + po) = uo; *(LDSP u32x4*)(lds + LC_X0 + po) = xo;
    }
    if (tid < 4) ((LDSP unsigned*)(lds + LC_Z))[tid] = 0u;
    __syncthreads();
    f32x16 acc;
#pragma unroll
    for (int r = 0; r < 16; ++r) acc[r] = 0.f;
    {
      const int par = n & 1;
      LDSP const unsigned char* fa = lds + LC_FR + wid * (REC * 2) + (par ? (2 * L + 40) * 2 : 0) + 2 * (L - n - par + 8 * hi);
      LDSP const unsigned char* ub = lds + LC_U + wid * 2560 + (40 * n + 8 * hi) * 2;
      const int ti = n & (P - 1);
      for (int dl = -(P - 1); dl <= P - 1; ++dl) {
        const bool valid = (unsigned)(ti - dl) < (unsigned)P;
#pragma unroll
        for (int ks = 0; ks < 2; ++ks) {
          LDSP const volatile unsigned* ap = (LDSP const volatile unsigned*)(fa + 2 * (-32 * dl + 16 * ks));
          u32x4 aw; aw.x = ap[0]; aw.y = ap[1]; aw.z = ap[2]; aw.w = ap[3];
          LDSP const unsigned char* bp = valid ? (ub + (-40 * dl + 16 * ks) * 2) : (lds + LC_Z);
          const bf16x8 bfrag = *(LDSP const bf16x8*)bp;
          acc = __builtin_amdgcn_mfma_f32_32x32x16_bf16(__builtin_bit_cast(bf16x8, aw), bfrag, acc, 0, 0, 0);
        }
      }
    }
    {
      const float rn = ((const float*)(p.ws + WS_RNORM))[(j * 2 + lsel) * 1024 + c0 + wid], bs = p.in[I_HBIAS][j * D + c0 + wid];
      LDSP const bf16_t* uu = (LDSP const bf16_t*)(lds + LC_U) + wid * 1280 + 40 * n;
      LDSP const bf16_t* xx = (LDSP const bf16_t*)(lds + LC_X0) + wid * 1280 + 40 * n;
      LDSP bf16_t* so = (LDSP bf16_t*)(lds + LC_S) + wid * 1088 + 34 * n;
#pragma unroll
      for (int r = 0; r < 16; ++r) {
        const int row = (r & 3) + 8 * (r >> 2) + 4 * hi;
        const float y = acc[r] * rn + bf2f(uu[row]) * bs;
        so[row] = f2bf(bf2f(xx[row]) * y);
      }
    }
    __syncthreads();
    for (int tok = tid; tok < 1024; tok += 512) {
      LDSP const bf16_t* so = (LDSP const bf16_t*)(lds + LC_S) + tok + 2 * (tok >> 5);
      u32x4 w;
      w.x = (unsigned)so[0] | ((unsigned)so[1088] << 16); w.y = (unsigned)so[2 * 1088] | ((unsigned)so[3 * 1088] << 16);
      w.z = (unsigned)so[4 * 1088] | ((unsigned)so[5 * 1088] << 16); w.w = (unsigned)so[6 * 1088] | ((unsigned)so[7 * 1088] << 16);
      *(u32x4*)(YG + (m0 + tok) * D + c0) = w;
    }
  }
  __syncthreads();
}

__device__ void phase_qkvpost(const Params& p, int j) {
  const int lane = tidx() & 63, wid = tidx() >> 6;
  const unsigned* QKV = (const unsigned*)(p.ws + WS_QKV);
  unsigned* Q = (unsigned*)(p.ws + WS_Q); unsigned* KP = (unsigned*)(p.ws + WS_KP); unsigned* VP = (unsigned*)(p.ws + WS_VP);
  unsigned* KS = (unsigned*)(p.ws + WS_KS) + (size_t)j * 4 * 1536 * 128; unsigned* VS = (unsigned*)(p.ws + WS_VS) + (size_t)j * 4 * 1536 * 128;
  const float* qn = p.in[I_QN] + j * 128; const float* kn = p.in[I_KN] + j * 128;
  float* newk = p.out + (size_t)2 * NPR * D; float* newv = newk + (size_t)16 * 2 * 256 * 256;
  const float qg0 = qn[2 * lane], qg1 = qn[2 * lane + 1], kg0 = kn[2 * lane], kg1 = kn[2 * lane + 1];
  const float freq = exp2f(-(float)(lane & 31) * 0.41524101186092029f);
  for (int m = blockIdx.x * 8 + wid; m < MTOK; m += gridDim.x * 8) {
    const bool smp = m >= NPR;
    float cs = 1.f, sn = 0.f;
    if (smp) { const int t = (m - NPR) & 1023; const float pos = (float)(lane < 32 ? (t >> 6) : (t & 63)); const float rev = (pos * freq) * INV_2PI; cs = cos_rev(rev); sn = sin_rev(rev); }
    for (int s = 0; s < 12; ++s) {
      const unsigned raw = QKV[(size_t)m * 768 + s * 64 + lane];
      float x0 = __uint_as_float(raw << 16), x1 = __uint_as_float(raw & 0xFFFF0000u);
      if (s < 10) {
        const float ss = wave_sum(x0 * x0 + x1 * x1);
        const float r = rsqrtf(ss * (1.f / 128.f) + EPS);
        x0 = x0 * r * (s < 8 ? qg0 : kg0); x1 = x1 * r * (s < 8 ? qg1 : kg1);
        if (smp) { const float a = x0, b = x1; x0 = a * cs - b * sn; x1 = a * sn + b * cs; }
      }
      const unsigned w = pack2(x0, x1);
      if (s < 8) Q[(size_t)m * 512 + s * 64 + lane] = w;
      else {
        const int kv = (s - 8) & 1; const bool isk = s < 10;
        if (!smp) {
          (isk ? KP : VP)[(size_t)m * 128 + kv * 64 + lane] = w;
          const int b = m >> 8, t = m & 255;
          float* o = (isk ? newk : newv) + ((((size_t)b * 2 + j) * 256 + t) * 2 + kv) * 128 + 2 * lane;
          o[0] = x0; o[1] = x1;
        } else {
          const int b = (m - NPR) >> 10, t = (m - NPR) & 1023;
          (isk ? KS : VS)[((size_t)b * 1536 + t) * 128 + kv * 64 + lane] = w;
        }
      }
    }
  }
}


namespace att {
typedef unsigned short bf16;
constexpr int   D = 128, NW = 8, QBLK = 32, KVBLK = 64;
constexpr float SCALE = 0.088388347648318440f;
constexpr float THR = 8.f;
constexpr int SDEPTH = 2;
constexpr int LDQ = 1024, LDK = 256, LDO = 1024;
constexpr size_t SHM_V = KVBLK * D * 2, SHM_K = KVBLK * D * 2, SHM_ATTN = 2 * SHM_V + 2 * SHM_K + NW * 64 * 4;

using s16x4  = __attribute__((ext_vector_type(4))) short;
using f32x16 = __attribute__((ext_vector_type(16))) float;
using f32x8  = __attribute__((ext_vector_type(8))) float;

#define KSWZ(row, colB) ((row) * 256 + ((colB) ^ (((row) & 7) << 4)))
#define SBAR() __builtin_amdgcn_sched_barrier(0)
__device__ __forceinline__ int crow(int r, int hi) { return (r & 3) + 8 * (r >> 2) + 4 * hi; }
__device__ __forceinline__ unsigned cvtpk(float lo, float hi) {
  unsigned r; asm volatile("v_cvt_pk_bf16_f32 %0, %1, %2" : "=v"(r) : "v"(lo), "v"(hi)); return r;
}
template <typename TIn> struct Stage;
template <> struct Stage<bf16>  { using T = bf16x8;
  __device__ static __forceinline__ T ld8(const bf16* p) { return *reinterpret_cast<const bf16x8*>(p); }
  __device__ static __forceinline__ bf16x8 tobf(T x) { return x; } };
template <> struct Stage<float> { using T = f32x8;
  __device__ static __forceinline__ T ld8(const float* p) { return *reinterpret_cast<const f32x8*>(p); }
  __device__ static __forceinline__ bf16x8 tobf(T x) {
    u32x4 w = {cvtpk(x[0], x[1]), cvtpk(x[2], x[3]), cvtpk(x[4], x[5]), cvtpk(x[6], x[7])}; return *reinterpret_cast<bf16x8*>(&w); } };

__device__ __forceinline__ void partialSM(f32x16& p0, f32x16& p1, float& m_reg, float& mn, float& alpha) {
  constexpr float C = SCALE * 1.4426950408889634f;
  float pmax = p0[0]; for (int r = 1; r < 16; ++r) pmax = fmaxf(pmax, p0[r]); for (int r = 0; r < 16; ++r) pmax = fmaxf(pmax, p1[r]);
  { auto rr = __builtin_amdgcn_permlane32_swap(__float_as_uint(pmax), __float_as_uint(pmax), false, false);
    pmax = fmaxf(__uint_as_float(rr[0]), __uint_as_float(rr[1])); }
  if (__builtin_expect(__all(pmax - m_reg <= THR / SCALE), 1)) { mn = m_reg; alpha = 1.f; }
  else { mn = fmaxf(m_reg, pmax); alpha = __builtin_amdgcn_exp2f((m_reg - mn) * C); m_reg = mn; }
  float mnC = -mn * C;
  for (int r = 0; r < 16; ++r) p0[r] = fmaf(p0[r], C, mnC); for (int r = 0; r < 16; ++r) p1[r] = fmaf(p1[r], C, mnC);
  for (int r = 0; r < 16; ++r) p0[r] = __builtin_amdgcn_exp2f(p0[r]);
}
__device__ __forceinline__ void finishSM(f32x16& p0, f32x16& p1, float alpha, float& l_reg, bf16x8& pa0, bf16x8& pa1, bf16x8& pa2, bf16x8& pa3) {
  for (int r = 0; r < 16; ++r) p1[r] = __builtin_amdgcn_exp2f(p1[r]);
  float ps = 0; for (int r = 0; r < 16; ++r) ps += p0[r]; for (int r = 0; r < 16; ++r) ps += p1[r];
  { auto rr = __builtin_amdgcn_permlane32_swap(__float_as_uint(ps), __float_as_uint(ps), false, false);
    ps = __uint_as_float(rr[0]) + __uint_as_float(rr[1]); }
  l_reg = l_reg * alpha + ps;
#define PK4(P, BASE, OUT) do { unsigned a0 = cvtpk(P[BASE + 0], P[BASE + 1]), a1 = cvtpk(P[BASE + 2], P[BASE + 3]);   \
    unsigned b0 = cvtpk(P[BASE + 4], P[BASE + 5]), b1 = cvtpk(P[BASE + 6], P[BASE + 7]);                              \
    auto r0 = __builtin_amdgcn_permlane32_swap(a0, b0, false, false); auto r1 = __builtin_amdgcn_permlane32_swap(a1, b1, false, false); \
    u32x4 w = {r0[0], r1[0], r0[1], r1[1]}; OUT = *reinterpret_cast<bf16x8*>(&w); } while (0)
  PK4(p0, 0, pa0); PK4(p0, 8, pa1); PK4(p1, 0, pa2); PK4(p1, 8, pa3);
#undef PK4
}
__device__ __forceinline__ void qkt(f32x16& p0, f32x16& p1, const bf16* Ks, const bf16x8* qr, int r32, int hi) {
  p0 = f32x16{}; p1 = f32x16{};
  for (int d0 = 0; d0 < 8; ++d0) { int cb = (d0 * 16 + hi * 8) * 2;
    bf16x8 b0 = *reinterpret_cast<const bf16x8*>((const char*)Ks + KSWZ(r32, cb));
    bf16x8 b1 = *reinterpret_cast<const bf16x8*>((const char*)Ks + KSWZ(32 + r32, cb));
    p0 = __builtin_amdgcn_mfma_f32_32x32x16_bf16(b0, qr[d0], p0, 0, 0, 0);
    p1 = __builtin_amdgcn_mfma_f32_32x32x16_bf16(b1, qr[d0], p1, 0, 0, 0); }
}
__device__ __forceinline__ int v_st(int k, int c) { const int kk = (k & ~0xC) | ((k & 4) << 1) | ((k & 8) >> 1); return ((kk >> 3) * 4 + (c >> 5)) * 512 + ((kk & 7) * 32 + (c & 31)) * 2; }
__device__ __forceinline__ int v_rd_base(int lane) { return ((lane & 3) << 3) | (((lane >> 2) & 3) << 6) | (((lane >> 4) & 1) << 5) | (((lane >> 5) & 1) << 8); }
constexpr int v_rd_off(int d0, int ks, int half) { return d0 * 512 + ks * 4096 + half * 2048; }
template <int OFF> __device__ __forceinline__ s16x4 tr_read(int vb) {
  s16x4 r; asm volatile("ds_read_b64_tr_b16 %0, %1 offset:%2" : "=&v"(r) : "v"(vb), "i"(OFF) : "memory"); return r;
}
template <int D0> __device__ __forceinline__ void pv_one(f32x16& od, int vb, bf16x8 pa0, bf16x8 pa1, bf16x8 pa2, bf16x8 pa3) {
  const s16x4 l0 = tr_read<v_rd_off(D0, 0, 0)>(vb), h0 = tr_read<v_rd_off(D0, 0, 1)>(vb), l1 = tr_read<v_rd_off(D0, 1, 0)>(vb), h1 = tr_read<v_rd_off(D0, 1, 1)>(vb);
  const s16x4 l2 = tr_read<v_rd_off(D0, 2, 0)>(vb), h2 = tr_read<v_rd_off(D0, 2, 1)>(vb), l3 = tr_read<v_rd_off(D0, 3, 0)>(vb), h3 = tr_read<v_rd_off(D0, 3, 1)>(vb);
  asm volatile("s_waitcnt lgkmcnt(0)" ::: "memory"); SBAR();
#define PK(L, H) (bf16x8){L[0], L[1], L[2], L[3], H[0], H[1], H[2], H[3]}
  od = __builtin_amdgcn_mfma_f32_32x32x16_bf16(pa0, PK(l0, h0), od, 0, 0, 0);
  od = __builtin_amdgcn_mfma_f32_32x32x16_bf16(pa1, PK(l1, h1), od, 0, 0, 0);
  od = __builtin_amdgcn_mfma_f32_32x32x16_bf16(pa2, PK(l2, h2), od, 0, 0, 0);
  od = __builtin_amdgcn_mfma_f32_32x32x16_bf16(pa3, PK(l3, h3), od, 0, 0, 0);
#undef PK
}
__device__ __forceinline__ void pv_d0(f32x16* o, int vb, bf16x8 pa0, bf16x8 pa1, bf16x8 pa2, bf16x8 pa3) {
  pv_one<0>(o[0], vb, pa0, pa1, pa2, pa3); pv_one<1>(o[1], vb, pa0, pa1, pa2, pa3); pv_one<2>(o[2], vb, pa0, pa1, pa2, pa3); pv_one<3>(o[3], vb, pa0, pa1, pa2, pa3);
}

template <typename TQ>
__device__ __forceinline__ void attn_dense_body(const TQ* __restrict__ Qb, const bf16* __restrict__ Kh, const bf16* __restrict__ Vh,
                                                bf16* __restrict__ Ob, int seq, char* lds) {
  using St = Stage<bf16>; using SQ = Stage<TQ>;
  const int tid = tidx(), wid = tid >> 6, lane = tid & 63, r32 = lane & 31, hi = lane >> 5;
  bf16* V_lds = (bf16*)lds; bf16* K_lds = (bf16*)(lds + 2 * SHM_V);
  float* ws = (float*)(lds + 2 * SHM_V + 2 * SHM_K) + wid * 64; float* li_l = ws; float* al_l = ws + 32;
  float m_reg = -1e30f, l_reg = 0; f32x16 o[4] = {}; bf16x8 qr[8];
  const TQ* Qw = Qb + (long)(wid * QBLK + r32) * LDQ + hi * 8;
#pragma unroll
  for (int d0 = 0; d0 < 8; ++d0) qr[d0] = SQ::tobf(SQ::ld8(Qw + d0 * 16));
  const int sr = tid >> 4, sc = (tid & 15) * 8, vst0 = v_st(sr, sc), vst1 = v_st(32 + sr, sc);
  const int vb0 = (int)(uintptr_t)V_lds + v_rd_base(lane);
  struct { typename St::T vs0, vs1, ks0, ks1; } sr_[SDEPTH];
#define SLOAD(i, k0) do { sr_[i].vs0 = St::ld8(&Vh[(long)((k0) + sr) * LDK + sc]); sr_[i].vs1 = St::ld8(&Vh[(long)((k0) + 32 + sr) * LDK + sc]); \
    sr_[i].ks0 = St::ld8(&Kh[(long)((k0) + sr) * LDK + sc]); sr_[i].ks1 = St::ld8(&Kh[(long)((k0) + 32 + sr) * LDK + sc]); } while (0)
#define SWRITE(b, i) do { *(bf16x8*)((char*)V_lds + (b) * SHM_V + vst0) = St::tobf(sr_[i].vs0);          \
    *(bf16x8*)((char*)V_lds + (b) * SHM_V + vst1) = St::tobf(sr_[i].vs1); int kc = sc * 2;               \
    *(bf16x8*)((char*)K_lds + (b) * SHM_K + KSWZ(sr, kc)) = St::tobf(sr_[i].ks0);                       \
    *(bf16x8*)((char*)K_lds + (b) * SHM_K + KSWZ(32 + sr, kc)) = St::tobf(sr_[i].ks1); } while (0)
#define SWAIT() do { if constexpr (SDEPTH == 2) asm volatile("s_waitcnt vmcnt(4)" ::: "memory"); else asm volatile("s_waitcnt vmcnt(0)" ::: "memory"); } while (0)
#define RESC(a) do { if (__any((a) < 1.f)) { if (hi == 0) al_l[r32] = (a); asm volatile("s_waitcnt lgkmcnt(0)" ::: "memory"); \
    for (int d = 0; d < 4; ++d) for (int r = 0; r < 16; ++r) o[d][r] *= al_l[crow(r, hi)]; } } while (0)
  f32x16 pA0, pA1, pB0, pB1; float mnA, mnB, alA, alB; bf16x8 pa0, pa1, pa2, pa3; const int NT = seq / KVBLK;
  constexpr int SE = 0, SO = SDEPTH - 1;
  SLOAD(SE, 0); asm volatile("s_waitcnt vmcnt(0)" ::: "memory"); SWRITE(0, SE); __syncthreads();
  qkt(pA0, pA1, K_lds, qr, r32, hi); partialSM(pA0, pA1, m_reg, mnA, alA);
  SLOAD(SO, KVBLK); if constexpr (SDEPTH == 2) { if (2 < NT) SLOAD(SE, 2 * KVBLK); }
  SWAIT(); SWRITE(1, SO); __syncthreads();
  for (int j = 1; j + 1 < NT; j += 2) {
    SBAR(); qkt(pB0, pB1, (bf16*)((char*)K_lds + SHM_K), qr, r32, hi);
    finishSM(pA0, pA1, alA, l_reg, pa0, pa1, pa2, pa3); SBAR();
    SLOAD(SO, (j + SDEPTH) * KVBLK); SBAR();
    pv_d0(o, vb0, pa0, pa1, pa2, pa3); partialSM(pB0, pB1, m_reg, mnB, alB);
    __syncthreads(); SWAIT(); SWRITE(0, SE);
    RESC(alB); __syncthreads();
    SBAR(); qkt(pA0, pA1, K_lds, qr, r32, hi);
    finishSM(pB0, pB1, alB, l_reg, pa0, pa1, pa2, pa3); SBAR();
    if (SDEPTH == 1 || j + 3 < NT) SLOAD(SE, (j + 1 + SDEPTH) * KVBLK); SBAR();
    pv_d0(o, vb0 + (int)SHM_V, pa0, pa1, pa2, pa3); partialSM(pA0, pA1, m_reg, mnA, alA);
    __syncthreads(); SWAIT(); SWRITE(1, SO);
    RESC(alA); __syncthreads();
  }
  SBAR(); qkt(pB0, pB1, (bf16*)((char*)K_lds + SHM_K), qr, r32, hi);
  finishSM(pA0, pA1, alA, l_reg, pa0, pa1, pa2, pa3); SBAR();
  pv_d0(o, vb0, pa0, pa1, pa2, pa3); partialSM(pB0, pB1, m_reg, mnB, alB);
  __syncthreads(); RESC(alB);
  finishSM(pB0, pB1, alB, l_reg, pa0, pa1, pa2, pa3); SBAR();
  pv_d0(o, vb0 + (int)SHM_V, pa0, pa1, pa2, pa3);
  if (hi == 0) li_l[r32] = l_reg; asm volatile("s_waitcnt lgkmcnt(0)" ::: "memory");
  float rli[16];
#pragma unroll
  for (int r = 0; r < 16; ++r) rli[r] = __builtin_amdgcn_rcpf(li_l[crow(r, hi)]);
  bf16* Ow = Ob + (long)(wid * QBLK) * LDO;
#pragma unroll
  for (int r = 0; r < 16; ++r) { int orow = crow(r, hi);
    for (int d0 = 0; d0 < 4; ++d0) Ow[(long)orow * LDO + d0 * 32 + r32] = f2bf(o[d0][r] * rli[r]); }
#undef SLOAD
#undef SWRITE
#undef SWAIT
#undef RESC
}
}

__device__ void phase_att(const Params& p, int j, unsigned char* lds) {
  const bf16_t* Q = (const bf16_t*)(p.ws + WS_Q); bf16_t* O = (bf16_t*)(p.ws + WS_O);
  const bf16_t* KP = (const bf16_t*)(p.ws + WS_KP); const bf16_t* VP = (const bf16_t*)(p.ws + WS_VP);
  const bf16_t* KS = (const bf16_t*)(p.ws + WS_KS) + (size_t)j * 4 * 1536 * 256; const bf16_t* VS = (const bf16_t*)(p.ws + WS_VS) + (size_t)j * 4 * 1536 * 256;
  for (int u = blockIdx.x; u < 256; u += gridDim.x) {
    __syncthreads();
    if (u < 128) {
      const int qb = u & 3, h = (u >> 2) & 7, b = u >> 5, kv = h >> 2;
      const size_t row0 = (size_t)NPR + b * 1024 + qb * 256, kb = ((size_t)b * 1536) * 256 + kv * 128;
      att::attn_dense_body<att::bf16>(Q + row0 * D + h * 128, KS + kb, VS + kb, O + row0 * D + h * 128, 1536, (char*)lds);
    } else {
      const int h = (u - 128) & 7, b = (u - 128) >> 3, kv = h >> 2;
      const size_t row0 = (size_t)b * 256, kb = row0 * 256 + kv * 128;
      att::attn_dense_body<att::bf16>(Q + row0 * D + h * 128, KP + kb, VP + kb, O + row0 * D + h * 128, 256, (char*)lds);
    }
  }
  __syncthreads();
}

#define XB_TMO      128
#define XB_XCNT(j)  (256  + 64 * (j))
#define XB_XSUB(j)  (1280 + 64 * (j))
#define XB_XGEN(j)  (2304 + 64 * (j))
#define XB_TOP      3328
#define XB_TOPGEN   3392
#define XCD_BAR_WORDS 3456
#define XB_SPIN_CAP (1u << 18)
#define LAS __attribute__((address_space(3)))

__device__ __forceinline__ unsigned xb_ld(unsigned* p)              { return __hip_atomic_load(p, __ATOMIC_RELAXED, __HIP_MEMORY_SCOPE_AGENT); }
__device__ __forceinline__ unsigned xb_add(unsigned* p, unsigned v) { return __hip_atomic_fetch_add(p, v, __ATOMIC_RELAXED, __HIP_MEMORY_SCOPE_AGENT); }
__device__ __forceinline__ unsigned xb_xcc_id() { return (unsigned)__builtin_amdgcn_s_getreg((3 << 11) | 20) & 0xFu; }
#define XB_SPIN(cond, bar) do { unsigned _sp = 0; while (cond) { __builtin_amdgcn_s_sleep(1); \
    if ((++_sp & 255u) == 0u) { if (xb_ld(&(bar)[XB_TMO])) break; if (_sp > XB_SPIN_CAP) { atomicAdd(&(bar)[XB_TMO], 1u); break; } } } } while (0)

struct XcdBarrier {
    unsigned* bar; unsigned x;
    volatile LAS unsigned* st;
};

__device__ __forceinline__ XcdBarrier xcd_barrier_post(unsigned* bar, volatile LAS unsigned* st) {
    XcdBarrier b; b.bar = bar; b.x = xb_xcc_id(); b.st = st;
    if (threadIdx.x == 0) (void)xb_add(&bar[XB_XCNT(b.x)], 1u);
    return b;
}
__device__ __forceinline__ void xcd_barrier_complete(unsigned* bar, unsigned x, unsigned& nloc, unsigned& nx) {
    const unsigned G = gridDim.x * gridDim.y * gridDim.z;
    unsigned sum, cnt, mine, sp = 0u;
    for (;;) {
        sum = 0u; cnt = 0u; mine = 0u;
#pragma unroll
        for (unsigned j = 0; j < 16; ++j) { const unsigned c = xb_ld(&bar[XB_XCNT(j)]); sum += c; cnt += (c > 0u) ? 1u : 0u; mine = (j == x) ? c : mine; }
        if (sum == G) break;
        __builtin_amdgcn_s_sleep(1);
        if ((++sp & 255u) == 0u) { if (xb_ld(&bar[XB_TMO])) break; if (sp > XB_SPIN_CAP) { atomicAdd(&bar[XB_TMO], 1u); break; } }
    }
    nloc = mine > 0u ? mine : 1u; nx = cnt > 0u ? cnt : 1u;
}

__device__ __forceinline__ void xcd_barrier(const XcdBarrier& b) {
    asm volatile("s_waitcnt vmcnt(0)" ::: "memory");
    __syncthreads();
    if (threadIdx.x == 0) {
        unsigned* bar = b.bar;
        __builtin_amdgcn_s_waitcnt(0);
        unsigned nloc = b.st[0], nx = b.st[1];
        if (nloc == 0u) { xcd_barrier_complete(bar, b.x, nloc, nx); b.st[0] = nloc; b.st[1] = nx; }
        const unsigned old = xb_add(&bar[XB_XSUB(b.x)], 1u);
        const unsigned gen = old / nloc;
        if (old + 1u == (gen + 1u) * nloc) {
            __builtin_amdgcn_fence(__ATOMIC_RELEASE, "agent");
            asm volatile("s_waitcnt vmcnt(0)" ::: "memory");
            const unsigned og = xb_add(&bar[XB_TOP], 1u);
            const unsigned tg = og / nx;
            if (og + 1u == (tg + 1u) * nx) xb_add(&bar[XB_TOPGEN], 1u);
            else XB_SPIN(xb_ld(&bar[XB_TOPGEN]) == tg, bar);
            __builtin_amdgcn_fence(__ATOMIC_ACQUIRE, "agent");
            xb_add(&bar[XB_XGEN(b.x)], 1u);
            asm volatile("s_waitcnt vmcnt(0)" ::: "memory");
        } else {
            XB_SPIN(xb_ld(&bar[XB_XGEN(b.x)]) == gen, bar);
            __builtin_amdgcn_fence(__ATOMIC_ACQUIRE, "agent");
            asm volatile("s_waitcnt vmcnt(0)" ::: "memory");
        }
    }
    __syncthreads();
}

__global__ void __launch_bounds__(512, 2) mega(Params p) {
  extern __shared__ __attribute__((aligned(16))) unsigned char lds[];
  cg::grid_group grid = cg::this_grid();
  volatile LAS unsigned* xst = (volatile LAS unsigned*)((LAS unsigned char*)lds + (LDS_BYTES - 16));
  if (threadIdx.x < 4) xst[threadIdx.x] = 0u;
  __syncthreads();
  const XcdBarrier xbar = xcd_barrier_post((unsigned*)p.ws, xst);
  int ph = 0;
#define RUN(stmt) do { if (ph >= p.ph_lo && ph < p.ph_hi) { stmt; if (ph + 1 < p.ph_hi) { if (ph == 0) grid.sync(); else xcd_barrier(xbar); } } ++ph; } while (0)
  bf16_t* XN = (bf16_t*)(p.ws + WS_XN); float* Y = (float*)(p.ws + WS_Y); const float* MOD = (const float*)(p.ws + WS_MOD);
  RUN(phase_p0(p, lds));
  RUN(phase_p0b(p));
#pragma unroll 1
  for (int l = 0; l < 4; ++l) {
    const int j = l >> 1;
    RUN(phase_nm(p, l, 0, l > 0));
    if ((l & 1) == 0) {
      RUN(gemm_run(lds, (const bf16_t*)(p.ws + WS_WIN) + (size_t)j * 3072 * D, XN, 3072, MTOK, D, 1, pg8::EpiBf16{(bf16_t*)(p.ws + WS_ZT), MTOK}));
      RUN(phase_lc(p, j, lds));
      RUN(gemm_run(lds, (const bf16_t*)(p.ws + WS_YG), (const bf16_t*)(p.ws + WS_WHO) + (size_t)j * D * D, MTOK, D, D, 2, pg8::EpiGate{Y, (float*)(p.ws + WS_P1), MOD + (size_t)l * 5 * 6144 + 2048}));
    } else {
      RUN(gemm_run(lds, XN, (const bf16_t*)(p.ws + WS_WQKV) + (size_t)j * QKVD * D, MTOK, QKVD, D, 1, pg8::EpiBf16{(bf16_t*)(p.ws + WS_QKV), QKVD}));
      RUN(phase_qkvpost(p, j));
      RUN(phase_att(p, j, lds));
      RUN(gemm_run(lds, (const bf16_t*)(p.ws + WS_O), (const bf16_t*)(p.ws + WS_WAO) + (size_t)j * D * D, MTOK, D, D, 2, pg8::EpiGate{Y, (float*)(p.ws + WS_P1), MOD + (size_t)l * 5 * 6144 + 2048}));
    }
    RUN(phase_nm(p, l, 1, true));
    RUN(gemm_run(lds, XN, (const bf16_t*)(p.ws + WS_WGU) + (size_t)l * 2 * DFF * D, MTOK, 2 * DFF, D, 1, pg8::EpiSwiglu{(bf16_t*)(p.ws + WS_H)}));
    RUN(gemm_run(lds, (const bf16_t*)(p.ws + WS_H), (const bf16_t*)(p.ws + WS_WDN) + (size_t)l * D * DFF, MTOK, D, DFF, 2, pg8::EpiGate{Y, (float*)(p.ws + WS_P1), MOD + (size_t)l * 5 * 6144 + 5 * 1024}));
  }
  RUN(phase_final(p));
#undef RUN
}
constexpr int N_PHASES = 2 + 2 * 7 + 2 * 8 + 1;


extern "C" void kernel_launch(void* const* d_in, const int* in_sizes, int n_in, void* d_out, int out_size, void* d_ws, size_t ws_size, hipStream_t stream) {
  static int grid = 0;
  if (grid == 0) {
    if (n_in != 29 || ws_size < WS_END) { fprintf(stderr, "kernel_launch: n_in %d ws %zu (need 29, >= %zu)\n", n_in, ws_size, (size_t)WS_END); grid = -1; return; }
    int dev = 0, cus = 0, per_cu = 0;
    hipGetDevice(&dev);
    hipDeviceGetAttribute(&cus, hipDeviceAttributeMultiprocessorCount, dev);
    if (hipFuncSetAttribute((const void*)mega, hipFuncAttributeMaxDynamicSharedMemorySize, LDS_BYTES) != hipSuccess) { fprintf(stderr, "kernel_launch: hipFuncSetAttribute failed\n"); grid = -1; return; }
    hipOccupancyMaxActiveBlocksPerMultiprocessor(&per_cu, (const void*)mega, 512, LDS_BYTES);
    if (per_cu < 1) { fprintf(stderr, "kernel_launch: occupancy query says %d blocks per CU\n", per_cu); per_cu = 1; }
    grid = cus * per_cu;
  }
  if (grid < 0) return;
  Params p{};
  for (int i = 0; i < 29; ++i) p.in[i] = (const float*)d_in[i];
  p.out = (float*)d_out; p.ws = (unsigned char*)d_ws;

  if (hipMemsetAsync(d_ws, 0, 16384, stream) != hipSuccess) { fprintf(stderr, "kernel_launch: memset of the barrier words failed\n"); return; }
  p.ph_lo = 0; p.ph_hi = N_PHASES;
  void* args[] = {&p};
  hipError_t e = hipLaunchCooperativeKernel((const void*)mega, dim3(grid), dim3(512), args, LDS_BYTES, stream);
  if (e != hipSuccess) fprintf(stderr, "cooperative launch failed: %s (grid %d)\n", hipGetErrorString(e), grid);

}
```

```cpp
#include <hip/hip_runtime.h>
#include <hip/hip_cooperative_groups.h>
#include <cstdio>
#include <cstdint>
namespace cg = cooperative_groups;

typedef unsigned short bf16_t;
typedef short bf16x8 __attribute__((ext_vector_type(8)));
typedef float f32x4 __attribute__((ext_vector_type(4)));
typedef unsigned u32x4 __attribute__((ext_vector_type(4)));
typedef float f32x16 __attribute__((ext_vector_type(16)));

constexpr int D = 1024, MTOK = 8192, NPR = 4096;
constexpr int DFF = 2816, QKVD = 1536;
constexpr float EPS = 1e-6f;
constexpr float MIN_DECAY = -3.0701134573253944f, MAX_DECAY = -15.350567286626972f;

constexpr size_t MiB = 1u << 20;
constexpr size_t WS_MOD = 1 * MiB, WS_MODP = 2 * MiB, WS_FSQP = 6 * MiB, WS_RNORM = 7 * MiB, WS_FILT = 8 * MiB;
constexpr size_t WS_WIN = 28 * MiB, WS_WHO = 40 * MiB, WS_WQKV = 44 * MiB, WS_WAO = 50 * MiB, WS_WGU = 54 * MiB, WS_WDN = 98 * MiB;
constexpr size_t WS_Y = 120 * MiB, WS_XN = 152 * MiB, WS_R = 168 * MiB;
constexpr size_t WS_ZT = WS_R, WS_YG = WS_R + 48 * MiB, WS_P1 = WS_R + 64 * MiB;
constexpr size_t WS_QKV = WS_R, WS_Q = WS_R + 24 * MiB, WS_KP = WS_R + 40 * MiB, WS_VP = WS_R + 42 * MiB, WS_O = WS_R + 44 * MiB;
constexpr size_t WS_H = WS_R;
constexpr size_t WS_KS = WS_R + 96 * MiB, WS_VS = WS_R + 102 * MiB, WS_FRG = WS_R + 108 * MiB, WS_END = WS_R + 130 * MiB;
constexpr size_t FRG_J = 11 * MiB / 2, FRG_L1 = (size_t)1024 * (4 * 256 + 40);
constexpr size_t FILT_J = 10 * MiB / 4;
constexpr size_t FILT_L1 = 1024 * 512;

constexpr int LDS_BYTES = 147456;

struct Params {
  const float* in[29];
  float* out;
  unsigned char* ws;
  int ph_lo, ph_hi;
};
enum { I_XP = 0, I_XS, I_CK, I_CV, I_C, I_CCTX, I_MODW, I_MODB, I_NMIX, I_NFFN, I_HWIN, I_HCW, I_HCB, I_FW1, I_FB1, I_FFREQ, I_FW2, I_FB2, I_FW3,
       I_HBIAS, I_HWOUT, I_WQKV, I_QN, I_KN, I_WAO, I_WG, I_WU, I_WD, I_FN };

__device__ __forceinline__ bf16_t f2bf(float f) { unsigned u = __float_as_uint(f); u += 0x7FFFu + ((u >> 16) & 1u); return (bf16_t)(u >> 16); }
__device__ __forceinline__ float bf2f(bf16_t b) { return __uint_as_float(((unsigned)b) << 16); }
__device__ __forceinline__ unsigned pack2(float lo, float hi) { return (unsigned)f2bf(lo) | ((unsigned)f2bf(hi) << 16); }
__device__ __forceinline__ float wave_sum(float v) {
#pragma unroll
  for (int o = 32; o >= 1; o >>= 1) v += __shfl_xor(v, o);
  return v;
}
__device__ __forceinline__ float wave_max(float v) {
#pragma unroll
  for (int o = 32; o >= 1; o >>= 1) v = fmaxf(v, __shfl_xor(v, o));
  return v;
}
__device__ __forceinline__ int tidx() { int t = threadIdx.x; asm volatile("" : "+v"(t)); return t; }
__device__ __forceinline__ int cond_of(int m) { return m < NPR ? 4 : ((m - NPR) >> 10); }
__device__ __forceinline__ float silu_f(float x) { return x / (1.f + expf(-x)); }
__device__ __forceinline__ float sin_rev(float r) { return __builtin_amdgcn_sinf(r - rintf(r)); }
__device__ __forceinline__ float cos_rev(float r) { return __builtin_amdgcn_cosf(r - rintf(r)); }
constexpr float INV_2PI = 0.15915494309189535f;

struct TileDesc { const float* src; bf16_t* dst; int K, N, k0, n0, mode; };
constexpr int NT_WIN = 2 * 16 * 24, NT_WHO = 2 * 16 * 8, NT_WQKV = 2 * 16 * 12, NT_WAO = 2 * 16 * 8, NT_G = 4 * 16 * 22, NT_DN = 4 * 44 * 8;
constexpr int NT_CVT = NT_WIN + NT_WHO + NT_WQKV + NT_WAO + 2 * NT_G + NT_DN;
__device__ __forceinline__ TileDesc cvt_decode(const Params& p, int t) {
  TileDesc d;
  if (t < NT_WIN) { const int l = t / (16 * 24), r = t % (16 * 24); d.src = p.in[I_HWIN] + (size_t)l * D * 3072; d.dst = (bf16_t*)(p.ws + WS_WIN) + (size_t)l * 3072 * D; d.K = D; d.N = 3072; d.k0 = (r / 24) * 64; d.n0 = (r % 24) * 128; d.mode = 0; return d; }
  t -= NT_WIN;
  if (t < NT_WHO) { const int l = t / 128, r = t % 128; d.src = p.in[I_HWOUT] + (size_t)l * D * D; d.dst = (bf16_t*)(p.ws + WS_WHO) + (size_t)l * D * D; d.K = D; d.N = D; d.k0 = (r / 8) * 64; d.n0 = (r % 8) * 128; d.mode = 0; return d; }
  t -= NT_WHO;
  if (t < NT_WQKV) { const int l = t / (16 * 12), r = t % (16 * 12); d.src = p.in[I_WQKV] + (size_t)l * D * QKVD; d.dst = (bf16_t*)(p.ws + WS_WQKV) + (size_t)l * QKVD * D; d.K = D; d.N = QKVD; d.k0 = (r / 12) * 64; d.n0 = (r % 12) * 128; d.mode = 0; return d; }
  t -= NT_WQKV;
  if (t < NT_WAO) { const int l = t / 128, r = t % 128; d.src = p.in[I_WAO] + (size_t)l * D * D; d.dst = (bf16_t*)(p.ws + WS_WAO) + (size_t)l * D * D; d.K = D; d.N = D; d.k0 = (r / 8) * 64; d.n0 = (r % 8) * 128; d.mode = 0; return d; }
  t -= NT_WAO;
  if (t < 2 * NT_G) { const int up = t >= NT_G ? 1 : 0; t -= up * NT_G; const int l = t / (16 * 22), r = t % (16 * 22);
    d.src = p.in[up ? I_WU : I_WG] + (size_t)l * D * DFF; d.dst = (bf16_t*)(p.ws + WS_WGU) + (size_t)l * 2 * DFF * D; d.K = D; d.N = DFF; d.k0 = (r / 22) * 64; d.n0 = (r % 22) * 128; d.mode = 1 + up; return d; }
  t -= 2 * NT_G;
  { const int l = t / (44 * 8), r = t % (44 * 8); d.src = p.in[I_WD] + (size_t)l * DFF * D; d.dst = (bf16_t*)(p.ws + WS_WDN) + (size_t)l * D * DFF; d.K = DFF; d.N = D; d.k0 = (r / 8) * 64; d.n0 = (r % 8) * 128; d.mode = 0; return d; }
}
__device__ __forceinline__ void cvt_load(const TileDesc& d, int tid, f32x4 (&v)[4]) {
  const int r = tid >> 5, c4 = (tid & 31) * 4;
#pragma unroll
  for (int h = 0; h < 4; ++h) v[h] = *(const f32x4*)(d.src + (size_t)(d.k0 + r + 16 * h) * d.N + d.n0 + c4);
}
__device__ void cvt_all(const Params& p, float* tile  ) {
  const int tid = tidx(), G = gridDim.x;
  int t = blockIdx.x;
  if (t >= NT_CVT) return;
  TileDesc cur = cvt_decode(p, t);
  f32x4 v[4];
  cvt_load(cur, tid, v);
  for (;;) {
    __syncthreads();
    {
      const int r = tid >> 5, c4 = (tid & 31) * 4;
#pragma unroll
      for (int h = 0; h < 4; ++h) { float* q = tile + (r + 16 * h) * 129 + c4; q[0] = v[h][0]; q[1] = v[h][1]; q[2] = v[h][2]; q[3] = v[h][3]; }
    }
    const int tn = t + G; const bool has = tn < NT_CVT;
    TileDesc nx = cur;
    if (has) { nx = cvt_decode(p, tn); cvt_load(nx, tid, v); }
    __syncthreads();
    {
      const int n = tid >> 2, kc = (tid & 3) * 16;
      u32x4 w0, w1;
      w0.x = pack2(tile[(kc + 0) * 129 + n], tile[(kc + 1) * 129 + n]); w0.y = pack2(tile[(kc + 2) * 129 + n], tile[(kc + 3) * 129 + n]);
      w0.z = pack2(tile[(kc + 4) * 129 + n], tile[(kc + 5) * 129 + n]); w0.w = pack2(tile[(kc + 6) * 129 + n], tile[(kc + 7) * 129 + n]);
      w1.x = pack2(tile[(kc + 8) * 129 + n], tile[(kc + 9) * 129 + n]); w1.y = pack2(tile[(kc + 10) * 129 + n], tile[(kc + 11) * 129 + n]);
      w1.z = pack2(tile[(kc + 12) * 129 + n], tile[(kc + 13) * 129 + n]); w1.w = pack2(tile[(kc + 14) * 129 + n], tile[(kc + 15) * 129 + n]);
      const int ng = cur.n0 + n;
      const int row = cur.mode == 0 ? ng : ((ng >> 7) * 256 + (ng & 127) + (cur.mode == 2 ? 128 : 0));
      bf16_t* o = cur.dst + (size_t)row * cur.K + cur.k0 + kc;
      *(u32x4*)o = w0; *(u32x4*)(o + 8) = w1;
    }
    if (!has) break;
    cur = nx; t = tn;
  }
  __syncthreads();
}

constexpr int NT_MOD = 4 * 3 * 16;
__device__ void task_mod(const Params& p, int t, float* sl  ) {
  const int tid = tidx();
  const int l = t / 48, rem = t % 48, cb = rem / 16, kc = rem % 16;
  __syncthreads();
  if (tid < 320) {
    const int j = tid >> 6, k = kc * 64 + (tid & 63);
    const float x = j < 4 ? p.in[I_C][j * D + k] : p.in[I_CCTX][k];
    sl[tid] = silu_f(x);
  }
  __syncthreads();
  const int n = cb * 2048 + tid * 4;
  const float* w = p.in[I_MODW] + ((size_t)l * D + kc * 64) * 6144 + n;
  f32x4 a0 = {0.f, 0.f, 0.f, 0.f}, a1 = a0, a2 = a0, a3 = a0, a4 = a0;
#pragma unroll 8
  for (int k = 0; k < 64; ++k) {
    const f32x4 wv = *(const f32x4*)(w + (size_t)k * 6144);
    a0 += wv * sl[k]; a1 += wv * sl[64 + k]; a2 += wv * sl[128 + k]; a3 += wv * sl[192 + k]; a4 += wv * sl[256 + k];
  }
  float* o = (float*)(p.ws + WS_ZT) + ((size_t)(kc * 4 + l) * 5) * 6144 + n;
  *(f32x4*)o = a0; *(f32x4*)(o + 6144) = a1; *(f32x4*)(o + 2 * 6144) = a2; *(f32x4*)(o + 3 * 6144) = a3; *(f32x4*)(o + 4 * 6144) = a4;
}

constexpr int NT_FILT = 320;
constexpr int FL_H1 = 0, FL_H2 = 4160, FL_W1 = 8320, FL_W2 = FL_W1 + 2112, FL_W3 = FL_W2 + 4096, FL_END = FL_W3 + 16384;
__device__ void task_filt(const Params& p, int t, float* fl) {
  const int tid = tidx(), lane = tid & 63, wid = __builtin_amdgcn_readfirstlane(tid >> 6);
  const int combo = t >> 3, nchunk = t & 7;
  const int j = combo / 20, r = combo % 20;
  const int lsel = r < 4 ? 0 : 1, tchunk = r < 4 ? r : r - 4, L = lsel ? 1024 : 256;
  const int tt = lane, tpos = tchunk * 64 + tt;
  const float tn = (float)tpos / (float)L;
  float* h1 = fl + FL_H1; float* h2 = fl + FL_H2; float* w1 = fl + FL_W1; float* w2 = fl + FL_W2; float* w3 = fl + FL_W3;
  const float* b1 = p.in[I_FB1] + j * 64; const float* fr = p.in[I_FFREQ] + j * 128; const float* b2 = p.in[I_FB2] + j * 64;
  __syncthreads();
  {
    const f32x4* g1 = (const f32x4*)(p.in[I_FW1] + (size_t)j * 33 * 64); const f32x4* g2 = (const f32x4*)(p.in[I_FW2] + (size_t)j * 64 * 64);
    const float* g3 = p.in[I_FW3] + (size_t)j * 64 * 2048 + nchunk * 256;
    for (int i = tid; i < 528; i += 512) ((f32x4*)w1)[i] = g1[i];
    for (int i = tid; i < 1024; i += 512) ((f32x4*)w2)[i] = g2[i];
#pragma unroll
    for (int h = 0; h < 8; ++h) { const int i = tid + 512 * h, v = i >> 6, c4 = (i & 63) * 4; *(f32x4*)(w3 + v * 256 + c4) = *(const f32x4*)(g3 + (size_t)v * 2048 + c4); }
  }
  __syncthreads();
  const int u0 = wid * 8;
  {
    float acc[8];
#pragma unroll
    for (int uu = 0; uu < 8; ++uu) acc[uu] = tn * w1[u0 + uu];
#pragma unroll 4
    for (int b = 1; b <= 16; ++b) {
      const float rev = tn * (float)b;
      const float cs = cos_rev(rev), sn = sin_rev(rev);
#pragma unroll
      for (int uu = 0; uu < 8; ++uu) acc[uu] += cs * w1[b * 64 + u0 + uu] + sn * w1[(16 + b) * 64 + u0 + uu];
    }
#pragma unroll
    for (int uu = 0; uu < 8; ++uu) h1[tt * 65 + u0 + uu] = sin_rev(INV_2PI * (fr[u0 + uu] * (acc[uu] + b1[u0 + uu])));
  }
  __syncthreads();
  {
    float acc[8];
#pragma unroll
    for (int uu = 0; uu < 8; ++uu) acc[uu] = 0.f;
#pragma unroll 8
    for (int v = 0; v < 64; ++v) {
      const float hv = h1[tt * 65 + v];
#pragma unroll
      for (int uu = 0; uu < 8; ++uu) acc[uu] += hv * w2[v * 64 + u0 + uu];
    }
#pragma unroll
    for (int uu = 0; uu < 8; ++uu) h2[tt * 65 + u0 + uu] = sin_rev(INV_2PI * (fr[64 + u0 + uu] * (acc[uu] + b2[u0 + uu])));
  }
  __syncthreads();
  float* fsq = (float*)(p.ws + WS_FSQP) + ((size_t)((j * 2 + lsel) * 16 + tchunk)) * 2048;
  const int nb = nchunk * 256 + wid * 32;
  float acc[32];
#pragma unroll
  for (int q = 0; q < 32; ++q) acc[q] = 0.f;
#pragma unroll 4
  for (int v = 0; v < 64; ++v) {
    const float hv = h2[tt * 65 + v];
    const float* wr = w3 + v * 256 + wid * 32;
#pragma unroll
    for (int q = 0; q < 32; ++q) acc[q] += hv * wr[q];
  }
#pragma unroll
  for (int q = 0; q < 32; ++q) {
    const int n = nb + q, c = n & 1023; const bool isb = n >= 1024;
    const float delta = fabsf(MIN_DECAY + (MAX_DECAY - MIN_DECAY) * ((float)c / 1023.f));
    float val = acc[q] * __expf(-tn * delta);
    if (isb && tpos == 0) val = 0.f;
    bf16_t* rec = (bf16_t*)(p.ws + WS_FRG) + (size_t)j * FRG_J + (lsel ? FRG_L1 : 0) + (size_t)c * (4 * L + 40);
    if (isb && tpos == 0) rec[0] = 0;
    else { const int i = isb ? (L + tpos) : (L - tpos); const bf16_t bv = f2bf(val); rec[i] = bv; rec[2 * L + 40 + i - 1] = bv; }
    acc[q] = val * val;
  }
  __syncthreads();
#pragma unroll
  for (int q = 0; q < 32; ++q) h1[(wid * 32 + q) * 65 + lane] = acc[q];
  __syncthreads();
  if (tid < 256) { float s = 0.f; for (int k = 0; k < 64; ++k) s += h1[tid * 65 + ((k + tid) & 63)]; fsq[nchunk * 256 + tid] = s; }
}

__device__ void phase_p0(const Params& p, unsigned char* lds) {
  float* fl = (float*)lds;
  const int G = gridDim.x, b = blockIdx.x, tid = tidx();
  for (int t = b; t < NT_FILT + NT_MOD; t += G) {
    __syncthreads();
    if (t < NT_FILT) task_filt(p, t, fl);
    else task_mod(p, t - NT_FILT, fl);
  }
  cvt_all(p, fl);
  {
    f32x4* Y = (f32x4*)(p.ws + WS_Y);
    const f32x4* xp = (const f32x4*)p.in[I_XP]; const f32x4* xs = (const f32x4*)p.in[I_XS];
    const int half = NPR * D / 4;
    for (int i = b * 512 + tid; i < 2 * half; i += G * 512) Y[i] = i < half ? xp[i] : xs[i - half];
  }
  {
    bf16_t* KS = (bf16_t*)(p.ws + WS_KS); bf16_t* VS = (bf16_t*)(p.ws + WS_VS);
    const int n = 4 * 2 * 512 * 256;
    for (int i = b * 512 + tid; i < n; i += G * 512) {
      const int e = i & 255, pos = (i >> 8) & 511, j = (i >> 17) & 1, bb = i >> 18;
      const size_t o = ((size_t)(j * 4 + bb) * 1536 + 1024 + pos) * 256 + e;
      KS[o] = f2bf(p.in[I_CK][i]); VS[o] = f2bf(p.in[I_CV][i]);
    }
  }
}

__device__ void phase_p0b(const Params& p) {
  const int G = gridDim.x, b = blockIdx.x, tid = tidx();
  float* MOD = (float*)(p.ws + WS_MOD); const float* MP = (const float*)(p.ws + WS_ZT);
  for (int i = b * 512 + tid; i < 4 * 5 * 6144; i += G * 512) {
    const int n = i % 6144, l = i / (5 * 6144);
    float s = p.in[I_MODB][l * 6144 + n];
#pragma unroll
    for (int kc = 0; kc < 16; ++kc) s += MP[(size_t)kc * (4 * 5 * 6144) + i];
    MOD[i] = s;
  }
  float* RN = (float*)(p.ws + WS_RNORM); const float* FS = (const float*)(p.ws + WS_FSQP);
  for (int i = b * 512 + tid; i < 4096; i += G * 512) {
    const int c = i & 1023, jl = i >> 10, nch = (jl & 1) ? 16 : 4;
    float s = 0.f;
    for (int ch = 0; ch < nch; ++ch) s += FS[((size_t)jl * 16 + ch) * 2048 + c] + FS[((size_t)jl * 16 + ch) * 2048 + 1024 + c];
    RN[i] = 1.f / sqrtf(s + EPS);
  }
}

__device__ void phase_nm(const Params& p, int layer, int which, bool addp) {
  const int lane = tidx() & 63, wid = tidx() >> 6;
  float* Y = (float*)(p.ws + WS_Y); const float* P1 = (const float*)(p.ws + WS_P1); bf16_t* XN = (bf16_t*)(p.ws + WS_XN);
  const float* g = p.in[which ? I_NFFN : I_NMIX] + layer * D;
  for (int m = blockIdx.x * 8 + wid; m < MTOK; m += gridDim.x * 8) {
    float* y = Y + (size_t)m * D;
    f32x4 v[4]; float ss = 0.f;
#pragma unroll
    for (int i = 0; i < 4; ++i) { v[i] = *(const f32x4*)(y + i * 256 + lane * 4);
      if (addp) { v[i] += *(const f32x4*)(P1 + (size_t)m * D + i * 256 + lane * 4); *(f32x4*)(y + i * 256 + lane * 4) = v[i]; }
      ss += v[i][0] * v[i][0] + v[i][1] * v[i][1] + v[i][2] * v[i][2] + v[i][3] * v[i][3]; }
    ss = wave_sum(ss);
    const float r = rsqrtf(ss * (1.f / D) + EPS);
    const float* mod = (const float*)(p.ws + WS_MOD) + (size_t)(layer * 5 + cond_of(m)) * 6144 + which * 3072;
#pragma unroll
    for (int i = 0; i < 4; ++i) {
      const int k = i * 256 + lane * 4;
      const f32x4 gg = *(const f32x4*)(g + k), sh = *(const f32x4*)(mod + k), sc = *(const f32x4*)(mod + 1024 + k);
      float o[4];
#pragma unroll
      for (int e = 0; e < 4; ++e) o[e] = (v[i][e] * r * gg[e]) * (1.f + sc[e]) + sh[e];
      uint2 w; w.x = pack2(o[0], o[1]); w.y = pack2(o[2], o[3]);
      *(uint2*)(XN + (size_t)m * D + k) = w;
    }
  }
}

__device__ void phase_final(const Params& p) {
  const int lane = tidx() & 63, wid = tidx() >> 6;
  const float* Y = (const float*)(p.ws + WS_Y);
  const float* g = p.in[I_FN];
  for (int m = blockIdx.x * 8 + wid; m < MTOK; m += gridDim.x * 8) {
    const float* y = Y + (size_t)m * D;
    f32x4 v[4]; float ss = 0.f;
#pragma unroll
    for (int i = 0; i < 4; ++i) { v[i] = *(const f32x4*)(y + i * 256 + lane * 4) + *(const f32x4*)((const float*)(p.ws + WS_P1) + (size_t)m * D + i * 256 + lane * 4);
      ss += v[i][0] * v[i][0] + v[i][1] * v[i][1] + v[i][2] * v[i][2] + v[i][3] * v[i][3]; }
    ss = wave_sum(ss);
    const float r = rsqrtf(ss * (1.f / D) + EPS);
#pragma unroll
    for (int i = 0; i < 4; ++i) {
      const int k = i * 256 + lane * 4;
      const f32x4 gg = *(const f32x4*)(g + k);
      f32x4 o; o[0] = v[i][0] * r * gg[0]; o[1] = v[i][1] * r * gg[1]; o[2] = v[i][2] * r * gg[2]; o[3] = v[i][3] * r * gg[3];
      *(f32x4*)(p.out + (size_t)m * D + k) = o;
    }
  }
}


namespace pg8 {
#define PG8_LAS __attribute__((address_space(3)))
constexpr int BM = 256, BK = 64, HALF = 128, HTB = HALF * BK * 2, STAGE_BYTES = 8 * HTB, NXCD = 8, WGM = 8;
__host__ __device__ __forceinline__ int lds_byte(int r, int c) { const int st = (r >> 4) * 2 + (c >> 5), rr = r & 15, cc = c & 31, ob = rr * 64 + cc * 2; return st * 1024 + (ob ^ (((ob >> 9) & 1) << 5)); }
__host__ __device__ __forceinline__ void stage_rc(int b, int& R, int& C) { const int st = b / 1024, sb = b % 1024, swz = sb ^ (((sb >> 9) & 1) << 5); R = (st >> 1) * 16 + swz / 64; C = (st & 1) * 32 + (swz % 64) / 2; }
__host__ __device__ __forceinline__ int perm32(int rho) { const int n = rho >> 4, i = rho & 15; return 8 * (i >> 2) + 4 * n + (i & 3); }
struct Unit { int pm, pn, ks; };
struct Gemm { const bf16_t* A; const bf16_t* Bt; int M, N, K, ld; };
struct StaticOrder {
    int nM, nN, nwg, G, c, KS;
    __device__ void init(int M, int N, int KS_, int G_, int c_) { nM = M / BM; KS = KS_; nN = (N / BM) * KS_; nwg = nM * nN; G = G_; c = c_; }
    __device__ bool next(int i, Unit& u) const {
        const long L = (long)i * G + c; if (L >= nwg) return false;
        int wgid = (int)L; { const int q = nwg / NXCD, r = nwg % NXCD, xcd = wgid % NXCD, off = wgid / NXCD; wgid = (xcd < r ? xcd * (q + 1) : r * (q + 1) + (xcd - r) * q) + off; }
        const int nig = WGM * nN, gid = wgid / nig, fm = gid * WGM, gsz = (nM - fm) < WGM ? (nM - fm) : WGM;
        u.pm = fm + ((wgid % nig) % gsz); const int pn2 = (wgid % nig) / gsz; u.pn = pn2 / KS; u.ks = pn2 % KS; return true;
    }
    __device__ __forceinline__ void a_ready(const Unit&) const {}
    __device__ __forceinline__ void done(const Unit&) const {}
};
__device__ __forceinline__ unsigned cvt_pk_bf16(float lo, float hi) { unsigned r; asm volatile("v_cvt_pk_bf16_f32 %0, %1, %2" : "=v"(r) : "v"(lo), "v"(hi)); return r; }
struct EpiBf16 {
    static constexpr bool PERM = true, AFTER_DRAIN = false;
    bf16_t* O; int ldc;
    __device__ __forceinline__ void operator()(const f32x4 (&acc)[2][2][4][2], const Unit& u, int wr, int wc, int fr, int fq) const {
        const int row0 = u.pm * BM + wr * 64 + fr, col0 = u.pn * BM + wc * 32 + 8 * fq;
#pragma unroll
        for (int ai = 0; ai < 2; ++ai)
#pragma unroll
            for (int m = 0; m < 4; ++m) { bf16_t* rowp = O + (size_t)(row0 + ai * HALF + m * 16) * ldc + col0;
#pragma unroll
                for (int bj = 0; bj < 2; ++bj) { const f32x4 v0 = acc[ai][bj][m][0], v1 = acc[ai][bj][m][1];
                    u32x4 w; w.x = cvt_pk_bf16(v0[0], v0[1]); w.y = cvt_pk_bf16(v0[2], v0[3]); w.z = cvt_pk_bf16(v1[0], v1[1]); w.w = cvt_pk_bf16(v1[2], v1[3]);
                    *(u32x4*)(rowp + bj * HALF) = w; } }
    }
};
struct EpiSwiglu {
    static constexpr bool PERM = true, AFTER_DRAIN = false;
    bf16_t* H;
    __device__ __forceinline__ void operator()(const f32x4 (&acc)[2][2][4][2], const Unit& u, int wr, int wc, int fr, int fq) const {
        const int row0 = u.pm * BM + wr * 64 + fr, col0 = u.pn * HALF + wc * 32 + 8 * fq;
#pragma unroll
        for (int ai = 0; ai < 2; ++ai)
#pragma unroll
            for (int m = 0; m < 4; ++m) {
                float h[8];
#pragma unroll
                for (int n = 0; n < 2; ++n)
#pragma unroll
                    for (int e = 0; e < 4; ++e) { const float gv = acc[ai][0][m][n][e], uv = acc[ai][1][m][n][e]; h[4 * n + e] = gv * __builtin_amdgcn_rcpf(1.f + __expf(-gv)) * uv; }
                u32x4 w; w.x = cvt_pk_bf16(h[0], h[1]); w.y = cvt_pk_bf16(h[2], h[3]); w.z = cvt_pk_bf16(h[4], h[5]); w.w = cvt_pk_bf16(h[6], h[7]);
                *(u32x4*)(H + (size_t)(row0 + ai * HALF + m * 16) * DFF + col0) = w; }
    }
};
struct EpiGate {
    static constexpr bool PERM = false, AFTER_DRAIN = false;
    float* Y; float* P1; const float* gate;
    __device__ __forceinline__ void operator()(const f32x4 (&acc)[2][2][4][2], const Unit& u, int wr, int wc, int fr, int fq) const {
        const int row0 = u.pm * BM + wr * 64 + fr, col0 = u.pn * BM + wc * 32 + 4 * fq;
        const bool rmw = u.ks == 0;
        float* const dstb = rmw ? Y : P1;
#pragma unroll
        for (int ai = 0; ai < 2; ++ai)
#pragma unroll
            for (int m = 0; m < 4; ++m) { const int row = row0 + ai * HALF + m * 16; const float* gp = gate + cond_of(row) * 6144 + col0; float* yp = dstb + (size_t)row * D + col0;
                f32x4 v[4];
#pragma unroll
                for (int q = 0; q < 4; ++q) { const int o = (q >> 1) * HALF + (q & 1) * 16; v[q] = acc[ai][q >> 1][m][q & 1] * *(const f32x4*)(gp + o); }
                if (rmw) {
#pragma unroll
                    for (int q = 0; q < 4; ++q) { const int o = (q >> 1) * HALF + (q & 1) * 16; v[q] += *(const f32x4*)(yp + o); }
                }
#pragma unroll
                for (int q = 0; q < 4; ++q) { const int o = (q >> 1) * HALF + (q & 1) * 16; *(f32x4*)(yp + o) = v[q]; }
                asm volatile("" ::: "memory");
            }
    }
};
template <class Epi, class Sched, bool ALIGN_EPI = false, bool SP2 = false>
__device__ __forceinline__ void gemm_phase(PG8_LAS unsigned char* lds, const Gemm g, const Sched& S, const Epi& E) {
    int tid_ = tidx();
    const int tid = tid_, wid = __builtin_amdgcn_readfirstlane(tid >> 6), lane = tid & 63, wr = wid >> 2, wc = wid & 3, fr = lane & 15, fq = lane >> 4;
    const int K = g.ld, nt = g.K / BK;
    unsigned voffA[2], voffB[2];
#pragma unroll
    for (int i = 0; i < 2; ++i) { int R, C; stage_rc(tid * 16 + i * 8192, R, C); const int Rb = Epi::PERM ? ((R & ~31) + perm32(R & 31)) : R;
        voffA[i] = (unsigned)(R * K + C) * 2u; voffB[i] = (unsigned)(Rb * K + C) * 2u; }
    const size_t kstep = (size_t)(BK * 2);
    const size_t hstep = (size_t)HALF * K * 2;
    const size_t tstep = 2 * hstep;
    const unsigned ldsw = (unsigned)wid * 1024u;
    const int aoff = lds_byte(wr * 64 + fr, fq * 8), boff = lds_byte(wc * 32 + fr, fq * 8);
#define PG8_SA(b, h) (((b) * 2 + (h)) * HTB)
#define PG8_SB(b, h) ((4 + (b) * 2 + (h)) * HTB)
#define PG8_STAGE(bufoff, gbase, voff) do { _Pragma("unroll") for (int _i = 0; _i < 2; ++_i) \
        __builtin_amdgcn_global_load_lds((const unsigned*)((const char*)(gbase) + (voff)[_i]), (PG8_LAS unsigned*)(lds + (bufoff) + ldsw + _i * 8192), 16, 0, 0); } while (0)
#define PG8_LDA(dst, b, h) do { _Pragma("unroll") for (int m = 0; m < 4; ++m) _Pragma("unroll") for (int k = 0; k < 2; ++k) dst[m][k] = *(const PG8_LAS bf16x8*)(lds + PG8_SA(b, h) + aoff + m * 2048 + k * 1024); } while (0)
#define PG8_LDB(dst, b, h) do { _Pragma("unroll") for (int n = 0; n < 2; ++n) _Pragma("unroll") for (int k = 0; k < 2; ++k) dst[n][k] = *(const PG8_LAS bf16x8*)(lds + PG8_SB(b, h) + boff + n * 2048 + k * 1024); } while (0)
#define PG8_MMA(ai, bj, At, Bt) do { __builtin_amdgcn_s_setprio(1); _Pragma("unroll") for (int m = 0; m < 4; ++m) _Pragma("unroll") for (int n = 0; n < 2; ++n) _Pragma("unroll") for (int k = 0; k < 2; ++k) \
        acc[ai][bj][m][n] = __builtin_amdgcn_mfma_f32_16x16x32_bf16(Bt[n][k], At[m][k], acc[ai][bj][m][n], 0, 0, 0); __builtin_amdgcn_s_setprio(0); } while (0)
#define PG8_WAIT_V(n) asm volatile("s_waitcnt vmcnt(" #n ")" ::: "memory")
#define PG8_WAIT_L(n) asm volatile("s_waitcnt lgkmcnt(" #n ")" ::: "memory")
#define PG8_BAR __builtin_amdgcn_s_barrier()
#define PG8_SCHED __builtin_amdgcn_sched_barrier(0)
    Unit cur, nxt; int ui = 0;
    if (!S.next(0, cur)) return;
    f32x4 acc[2][2][4][2];
#pragma unroll
    for (int a = 0; a < 2; ++a)
#pragma unroll
        for (int b = 0; b < 2; ++b)
#pragma unroll
            for (int m = 0; m < 4; ++m)
#pragma unroll
                for (int n = 0; n < 2; ++n) acc[a][b][m][n] = (f32x4){0.f, 0.f, 0.f, 0.f};
    bf16x8 At[4][2], B0[2][2], B1[2][2];
    const size_t ksb = (size_t)g.K * 2; const char* cA = (const char*)g.A + (size_t)cur.pm * tstep + cur.ks * ksb; const char* cB = (const char*)g.Bt + (size_t)cur.pn * tstep + cur.ks * ksb;
    S.a_ready(cur);
    if constexpr (SP2) {
        PG8_STAGE(PG8_SB(0, 0), cB, voffB); PG8_STAGE(PG8_SB(0, 1), cB + hstep, voffB); PG8_STAGE(PG8_SA(0, 0), cA, voffA); PG8_STAGE(PG8_SA(0, 1), cA + hstep, voffA);
        if (wr == 1) PG8_BAR;
        PG8_WAIT_V(2); PG8_BAR;
        PG8_STAGE(PG8_SB(1, 0), cB + kstep, voffB); PG8_STAGE(PG8_SA(1, 0), cA + kstep, voffA); PG8_STAGE(PG8_SB(1, 1), cB + hstep + kstep, voffB);
        PG8_WAIT_V(6); PG8_BAR;
    } else {
        PG8_STAGE(PG8_SB(0, 0), cB, voffB); PG8_STAGE(PG8_SA(0, 0), cA, voffA); PG8_STAGE(PG8_SB(0, 1), cB + hstep, voffB); PG8_STAGE(PG8_SA(0, 1), cA + hstep, voffA);
        if (wr == 1) PG8_BAR;
        PG8_WAIT_V(4); PG8_BAR;
        PG8_STAGE(PG8_SB(1, 0), cB + kstep, voffB); PG8_STAGE(PG8_SA(1, 0), cA + kstep, voffA); PG8_STAGE(PG8_SB(1, 1), cB + hstep + kstep, voffB);
        PG8_WAIT_V(6); PG8_BAR;
    }
    for (;;) {
        const bool has_next = S.next(ui + 1, nxt);
        const char* nA = has_next ? (const char*)g.A + (size_t)nxt.pm * tstep + nxt.ks * ksb : cA; const char* nB = has_next ? (const char*)g.Bt + (size_t)nxt.pn * tstep + nxt.ks * ksb : cB;
        for (int t = 0; t < nt; t += 2) {
            const bool last = (t == nt - 2);
            const char* a1 = cA + (size_t)(t + 1) * kstep;
            const char* a2 = last ? nA : cA + (size_t)(t + 2) * kstep; const char* b2 = last ? nB : cB + (size_t)(t + 2) * kstep;
            const char* a3 = a2 + kstep; const char* b3 = b2 + kstep;
            if (last && has_next) S.a_ready(nxt);
            if constexpr (SP2) {
            PG8_LDB(B0, 0, 0); PG8_LDB(B1, 0, 1); PG8_SCHED; PG8_LDA(At, 0, 0); PG8_STAGE(PG8_SA(1, 1), a1 + hstep, voffA);
            PG8_WAIT_V(8); PG8_WAIT_L(0); PG8_BAR; PG8_MMA(0, 0, At, B0); PG8_MMA(0, 1, At, B1); PG8_BAR; PG8_SCHED;
            PG8_LDA(At, 0, 1); PG8_STAGE(PG8_SB(0, 0), b2, voffB); PG8_STAGE(PG8_SB(0, 1), b2 + hstep, voffB); PG8_STAGE(PG8_SA(0, 0), a2, voffA);
            PG8_WAIT_V(8); PG8_WAIT_L(0); PG8_BAR; PG8_MMA(1, 0, At, B0); PG8_MMA(1, 1, At, B1); PG8_BAR; PG8_SCHED;
            PG8_LDB(B0, 1, 0); PG8_LDB(B1, 1, 1); PG8_SCHED; PG8_LDA(At, 1, 0); PG8_STAGE(PG8_SA(0, 1), a2 + hstep, voffA);
            PG8_WAIT_V(8); PG8_WAIT_L(0); PG8_BAR; PG8_MMA(0, 0, At, B0); PG8_MMA(0, 1, At, B1); PG8_BAR; PG8_SCHED;
            PG8_LDA(At, 1, 1); PG8_STAGE(PG8_SB(1, 0), b3, voffB); PG8_STAGE(PG8_SB(1, 1), b3 + hstep, voffB); PG8_STAGE(PG8_SA(1, 0), a3, voffA);
            PG8_WAIT_V(8); PG8_WAIT_L(0); PG8_BAR; PG8_MMA(1, 0, At, B0); PG8_MMA(1, 1, At, B1); PG8_BAR; PG8_SCHED;
            } else {
            PG8_LDB(B0, 0, 0); PG8_SCHED; PG8_LDA(At, 0, 0); PG8_STAGE(PG8_SA(1, 1), a1 + hstep, voffA);
            PG8_WAIT_L(8); PG8_BAR; PG8_WAIT_L(0); PG8_MMA(0, 0, At, B0); PG8_BAR; PG8_SCHED;
            PG8_LDB(B1, 0, 1); PG8_STAGE(PG8_SB(0, 0), b2, voffB);
            PG8_BAR; PG8_WAIT_L(0); PG8_MMA(0, 1, At, B1); PG8_BAR;
            PG8_LDA(At, 0, 1); PG8_STAGE(PG8_SA(0, 0), a2, voffA);
            PG8_BAR; PG8_WAIT_L(0); PG8_MMA(1, 0, At, B0); PG8_BAR; PG8_SCHED;
            PG8_STAGE(PG8_SB(0, 1), b2 + hstep, voffB);
            PG8_WAIT_V(6); PG8_BAR; PG8_MMA(1, 1, At, B1); PG8_BAR;
            PG8_LDB(B0, 1, 0); PG8_SCHED; PG8_LDA(At, 1, 0); PG8_STAGE(PG8_SA(0, 1), a2 + hstep, voffA);
            PG8_WAIT_L(8); PG8_BAR; PG8_WAIT_L(0); PG8_MMA(0, 0, At, B0); PG8_BAR; PG8_SCHED;
            PG8_LDB(B1, 1, 1); PG8_STAGE(PG8_SB(1, 0), b3, voffB);
            PG8_BAR; PG8_WAIT_L(0); PG8_MMA(0, 1, At, B1); PG8_BAR;
            PG8_LDA(At, 1, 1); PG8_STAGE(PG8_SA(1, 0), a3, voffA);
            PG8_BAR; PG8_WAIT_L(0); PG8_MMA(1, 0, At, B0); PG8_BAR; PG8_SCHED;
            PG8_STAGE(PG8_SB(1, 1), b3 + hstep, voffB);
            PG8_WAIT_V(6); PG8_BAR; PG8_MMA(1, 1, At, B1); PG8_BAR;
            }
        }
        if constexpr (ALIGN_EPI) { if (wr == 0) PG8_BAR; }
        if constexpr (!Epi::AFTER_DRAIN) { E(acc, cur, wr, wc, fr, fq); S.done(cur); }
        if (!has_next) break;
#pragma unroll
        for (int a = 0; a < 2; ++a)
#pragma unroll
            for (int b = 0; b < 2; ++b)
#pragma unroll
                for (int m = 0; m < 4; ++m)
#pragma unroll
                    for (int n = 0; n < 2; ++n) acc[a][b][m][n] = (f32x4){0.f, 0.f, 0.f, 0.f};
        cur = nxt; cA = nA; cB = nB; ++ui;
        if constexpr (ALIGN_EPI) { if (wr == 1) PG8_BAR; }
    }
    PG8_WAIT_V(0);
    if constexpr (!ALIGN_EPI) { if (wr == 0) PG8_BAR; }
    PG8_BAR;
    if constexpr (Epi::AFTER_DRAIN) { E.fused(acc, cur, wr, wc, fr, fq, lds, wid, lane); S.done(cur); }
#undef PG8_SA
#undef PG8_SB
#undef PG8_STAGE
#undef PG8_LDA
#undef PG8_LDB
#undef PG8_MMA
#undef PG8_WAIT_V
#undef PG8_WAIT_L
#undef PG8_BAR
#undef PG8_SCHED
}
}

template <class Epi>
__device__ __forceinline__ void gemm_run(unsigned char* lds, const bf16_t* A, const bf16_t* Bt, int M, int N, int Ktot, int KS, const Epi& E) {
    pg8::StaticOrder S; S.init(M, N, KS, (int)gridDim.x, (int)blockIdx.x);
    pg8::Gemm g; g.A = A; g.Bt = Bt; g.M = M; g.N = N; g.K = Ktot / KS; g.ld = Ktot;
    __syncthreads();
    pg8::gemm_phase<Epi, pg8::StaticOrder, true, true>((PG8_LAS unsigned char*)lds, g, S, E);
    __syncthreads();
}


#define LDSP __attribute__((address_space(3)))
constexpr int LC_FR = 0, LC_U = 66176, LC_X0 = LC_U + 20480, LC_S = LC_X0 + 20480, LC_Z = LC_S + 17408;
__device__ void phase_lc(const Params& p, int j, unsigned char* lds_) {
  LDSP unsigned char* lds = (LDSP unsigned char*)lds_;
  const int tid = tidx(), lane = tid & 63, wid = tid >> 6, n = lane & 31, hi = lane >> 5;
  const bf16_t* ZT = (const bf16_t*)(p.ws + WS_ZT); bf16_t* YG = (bf16_t*)(p.ws + WS_YG);
  const float* cw = p.in[I_HCW] + (size_t)j * 3 * 3072; const float* cb = p.in[I_HCB] + (size_t)j * 3072;
  for (int q = blockIdx.x; q < 1024; q += gridDim.x) {
    const int lsel = q < 512 ? 1 : 0, qq = q & 511, cg = qq >> 2, tb = (lsel ? 4 : 0) + (qq & 3);
    const int L = lsel ? 1024 : 256, P = L >> 5, REC = 4 * L + 40, c0 = cg * 8;
    const size_t m0 = (size_t)tb * 1024;
    __syncthreads();
    {
      const u32x4* src = (const u32x4*)((const bf16_t*)(p.ws + WS_FRG) + (size_t)j * FRG_J + (lsel ? FRG_L1 : 0) + (size_t)c0 * REC);
      LDSP u32x4* dst = (LDSP u32x4*)(lds + LC_FR);
      for (int i = tid; i < REC; i += 512) dst[i] = src[i];
    }
    for (int task = tid; task < 1024; task += 512) {
      const int ch = task >> 7, tok0 = (task & 127) * 8;
      const bool first = (tok0 & (L - 1)) == 0, last = ((tok0 + 8) & (L - 1)) == 0;
      float sc[3][8];
#pragma unroll
      for (int part = 0; part < 3; ++part) {
        const int chn = part * 1024 + c0 + ch;
        const bf16_t* z = ZT + (size_t)chn * MTOK + m0 + tok0;
        const u32x4 w = *(const u32x4*)z;
        float zv[10];
        zv[0] = first ? 0.f : bf2f(z[-1]); zv[9] = last ? 0.f : bf2f(z[8]);
        zv[1] = __uint_as_float(w.x << 16); zv[2] = __uint_as_float(w.x & 0xFFFF0000u); zv[3] = __uint_as_float(w.y << 16); zv[4] = __uint_as_float(w.y & 0xFFFF0000u);
        zv[5] = __uint_as_float(w.z << 16); zv[6] = __uint_as_float(w.z & 0xFFFF0000u); zv[7] = __uint_as_float(w.w << 16); zv[8] = __uint_as_float(w.w & 0xFFFF0000u);
        const float w0 = cw[chn], w1 = cw[3072 + chn], w2 = cw[2 * 3072 + chn], bb = cb[chn];
#pragma unroll
        for (int i = 0; i < 8; ++i) sc[part][i] = zv[i] * w0 + zv[i + 1] * w1 + zv[i + 2] * w2 + bb;
      }
      u32x4 xo, uo;
      xo.x = pack2(sc[0][0], sc[0][1]); xo.y = pack2(sc[0][2], sc[0][3]); xo.z = pack2(sc[0][4], sc[0][5]); xo.w = pack2(sc[0][6], sc[0][7]);
      uo.x = pack2(sc[1][0] * sc[2][0], sc[1][1] * sc[2][1]); uo.y = pack2(sc[1][2] * sc[2][2], sc[1][3] * sc[2][3]);
      uo.z = pack2(sc[1][4] * sc[2][4], sc[1][5] * sc[2][5]); uo.w = pack2(sc[1][6] * sc[2][6], sc[1][7] * sc[2][7]);
      const int po = (ch * 1280 + tok0 + 8 * (tok0 >> 5)) * 2;
      *(LDSP u32x4*)(lds + LC_U + po) = uo; *(LDSP u32x4*)(lds + LC_X0 + po) = xo;
    }
    if (tid < 4) ((LDSP unsigned*)(lds + LC_Z))[tid] = 0u;
    __syncthreads();
    f32x16 acc;
#pragma unroll
    for (int r = 0; r < 16; ++r) acc[r] = 0.f;
    {
      const int par = n & 1;
      LDSP const unsigned char* fa = lds + LC_FR + wid * (REC * 2) + (par ? (2 * L + 40) * 2 : 0) + 2 * (L - n - par + 8 * hi);
      LDSP const unsigned char* ub = lds + LC_U + wid * 2560 + (40 * n + 8 * hi) * 2;
      const int ti = n & (P - 1);
#define LC_LOAD(s_, AW, BF) do { const int dl_ = ((s_) >> 1) - (P - 1), ks_ = (s_) & 1; \
        LDSP const volatile unsigned* ap_ = (LDSP const volatile unsigned*)(fa + 2 * (-32 * dl_ + 16 * ks_)); \
        AW.x = ap_[0]; AW.y = ap_[1]; AW.z = ap_[2]; AW.w = ap_[3]; \
        LDSP const unsigned char* bp_ = ((unsigned)(ti - dl_) < (unsigned)P) ? (ub + (-40 * dl_ + 16 * ks_) * 2) : (lds + LC_Z); \
        BF = *(LDSP const volatile bf16x8*)bp_; } while (0)
      const int nsteps = 2 * (2 * P - 1);
      u32x4 a0, a1; bf16x8 b0, b1;
      LC_LOAD(0, a0, b0);
      for (int s2 = 0; s2 < nsteps; s2 += 2) {
        LC_LOAD(s2 + 1, a1, b1);
        acc = __builtin_amdgcn_mfma_f32_32x32x16_bf16(__builtin_bit_cast(bf16x8, a0), b0, acc, 0, 0, 0);
        if (s2 + 2 < nsteps) LC_LOAD(s2 + 2, a0, b0);
        acc = __builtin_amdgcn_mfma_f32_32x32x16_bf16(__builtin_bit_cast(bf16x8, a1), b1, acc, 0, 0, 0);
      }
#undef LC_LOAD
    }
    {
      const float rn = ((const float*)(p.ws + WS_RNORM))[(j * 2 + lsel) * 1024 + c0 + wid], bs = p.in[I_HBIAS][j * D + c0 + wid];
      LDSP const bf16_t* uu = (LDSP const bf16_t*)(lds + LC_U) + wid * 1280 + 40 * n;
      LDSP const bf16_t* xx = (LDSP const bf16_t*)(lds + LC_X0) + wid * 1280 + 40 * n;
      LDSP bf16_t* so = (LDSP bf16_t*)(lds + LC_S) + wid * 1088 + 34 * n;
#pragma unroll
      for (int r = 0; r < 16; ++r) {
        const int row = (r & 3) + 8 * (r >> 2) + 4 * hi;
        const float y = acc[r] * rn + bf2f(uu[row]) * bs;
        so[row] = f2bf(bf2f(xx[row]) * y);
      }
    }
    __syncthreads();
    for (int tok = tid; tok < 1024; tok += 512) {
      LDSP const bf16_t* so = (LDSP const bf16_t*)(lds + LC_S) + tok + 2 * (tok >> 5);
      u32x4 w;
      w.x = (unsigned)so[0] | ((unsigned)so[1088] << 16); w.y = (unsigned)so[2 * 1088] | ((unsigned)so[3 * 1088] << 16);
      w.z = (unsigned)so[4 * 1088] | ((unsigned)so[5 * 1088] << 16); w.w = (unsigned)so[6 * 1088] | ((unsigned)so[7 * 1088] << 16);
      *(u32x4*)(YG + (m0 + tok) * D + c0) = w;
    }
  }
  __syncthreads();
}

__device__ void phase_qkvpost(const Params& p, int j) {
  const int lane = tidx() & 63, wid = tidx() >> 6;
  const unsigned* QKV = (const unsigned*)(p.ws + WS_QKV);
  unsigned* Q = (unsigned*)(p.ws + WS_Q); unsigned* KP = (unsigned*)(p.ws + WS_KP); unsigned* VP = (unsigned*)(p.ws + WS_VP);
  unsigned* KS = (unsigned*)(p.ws + WS_KS) + (size_t)j * 4 * 1536 * 128; unsigned* VS = (unsigned*)(p.ws + WS_VS) + (size_t)j * 4 * 1536 * 128;
  const float* qn = p.in[I_QN] + j * 128; const float* kn = p.in[I_KN] + j * 128;
  float* newk = p.out + (size_t)2 * NPR * D; float* newv = newk + (size_t)16 * 2 * 256 * 256;
  const float qg0 = qn[2 * lane], qg1 = qn[2 * lane + 1], kg0 = kn[2 * lane], kg1 = kn[2 * lane + 1];
  const float freq = exp2f(-(float)(lane & 31) * 0.41524101186092029f);
  for (int m = blockIdx.x * 8 + wid; m < MTOK; m += gridDim.x * 8) {
    const bool smp = m >= NPR;
    float cs = 1.f, sn = 0.f;
    if (smp) { const int t = (m - NPR) & 1023; const float pos = (float)(lane < 32 ? (t >> 6) : (t & 63)); const float rev = (pos * freq) * INV_2PI; cs = cos_rev(rev); sn = sin_rev(rev); }
#pragma unroll
    for (int s = 0; s < 12; ++s) {
      const unsigned raw = QKV[(size_t)m * 768 + s * 64 + lane];
      float x0 = __uint_as_float(raw << 16), x1 = __uint_as_float(raw & 0xFFFF0000u);
      if (s < 10) {
        const float ss = wave_sum(x0 * x0 + x1 * x1);
        const float r = rsqrtf(ss * (1.f / 128.f) + EPS);
        x0 = x0 * r * (s < 8 ? qg0 : kg0); x1 = x1 * r * (s < 8 ? qg1 : kg1);
        if (smp) { const float a = x0, b = x1; x0 = a * cs - b * sn; x1 = a * sn + b * cs; }
      }
      const unsigned w = pack2(x0, x1);
      if (s < 8) Q[(size_t)m * 512 + s * 64 + lane] = w;
      else {
        const int kv = (s - 8) & 1; const bool isk = s < 10;
        if (!smp) {
          (isk ? KP : VP)[(size_t)m * 128 + kv * 64 + lane] = w;
          const int b = m >> 8, t = m & 255;
          float* o = (isk ? newk : newv) + ((((size_t)b * 2 + j) * 256 + t) * 2 + kv) * 128 + 2 * lane;
          o[0] = x0; o[1] = x1;
        } else {
          const int b = (m - NPR) >> 10, t = (m - NPR) & 1023;
          (isk ? KS : VS)[((size_t)b * 1536 + t) * 128 + kv * 64 + lane] = w;
        }
      }
    }
  }
}


namespace att {
typedef unsigned short bf16;
constexpr int   D = 128, NW = 8, QBLK = 32, KVBLK = 64;
constexpr float SCALE = 0.088388347648318440f;
constexpr float THR = 8.f;
constexpr int SDEPTH = 2;
constexpr int LDQ = 1024, LDK = 256, LDO = 1024;
constexpr size_t SHM_V = KVBLK * D * 2, SHM_K = KVBLK * D * 2, SHM_ATTN = 2 * SHM_V + 2 * SHM_K + NW * 64 * 4;

using s16x4  = __attribute__((ext_vector_type(4))) short;
using f32x16 = __attribute__((ext_vector_type(16))) float;
using f32x8  = __attribute__((ext_vector_type(8))) float;

#define KSWZ(row, colB) ((row) * 256 + ((colB) ^ (((row) & 7) << 4)))
#define SBAR() __builtin_amdgcn_sched_barrier(0)
__device__ __forceinline__ int crow(int r, int hi) { return (r & 3) + 8 * (r >> 2) + 4 * hi; }
__device__ __forceinline__ unsigned cvtpk(float lo, float hi) {
  unsigned r; asm volatile("v_cvt_pk_bf16_f32 %0, %1, %2" : "=v"(r) : "v"(lo), "v"(hi)); return r;
}
template <typename TIn> struct Stage;
template <> struct Stage<bf16>  { using T = bf16x8;
  __device__ static __forceinline__ T ld8(const bf16* p) { return *reinterpret_cast<const bf16x8*>(p); }
  __device__ static __forceinline__ bf16x8 tobf(T x) { return x; } };
template <> struct Stage<float> { using T = f32x8;
  __device__ static __forceinline__ T ld8(const float* p) { return *reinterpret_cast<const f32x8*>(p); }
  __device__ static __forceinline__ bf16x8 tobf(T x) {
    u32x4 w = {cvtpk(x[0], x[1]), cvtpk(x[2], x[3]), cvtpk(x[4], x[5]), cvtpk(x[6], x[7])}; return *reinterpret_cast<bf16x8*>(&w); } };

__device__ __forceinline__ void partialSM(f32x16& p0, f32x16& p1, float& m_reg, float& mn, float& alpha) {
  constexpr float C = SCALE * 1.4426950408889634f;
  float pmax = p0[0]; for (int r = 1; r < 16; ++r) pmax = fmaxf(pmax, p0[r]); for (int r = 0; r < 16; ++r) pmax = fmaxf(pmax, p1[r]);
  { auto rr = __builtin_amdgcn_permlane32_swap(__float_as_uint(pmax), __float_as_uint(pmax), false, false);
    pmax = fmaxf(__uint_as_float(rr[0]), __uint_as_float(rr[1])); }
  if (__builtin_expect(__all(pmax - m_reg <= THR / SCALE), 1)) { mn = m_reg; alpha = 1.f; }
  else { mn = fmaxf(m_reg, pmax); alpha = __builtin_amdgcn_exp2f((m_reg - mn) * C); m_reg = mn; }
  float mnC = -mn * C;
  for (int r = 0; r < 16; ++r) p0[r] = fmaf(p0[r], C, mnC); for (int r = 0; r < 16; ++r) p1[r] = fmaf(p1[r], C, mnC);
  for (int r = 0; r < 16; ++r) p0[r] = __builtin_amdgcn_exp2f(p0[r]);
}
__device__ __forceinline__ void finishSM(f32x16& p0, f32x16& p1, float alpha, float& l_reg, bf16x8& pa0, bf16x8& pa1, bf16x8& pa2, bf16x8& pa3) {
  for (int r = 0; r < 16; ++r) p1[r] = __builtin_amdgcn_exp2f(p1[r]);
  float ps = 0; for (int r = 0; r < 16; ++r) ps += p0[r]; for (int r = 0; r < 16; ++r) ps += p1[r];
  { auto rr = __builtin_amdgcn_permlane32_swap(__float_as_uint(ps), __float_as_uint(ps), false, false);
    ps = __uint_as_float(rr[0]) + __uint_as_float(rr[1]); }
  l_reg = l_reg * alpha + ps;
#define PK4(P, BASE, OUT) do { unsigned a0 = cvtpk(P[BASE + 0], P[BASE + 1]), a1 = cvtpk(P[BASE + 2], P[BASE + 3]);   \
    unsigned b0 = cvtpk(P[BASE + 4], P[BASE + 5]), b1 = cvtpk(P[BASE + 6], P[BASE + 7]);                              \
    auto r0 = __builtin_amdgcn_permlane32_swap(a0, b0, false, false); auto r1 = __builtin_amdgcn_permlane32_swap(a1, b1, false, false); \
    u32x4 w = {r0[0], r1[0], r0[1], r1[1]}; OUT = *reinterpret_cast<bf16x8*>(&w); } while (0)
  PK4(p0, 0, pa0); PK4(p0, 8, pa1); PK4(p1, 0, pa2); PK4(p1, 8, pa3);
#undef PK4
}
__device__ __forceinline__ void qkt(f32x16& p0, f32x16& p1, const bf16* Ks, const bf16x8* qr, int r32, int hi) {
  p0 = f32x16{}; p1 = f32x16{};
  for (int d0 = 0; d0 < 8; ++d0) { int cb = (d0 * 16 + hi * 8) * 2;
    bf16x8 b0 = *reinterpret_cast<const bf16x8*>((const char*)Ks + KSWZ(r32, cb));
    bf16x8 b1 = *reinterpret_cast<const bf16x8*>((const char*)Ks + KSWZ(32 + r32, cb));
    p0 = __builtin_amdgcn_mfma_f32_32x32x16_bf16(b0, qr[d0], p0, 0, 0, 0);
    p1 = __builtin_amdgcn_mfma_f32_32x32x16_bf16(b1, qr[d0], p1, 0, 0, 0); }
}
__device__ __forceinline__ int v_st(int k, int c) { const int kk = (k & ~0xC) | ((k & 4) << 1) | ((k & 8) >> 1); return ((kk >> 3) * 4 + (c >> 5)) * 512 + ((kk & 7) * 32 + (c & 31)) * 2; }
__device__ __forceinline__ int v_rd_base(int lane) { return ((lane & 3) << 3) | (((lane >> 2) & 3) << 6) | (((lane >> 4) & 1) << 5) | (((lane >> 5) & 1) << 8); }
constexpr int v_rd_off(int d0, int ks, int half) { return d0 * 512 + ks * 4096 + half * 2048; }
template <int OFF> __device__ __forceinline__ s16x4 tr_read(int vb) {
  s16x4 r; asm volatile("ds_read_b64_tr_b16 %0, %1 offset:%2" : "=&v"(r) : "v"(vb), "i"(OFF) : "memory"); return r;
}
template <int D0> __device__ __forceinline__ void pv_one(f32x16& od, int vb, bf16x8 pa0, bf16x8 pa1, bf16x8 pa2, bf16x8 pa3) {
  const s16x4 l0 = tr_read<v_rd_off(D0, 0, 0)>(vb), h0 = tr_read<v_rd_off(D0, 0, 1)>(vb), l1 = tr_read<v_rd_off(D0, 1, 0)>(vb), h1 = tr_read<v_rd_off(D0, 1, 1)>(vb);
  const s16x4 l2 = tr_read<v_rd_off(D0, 2, 0)>(vb), h2 = tr_read<v_rd_off(D0, 2, 1)>(vb), l3 = tr_read<v_rd_off(D0, 3, 0)>(vb), h3 = tr_read<v_rd_off(D0, 3, 1)>(vb);
  asm volatile("s_waitcnt lgkmcnt(0)" ::: "memory"); SBAR();
#define PK(L, H) (bf16x8){L[0], L[1], L[2], L[3], H[0], H[1], H[2], H[3]}
  od = __builtin_amdgcn_mfma_f32_32x32x16_bf16(pa0, PK(l0, h0), od, 0, 0, 0);
  od = __builtin_amdgcn_mfma_f32_32x32x16_bf16(pa1, PK(l1, h1), od, 0, 0, 0);
  od = __builtin_amdgcn_mfma_f32_32x32x16_bf16(pa2, PK(l2, h2), od, 0, 0, 0);
  od = __builtin_amdgcn_mfma_f32_32x32x16_bf16(pa3, PK(l3, h3), od, 0, 0, 0);
#undef PK
}
__device__ __forceinline__ void pv_d0(f32x16* o, int vb, bf16x8 pa0, bf16x8 pa1, bf16x8 pa2, bf16x8 pa3) {
  pv_one<0>(o[0], vb, pa0, pa1, pa2, pa3); pv_one<1>(o[1], vb, pa0, pa1, pa2, pa3); pv_one<2>(o[2], vb, pa0, pa1, pa2, pa3); pv_one<3>(o[3], vb, pa0, pa1, pa2, pa3);
}

template <typename TQ>
__device__ __forceinline__ void attn_dense_body(const TQ* __restrict__ Qb, const bf16* __restrict__ Kh, const bf16* __restrict__ Vh,
                                                bf16* __restrict__ Ob, int seq, char* lds) {
  using St = Stage<bf16>; using SQ = Stage<TQ>;
  const int tid = tidx(), wid = tid >> 6, lane = tid & 63, r32 = lane & 31, hi = lane >> 5;
  bf16* V_lds = (bf16*)lds; bf16* K_lds = (bf16*)(lds + 2 * SHM_V);
  float* ws = (float*)(lds + 2 * SHM_V + 2 * SHM_K) + wid * 64; float* li_l = ws; float* al_l = ws + 32;
  float m_reg = -1e30f, l_reg = 0; f32x16 o[4] = {}; bf16x8 qr[8];
  const TQ* Qw = Qb + (long)(wid * QBLK + r32) * LDQ + hi * 8;
#pragma unroll
  for (int d0 = 0; d0 < 8; ++d0) qr[d0] = SQ::tobf(SQ::ld8(Qw + d0 * 16));
  const int sr = tid >> 4, sc = (tid & 15) * 8, vst0 = v_st(sr, sc), vst1 = v_st(32 + sr, sc);
  const int vb0 = (int)(uintptr_t)V_lds + v_rd_base(lane);
  struct { typename St::T vs0, vs1, ks0, ks1; } sr_[SDEPTH];
#define SLOAD(i, k0) do { sr_[i].vs0 = St::ld8(&Vh[(long)((k0) + sr) * LDK + sc]); sr_[i].vs1 = St::ld8(&Vh[(long)((k0) + 32 + sr) * LDK + sc]); \
    sr_[i].ks0 = St::ld8(&Kh[(long)((k0) + sr) * LDK + sc]); sr_[i].ks1 = St::ld8(&Kh[(long)((k0) + 32 + sr) * LDK + sc]); } while (0)
#define SWRITE(b, i) do { *(bf16x8*)((char*)V_lds + (b) * SHM_V + vst0) = St::tobf(sr_[i].vs0);          \
    *(bf16x8*)((char*)V_lds + (b) * SHM_V + vst1) = St::tobf(sr_[i].vs1); int kc = sc * 2;               \
    *(bf16x8*)((char*)K_lds + (b) * SHM_K + KSWZ(sr, kc)) = St::tobf(sr_[i].ks0);                       \
    *(bf16x8*)((char*)K_lds + (b) * SHM_K + KSWZ(32 + sr, kc)) = St::tobf(sr_[i].ks1); } while (0)
#define SWAIT() do { if constexpr (SDEPTH == 2) asm volatile("s_waitcnt vmcnt(4)" ::: "memory"); else asm volatile("s_waitcnt vmcnt(0)" ::: "memory"); } while (0)
#define RESC(a) do { if (__any((a) < 1.f)) { if (hi == 0) al_l[r32] = (a); asm volatile("s_waitcnt lgkmcnt(0)" ::: "memory"); \
    for (int d = 0; d < 4; ++d) for (int r = 0; r < 16; ++r) o[d][r] *= al_l[crow(r, hi)]; } } while (0)
  f32x16 pA0, pA1, pB0, pB1; float mnA, mnB, alA, alB; bf16x8 pa0, pa1, pa2, pa3; const int NT = seq / KVBLK;
  constexpr int SE = 0, SO = SDEPTH - 1;
  SLOAD(SE, 0); asm volatile("s_waitcnt vmcnt(0)" ::: "memory"); SWRITE(0, SE); __syncthreads();
  qkt(pA0, pA1, K_lds, qr, r32, hi); partialSM(pA0, pA1, m_reg, mnA, alA);
  SLOAD(SO, KVBLK); if constexpr (SDEPTH == 2) { if (2 < NT) SLOAD(SE, 2 * KVBLK); }
  SWAIT(); SWRITE(1, SO); __syncthreads();
  for (int j = 1; j + 1 < NT; j += 2) {
    SBAR(); qkt(pB0, pB1, (bf16*)((char*)K_lds + SHM_K), qr, r32, hi);
    finishSM(pA0, pA1, alA, l_reg, pa0, pa1, pa2, pa3); SBAR();
    SLOAD(SO, (j + SDEPTH) * KVBLK); SBAR();
    pv_d0(o, vb0, pa0, pa1, pa2, pa3); partialSM(pB0, pB1, m_reg, mnB, alB);
    __syncthreads(); SWAIT(); SWRITE(0, SE);
    RESC(alB); __syncthreads();
    SBAR(); qkt(pA0, pA1, K_lds, qr, r32, hi);
    finishSM(pB0, pB1, alB, l_reg, pa0, pa1, pa2, pa3); SBAR();
    if (SDEPTH == 1 || j + 3 < NT) SLOAD(SE, (j + 1 + SDEPTH) * KVBLK); SBAR();
    pv_d0(o, vb0 + (int)SHM_V, pa0, pa1, pa2, pa3); partialSM(pA0, pA1, m_reg, mnA, alA);
    __syncthreads(); SWAIT(); SWRITE(1, SO);
    RESC(alA); __syncthreads();
  }
  SBAR(); qkt(pB0, pB1, (bf16*)((char*)K_lds + SHM_K), qr, r32, hi);
  finishSM(pA0, pA1, alA, l_reg, pa0, pa1, pa2, pa3); SBAR();
  pv_d0(o, vb0, pa0, pa1, pa2, pa3); partialSM(pB0, pB1, m_reg, mnB, alB);
  __syncthreads(); RESC(alB);
  finishSM(pB0, pB1, alB, l_reg, pa0, pa1, pa2, pa3); SBAR();
  pv_d0(o, vb0 + (int)SHM_V, pa0, pa1, pa2, pa3);
  if (hi == 0) li_l[r32] = l_reg; asm volatile("s_waitcnt lgkmcnt(0)" ::: "memory");
  float rli[16];
#pragma unroll
  for (int r = 0; r < 16; ++r) rli[r] = __builtin_amdgcn_rcpf(li_l[crow(r, hi)]);
  bf16* Ow = Ob + (long)(wid * QBLK) * LDO;
#pragma unroll
  for (int r = 0; r < 16; ++r) { int orow = crow(r, hi);
    for (int d0 = 0; d0 < 4; ++d0) Ow[(long)orow * LDO + d0 * 32 + r32] = f2bf(o[d0][r] * rli[r]); }
#undef SLOAD
#undef SWRITE
#undef SWAIT
#undef RESC
}
}

__device__ void phase_att(const Params& p, int j, unsigned char* lds) {
  const bf16_t* Q = (const bf16_t*)(p.ws + WS_Q); bf16_t* O = (bf16_t*)(p.ws + WS_O);
  const bf16_t* KP = (const bf16_t*)(p.ws + WS_KP); const bf16_t* VP = (const bf16_t*)(p.ws + WS_VP);
  const bf16_t* KS = (const bf16_t*)(p.ws + WS_KS) + (size_t)j * 4 * 1536 * 256; const bf16_t* VS = (const bf16_t*)(p.ws + WS_VS) + (size_t)j * 4 * 1536 * 256;
  for (int u = blockIdx.x; u < 256; u += gridDim.x) {
    __syncthreads();
    if (u < 128) {
      const int qb = u & 3, h = (u >> 2) & 7, b = u >> 5, kv = h >> 2;
      const size_t row0 = (size_t)NPR + b * 1024 + qb * 256, kb = ((size_t)b * 1536) * 256 + kv * 128;
      att::attn_dense_body<att::bf16>(Q + row0 * D + h * 128, KS + kb, VS + kb, O + row0 * D + h * 128, 1536, (char*)lds);
    } else {
      const int h = (u - 128) & 7, b = (u - 128) >> 3, kv = h >> 2;
      const size_t row0 = (size_t)b * 256, kb = row0 * 256 + kv * 128;
      att::attn_dense_body<att::bf16>(Q + row0 * D + h * 128, KP + kb, VP + kb, O + row0 * D + h * 128, 256, (char*)lds);
    }
  }
  __syncthreads();
}

#define XB_TMO      128
#define XB_XCNT(j)  (256  + 64 * (j))
#define XB_XSUB(j)  (1280 + 64 * (j))
#define XB_XGEN(j)  (2304 + 64 * (j))
#define XB_TOP      3328
#define XB_TOPGEN   3392
#define XCD_BAR_WORDS 3456
#define XB_SPIN_CAP (1u << 18)
#define LAS __attribute__((address_space(3)))

__device__ __forceinline__ unsigned xb_ld(unsigned* p)              { return __hip_atomic_load(p, __ATOMIC_RELAXED, __HIP_MEMORY_SCOPE_AGENT); }
__device__ __forceinline__ unsigned xb_add(unsigned* p, unsigned v) { return __hip_atomic_fetch_add(p, v, __ATOMIC_RELAXED, __HIP_MEMORY_SCOPE_AGENT); }
__device__ __forceinline__ unsigned xb_xcc_id() { return (unsigned)__builtin_amdgcn_s_getreg((3 << 11) | 20) & 0xFu; }
#define XB_SPIN(cond, bar) do { unsigned _sp = 0; while (cond) { __builtin_amdgcn_s_sleep(1); \
    if ((++_sp & 255u) == 0u) { if (xb_ld(&(bar)[XB_TMO])) break; if (_sp > XB_SPIN_CAP) { atomicAdd(&(bar)[XB_TMO], 1u); break; } } } } while (0)

struct XcdBarrier {
    unsigned* bar; unsigned x;
    volatile LAS unsigned* st;
};

__device__ __forceinline__ XcdBarrier xcd_barrier_post(unsigned* bar, volatile LAS unsigned* st) {
    XcdBarrier b; b.bar = bar; b.x = xb_xcc_id(); b.st = st;
    if (threadIdx.x == 0) (void)xb_add(&bar[XB_XCNT(b.x)], 1u);
    return b;
}
__device__ __forceinline__ void xcd_barrier_complete(unsigned* bar, unsigned x, unsigned& nloc, unsigned& nx) {
    const unsigned G = gridDim.x * gridDim.y * gridDim.z;
    unsigned sum, cnt, mine, sp = 0u;
    for (;;) {
        sum = 0u; cnt = 0u; mine = 0u;
#pragma unroll
        for (unsigned j = 0; j < 16; ++j) { const unsigned c = xb_ld(&bar[XB_XCNT(j)]); sum += c; cnt += (c > 0u) ? 1u : 0u; mine = (j == x) ? c : mine; }
        if (sum == G) break;
        __builtin_amdgcn_s_sleep(1);
        if ((++sp & 255u) == 0u) { if (xb_ld(&bar[XB_TMO])) break; if (sp > XB_SPIN_CAP) { atomicAdd(&bar[XB_TMO], 1u); break; } }
    }
    nloc = mine > 0u ? mine : 1u; nx = cnt > 0u ? cnt : 1u;
}

__device__ __forceinline__ void xcd_barrier(const XcdBarrier& b) {
    asm volatile("s_waitcnt vmcnt(0)" ::: "memory");
    __syncthreads();
    if (threadIdx.x == 0) {
        unsigned* bar = b.bar;
        __builtin_amdgcn_s_waitcnt(0);
        unsigned nloc = b.st[0], nx = b.st[1];
        if (nloc == 0u) { xcd_barrier_complete(bar, b.x, nloc, nx); b.st[0] = nloc; b.st[1] = nx; }
        const unsigned old = xb_add(&bar[XB_XSUB(b.x)], 1u);
        const unsigned gen = old / nloc;
        if (old + 1u == (gen + 1u) * nloc) {
            __builtin_amdgcn_fence(__ATOMIC_RELEASE, "agent");
            asm volatile("s_waitcnt vmcnt(0)" ::: "memory");
            const unsigned og = xb_add(&bar[XB_TOP], 1u);
            const unsigned tg = og / nx;
            if (og + 1u == (tg + 1u) * nx) xb_add(&bar[XB_TOPGEN], 1u);
            else XB_SPIN(xb_ld(&bar[XB_TOPGEN]) == tg, bar);
            __builtin_amdgcn_fence(__ATOMIC_ACQUIRE, "agent");
            xb_add(&bar[XB_XGEN(b.x)], 1u);
            asm volatile("s_waitcnt vmcnt(0)" ::: "memory");
        } else {
            XB_SPIN(xb_ld(&bar[XB_XGEN(b.x)]) == gen, bar);
            __builtin_amdgcn_fence(__ATOMIC_ACQUIRE, "agent");
            asm volatile("s_waitcnt vmcnt(0)" ::: "memory");
        }
    }
    __syncthreads();
}

__global__ void __launch_bounds__(512, 2) mega(Params p) {
  extern __shared__ __attribute__((aligned(16))) unsigned char lds[];
  cg::grid_group grid = cg::this_grid();
  volatile LAS unsigned* xst = (volatile LAS unsigned*)((LAS unsigned char*)lds + (LDS_BYTES - 16));
  if (threadIdx.x < 4) xst[threadIdx.x] = 0u;
  __syncthreads();
  const XcdBarrier xbar = xcd_barrier_post((unsigned*)p.ws, xst);
  int ph = 0;
#define RUN(stmt) do { if (ph >= p.ph_lo && ph < p.ph_hi) { stmt; if (ph + 1 < p.ph_hi) { if (ph == 0) grid.sync(); else xcd_barrier(xbar); } } ++ph; } while (0)
  bf16_t* XN = (bf16_t*)(p.ws + WS_XN); float* Y = (float*)(p.ws + WS_Y); const float* MOD = (const float*)(p.ws + WS_MOD);
  RUN(phase_p0(p, lds));
  RUN(phase_p0b(p));
#pragma unroll 1
  for (int l = 0; l < 4; ++l) {
    const int j = l >> 1;
    RUN(phase_nm(p, l, 0, l > 0));
    if ((l & 1) == 0) {
      RUN(gemm_run(lds, (const bf16_t*)(p.ws + WS_WIN) + (size_t)j * 3072 * D, XN, 3072, MTOK, D, 1, pg8::EpiBf16{(bf16_t*)(p.ws + WS_ZT), MTOK}));
      RUN(phase_lc(p, j, lds));
      RUN(gemm_run(lds, (const bf16_t*)(p.ws + WS_YG), (const bf16_t*)(p.ws + WS_WHO) + (size_t)j * D * D, MTOK, D, D, 2, pg8::EpiGate{Y, (float*)(p.ws + WS_P1), MOD + (size_t)l * 5 * 6144 + 2048}));
    } else {
      RUN(gemm_run(lds, XN, (const bf16_t*)(p.ws + WS_WQKV) + (size_t)j * QKVD * D, MTOK, QKVD, D, 1, pg8::EpiBf16{(bf16_t*)(p.ws + WS_QKV), QKVD}));
      RUN(phase_qkvpost(p, j));
      RUN(phase_att(p, j, lds));
      RUN(gemm_run(lds, (const bf16_t*)(p.ws + WS_O), (const bf16_t*)(p.ws + WS_WAO) + (size_t)j * D * D, MTOK, D, D, 2, pg8::EpiGate{Y, (float*)(p.ws + WS_P1), MOD + (size_t)l * 5 * 6144 + 2048}));
    }
    RUN(phase_nm(p, l, 1, true));
    RUN(gemm_run(lds, XN, (const bf16_t*)(p.ws + WS_WGU) + (size_t)l * 2 * DFF * D, MTOK, 2 * DFF, D, 1, pg8::EpiSwiglu{(bf16_t*)(p.ws + WS_H)}));
    RUN(gemm_run(lds, (const bf16_t*)(p.ws + WS_H), (const bf16_t*)(p.ws + WS_WDN) + (size_t)l * D * DFF, MTOK, D, DFF, 2, pg8::EpiGate{Y, (float*)(p.ws + WS_P1), MOD + (size_t)l * 5 * 6144 + 5 * 1024}));
  }
  RUN(phase_final(p));
#undef RUN
}
constexpr int N_PHASES = 2 + 2 * 7 + 2 * 8 + 1;


extern "C" void kernel_launch(void* const* d_in, const int* in_sizes, int n_in, void* d_out, int out_size, void* d_ws, size_t ws_size, hipStream_t stream) {
  static int grid = 0;
  if (grid == 0) {
    if (n_in != 29 || ws_size < WS_END) { fprintf(stderr, "kernel_launch: n_in %d ws %zu (need 29, >= %zu)\n", n_in, ws_size, (size_t)WS_END); grid = -1; return; }
    int dev = 0, cus = 0, per_cu = 0;
    hipGetDevice(&dev);
    hipDeviceGetAttribute(&cus, hipDeviceAttributeMultiprocessorCount, dev);
    if (hipFuncSetAttribute((const void*)mega, hipFuncAttributeMaxDynamicSharedMemorySize, LDS_BYTES) != hipSuccess) { fprintf(stderr, "kernel_launch: hipFuncSetAttribute failed\n"); grid = -1; return; }
    hipOccupancyMaxActiveBlocksPerMultiprocessor(&per_cu, (const void*)mega, 512, LDS_BYTES);
    if (per_cu < 1) { fprintf(stderr, "kernel_launch: occupancy query says %d blocks per CU\n", per_cu); per_cu = 1; }
    grid = cus * per_cu;
  }
  if (grid < 0) return;
  Params p{};
  for (int i = 0; i < 29; ++i) p.in[i] = (const float*)d_in[i];
  p.out = (float*)d_out; p.ws = (unsigned char*)d_ws;

  if (hipMemsetAsync(d_ws, 0, 16384, stream) != hipSuccess) { fprintf(stderr, "kernel_launch: memset of the barrier words failed\n"); return; }
  p.ph_lo = 0; p.ph_hi = N_PHASES;
  void* args[] = {&p};
  hipError_t e = hipLaunchCooperativeKernel((const void*)mega, dim3(grid), dim3(512), args, LDS_BYTES, stream);
  if (e != hipSuccess) fprintf(stderr, "cooperative launch failed: %s (grid %d)\n", hipGetErrorString(e), grid);

}
```

```cpp
#include <hip/hip_runtime.h>
#include <hip/hip_cooperative_groups.h>
#include <cstdio>
#include <cstdint>
namespace cg = cooperative_groups;

typedef unsigned short bf16_t;
typedef short bf16x8 __attribute__((ext_vector_type(8)));
typedef float f32x4 __attribute__((ext_vector_type(4)));
typedef unsigned u32x4 __attribute__((ext_vector_type(4)));
typedef float f32x16 __attribute__((ext_vector_type(16)));

constexpr int D = 1024, MTOK = 8192, NPR = 4096;
constexpr int DFF = 2816, QKVD = 1536;
constexpr float EPS = 1e-6f;
constexpr float MIN_DECAY = -3.0701134573253944f, MAX_DECAY = -15.350567286626972f;

constexpr size_t MiB = 1u << 20;
constexpr size_t WS_MOD = 1 * MiB, WS_MODP = 2 * MiB, WS_FSQP = 6 * MiB, WS_RNORM = 7 * MiB, WS_FILT = 8 * MiB;
constexpr size_t WS_WIN = 28 * MiB, WS_WHO = 40 * MiB, WS_WQKV = 44 * MiB, WS_WAO = 50 * MiB, WS_WGU = 54 * MiB, WS_WDN = 98 * MiB;
constexpr size_t WS_Y = 120 * MiB, WS_XN = 152 * MiB, WS_R = 168 * MiB;
constexpr size_t WS_ZT = WS_R, WS_YG = WS_R + 48 * MiB, WS_P1 = WS_R + 64 * MiB;
constexpr size_t P1_HALF = (size_t)MTOK * D;
constexpr size_t WS_QKV = WS_R, WS_Q = WS_R + 24 * MiB, WS_KP = WS_R + 40 * MiB, WS_VP = WS_R + 42 * MiB, WS_O = WS_R + 44 * MiB;
constexpr size_t WS_H = WS_R;
constexpr size_t WS_KS = WS_R + 96 * MiB, WS_VS = WS_R + 102 * MiB, WS_FRG = WS_R + 108 * MiB, WS_END = WS_R + 130 * MiB;
constexpr size_t FRG_J = 11 * MiB / 2, FRG_L1 = (size_t)1024 * (4 * 256 + 40);
constexpr size_t FILT_J = 10 * MiB / 4;
constexpr size_t FILT_L1 = 1024 * 512;

constexpr int LDS_BYTES = 147456;

struct Params {
  const float* in[29];
  float* out;
  unsigned char* ws;
  int ph_lo, ph_hi;
};
enum { I_XP = 0, I_XS, I_CK, I_CV, I_C, I_CCTX, I_MODW, I_MODB, I_NMIX, I_NFFN, I_HWIN, I_HCW, I_HCB, I_FW1, I_FB1, I_FFREQ, I_FW2, I_FB2, I_FW3,
       I_HBIAS, I_HWOUT, I_WQKV, I_QN, I_KN, I_WAO, I_WG, I_WU, I_WD, I_FN };

__device__ __forceinline__ bf16_t f2bf(float f) { unsigned u = __float_as_uint(f); u += 0x7FFFu + ((u >> 16) & 1u); return (bf16_t)(u >> 16); }
__device__ __forceinline__ float bf2f(bf16_t b) { return __uint_as_float(((unsigned)b) << 16); }
__device__ __forceinline__ unsigned pack2(float lo, float hi) { return (unsigned)f2bf(lo) | ((unsigned)f2bf(hi) << 16); }
__device__ __forceinline__ float wave_sum(float v) {
#pragma unroll
  for (int o = 32; o >= 1; o >>= 1) v += __shfl_xor(v, o);
  return v;
}
__device__ __forceinline__ float wave_max(float v) {
#pragma unroll
  for (int o = 32; o >= 1; o >>= 1) v = fmaxf(v, __shfl_xor(v, o));
  return v;
}
__device__ __forceinline__ int tidx() { int t = threadIdx.x; asm volatile("" : "+v"(t)); return t; }
__device__ __forceinline__ int cond_of(int m) { return m < NPR ? 4 : ((m - NPR) >> 10); }
__device__ __forceinline__ float silu_f(float x) { return x / (1.f + expf(-x)); }
__device__ __forceinline__ float sin_rev(float r) { return __builtin_amdgcn_sinf(r - rintf(r)); }
__device__ __forceinline__ float cos_rev(float r) { return __builtin_amdgcn_cosf(r - rintf(r)); }
constexpr float INV_2PI = 0.15915494309189535f;

struct TileDesc { const float* src; bf16_t* dst; int K, N, k0, n0, mode; };
constexpr int NT_WIN = 2 * 16 * 24, NT_WHO = 2 * 16 * 8, NT_WQKV = 2 * 16 * 12, NT_WAO = 2 * 16 * 8, NT_G = 4 * 16 * 22, NT_DN = 4 * 44 * 8;
constexpr int NT_CVT = NT_WIN + NT_WHO + NT_WQKV + NT_WAO + 2 * NT_G + NT_DN;
__device__ __forceinline__ TileDesc cvt_decode(const Params& p, int t) {
  TileDesc d;
  if (t < NT_WIN) { const int l = t / (16 * 24), r = t % (16 * 24); d.src = p.in[I_HWIN] + (size_t)l * D * 3072; d.dst = (bf16_t*)(p.ws + WS_WIN) + (size_t)l * 3072 * D; d.K = D; d.N = 3072; d.k0 = (r / 24) * 64; d.n0 = (r % 24) * 128; d.mode = 0; return d; }
  t -= NT_WIN;
  if (t < NT_WHO) { const int l = t / 128, r = t % 128; d.src = p.in[I_HWOUT] + (size_t)l * D * D; d.dst = (bf16_t*)(p.ws + WS_WHO) + (size_t)l * D * D; d.K = D; d.N = D; d.k0 = (r / 8) * 64; d.n0 = (r % 8) * 128; d.mode = 0; return d; }
  t -= NT_WHO;
  if (t < NT_WQKV) { const int l = t / (16 * 12), r = t % (16 * 12); d.src = p.in[I_WQKV] + (size_t)l * D * QKVD; d.dst = (bf16_t*)(p.ws + WS_WQKV) + (size_t)l * QKVD * D; d.K = D; d.N = QKVD; d.k0 = (r / 12) * 64; d.n0 = (r % 12) * 128; d.mode = 0; return d; }
  t -= NT_WQKV;
  if (t < NT_WAO) { const int l = t / 128, r = t % 128; d.src = p.in[I_WAO] + (size_t)l * D * D; d.dst = (bf16_t*)(p.ws + WS_WAO) + (size_t)l * D * D; d.K = D; d.N = D; d.k0 = (r / 8) * 64; d.n0 = (r % 8) * 128; d.mode = 0; return d; }
  t -= NT_WAO;
  if (t < 2 * NT_G) { const int up = t >= NT_G ? 1 : 0; t -= up * NT_G; const int l = t / (16 * 22), r = t % (16 * 22);
    d.src = p.in[up ? I_WU : I_WG] + (size_t)l * D * DFF; d.dst = (bf16_t*)(p.ws + WS_WGU) + (size_t)l * 2 * DFF * D; d.K = D; d.N = DFF; d.k0 = (r / 22) * 64; d.n0 = (r % 22) * 128; d.mode = 1 + up; return d; }
  t -= 2 * NT_G;
  { const int l = t / (44 * 8), r = t % (44 * 8); d.src = p.in[I_WD] + (size_t)l * DFF * D; d.dst = (bf16_t*)(p.ws + WS_WDN) + (size_t)l * D * DFF; d.K = DFF; d.N = D; d.k0 = (r / 8) * 64; d.n0 = (r % 8) * 128; d.mode = 0; return d; }
}
__device__ __forceinline__ void cvt_load(const TileDesc& d, int tid, f32x4 (&v)[4]) {
  const int r = tid >> 5, c4 = (tid & 31) * 4;
#pragma unroll
  for (int h = 0; h < 4; ++h) v[h] = *(const f32x4*)(d.src + (size_t)(d.k0 + r + 16 * h) * d.N + d.n0 + c4);
}
__device__ __forceinline__ void cvt_to_lds(float* tile, int tid, const f32x4 (&v)[4]) {
  const int r = tid >> 5, c4 = (tid & 31) * 4;
#pragma unroll
  for (int h = 0; h < 4; ++h) { float* q = tile + (r + 16 * h) * 129 + c4; q[0] = v[h][0]; q[1] = v[h][1]; q[2] = v[h][2]; q[3] = v[h][3]; }
}
__device__ __forceinline__ void cvt_store(const TileDesc& cur, const float* tile, int tid) {
  const int n = tid >> 2, kc = (tid & 3) * 16;
  u32x4 w0, w1;
  w0.x = pack2(tile[(kc + 0) * 129 + n], tile[(kc + 1) * 129 + n]); w0.y = pack2(tile[(kc + 2) * 129 + n], tile[(kc + 3) * 129 + n]);
  w0.z = pack2(tile[(kc + 4) * 129 + n], tile[(kc + 5) * 129 + n]); w0.w = pack2(tile[(kc + 6) * 129 + n], tile[(kc + 7) * 129 + n]);
  w1.x = pack2(tile[(kc + 8) * 129 + n], tile[(kc + 9) * 129 + n]); w1.y = pack2(tile[(kc + 10) * 129 + n], tile[(kc + 11) * 129 + n]);
  w1.z = pack2(tile[(kc + 12) * 129 + n], tile[(kc + 13) * 129 + n]); w1.w = pack2(tile[(kc + 14) * 129 + n], tile[(kc + 15) * 129 + n]);
  const int ng = cur.n0 + n;
  const int row = cur.mode == 0 ? ng : ((ng >> 7) * 256 + (ng & 127) + (cur.mode == 2 ? 128 : 0));
  bf16_t* o = cur.dst + (size_t)row * cur.K + cur.k0 + kc;
  *(u32x4*)o = w0; *(u32x4*)(o + 8) = w1;
}
__device__ void cvt_all(const Params& p, float* lds_f) {
  const int tid = tidx(), G = gridDim.x;
  float* tileA = lds_f; float* tileB = lds_f + 64 * 129 + 64;
  const int t0 = blockIdx.x;
  if (t0 >= NT_CVT) return;
  TileDesc d0 = cvt_decode(p, t0), d1 = d0;
  f32x4 va[4], vb[4];
  cvt_load(d0, tid, va);
  const bool has1 = t0 + G < NT_CVT;
  if (has1) { d1 = cvt_decode(p, t0 + G); cvt_load(d1, tid, vb); }
  __syncthreads();
  for (int t = t0;; t += 2 * G) {
    cvt_to_lds(tileA, tid, va);
    const TileDesc ca = d0;
    const bool hasA = t + 2 * G < NT_CVT;
    if (hasA) { d0 = cvt_decode(p, t + 2 * G); cvt_load(d0, tid, va); }
    __syncthreads();
    cvt_store(ca, tileA, tid);
    if (t + G >= NT_CVT) break;
    cvt_to_lds(tileB, tid, vb);
    const TileDesc cb = d1;
    const bool hasB = t + 3 * G < NT_CVT;
    if (hasB) { d1 = cvt_decode(p, t + 3 * G); cvt_load(d1, tid, vb); }
    __syncthreads();
    cvt_store(cb, tileB, tid);
    if (!hasA) break;
  }
  __syncthreads();
}

constexpr int NT_MOD = 4 * 3 * 16;
__device__ void task_mod(const Params& p, int t, float* sl  ) {
  const int tid = tidx();
  const int l = t / 48, rem = t % 48, cb = rem / 16, kc = rem % 16;
  __syncthreads();
  if (tid < 320) {
    const int j = tid >> 6, k = kc * 64 + (tid & 63);
    const float x = j < 4 ? p.in[I_C][j * D + k] : p.in[I_CCTX][k];
    sl[tid] = silu_f(x);
  }
  __syncthreads();
  const int n = cb * 2048 + tid * 4;
  const float* w = p.in[I_MODW] + ((size_t)l * D + kc * 64) * 6144 + n;
  f32x4 a0 = {0.f, 0.f, 0.f, 0.f}, a1 = a0, a2 = a0, a3 = a0, a4 = a0;
#pragma unroll 8
  for (int k = 0; k < 64; ++k) {
    const f32x4 wv = *(const f32x4*)(w + (size_t)k * 6144);
    a0 += wv * sl[k]; a1 += wv * sl[64 + k]; a2 += wv * sl[128 + k]; a3 += wv * sl[192 + k]; a4 += wv * sl[256 + k];
  }
  float* o = (float*)(p.ws + WS_ZT) + ((size_t)(kc * 4 + l) * 5) * 6144 + n;
  *(f32x4*)o = a0; *(f32x4*)(o + 6144) = a1; *(f32x4*)(o + 2 * 6144) = a2; *(f32x4*)(o + 3 * 6144) = a3; *(f32x4*)(o + 4 * 6144) = a4;
}

constexpr int NT_FILT = 320;
constexpr int FL_H1 = 0, FL_H2 = 4160, FL_W1 = 8320, FL_W2 = FL_W1 + 2112, FL_W3 = FL_W2 + 4096, FL_END = FL_W3 + 16384;
__device__ void task_filt(const Params& p, int t, float* fl) {
  const int tid = tidx(), lane = tid & 63, wid = __builtin_amdgcn_readfirstlane(tid >> 6);
  const int combo = t >> 3, nchunk = t & 7;
  const int j = combo / 20, r = combo % 20;
  const int lsel = r < 4 ? 0 : 1, tchunk = r < 4 ? r : r - 4, L = lsel ? 1024 : 256;
  const int tt = lane, tpos = tchunk * 64 + tt;
  const float tn = (float)tpos / (float)L;
  float* h1 = fl + FL_H1; float* h2 = fl + FL_H2; float* w1 = fl + FL_W1; float* w2 = fl + FL_W2; float* w3 = fl + FL_W3;
  const float* b1 = p.in[I_FB1] + j * 64; const float* fr = p.in[I_FFREQ] + j * 128; const float* b2 = p.in[I_FB2] + j * 64;
  __syncthreads();
  {
    const f32x4* g1 = (const f32x4*)(p.in[I_FW1] + (size_t)j * 33 * 64); const f32x4* g2 = (const f32x4*)(p.in[I_FW2] + (size_t)j * 64 * 64);
    const float* g3 = p.in[I_FW3] + (size_t)j * 64 * 2048 + nchunk * 256;
    for (int i = tid; i < 528; i += 512) ((f32x4*)w1)[i] = g1[i];
    for (int i = tid; i < 1024; i += 512) ((f32x4*)w2)[i] = g2[i];
#pragma unroll
    for (int h = 0; h < 8; ++h) { const int i = tid + 512 * h, v = i >> 6, c4 = (i & 63) * 4; *(f32x4*)(w3 + v * 256 + c4) = *(const f32x4*)(g3 + (size_t)v * 2048 + c4); }
  }
  __syncthreads();
  const int u0 = wid * 8;
  {
    float acc[8];
#pragma unroll
    for (int uu = 0; uu < 8; ++uu) acc[uu] = tn * w1[u0 + uu];
#pragma unroll 4
    for (int b = 1; b <= 16; ++b) {
      const float rev = tn * (float)b;
      const float cs = cos_rev(rev), sn = sin_rev(rev);
#pragma unroll
      for (int uu = 0; uu < 8; ++uu) acc[uu] += cs * w1[b * 64 + u0 + uu] + sn * w1[(16 + b) * 64 + u0 + uu];
    }
#pragma unroll
    for (int uu = 0; uu < 8; ++uu) h1[tt * 65 + u0 + uu] = sin_rev(INV_2PI * (fr[u0 + uu] * (acc[uu] + b1[u0 + uu])));
  }
  __syncthreads();
  {
    float acc[8];
#pragma unroll
    for (int uu = 0; uu < 8; ++uu) acc[uu] = 0.f;
#pragma unroll 8
    for (int v = 0; v < 64; ++v) {
      const float hv = h1[tt * 65 + v];
#pragma unroll
      for (int uu = 0; uu < 8; ++uu) acc[uu] += hv * w2[v * 64 + u0 + uu];
    }
#pragma unroll
    for (int uu = 0; uu < 8; ++uu) h2[tt * 65 + u0 + uu] = sin_rev(INV_2PI * (fr[64 + u0 + uu] * (acc[uu] + b2[u0 + uu])));
  }
  __syncthreads();
  float* fsq = (float*)(p.ws + WS_FSQP) + ((size_t)((j * 2 + lsel) * 16 + tchunk)) * 2048;
  const int nb = nchunk * 256 + wid * 32;
  float acc[32];
#pragma unroll
  for (int q = 0; q < 32; ++q) acc[q] = 0.f;
#pragma unroll 4
  for (int v = 0; v < 64; ++v) {
    const float hv = h2[tt * 65 + v];
    const float* wr = w3 + v * 256 + wid * 32;
#pragma unroll
    for (int q = 0; q < 32; ++q) acc[q] += hv * wr[q];
  }
#pragma unroll
  for (int q = 0; q < 32; ++q) {
    const int n = nb + q, c = n & 1023; const bool isb = n >= 1024;
    const float delta = fabsf(MIN_DECAY + (MAX_DECAY - MIN_DECAY) * ((float)c / 1023.f));
    float val = acc[q] * __expf(-tn * delta);
    if (isb && tpos == 0) val = 0.f;
    bf16_t* rec = (bf16_t*)(p.ws + WS_FRG) + (size_t)j * FRG_J + (lsel ? FRG_L1 : 0) + (size_t)c * (4 * L + 40);
    if (isb && tpos == 0) rec[0] = 0;
    else { const int i = isb ? (L + tpos) : (L - tpos); const bf16_t bv = f2bf(val); rec[i] = bv; rec[2 * L + 40 + i - 1] = bv; }
    acc[q] = val * val;
  }
  __syncthreads();
#pragma unroll
  for (int q = 0; q < 32; ++q) h1[(wid * 32 + q) * 65 + lane] = acc[q];
  __syncthreads();
  if (tid < 256) { float s = 0.f; for (int k = 0; k < 64; ++k) s += h1[tid * 65 + ((k + tid) & 63)]; fsq[nchunk * 256 + tid] = s; }
}

__device__ void phase_p0(const Params& p, unsigned char* lds) {
  float* fl = (float*)lds;
  const int G = gridDim.x, b = blockIdx.x, tid = tidx();
  for (int t = b; t < NT_FILT + NT_MOD; t += G) {
    __syncthreads();
    if (t < NT_FILT) task_filt(p, t, fl);
    else task_mod(p, t - NT_FILT, fl);
  }
  cvt_all(p, fl);
  {
    f32x4* Y = (f32x4*)(p.ws + WS_Y);
    const f32x4* xp = (const f32x4*)p.in[I_XP]; const f32x4* xs = (const f32x4*)p.in[I_XS];
    const int half = NPR * D / 4;
    for (int i = b * 512 + tid; i < 2 * half; i += G * 512) Y[i] = i < half ? xp[i] : xs[i - half];
  }
  {
    bf16_t* KS = (bf16_t*)(p.ws + WS_KS); bf16_t* VS = (bf16_t*)(p.ws + WS_VS);
    const int n = 4 * 2 * 512 * 256;
    for (int i = b * 512 + tid; i < n; i += G * 512) {
      const int e = i & 255, pos = (i >> 8) & 511, j = (i >> 17) & 1, bb = i >> 18;
      const size_t o = ((size_t)(j * 4 + bb) * 1536 + 1024 + pos) * 256 + e;
      KS[o] = f2bf(p.in[I_CK][i]); VS[o] = f2bf(p.in[I_CV][i]);
    }
  }
}

__device__ void phase_p0b(const Params& p) {
  const int G = gridDim.x, b = blockIdx.x, tid = tidx();
  float* MOD = (float*)(p.ws + WS_MOD); const float* MP = (const float*)(p.ws + WS_ZT);
  for (int i = b * 512 + tid; i < 4 * 5 * 6144; i += G * 512) {
    const int n = i % 6144, l = i / (5 * 6144);
    float s = p.in[I_MODB][l * 6144 + n];
#pragma unroll
    for (int kc = 0; kc < 16; ++kc) s += MP[(size_t)kc * (4 * 5 * 6144) + i];
    MOD[i] = s;
  }
  float* RN = (float*)(p.ws + WS_RNORM); const float* FS = (const float*)(p.ws + WS_FSQP);
  for (int i = b * 512 + tid; i < 4096; i += G * 512) {
    const int c = i & 1023, jl = i >> 10, nch = (jl & 1) ? 16 : 4;
    float s = 0.f;
    for (int ch = 0; ch < nch; ++ch) s += FS[((size_t)jl * 16 + ch) * 2048 + c] + FS[((size_t)jl * 16 + ch) * 2048 + 1024 + c];
    RN[i] = 1.f / sqrtf(s + EPS);
  }
}

__device__ void phase_nm(const Params& p, int layer, int which, bool addp) {
  const int lane = tidx() & 63, wid = tidx() >> 6;
  float* Y = (float*)(p.ws + WS_Y); const bf16_t* P1 = (const bf16_t*)(p.ws + WS_P1); bf16_t* XN = (bf16_t*)(p.ws + WS_XN);
  const float* g = p.in[which ? I_NFFN : I_NMIX] + layer * D;
  for (int m = blockIdx.x * 8 + wid; m < MTOK; m += gridDim.x * 8) {
    float* y = Y + (size_t)m * D;
    f32x4 v[4]; float ss = 0.f;
#pragma unroll
    for (int i = 0; i < 4; ++i) { v[i] = *(const f32x4*)(y + i * 256 + lane * 4);
      if (addp) { const uint2 pa = *(const uint2*)(P1 + (size_t)m * D + i * 256 + lane * 4), pb = *(const uint2*)(P1 + P1_HALF + (size_t)m * D + i * 256 + lane * 4);
        v[i][0] += __uint_as_float(pa.x << 16) + __uint_as_float(pb.x << 16); v[i][1] += __uint_as_float(pa.x & 0xFFFF0000u) + __uint_as_float(pb.x & 0xFFFF0000u);
        v[i][2] += __uint_as_float(pa.y << 16) + __uint_as_float(pb.y << 16); v[i][3] += __uint_as_float(pa.y & 0xFFFF0000u) + __uint_as_float(pb.y & 0xFFFF0000u);
        *(f32x4*)(y + i * 256 + lane * 4) = v[i]; }
      ss += v[i][0] * v[i][0] + v[i][1] * v[i][1] + v[i][2] * v[i][2] + v[i][3] * v[i][3]; }
    ss = wave_sum(ss);
    const float r = rsqrtf(ss * (1.f / D) + EPS);
    const float* mod = (const float*)(p.ws + WS_MOD) + (size_t)(layer * 5 + cond_of(m)) * 6144 + which * 3072;
#pragma unroll
    for (int i = 0; i < 4; ++i) {
      const int k = i * 256 + lane * 4;
      const f32x4 gg = *(const f32x4*)(g + k), sh = *(const f32x4*)(mod + k), sc = *(const f32x4*)(mod + 1024 + k);
      float o[4];
#pragma unroll
      for (int e = 0; e < 4; ++e) o[e] = (v[i][e] * r * gg[e]) * (1.f + sc[e]) + sh[e];
      uint2 w; w.x = pack2(o[0], o[1]); w.y = pack2(o[2], o[3]);
      *(uint2*)(XN + (size_t)m * D + k) = w;
    }
  }
}

__device__ void phase_final(const Params& p) {
  const int lane = tidx() & 63, wid = tidx() >> 6;
  const float* Y = (const float*)(p.ws + WS_Y);
  const float* g = p.in[I_FN];
  for (int m = blockIdx.x * 8 + wid; m < MTOK; m += gridDim.x * 8) {
    const float* y = Y + (size_t)m * D;
    f32x4 v[4]; float ss = 0.f;
#pragma unroll
    for (int i = 0; i < 4; ++i) { v[i] = *(const f32x4*)(y + i * 256 + lane * 4);
      { const bf16_t* P1 = (const bf16_t*)(p.ws + WS_P1); const uint2 pa = *(const uint2*)(P1 + (size_t)m * D + i * 256 + lane * 4), pb = *(const uint2*)(P1 + P1_HALF + (size_t)m * D + i * 256 + lane * 4);
        v[i][0] += __uint_as_float(pa.x << 16) + __uint_as_float(pb.x << 16); v[i][1] += __uint_as_float(pa.x & 0xFFFF0000u) + __uint_as_float(pb.x & 0xFFFF0000u);
        v[i][2] += __uint_as_float(pa.y << 16) + __uint_as_float(pb.y << 16); v[i][3] += __uint_as_float(pa.y & 0xFFFF0000u) + __uint_as_float(pb.y & 0xFFFF0000u); }
      ss += v[i][0] * v[i][0] + v[i][1] * v[i][1] + v[i][2] * v[i][2] + v[i][3] * v[i][3]; }
    ss = wave_sum(ss);
    const float r = rsqrtf(ss * (1.f / D) + EPS);
#pragma unroll
    for (int i = 0; i < 4; ++i) {
      const int k = i * 256 + lane * 4;
      const f32x4 gg = *(const f32x4*)(g + k);
      f32x4 o; o[0] = v[i][0] * r * gg[0]; o[1] = v[i][1] * r * gg[1]; o[2] = v[i][2] * r * gg[2]; o[3] = v[i][3] * r * gg[3];
      *(f32x4*)(p.out + (size_t)m * D + k) = o;
    }
  }
}


namespace pg8 {
#define PG8_LAS __attribute__((address_space(3)))
constexpr int BM = 256, BK = 64, HALF = 128, HTB = HALF * BK * 2, STAGE_BYTES = 8 * HTB, NXCD = 8, WGM = 8;
__host__ __device__ __forceinline__ int lds_byte(int r, int c) { const int st = (r >> 4) * 2 + (c >> 5), rr = r & 15, cc = c & 31, ob = rr * 64 + cc * 2; return st * 1024 + (ob ^ (((ob >> 9) & 1) << 5)); }
__host__ __device__ __forceinline__ void stage_rc(int b, int& R, int& C) { const int st = b / 1024, sb = b % 1024, swz = sb ^ (((sb >> 9) & 1) << 5); R = (st >> 1) * 16 + swz / 64; C = (st & 1) * 32 + (swz % 64) / 2; }
__host__ __device__ __forceinline__ int perm32(int rho) { const int n = rho >> 4, i = rho & 15; return 8 * (i >> 2) + 4 * n + (i & 3); }
struct Unit { int pm, pn, ks; };
struct Gemm { const bf16_t* A; const bf16_t* Bt; int M, N, K, ld; };
struct StaticOrder {
    int nM, nN, nwg, G, c, KS;
    __device__ void init(int M, int N, int KS_, int G_, int c_) { nM = M / BM; KS = KS_; nN = (N / BM) * KS_; nwg = nM * nN; G = G_; c = c_; }
    __device__ bool next(int i, Unit& u) const {
        const long L = (long)i * G + c; if (L >= nwg) return false;
        int wgid = (int)L; { const int q = nwg / NXCD, r = nwg % NXCD, xcd = wgid % NXCD, off = wgid / NXCD; wgid = (xcd < r ? xcd * (q + 1) : r * (q + 1) + (xcd - r) * q) + off; }
        const int nig = WGM * nN, gid = wgid / nig, fm = gid * WGM, gsz = (nM - fm) < WGM ? (nM - fm) : WGM;
        u.pm = fm + ((wgid % nig) % gsz); const int pn2 = (wgid % nig) / gsz; u.pn = pn2 / KS; u.ks = pn2 % KS; return true;
    }
    __device__ __forceinline__ void a_ready(const Unit&) const {}
    __device__ __forceinline__ void done(const Unit&) const {}
};
__device__ __forceinline__ unsigned cvt_pk_bf16(float lo, float hi) { unsigned r; asm volatile("v_cvt_pk_bf16_f32 %0, %1, %2" : "=v"(r) : "v"(lo), "v"(hi)); return r; }
struct EpiBf16 {
    static constexpr bool PERM = true, AFTER_DRAIN = false;
    bf16_t* O; int ldc;
    __device__ __forceinline__ void operator()(const f32x4 (&acc)[2][2][4][2], const Unit& u, int wr, int wc, int fr, int fq) const {
        const int row0 = u.pm * BM + wr * 64 + fr, col0 = u.pn * BM + wc * 32 + 8 * fq;
#pragma unroll
        for (int ai = 0; ai < 2; ++ai)
#pragma unroll
            for (int m = 0; m < 4; ++m) { bf16_t* rowp = O + (size_t)(row0 + ai * HALF + m * 16) * ldc + col0;
#pragma unroll
                for (int bj = 0; bj < 2; ++bj) { const f32x4 v0 = acc[ai][bj][m][0], v1 = acc[ai][bj][m][1];
                    u32x4 w; w.x = cvt_pk_bf16(v0[0], v0[1]); w.y = cvt_pk_bf16(v0[2], v0[3]); w.z = cvt_pk_bf16(v1[0], v1[1]); w.w = cvt_pk_bf16(v1[2], v1[3]);
                    *(u32x4*)(rowp + bj * HALF) = w; } }
    }
};
struct EpiSwiglu {
    static constexpr bool PERM = true, AFTER_DRAIN = false;
    bf16_t* H;
    __device__ __forceinline__ void operator()(const f32x4 (&acc)[2][2][4][2], const Unit& u, int wr, int wc, int fr, int fq) const {
        const int row0 = u.pm * BM + wr * 64 + fr, col0 = u.pn * HALF + wc * 32 + 8 * fq;
#pragma unroll
        for (int ai = 0; ai < 2; ++ai)
#pragma unroll
            for (int m = 0; m < 4; ++m) {
                float h[8];
#pragma unroll
                for (int n = 0; n < 2; ++n)
#pragma unroll
                    for (int e = 0; e < 4; ++e) { const float gv = acc[ai][0][m][n][e], uv = acc[ai][1][m][n][e]; h[4 * n + e] = gv * __builtin_amdgcn_rcpf(1.f + __expf(-gv)) * uv; }
                u32x4 w; w.x = cvt_pk_bf16(h[0], h[1]); w.y = cvt_pk_bf16(h[2], h[3]); w.z = cvt_pk_bf16(h[4], h[5]); w.w = cvt_pk_bf16(h[6], h[7]);
                *(u32x4*)(H + (size_t)(row0 + ai * HALF + m * 16) * DFF + col0) = w; }
    }
};
struct EpiGate {
    static constexpr bool PERM = true, AFTER_DRAIN = false;
    bf16_t* P; const float* gate;
    __device__ __forceinline__ void operator()(const f32x4 (&acc)[2][2][4][2], const Unit& u, int wr, int wc, int fr, int fq) const {
        const int row0 = u.pm * BM + wr * 64 + fr, col0 = u.pn * BM + wc * 32 + 8 * fq;
        bf16_t* const dstb = P + (size_t)u.ks * P1_HALF;
#pragma unroll
        for (int ai = 0; ai < 2; ++ai)
#pragma unroll
            for (int m = 0; m < 4; ++m) { const int row = row0 + ai * HALF + m * 16; const float* gp = gate + cond_of(row) * 6144 + col0; bf16_t* rowp = dstb + (size_t)row * D + col0;
#pragma unroll
                for (int bj = 0; bj < 2; ++bj) { const f32x4 v0 = acc[ai][bj][m][0] * *(const f32x4*)(gp + bj * HALF), v1 = acc[ai][bj][m][1] * *(const f32x4*)(gp + bj * HALF + 4);
                    u32x4 w; w.x = cvt_pk_bf16(v0[0], v0[1]); w.y = cvt_pk_bf16(v0[2], v0[3]); w.z = cvt_pk_bf16(v1[0], v1[1]); w.w = cvt_pk_bf16(v1[2], v1[3]);
                    *(u32x4*)(rowp + bj * HALF) = w; } }
    }
};
template <class Epi, class Sched, bool ALIGN_EPI = false, bool SP2 = false>
__device__ __forceinline__ void gemm_phase(PG8_LAS unsigned char* lds, const Gemm g, const Sched& S, const Epi& E) {
    int tid_ = tidx();
    const int tid = tid_, wid = __builtin_amdgcn_readfirstlane(tid >> 6), lane = tid & 63, wr = wid >> 2, wc = wid & 3, fr = lane & 15, fq = lane >> 4;
    const int K = g.ld, nt = g.K / BK;
    unsigned voffA[2], voffB[2];
#pragma unroll
    for (int i = 0; i < 2; ++i) { int R, C; stage_rc(tid * 16 + i * 8192, R, C); const int Rb = Epi::PERM ? ((R & ~31) + perm32(R & 31)) : R;
        voffA[i] = (unsigned)(R * K + C) * 2u; voffB[i] = (unsigned)(Rb * K + C) * 2u; }
    const size_t kstep = (size_t)(BK * 2);
    const size_t hstep = (size_t)HALF * K * 2;
    const size_t tstep = 2 * hstep;
    const unsigned ldsw = (unsigned)wid * 1024u;
    const int aoff = lds_byte(wr * 64 + fr, fq * 8), boff = lds_byte(wc * 32 + fr, fq * 8);
#define PG8_SA(b, h) (((b) * 2 + (h)) * HTB)
#define PG8_SB(b, h) ((4 + (b) * 2 + (h)) * HTB)
#define PG8_STAGE(bufoff, gbase, voff) do { _Pragma("unroll") for (int _i = 0; _i < 2; ++_i) \
        __builtin_amdgcn_global_load_lds((const unsigned*)((const char*)(gbase) + (voff)[_i]), (PG8_LAS unsigned*)(lds + (bufoff) + ldsw + _i * 8192), 16, 0, 0); } while (0)
#define PG8_LDA(dst, b, h) do { _Pragma("unroll") for (int m = 0; m < 4; ++m) _Pragma("unroll") for (int k = 0; k < 2; ++k) dst[m][k] = *(const PG8_LAS bf16x8*)(lds + PG8_SA(b, h) + aoff + m * 2048 + k * 1024); } while (0)
#define PG8_LDB(dst, b, h) do { _Pragma("unroll") for (int n = 0; n < 2; ++n) _Pragma("unroll") for (int k = 0; k < 2; ++k) dst[n][k] = *(const PG8_LAS bf16x8*)(lds + PG8_SB(b, h) + boff + n * 2048 + k * 1024); } while (0)
#define PG8_MMA(ai, bj, At, Bt) do { __builtin_amdgcn_s_setprio(1); _Pragma("unroll") for (int m = 0; m < 4; ++m) _Pragma("unroll") for (int n = 0; n < 2; ++n) _Pragma("unroll") for (int k = 0; k < 2; ++k) \
        acc[ai][bj][m][n] = __builtin_amdgcn_mfma_f32_16x16x32_bf16(Bt[n][k], At[m][k], acc[ai][bj][m][n], 0, 0, 0); __builtin_amdgcn_s_setprio(0); } while (0)
#define PG8_WAIT_V(n) asm volatile("s_waitcnt vmcnt(" #n ")" ::: "memory")
#define PG8_WAIT_L(n) asm volatile("s_waitcnt lgkmcnt(" #n ")" ::: "memory")
#define PG8_BAR __builtin_amdgcn_s_barrier()
#define PG8_SCHED __builtin_amdgcn_sched_barrier(0)
    Unit cur, nxt; int ui = 0;
    if (!S.next(0, cur)) return;
    f32x4 acc[2][2][4][2];
#pragma unroll
    for (int a = 0; a < 2; ++a)
#pragma unroll
        for (int b = 0; b < 2; ++b)
#pragma unroll
            for (int m = 0; m < 4; ++m)
#pragma unroll
                for (int n = 0; n < 2; ++n) acc[a][b][m][n] = (f32x4){0.f, 0.f, 0.f, 0.f};
    bf16x8 At[4][2], B0[2][2], B1[2][2];
    const size_t ksb = (size_t)g.K * 2; const char* cA = (const char*)g.A + (size_t)cur.pm * tstep + cur.ks * ksb; const char* cB = (const char*)g.Bt + (size_t)cur.pn * tstep + cur.ks * ksb;
    S.a_ready(cur);
    if constexpr (SP2) {
        PG8_STAGE(PG8_SB(0, 0), cB, voffB); PG8_STAGE(PG8_SB(0, 1), cB + hstep, voffB); PG8_STAGE(PG8_SA(0, 0), cA, voffA); PG8_STAGE(PG8_SA(0, 1), cA + hstep, voffA);
        if (wr == 1) PG8_BAR;
        PG8_WAIT_V(2); PG8_BAR;
        PG8_STAGE(PG8_SB(1, 0), cB + kstep, voffB); PG8_STAGE(PG8_SA(1, 0), cA + kstep, voffA); PG8_STAGE(PG8_SB(1, 1), cB + hstep + kstep, voffB);
        PG8_WAIT_V(6); PG8_BAR;
    } else {
        PG8_STAGE(PG8_SB(0, 0), cB, voffB); PG8_STAGE(PG8_SA(0, 0), cA, voffA); PG8_STAGE(PG8_SB(0, 1), cB + hstep, voffB); PG8_STAGE(PG8_SA(0, 1), cA + hstep, voffA);
        if (wr == 1) PG8_BAR;
        PG8_WAIT_V(4); PG8_BAR;
        PG8_STAGE(PG8_SB(1, 0), cB + kstep, voffB); PG8_STAGE(PG8_SA(1, 0), cA + kstep, voffA); PG8_STAGE(PG8_SB(1, 1), cB + hstep + kstep, voffB);
        PG8_WAIT_V(6); PG8_BAR;
    }
    for (;;) {
        const bool has_next = S.next(ui + 1, nxt);
        const char* nA = has_next ? (const char*)g.A + (size_t)nxt.pm * tstep + nxt.ks * ksb : cA; const char* nB = has_next ? (const char*)g.Bt + (size_t)nxt.pn * tstep + nxt.ks * ksb : cB;
        for (int t = 0; t < nt; t += 2) {
            const bool last = (t == nt - 2);
            const char* a1 = cA + (size_t)(t + 1) * kstep;
            const char* a2 = last ? nA : cA + (size_t)(t + 2) * kstep; const char* b2 = last ? nB : cB + (size_t)(t + 2) * kstep;
            const char* a3 = a2 + kstep; const char* b3 = b2 + kstep;
            if (last && has_next) S.a_ready(nxt);
            if constexpr (SP2) {
            PG8_LDB(B0, 0, 0); PG8_LDB(B1, 0, 1); PG8_SCHED; PG8_LDA(At, 0, 0); PG8_STAGE(PG8_SA(1, 1), a1 + hstep, voffA);
            PG8_WAIT_V(8); PG8_WAIT_L(0); PG8_BAR; PG8_MMA(0, 0, At, B0); PG8_MMA(0, 1, At, B1); PG8_BAR; PG8_SCHED;
            PG8_LDA(At, 0, 1); PG8_STAGE(PG8_SB(0, 0), b2, voffB); PG8_STAGE(PG8_SB(0, 1), b2 + hstep, voffB); PG8_STAGE(PG8_SA(0, 0), a2, voffA);
            PG8_WAIT_V(8); PG8_WAIT_L(0); PG8_BAR; PG8_MMA(1, 0, At, B0); PG8_MMA(1, 1, At, B1); PG8_BAR; PG8_SCHED;
            PG8_LDB(B0, 1, 0); PG8_LDB(B1, 1, 1); PG8_SCHED; PG8_LDA(At, 1, 0); PG8_STAGE(PG8_SA(0, 1), a2 + hstep, voffA);
            PG8_WAIT_V(8); PG8_WAIT_L(0); PG8_BAR; PG8_MMA(0, 0, At, B0); PG8_MMA(0, 1, At, B1); PG8_BAR; PG8_SCHED;
            PG8_LDA(At, 1, 1); PG8_STAGE(PG8_SB(1, 0), b3, voffB); PG8_STAGE(PG8_SB(1, 1), b3 + hstep, voffB); PG8_STAGE(PG8_SA(1, 0), a3, voffA);
            PG8_WAIT_V(8); PG8_WAIT_L(0); PG8_BAR; PG8_MMA(1, 0, At, B0); PG8_MMA(1, 1, At, B1); PG8_BAR; PG8_SCHED;
            } else {
            PG8_LDB(B0, 0, 0); PG8_SCHED; PG8_LDA(At, 0, 0); PG8_STAGE(PG8_SA(1, 1), a1 + hstep, voffA);
            PG8_WAIT_L(8); PG8_BAR; PG8_WAIT_L(0); PG8_MMA(0, 0, At, B0); PG8_BAR; PG8_SCHED;
            PG8_LDB(B1, 0, 1); PG8_STAGE(PG8_SB(0, 0), b2, voffB);
            PG8_BAR; PG8_WAIT_L(0); PG8_MMA(0, 1, At, B1); PG8_BAR;
            PG8_LDA(At, 0, 1); PG8_STAGE(PG8_SA(0, 0), a2, voffA);
            PG8_BAR; PG8_WAIT_L(0); PG8_MMA(1, 0, At, B0); PG8_BAR; PG8_SCHED;
            PG8_STAGE(PG8_SB(0, 1), b2 + hstep, voffB);
            PG8_WAIT_V(6); PG8_BAR; PG8_MMA(1, 1, At, B1); PG8_BAR;
            PG8_LDB(B0, 1, 0); PG8_SCHED; PG8_LDA(At, 1, 0); PG8_STAGE(PG8_SA(0, 1), a2 + hstep, voffA);
            PG8_WAIT_L(8); PG8_BAR; PG8_WAIT_L(0); PG8_MMA(0, 0, At, B0); PG8_BAR; PG8_SCHED;
            PG8_LDB(B1, 1, 1); PG8_STAGE(PG8_SB(1, 0), b3, voffB);
            PG8_BAR; PG8_WAIT_L(0); PG8_MMA(0, 1, At, B1); PG8_BAR;
            PG8_LDA(At, 1, 1); PG8_STAGE(PG8_SA(1, 0), a3, voffA);
            PG8_BAR; PG8_WAIT_L(0); PG8_MMA(1, 0, At, B0); PG8_BAR; PG8_SCHED;
            PG8_STAGE(PG8_SB(1, 1), b3 + hstep, voffB);
            PG8_WAIT_V(6); PG8_BAR; PG8_MMA(1, 1, At, B1); PG8_BAR;
            }
        }
        if constexpr (ALIGN_EPI) { if (wr == 0) PG8_BAR; }
        if constexpr (!Epi::AFTER_DRAIN) { E(acc, cur, wr, wc, fr, fq); S.done(cur); }
        if (!has_next) break;
#pragma unroll
        for (int a = 0; a < 2; ++a)
#pragma unroll
            for (int b = 0; b < 2; ++b)
#pragma unroll
                for (int m = 0; m < 4; ++m)
#pragma unroll
                    for (int n = 0; n < 2; ++n) acc[a][b][m][n] = (f32x4){0.f, 0.f, 0.f, 0.f};
        cur = nxt; cA = nA; cB = nB; ++ui;
        if constexpr (ALIGN_EPI) { if (wr == 1) PG8_BAR; }
    }
    PG8_WAIT_V(0);
    if constexpr (!ALIGN_EPI) { if (wr == 0) PG8_BAR; }
    PG8_BAR;
    if constexpr (Epi::AFTER_DRAIN) { E.fused(acc, cur, wr, wc, fr, fq, lds, wid, lane); S.done(cur); }
#undef PG8_SA
#undef PG8_SB
#undef PG8_STAGE
#undef PG8_LDA
#undef PG8_LDB
#undef PG8_MMA
#undef PG8_WAIT_V
#undef PG8_WAIT_L
#undef PG8_BAR
#undef PG8_SCHED
}
}

template <class Epi>
__device__ __forceinline__ void gemm_run(unsigned char* lds, const bf16_t* A, const bf16_t* Bt, int M, int N, int Ktot, int KS, const Epi& E) {
    pg8::StaticOrder S; S.init(M, N, KS, (int)gridDim.x, (int)blockIdx.x);
    pg8::Gemm g; g.A = A; g.Bt = Bt; g.M = M; g.N = N; g.K = Ktot / KS; g.ld = Ktot;
    __syncthreads();
    pg8::gemm_phase<Epi, pg8::StaticOrder, true, true>((PG8_LAS unsigned char*)lds, g, S, E);
    __syncthreads();
}


#define LDSP __attribute__((address_space(3)))
constexpr int LC_FR = 0, LC_U = 66176, LC_X0 = LC_U + 20480, LC_S = LC_X0 + 20480, LC_Z = LC_S + 17408;
__device__ void phase_lc(const Params& p, int j, unsigned char* lds_) {
  LDSP unsigned char* lds = (LDSP unsigned char*)lds_;
  const int tid = tidx(), lane = tid & 63, wid = tid >> 6, n = lane & 31, hi = lane >> 5;
  const bf16_t* ZT = (const bf16_t*)(p.ws + WS_ZT); bf16_t* YG = (bf16_t*)(p.ws + WS_YG);
  const float* cw = p.in[I_HCW] + (size_t)j * 3 * 3072; const float* cb = p.in[I_HCB] + (size_t)j * 3072;
  for (int q = blockIdx.x; q < 1024; q += gridDim.x) {
    const int lsel = q < 512 ? 1 : 0, qq = q & 511, cg = qq >> 2, tb = (lsel ? 4 : 0) + (qq & 3);
    const int L = lsel ? 1024 : 256, P = L >> 5, REC = 4 * L + 40, c0 = cg * 8;
    const size_t m0 = (size_t)tb * 1024;
    __syncthreads();
    {
      const u32x4* src = (const u32x4*)((const bf16_t*)(p.ws + WS_FRG) + (size_t)j * FRG_J + (lsel ? FRG_L1 : 0) + (size_t)c0 * REC);
      LDSP u32x4* dst = (LDSP u32x4*)(lds + LC_FR);
      for (int i = tid; i < REC; i += 512) dst[i] = src[i];
    }
    for (int task = tid; task < 1024; task += 512) {
      const int ch = task >> 7, tok0 = (task & 127) * 8;
      const bool first = (tok0 & (L - 1)) == 0, last = ((tok0 + 8) & (L - 1)) == 0;
      float sc[3][8];
#pragma unroll
      for (int part = 0; part < 3; ++part) {
        const int chn = part * 1024 + c0 + ch;
        const bf16_t* z = ZT + (size_t)chn * MTOK + m0 + tok0;
        const u32x4 w = *(const u32x4*)z;
        float zv[10];
        zv[0] = first ? 0.f : bf2f(z[-1]); zv[9] = last ? 0.f : bf2f(z[8]);
        zv[1] = __uint_as_float(w.x << 16); zv[2] = __uint_as_float(w.x & 0xFFFF0000u); zv[3] = __uint_as_float(w.y << 16); zv[4] = __uint_as_float(w.y & 0xFFFF0000u);
        zv[5] = __uint_as_float(w.z << 16); zv[6] = __uint_as_float(w.z & 0xFFFF0000u); zv[7] = __uint_as_float(w.w << 16); zv[8] = __uint_as_float(w.w & 0xFFFF0000u);
        const float w0 = cw[chn], w1 = cw[3072 + chn], w2 = cw[2 * 3072 + chn], bb = cb[chn];
#pragma unroll
        for (int i = 0; i < 8; ++i) sc[part][i] = zv[i] * w0 + zv[i + 1] * w1 + zv[i + 2] * w2 + bb;
      }
      u32x4 xo, uo;
      xo.x = pack2(sc[0][0], sc[0][1]); xo.y = pack2(sc[0][2], sc[0][3]); xo.z = pack2(sc[0][4], sc[0][5]); xo.w = pack2(sc[0][6], sc[0][7]);
      uo.x = pack2(sc[1][0] * sc[2][0], sc[1][1] * sc[2][1]); uo.y = pack2(sc[1][2] * sc[2][2], sc[1][3] * sc[2][3]);
      uo.z = pack2(sc[1][4] * sc[2][4], sc[1][5] * sc[2][5]); uo.w = pack2(sc[1][6] * sc[2][6], sc[1][7] * sc[2][7]);
      const int po = (ch * 1280 + tok0 + 8 * (tok0 >> 5)) * 2;
      *(LDSP u32x4*)(lds + LC_U + po) = uo; *(LDSP u32x4*)(lds + LC_X0 + po) = xo;
    }
    if (tid < 4) ((LDSP unsigned*)(lds + LC_Z))[tid] = 0u;
    __syncthreads();
    f32x16 acc;
#pragma unroll
    for (int r = 0; r < 16; ++r) acc[r] = 0.f;
    {
      const int par = n & 1;
      LDSP const unsigned char* fa = lds + LC_FR + wid * (REC * 2) + (par ? (2 * L + 40) * 2 : 0) + 2 * (L - n - par + 8 * hi);
      LDSP const unsigned char* ub = lds + LC_U + wid * 2560 + (40 * n + 8 * hi) * 2;
      const int ti = n & (P - 1);
#define LC_LOAD(s_, AW, BF) do { const int dl_ = ((s_) >> 1) - (P - 1), ks_ = (s_) & 1; \
        LDSP const volatile unsigned* ap_ = (LDSP const volatile unsigned*)(fa + 2 * (-32 * dl_ + 16 * ks_)); \
        AW.x = ap_[0]; AW.y = ap_[1]; AW.z = ap_[2]; AW.w = ap_[3]; \
        LDSP const unsigned char* bp_ = ((unsigned)(ti - dl_) < (unsigned)P) ? (ub + (-40 * dl_ + 16 * ks_) * 2) : (lds + LC_Z); \
        BF = *(LDSP const volatile bf16x8*)bp_; } while (0)
      const int nsteps = 2 * (2 * P - 1);
      u32x4 a0, a1; bf16x8 b0, b1;
      LC_LOAD(0, a0, b0);
      for (int s2 = 0; s2 < nsteps; s2 += 2) {
        LC_LOAD(s2 + 1, a1, b1);
        acc = __builtin_amdgcn_mfma_f32_32x32x16_bf16(__builtin_bit_cast(bf16x8, a0), b0, acc, 0, 0, 0);
        if (s2 + 2 < nsteps) LC_LOAD(s2 + 2, a0, b0);
        acc = __builtin_amdgcn_mfma_f32_32x32x16_bf16(__builtin_bit_cast(bf16x8, a1), b1, acc, 0, 0, 0);
      }
#undef LC_LOAD
    }
    {
      const float rn = ((const float*)(p.ws + WS_RNORM))[(j * 2 + lsel) * 1024 + c0 + wid], bs = p.in[I_HBIAS][j * D + c0 + wid];
      LDSP const bf16_t* uu = (LDSP const bf16_t*)(lds + LC_U) + wid * 1280 + 40 * n;
      LDSP const bf16_t* xx = (LDSP const bf16_t*)(lds + LC_X0) + wid * 1280 + 40 * n;
      LDSP bf16_t* so = (LDSP bf16_t*)(lds + LC_S) + wid * 1088 + 34 * n;
#pragma unroll
      for (int r = 0; r < 16; ++r) {
        const int row = (r & 3) + 8 * (r >> 2) + 4 * hi;
        const float y = acc[r] * rn + bf2f(uu[row]) * bs;
        so[row] = f2bf(bf2f(xx[row]) * y);
      }
    }
    __syncthreads();
    for (int tok = tid; tok < 1024; tok += 512) {
      LDSP const bf16_t* so = (LDSP const bf16_t*)(lds + LC_S) + tok + 2 * (tok >> 5);
      u32x4 w;
      w.x = (unsigned)so[0] | ((unsigned)so[1088] << 16); w.y = (unsigned)so[2 * 1088] | ((unsigned)so[3 * 1088] << 16);
      w.z = (unsigned)so[4 * 1088] | ((unsigned)so[5 * 1088] << 16); w.w = (unsigned)so[6 * 1088] | ((unsigned)so[7 * 1088] << 16);
      *(u32x4*)(YG + (m0 + tok) * D + c0) = w;
    }
  }
  __syncthreads();
}

__device__ void phase_qkvpost(const Params& p, int j) {
  const int lane = tidx() & 63, wid = tidx() >> 6;
  const unsigned* QKV = (const unsigned*)(p.ws + WS_QKV);
  unsigned* Q = (unsigned*)(p.ws + WS_Q); unsigned* KP = (unsigned*)(p.ws + WS_KP); unsigned* VP = (unsigned*)(p.ws + WS_VP);
  unsigned* KS = (unsigned*)(p.ws + WS_KS) + (size_t)j * 4 * 1536 * 128; unsigned* VS = (unsigned*)(p.ws + WS_VS) + (size_t)j * 4 * 1536 * 128;
  const float* qn = p.in[I_QN] + j * 128; const float* kn = p.in[I_KN] + j * 128;
  float* newk = p.out + (size_t)2 * NPR * D; float* newv = newk + (size_t)16 * 2 * 256 * 256;
  const float qg0 = qn[2 * lane], qg1 = qn[2 * lane + 1], kg0 = kn[2 * lane], kg1 = kn[2 * lane + 1];
  const float freq = exp2f(-(float)(lane & 31) * 0.41524101186092029f);
  for (int m = blockIdx.x * 8 + wid; m < MTOK; m += gridDim.x * 8) {
    const bool smp = m >= NPR;
    float cs = 1.f, sn = 0.f;
    if (smp) { const int t = (m - NPR) & 1023; const float pos = (float)(lane < 32 ? (t >> 6) : (t & 63)); const float rev = (pos * freq) * INV_2PI; cs = cos_rev(rev); sn = sin_rev(rev); }
#pragma unroll
    for (int s = 0; s < 12; ++s) {
      const unsigned raw = QKV[(size_t)m * 768 + s * 64 + lane];
      float x0 = __uint_as_float(raw << 16), x1 = __uint_as_float(raw & 0xFFFF0000u);
      if (s < 10) {
        const float ss = wave_sum(x0 * x0 + x1 * x1);
        const float r = rsqrtf(ss * (1.f / 128.f) + EPS);
        x0 = x0 * r * (s < 8 ? qg0 : kg0); x1 = x1 * r * (s < 8 ? qg1 : kg1);
        if (smp) { const float a = x0, b = x1; x0 = a * cs - b * sn; x1 = a * sn + b * cs; }
      }
      const unsigned w = pack2(x0, x1);
      if (s < 8) Q[(size_t)m * 512 + s * 64 + lane] = w;
      else {
        const int kv = (s - 8) & 1; const bool isk = s < 10;
        if (!smp) {
          (isk ? KP : VP)[(size_t)m * 128 + kv * 64 + lane] = w;
          const int b = m >> 8, t = m & 255;
          float* o = (isk ? newk : newv) + ((((size_t)b * 2 + j) * 256 + t) * 2 + kv) * 128 + 2 * lane;
          o[0] = x0; o[1] = x1;
        } else {
          const int b = (m - NPR) >> 10, t = (m - NPR) & 1023;
          (isk ? KS : VS)[((size_t)b * 1536 + t) * 128 + kv * 64 + lane] = w;
        }
      }
    }
  }
}


namespace att {
typedef unsigned short bf16;
constexpr int   D = 128, NW = 8, QBLK = 32, KVBLK = 64;
constexpr float SCALE = 0.088388347648318440f;
constexpr float THR = 8.f;
constexpr int SDEPTH = 2;
constexpr int LDQ = 1024, LDK = 256, LDO = 1024;
constexpr size_t SHM_V = KVBLK * D * 2, SHM_K = KVBLK * D * 2, SHM_ATTN = 2 * SHM_V + 2 * SHM_K + NW * 64 * 4;

using s16x4  = __attribute__((ext_vector_type(4))) short;
using f32x16 = __attribute__((ext_vector_type(16))) float;
using f32x8  = __attribute__((ext_vector_type(8))) float;

#define KSWZ(row, colB) ((row) * 256 + ((colB) ^ (((row) & 7) << 4)))
#define SBAR() __builtin_amdgcn_sched_barrier(0)
__device__ __forceinline__ int crow(int r, int hi) { return (r & 3) + 8 * (r >> 2) + 4 * hi; }
__device__ __forceinline__ unsigned cvtpk(float lo, float hi) {
  unsigned r; asm volatile("v_cvt_pk_bf16_f32 %0, %1, %2" : "=v"(r) : "v"(lo), "v"(hi)); return r;
}
template <typename TIn> struct Stage;
template <> struct Stage<bf16>  { using T = bf16x8;
  __device__ static __forceinline__ T ld8(const bf16* p) { return *reinterpret_cast<const bf16x8*>(p); }
  __device__ static __forceinline__ bf16x8 tobf(T x) { return x; } };
template <> struct Stage<float> { using T = f32x8;
  __device__ static __forceinline__ T ld8(const float* p) { return *reinterpret_cast<const f32x8*>(p); }
  __device__ static __forceinline__ bf16x8 tobf(T x) {
    u32x4 w = {cvtpk(x[0], x[1]), cvtpk(x[2], x[3]), cvtpk(x[4], x[5]), cvtpk(x[6], x[7])}; return *reinterpret_cast<bf16x8*>(&w); } };

__device__ __forceinline__ void partialSM(f32x16& p0, f32x16& p1, float& m_reg, float& mn, float& alpha) {
  constexpr float C = SCALE * 1.4426950408889634f;
  float pmax = p0[0]; for (int r = 1; r < 16; ++r) pmax = fmaxf(pmax, p0[r]); for (int r = 0; r < 16; ++r) pmax = fmaxf(pmax, p1[r]);
  { auto rr = __builtin_amdgcn_permlane32_swap(__float_as_uint(pmax), __float_as_uint(pmax), false, false);
    pmax = fmaxf(__uint_as_float(rr[0]), __uint_as_float(rr[1])); }
  if (__builtin_expect(__all(pmax - m_reg <= THR / SCALE), 1)) { mn = m_reg; alpha = 1.f; }
  else { mn = fmaxf(m_reg, pmax); alpha = __builtin_amdgcn_exp2f((m_reg - mn) * C); m_reg = mn; }
  float mnC = -mn * C;
  for (int r = 0; r < 16; ++r) p0[r] = fmaf(p0[r], C, mnC); for (int r = 0; r < 16; ++r) p1[r] = fmaf(p1[r], C, mnC);
  for (int r = 0; r < 16; ++r) p0[r] = __builtin_amdgcn_exp2f(p0[r]);
}
__device__ __forceinline__ void finishSM(f32x16& p0, f32x16& p1, float alpha, float& l_reg, bf16x8& pa0, bf16x8& pa1, bf16x8& pa2, bf16x8& pa3) {
  for (int r = 0; r < 16; ++r) p1[r] = __builtin_amdgcn_exp2f(p1[r]);
  float ps = 0; for (int r = 0; r < 16; ++r) ps += p0[r]; for (int r = 0; r < 16; ++r) ps += p1[r];
  { auto rr = __builtin_amdgcn_permlane32_swap(__float_as_uint(ps), __float_as_uint(ps), false, false);
    ps = __uint_as_float(rr[0]) + __uint_as_float(rr[1]); }
  l_reg = l_reg * alpha + ps;
#define PK4(P, BASE, OUT) do { unsigned a0 = cvtpk(P[BASE + 0], P[BASE + 1]), a1 = cvtpk(P[BASE + 2], P[BASE + 3]);   \
    unsigned b0 = cvtpk(P[BASE + 4], P[BASE + 5]), b1 = cvtpk(P[BASE + 6], P[BASE + 7]);                              \
    auto r0 = __builtin_amdgcn_permlane32_swap(a0, b0, false, false); auto r1 = __builtin_amdgcn_permlane32_swap(a1, b1, false, false); \
    u32x4 w = {r0[0], r1[0], r0[1], r1[1]}; OUT = *reinterpret_cast<bf16x8*>(&w); } while (0)
  PK4(p0, 0, pa0); PK4(p0, 8, pa1); PK4(p1, 0, pa2); PK4(p1, 8, pa3);
#undef PK4
}
__device__ __forceinline__ void qkt(f32x16& p0, f32x16& p1, const bf16* Ks, const bf16x8* qr, int r32, int hi) {
  p0 = f32x16{}; p1 = f32x16{};
  for (int d0 = 0; d0 < 8; ++d0) { int cb = (d0 * 16 + hi * 8) * 2;
    bf16x8 b0 = *reinterpret_cast<const bf16x8*>((const char*)Ks + KSWZ(r32, cb));
    bf16x8 b1 = *reinterpret_cast<const bf16x8*>((const char*)Ks + KSWZ(32 + r32, cb));
    p0 = __builtin_amdgcn_mfma_f32_32x32x16_bf16(b0, qr[d0], p0, 0, 0, 0);
    p1 = __builtin_amdgcn_mfma_f32_32x32x16_bf16(b1, qr[d0], p1, 0, 0, 0); }
}
__device__ __forceinline__ int v_st(int k, int c) { const int kk = (k & ~0xC) | ((k & 4) << 1) | ((k & 8) >> 1); return ((kk >> 3) * 4 + (c >> 5)) * 512 + ((kk & 7) * 32 + (c & 31)) * 2; }
__device__ __forceinline__ int v_rd_base(int lane) { return ((lane & 3) << 3) | (((lane >> 2) & 3) << 6) | (((lane >> 4) & 1) << 5) | (((lane >> 5) & 1) << 8); }
constexpr int v_rd_off(int d0, int ks, int half) { return d0 * 512 + ks * 4096 + half * 2048; }
template <int OFF> __device__ __forceinline__ s16x4 tr_read(int vb) {
  s16x4 r; asm volatile("ds_read_b64_tr_b16 %0, %1 offset:%2" : "=&v"(r) : "v"(vb), "i"(OFF) : "memory"); return r;
}
template <int D0> __device__ __forceinline__ void pv_one(f32x16& od, int vb, bf16x8 pa0, bf16x8 pa1, bf16x8 pa2, bf16x8 pa3) {
  const s16x4 l0 = tr_read<v_rd_off(D0, 0, 0)>(vb), h0 = tr_read<v_rd_off(D0, 0, 1)>(vb), l1 = tr_read<v_rd_off(D0, 1, 0)>(vb), h1 = tr_read<v_rd_off(D0, 1, 1)>(vb);
  const s16x4 l2 = tr_read<v_rd_off(D0, 2, 0)>(vb), h2 = tr_read<v_rd_off(D0, 2, 1)>(vb), l3 = tr_read<v_rd_off(D0, 3, 0)>(vb), h3 = tr_read<v_rd_off(D0, 3, 1)>(vb);
  asm volatile("s_waitcnt lgkmcnt(0)" ::: "memory"); SBAR();
#define PK(L, H) (bf16x8){L[0], L[1], L[2], L[3], H[0], H[1], H[2], H[3]}
  od = __builtin_amdgcn_mfma_f32_32x32x16_bf16(pa0, PK(l0, h0), od, 0, 0, 0);
  od = __builtin_amdgcn_mfma_f32_32x32x16_bf16(pa1, PK(l1, h1), od, 0, 0, 0);
  od = __builtin_amdgcn_mfma_f32_32x32x16_bf16(pa2, PK(l2, h2), od, 0, 0, 0);
  od = __builtin_amdgcn_mfma_f32_32x32x16_bf16(pa3, PK(l3, h3), od, 0, 0, 0);
#undef PK
}
__device__ __forceinline__ void pv_d0(f32x16* o, int vb, bf16x8 pa0, bf16x8 pa1, bf16x8 pa2, bf16x8 pa3) {
  pv_one<0>(o[0], vb, pa0, pa1, pa2, pa3); pv_one<1>(o[1], vb, pa0, pa1, pa2, pa3); pv_one<2>(o[2], vb, pa0, pa1, pa2, pa3); pv_one<3>(o[3], vb, pa0, pa1, pa2, pa3);
}

template <typename TQ>
__device__ __forceinline__ void attn_dense_body(const TQ* __restrict__ Qb, const bf16* __restrict__ Kh, const bf16* __restrict__ Vh,
                                                bf16* __restrict__ Ob, int seq, char* lds) {
  using St = Stage<bf16>; using SQ = Stage<TQ>;
  const int tid = tidx(), wid = tid >> 6, lane = tid & 63, r32 = lane & 31, hi = lane >> 5;
  bf16* V_lds = (bf16*)lds; bf16* K_lds = (bf16*)(lds + 2 * SHM_V);
  float* ws = (float*)(lds + 2 * SHM_V + 2 * SHM_K) + wid * 64; float* li_l = ws; float* al_l = ws + 32;
  float m_reg = -1e30f, l_reg = 0; f32x16 o[4] = {}; bf16x8 qr[8];
  const TQ* Qw = Qb + (long)(wid * QBLK + r32) * LDQ + hi * 8;
#pragma unroll
  for (int d0 = 0; d0 < 8; ++d0) qr[d0] = SQ::tobf(SQ::ld8(Qw + d0 * 16));
  const int sr = tid >> 4, sc = (tid & 15) * 8, vst0 = v_st(sr, sc), vst1 = v_st(32 + sr, sc);
  const int vb0 = (int)(uintptr_t)V_lds + v_rd_base(lane);
  struct { typename St::T vs0, vs1, ks0, ks1; } sr_[SDEPTH];
#define SLOAD(i, k0) do { sr_[i].vs0 = St::ld8(&Vh[(long)((k0) + sr) * LDK + sc]); sr_[i].vs1 = St::ld8(&Vh[(long)((k0) + 32 + sr) * LDK + sc]); \
    sr_[i].ks0 = St::ld8(&Kh[(long)((k0) + sr) * LDK + sc]); sr_[i].ks1 = St::ld8(&Kh[(long)((k0) + 32 + sr) * LDK + sc]); } while (0)
#define SWRITE(b, i) do { *(bf16x8*)((char*)V_lds + (b) * SHM_V + vst0) = St::tobf(sr_[i].vs0);          \
    *(bf16x8*)((char*)V_lds + (b) * SHM_V + vst1) = St::tobf(sr_[i].vs1); int kc = sc * 2;               \
    *(bf16x8*)((char*)K_lds + (b) * SHM_K + KSWZ(sr, kc)) = St::tobf(sr_[i].ks0);                       \
    *(bf16x8*)((char*)K_lds + (b) * SHM_K + KSWZ(32 + sr, kc)) = St::tobf(sr_[i].ks1); } while (0)
#define SWAIT() do { if constexpr (SDEPTH == 2) asm volatile("s_waitcnt vmcnt(4)" ::: "memory"); else asm volatile("s_waitcnt vmcnt(0)" ::: "memory"); } while (0)
#define RESC(a) do { if (__any((a) < 1.f)) { if (hi == 0) al_l[r32] = (a); asm volatile("s_waitcnt lgkmcnt(0)" ::: "memory"); \
    for (int d = 0; d < 4; ++d) for (int r = 0; r < 16; ++r) o[d][r] *= al_l[crow(r, hi)]; } } while (0)
  f32x16 pA0, pA1, pB0, pB1; float mnA, mnB, alA, alB; bf16x8 pa0, pa1, pa2, pa3; const int NT = seq / KVBLK;
  constexpr int SE = 0, SO = SDEPTH - 1;
  SLOAD(SE, 0); asm volatile("s_waitcnt vmcnt(0)" ::: "memory"); SWRITE(0, SE); __syncthreads();
  qkt(pA0, pA1, K_lds, qr, r32, hi); partialSM(pA0, pA1, m_reg, mnA, alA);
  SLOAD(SO, KVBLK); if constexpr (SDEPTH == 2) { if (2 < NT) SLOAD(SE, 2 * KVBLK); }
  SWAIT(); SWRITE(1, SO); __syncthreads();
  for (int j = 1; j + 1 < NT; j += 2) {
    SBAR(); qkt(pB0, pB1, (bf16*)((char*)K_lds + SHM_K), qr, r32, hi);
    finishSM(pA0, pA1, alA, l_reg, pa0, pa1, pa2, pa3); SBAR();
    SLOAD(SO, (j + SDEPTH) * KVBLK); SBAR();
    pv_d0(o, vb0, pa0, pa1, pa2, pa3); partialSM(pB0, pB1, m_reg, mnB, alB);
    __syncthreads(); SWAIT(); SWRITE(0, SE);
    RESC(alB); __syncthreads();
    SBAR(); qkt(pA0, pA1, K_lds, qr, r32, hi);
    finishSM(pB0, pB1, alB, l_reg, pa0, pa1, pa2, pa3); SBAR();
    if (SDEPTH == 1 || j + 3 < NT) SLOAD(SE, (j + 1 + SDEPTH) * KVBLK); SBAR();
    pv_d0(o, vb0 + (int)SHM_V, pa0, pa1, pa2, pa3); partialSM(pA0, pA1, m_reg, mnA, alA);
    __syncthreads(); SWAIT(); SWRITE(1, SO);
    RESC(alA); __syncthreads();
  }
  SBAR(); qkt(pB0, pB1, (bf16*)((char*)K_lds + SHM_K), qr, r32, hi);
  finishSM(pA0, pA1, alA, l_reg, pa0, pa1, pa2, pa3); SBAR();
  pv_d0(o, vb0, pa0, pa1, pa2, pa3); partialSM(pB0, pB1, m_reg, mnB, alB);
  __syncthreads(); RESC(alB);
  finishSM(pB0, pB1, alB, l_reg, pa0, pa1, pa2, pa3); SBAR();
  pv_d0(o, vb0 + (int)SHM_V, pa0, pa1, pa2, pa3);
  if (hi == 0) li_l[r32] = l_reg; asm volatile("s_waitcnt lgkmcnt(0)" ::: "memory");
  float rli[16];
#pragma unroll
  for (int r = 0; r < 16; ++r) rli[r] = __builtin_amdgcn_rcpf(li_l[crow(r, hi)]);
  bf16* Ow = Ob + (long)(wid * QBLK) * LDO;
#pragma unroll
  for (int r = 0; r < 16; ++r) { int orow = crow(r, hi);
    for (int d0 = 0; d0 < 4; ++d0) Ow[(long)orow * LDO + d0 * 32 + r32] = f2bf(o[d0][r] * rli[r]); }
#undef SLOAD
#undef SWRITE
#undef SWAIT
#undef RESC
}
}

__device__ void phase_att(const Params& p, int j, unsigned char* lds) {
  const bf16_t* Q = (const bf16_t*)(p.ws + WS_Q); bf16_t* O = (bf16_t*)(p.ws + WS_O);
  const bf16_t* KP = (const bf16_t*)(p.ws + WS_KP); const bf16_t* VP = (const bf16_t*)(p.ws + WS_VP);
  const bf16_t* KS = (const bf16_t*)(p.ws + WS_KS) + (size_t)j * 4 * 1536 * 256; const bf16_t* VS = (const bf16_t*)(p.ws + WS_VS) + (size_t)j * 4 * 1536 * 256;
  for (int u = blockIdx.x; u < 256; u += gridDim.x) {
    __syncthreads();
    if (u < 128) {
      const int qb = u & 3, h = (u >> 2) & 7, b = u >> 5, kv = h >> 2;
      const size_t row0 = (size_t)NPR + b * 1024 + qb * 256, kb = ((size_t)b * 1536) * 256 + kv * 128;
      att::attn_dense_body<att::bf16>(Q + row0 * D + h * 128, KS + kb, VS + kb, O + row0 * D + h * 128, 1536, (char*)lds);
    } else {
      const int h = (u - 128) & 7, b = (u - 128) >> 3, kv = h >> 2;
      const size_t row0 = (size_t)b * 256, kb = row0 * 256 + kv * 128;
      att::attn_dense_body<att::bf16>(Q + row0 * D + h * 128, KP + kb, VP + kb, O + row0 * D + h * 128, 256, (char*)lds);
    }
  }
  __syncthreads();
}

#define XB_TMO      128
#define XB_XCNT(j)  (256  + 64 * (j))
#define XB_XSUB(j)  (1280 + 64 * (j))
#define XB_XGEN(j)  (2304 + 64 * (j))
#define XB_TOP      3328
#define XB_TOPGEN   3392
#define XCD_BAR_WORDS 3456
#define XB_SPIN_CAP (1u << 18)
#define LAS __attribute__((address_space(3)))

__device__ __forceinline__ unsigned xb_ld(unsigned* p)              { return __hip_atomic_load(p, __ATOMIC_RELAXED, __HIP_MEMORY_SCOPE_AGENT); }
__device__ __forceinline__ unsigned xb_add(unsigned* p, unsigned v) { return __hip_atomic_fetch_add(p, v, __ATOMIC_RELAXED, __HIP_MEMORY_SCOPE_AGENT); }
__device__ __forceinline__ unsigned xb_xcc_id() { return (unsigned)__builtin_amdgcn_s_getreg((3 << 11) | 20) & 0xFu; }
#define XB_SPIN(cond, bar) do { unsigned _sp = 0; while (cond) { __builtin_amdgcn_s_sleep(1); \
    if ((++_sp & 255u) == 0u) { if (xb_ld(&(bar)[XB_TMO])) break; if (_sp > XB_SPIN_CAP) { atomicAdd(&(bar)[XB_TMO], 1u); break; } } } } while (0)

struct XcdBarrier {
    unsigned* bar; unsigned x;
    volatile LAS unsigned* st;
};

__device__ __forceinline__ XcdBarrier xcd_barrier_post(unsigned* bar, volatile LAS unsigned* st) {
    XcdBarrier b; b.bar = bar; b.x = xb_xcc_id(); b.st = st;
    if (threadIdx.x == 0) (void)xb_add(&bar[XB_XCNT(b.x)], 1u);
    return b;
}
__device__ __forceinline__ void xcd_barrier_complete(unsigned* bar, unsigned x, unsigned& nloc, unsigned& nx) {
    const unsigned G = gridDim.x * gridDim.y * gridDim.z;
    unsigned sum, cnt, mine, sp = 0u;
    for (;;) {
        sum = 0u; cnt = 0u; mine = 0u;
#pragma unroll
        for (unsigned j = 0; j < 16; ++j) { const unsigned c = xb_ld(&bar[XB_XCNT(j)]); sum += c; cnt += (c > 0u) ? 1u : 0u; mine = (j == x) ? c : mine; }
        if (sum == G) break;
        __builtin_amdgcn_s_sleep(1);
        if ((++sp & 255u) == 0u) { if (xb_ld(&bar[XB_TMO])) break; if (sp > XB_SPIN_CAP) { atomicAdd(&bar[XB_TMO], 1u); break; } }
    }
    nloc = mine > 0u ? mine : 1u; nx = cnt > 0u ? cnt : 1u;
}

__device__ __forceinline__ void xcd_barrier(const XcdBarrier& b) {
    asm volatile("s_waitcnt vmcnt(0)" ::: "memory");
    __syncthreads();
    if (threadIdx.x == 0) {
        unsigned* bar = b.bar;
        __builtin_amdgcn_s_waitcnt(0);
        unsigned nloc = b.st[0], nx = b.st[1];
        if (nloc == 0u) { xcd_barrier_complete(bar, b.x, nloc, nx); b.st[0] = nloc; b.st[1] = nx; }
        const unsigned old = xb_add(&bar[XB_XSUB(b.x)], 1u);
        const unsigned gen = old / nloc;
        if (old + 1u == (gen + 1u) * nloc) {
            __builtin_amdgcn_fence(__ATOMIC_RELEASE, "agent");
            asm volatile("s_waitcnt vmcnt(0)" ::: "memory");
            const unsigned og = xb_add(&bar[XB_TOP], 1u);
            const unsigned tg = og / nx;
            if (og + 1u == (tg + 1u) * nx) xb_add(&bar[XB_TOPGEN], 1u);
            else XB_SPIN(xb_ld(&bar[XB_TOPGEN]) == tg, bar);
            __builtin_amdgcn_fence(__ATOMIC_ACQUIRE, "agent");
            xb_add(&bar[XB_XGEN(b.x)], 1u);
            asm volatile("s_waitcnt vmcnt(0)" ::: "memory");
        } else {
            XB_SPIN(xb_ld(&bar[XB_XGEN(b.x)]) == gen, bar);
            __builtin_amdgcn_fence(__ATOMIC_ACQUIRE, "agent");
            asm volatile("s_waitcnt vmcnt(0)" ::: "memory");
        }
    }
    __syncthreads();
}

__global__ void __launch_bounds__(512, 2) mega(Params p) {
  extern __shared__ __attribute__((aligned(16))) unsigned char lds[];
  cg::grid_group grid = cg::this_grid();
  volatile LAS unsigned* xst = (volatile LAS unsigned*)((LAS unsigned char*)lds + (LDS_BYTES - 16));
  if (threadIdx.x < 4) xst[threadIdx.x] = 0u;
  __syncthreads();
  const XcdBarrier xbar = xcd_barrier_post((unsigned*)p.ws, xst);
  int ph = 0;
#define RUN(stmt) do { if (ph >= p.ph_lo && ph < p.ph_hi) { stmt; if (ph + 1 < p.ph_hi) { if (ph == 0) grid.sync(); else xcd_barrier(xbar); } } ++ph; } while (0)
  bf16_t* XN = (bf16_t*)(p.ws + WS_XN); float* Y = (float*)(p.ws + WS_Y); const float* MOD = (const float*)(p.ws + WS_MOD);
  RUN(phase_p0(p, lds));
  RUN(phase_p0b(p));
#pragma unroll 1
  for (int l = 0; l < 4; ++l) {
    const int j = l >> 1;
    RUN(phase_nm(p, l, 0, l > 0));
    if ((l & 1) == 0) {
      RUN(gemm_run(lds, (const bf16_t*)(p.ws + WS_WIN) + (size_t)j * 3072 * D, XN, 3072, MTOK, D, 1, pg8::EpiBf16{(bf16_t*)(p.ws + WS_ZT), MTOK}));
      RUN(phase_lc(p, j, lds));
      RUN(gemm_run(lds, (const bf16_t*)(p.ws + WS_YG), (const bf16_t*)(p.ws + WS_WHO) + (size_t)j * D * D, MTOK, D, D, 2, pg8::EpiGate{(bf16_t*)(p.ws + WS_P1), MOD + (size_t)l * 5 * 6144 + 2048}));
    } else {
      RUN(gemm_run(lds, XN, (const bf16_t*)(p.ws + WS_WQKV) + (size_t)j * QKVD * D, MTOK, QKVD, D, 1, pg8::EpiBf16{(bf16_t*)(p.ws + WS_QKV), QKVD}));
      RUN(phase_qkvpost(p, j));
      RUN(phase_att(p, j, lds));
      RUN(gemm_run(lds, (const bf16_t*)(p.ws + WS_O), (const bf16_t*)(p.ws + WS_WAO) + (size_t)j * D * D, MTOK, D, D, 2, pg8::EpiGate{(bf16_t*)(p.ws + WS_P1), MOD + (size_t)l * 5 * 6144 + 2048}));
    }
    RUN(phase_nm(p, l, 1, true));
    RUN(gemm_run(lds, XN, (const bf16_t*)(p.ws + WS_WGU) + (size_t)l * 2 * DFF * D, MTOK, 2 * DFF, D, 1, pg8::EpiSwiglu{(bf16_t*)(p.ws + WS_H)}));
    RUN(gemm_run(lds, (const bf16_t*)(p.ws + WS_H), (const bf16_t*)(p.ws + WS_WDN) + (size_t)l * D * DFF, MTOK, D, DFF, 2, pg8::EpiGate{(bf16_t*)(p.ws + WS_P1), MOD + (size_t)l * 5 * 6144 + 5 * 1024}));
  }
  RUN(phase_final(p));
#undef RUN
}
constexpr int N_PHASES = 2 + 2 * 7 + 2 * 8 + 1;


extern "C" void kernel_launch(void* const* d_in, const int* in_sizes, int n_in, void* d_out, int out_size, void* d_ws, size_t ws_size, hipStream_t stream) {
  static int grid = 0;
  if (grid == 0) {
    if (n_in != 29 || ws_size < WS_END) { fprintf(stderr, "kernel_launch: n_in %d ws %zu (need 29, >= %zu)\n", n_in, ws_size, (size_t)WS_END); grid = -1; return; }
    int dev = 0, cus = 0, per_cu = 0;
    hipGetDevice(&dev);
    hipDeviceGetAttribute(&cus, hipDeviceAttributeMultiprocessorCount, dev);
    if (hipFuncSetAttribute((const void*)mega, hipFuncAttributeMaxDynamicSharedMemorySize, LDS_BYTES) != hipSuccess) { fprintf(stderr, "kernel_launch: hipFuncSetAttribute failed\n"); grid = -1; return; }
    hipOccupancyMaxActiveBlocksPerMultiprocessor(&per_cu, (const void*)mega, 512, LDS_BYTES);
    if (per_cu < 1) { fprintf(stderr, "kernel_launch: occupancy query says %d blocks per CU\n", per_cu); per_cu = 1; }
    grid = cus * per_cu;
  }
  if (grid < 0) return;
  Params p{};
  for (int i = 0; i < 29; ++i) p.in[i] = (const float*)d_in[i];
  p.out = (float*)d_out; p.ws = (unsigned char*)d_ws;

  if (hipMemsetAsync(d_ws, 0, 16384, stream) != hipSuccess) { fprintf(stderr, "kernel_launch: memset of the barrier words failed\n"); return; }
  p.ph_lo = 0; p.ph_hi = N_PHASES;
  void* args[] = {&p};
  hipError_t e = hipLaunchCooperativeKernel((const void*)mega, dim3(grid), dim3(512), args, LDS_BYTES, stream);
  if (e != hipSuccess) fprintf(stderr, "cooperative launch failed: %s (grid %d)\n", hipGetErrorString(e), grid);

}
```

```cpp
#include <hip/hip_runtime.h>
#include <hip/hip_cooperative_groups.h>
#include <cstdio>
#include <cstdint>
namespace cg = cooperative_groups;

typedef unsigned short bf16_t;
typedef short bf16x8 __attribute__((ext_vector_type(8)));
typedef float f32x4 __attribute__((ext_vector_type(4)));
typedef unsigned u32x4 __attribute__((ext_vector_type(4)));
typedef float f32x16 __attribute__((ext_vector_type(16)));

constexpr int D = 1024, MTOK = 8192, NPR = 4096;
constexpr int DFF = 2816, QKVD = 1536;
constexpr float EPS = 1e-6f;
constexpr float MIN_DECAY = -3.0701134573253944f, MAX_DECAY = -15.350567286626972f;

constexpr size_t MiB = 1u << 20;
constexpr size_t WS_MOD = 1 * MiB, WS_MODP = 2 * MiB, WS_FSQP = 6 * MiB, WS_RNORM = 7 * MiB, WS_FILT = 8 * MiB;
constexpr size_t WS_WIN = 28 * MiB, WS_WHO = 40 * MiB, WS_WQKV = 44 * MiB, WS_WAO = 50 * MiB, WS_WGU = 54 * MiB, WS_WDN = 98 * MiB;
constexpr size_t WS_Y = 120 * MiB, WS_XN = 152 * MiB, WS_R = 168 * MiB;
constexpr size_t WS_ZT = WS_R, WS_YG = WS_R + 48 * MiB, WS_P1 = WS_R + 64 * MiB;
constexpr size_t P1_HALF = (size_t)MTOK * D;
constexpr size_t WS_QKV = WS_R, WS_Q = WS_R + 24 * MiB, WS_KP = WS_R + 40 * MiB, WS_VP = WS_R + 42 * MiB, WS_O = WS_R + 44 * MiB;
constexpr size_t WS_H = WS_R;
constexpr size_t WS_KS = WS_R + 96 * MiB, WS_VS = WS_R + 102 * MiB, WS_FRG = WS_R + 108 * MiB, WS_END = WS_R + 130 * MiB;
constexpr size_t FRG_J = 11 * MiB / 2, FRG_L1 = (size_t)1024 * (4 * 256 + 40);
constexpr size_t FILT_J = 10 * MiB / 4;
constexpr size_t FILT_L1 = 1024 * 512;

constexpr int LDS_BYTES = 147456;

struct Params {
  const float* in[29];
  float* out;
  unsigned char* ws;
  int ph_lo, ph_hi;
};
enum { I_XP = 0, I_XS, I_CK, I_CV, I_C, I_CCTX, I_MODW, I_MODB, I_NMIX, I_NFFN, I_HWIN, I_HCW, I_HCB, I_FW1, I_FB1, I_FFREQ, I_FW2, I_FB2, I_FW3,
       I_HBIAS, I_HWOUT, I_WQKV, I_QN, I_KN, I_WAO, I_WG, I_WU, I_WD, I_FN };

__device__ __forceinline__ bf16_t f2bf(float f) { unsigned u = __float_as_uint(f); u += 0x7FFFu + ((u >> 16) & 1u); return (bf16_t)(u >> 16); }
__device__ __forceinline__ float bf2f(bf16_t b) { return __uint_as_float(((unsigned)b) << 16); }
__device__ __forceinline__ unsigned pack2(float lo, float hi) { return (unsigned)f2bf(lo) | ((unsigned)f2bf(hi) << 16); }
__device__ __forceinline__ float wave_sum(float v) {
#pragma unroll
  for (int o = 32; o >= 1; o >>= 1) v += __shfl_xor(v, o);
  return v;
}
__device__ __forceinline__ float wave_max(float v) {
#pragma unroll
  for (int o = 32; o >= 1; o >>= 1) v = fmaxf(v, __shfl_xor(v, o));
  return v;
}
__device__ __forceinline__ int tidx() { int t = threadIdx.x; asm volatile("" : "+v"(t)); return t; }
__device__ __forceinline__ int cond_of(int m) { return m < NPR ? 4 : ((m - NPR) >> 10); }
__device__ __forceinline__ float silu_f(float x) { return x / (1.f + expf(-x)); }
__device__ __forceinline__ float sin_rev(float r) { return __builtin_amdgcn_sinf(r - rintf(r)); }
__device__ __forceinline__ float cos_rev(float r) { return __builtin_amdgcn_cosf(r - rintf(r)); }
constexpr float INV_2PI = 0.15915494309189535f;

struct TileDesc { const float* src; bf16_t* dst; int K, N, k0, n0, mode; };
constexpr int H_WIN = 16 * 24, H_WHO = 16 * 8, H_WQKV = 16 * 12, H_WAO = 16 * 8, H_G = 2 * 16 * 22, H_DN = 2 * 44 * 8;
constexpr int NT_CVT_HALF = H_WIN + H_WHO + H_WQKV + H_WAO + 2 * H_G + H_DN;
__device__ __forceinline__ TileDesc cvt_decode(const Params& p, int t, int late) {
  TileDesc d;
  if (t < H_WIN) { const int l = late, r = t; d.src = p.in[I_HWIN] + (size_t)l * D * 3072; d.dst = (bf16_t*)(p.ws + WS_WIN) + (size_t)l * 3072 * D; d.K = D; d.N = 3072; d.k0 = (r / 24) * 64; d.n0 = (r % 24) * 128; d.mode = 0; return d; }
  t -= H_WIN;
  if (t < H_WHO) { const int l = late, r = t; d.src = p.in[I_HWOUT] + (size_t)l * D * D; d.dst = (bf16_t*)(p.ws + WS_WHO) + (size_t)l * D * D; d.K = D; d.N = D; d.k0 = (r / 8) * 64; d.n0 = (r % 8) * 128; d.mode = 0; return d; }
  t -= H_WHO;
  if (t < H_WQKV) { const int l = late, r = t; d.src = p.in[I_WQKV] + (size_t)l * D * QKVD; d.dst = (bf16_t*)(p.ws + WS_WQKV) + (size_t)l * QKVD * D; d.K = D; d.N = QKVD; d.k0 = (r / 12) * 64; d.n0 = (r % 12) * 128; d.mode = 0; return d; }
  t -= H_WQKV;
  if (t < H_WAO) { const int l = late, r = t; d.src = p.in[I_WAO] + (size_t)l * D * D; d.dst = (bf16_t*)(p.ws + WS_WAO) + (size_t)l * D * D; d.K = D; d.N = D; d.k0 = (r / 8) * 64; d.n0 = (r % 8) * 128; d.mode = 0; return d; }
  t -= H_WAO;
  if (t < 2 * H_G) { const int up = t >= H_G ? 1 : 0; t -= up * H_G; const int l = 2 * late + t / (16 * 22), r = t % (16 * 22);
    d.src = p.in[up ? I_WU : I_WG] + (size_t)l * D * DFF; d.dst = (bf16_t*)(p.ws + WS_WGU) + (size_t)l * 2 * DFF * D; d.K = D; d.N = DFF; d.k0 = (r / 22) * 64; d.n0 = (r % 22) * 128; d.mode = 1 + up; return d; }
  t -= 2 * H_G;
  { const int l = 2 * late + t / (44 * 8), r = t % (44 * 8); d.src = p.in[I_WD] + (size_t)l * DFF * D; d.dst = (bf16_t*)(p.ws + WS_WDN) + (size_t)l * D * DFF; d.K = DFF; d.N = D; d.k0 = (r / 8) * 64; d.n0 = (r % 8) * 128; d.mode = 0; return d; }
}
__device__ __forceinline__ void cvt_load(const TileDesc& d, int tid, f32x4 (&v)[4]) {
  const int r = tid >> 5, c4 = (tid & 31) * 4;
#pragma unroll
  for (int h = 0; h < 4; ++h) v[h] = *(const f32x4*)(d.src + (size_t)(d.k0 + r + 16 * h) * d.N + d.n0 + c4);
}
__device__ __forceinline__ void cvt_to_lds(float* tile, int tid, const f32x4 (&v)[4]) {
  const int r = tid >> 5, c4 = (tid & 31) * 4;
#pragma unroll
  for (int h = 0; h < 4; ++h) { float* q = tile + (r + 16 * h) * 129 + c4; q[0] = v[h][0]; q[1] = v[h][1]; q[2] = v[h][2]; q[3] = v[h][3]; }
}
__device__ __forceinline__ void cvt_store(const TileDesc& cur, const float* tile, int tid) {
  const int n = tid >> 2, kc = (tid & 3) * 16;
  u32x4 w0, w1;
  w0.x = pack2(tile[(kc + 0) * 129 + n], tile[(kc + 1) * 129 + n]); w0.y = pack2(tile[(kc + 2) * 129 + n], tile[(kc + 3) * 129 + n]);
  w0.z = pack2(tile[(kc + 4) * 129 + n], tile[(kc + 5) * 129 + n]); w0.w = pack2(tile[(kc + 6) * 129 + n], tile[(kc + 7) * 129 + n]);
  w1.x = pack2(tile[(kc + 8) * 129 + n], tile[(kc + 9) * 129 + n]); w1.y = pack2(tile[(kc + 10) * 129 + n], tile[(kc + 11) * 129 + n]);
  w1.z = pack2(tile[(kc + 12) * 129 + n], tile[(kc + 13) * 129 + n]); w1.w = pack2(tile[(kc + 14) * 129 + n], tile[(kc + 15) * 129 + n]);
  const int ng = cur.n0 + n;
  const int row = cur.mode == 0 ? ng : ((ng >> 7) * 256 + (ng & 127) + (cur.mode == 2 ? 128 : 0));
  bf16_t* o = cur.dst + (size_t)row * cur.K + cur.k0 + kc;
  *(u32x4*)o = w0; *(u32x4*)(o + 8) = w1;
}
__device__ void cvt_all(const Params& p, float* lds_f, int late, int start, int count, int stride) {
  const int tid = tidx();
  float* tileA = lds_f; float* tileB = lds_f + 64 * 129 + 64;
  if (count <= 0) return;
  TileDesc d0 = cvt_decode(p, start, late), d1 = d0;
  f32x4 va[4], vb[4];
  cvt_load(d0, tid, va);
  if (count > 1) { d1 = cvt_decode(p, start + stride, late); cvt_load(d1, tid, vb); }
  __syncthreads();
  for (int i = 0;; i += 2) {
    cvt_to_lds(tileA, tid, va);
    const TileDesc ca = d0;
    const bool hasA = i + 2 < count;
    if (hasA) { d0 = cvt_decode(p, start + (i + 2) * stride, late); cvt_load(d0, tid, va); }
    __syncthreads();
    cvt_store(ca, tileA, tid);
    if (i + 1 >= count) break;
    cvt_to_lds(tileB, tid, vb);
    const TileDesc cb = d1;
    const bool hasB = i + 3 < count;
    if (hasB) { d1 = cvt_decode(p, start + (i + 3) * stride, late); cvt_load(d1, tid, vb); }
    __syncthreads();
    cvt_store(cb, tileB, tid);
    if (!hasA) break;
  }
  __syncthreads();
}

constexpr int NT_MOD = 4 * 3 * 16;
__device__ void task_mod(const Params& p, int t, float* sl  ) {
  const int tid = tidx();
  const int l = t / 48, rem = t % 48, cb = rem / 16, kc = rem % 16;
  __syncthreads();
  if (tid < 320) {
    const int j = tid >> 6, k = kc * 64 + (tid & 63);
    const float x = j < 4 ? p.in[I_C][j * D + k] : p.in[I_CCTX][k];
    sl[tid] = silu_f(x);
  }
  __syncthreads();
  const int n = cb * 2048 + tid * 4;
  const float* w = p.in[I_MODW] + ((size_t)l * D + kc * 64) * 6144 + n;
  f32x4 a0 = {0.f, 0.f, 0.f, 0.f}, a1 = a0, a2 = a0, a3 = a0, a4 = a0;
#pragma unroll 8
  for (int k = 0; k < 64; ++k) {
    const f32x4 wv = *(const f32x4*)(w + (size_t)k * 6144);
    a0 += wv * sl[k]; a1 += wv * sl[64 + k]; a2 += wv * sl[128 + k]; a3 += wv * sl[192 + k]; a4 += wv * sl[256 + k];
  }
  float* o = (float*)(p.ws + WS_ZT) + ((size_t)(kc * 4 + l) * 5) * 6144 + n;
  *(f32x4*)o = a0; *(f32x4*)(o + 6144) = a1; *(f32x4*)(o + 2 * 6144) = a2; *(f32x4*)(o + 3 * 6144) = a3; *(f32x4*)(o + 4 * 6144) = a4;
}

constexpr int NT_FILT = 320;
constexpr int FL_H1 = 0, FL_H2 = 4160, FL_W1 = 8320, FL_W2 = FL_W1 + 2112, FL_W3 = FL_W2 + 4096, FL_END = FL_W3 + 16384;
__device__ void task_filt(const Params& p, int t, float* fl) {
  const int tid = tidx(), lane = tid & 63, wid = __builtin_amdgcn_readfirstlane(tid >> 6);
  const int combo = t >> 3, nchunk = t & 7;
  const int j = combo / 20, r = combo % 20;
  const int lsel = r < 4 ? 0 : 1, tchunk = r < 4 ? r : r - 4, L = lsel ? 1024 : 256;
  const int tt = lane, tpos = tchunk * 64 + tt;
  const float tn = (float)tpos / (float)L;
  float* h1 = fl + FL_H1; float* h2 = fl + FL_H2; float* w1 = fl + FL_W1; float* w2 = fl + FL_W2; float* w3 = fl + FL_W3;
  const float* b1 = p.in[I_FB1] + j * 64; const float* fr = p.in[I_FFREQ] + j * 128; const float* b2 = p.in[I_FB2] + j * 64;
  __syncthreads();
  {
    const f32x4* g1 = (const f32x4*)(p.in[I_FW1] + (size_t)j * 33 * 64); const f32x4* g2 = (const f32x4*)(p.in[I_FW2] + (size_t)j * 64 * 64);
    const float* g3 = p.in[I_FW3] + (size_t)j * 64 * 2048 + nchunk * 256;
    for (int i = tid; i < 528; i += 512) ((f32x4*)w1)[i] = g1[i];
    for (int i = tid; i < 1024; i += 512) ((f32x4*)w2)[i] = g2[i];
#pragma unroll
    for (int h = 0; h < 8; ++h) { const int i = tid + 512 * h, v = i >> 6, c4 = (i & 63) * 4; *(f32x4*)(w3 + v * 256 + c4) = *(const f32x4*)(g3 + (size_t)v * 2048 + c4); }
  }
  __syncthreads();
  const int u0 = wid * 8;
  {
    float acc[8];
#pragma unroll
    for (int uu = 0; uu < 8; ++uu) acc[uu] = tn * w1[u0 + uu];
#pragma unroll 4
    for (int b = 1; b <= 16; ++b) {
      const float rev = tn * (float)b;
      const float cs = cos_rev(rev), sn = sin_rev(rev);
#pragma unroll
      for (int uu = 0; uu < 8; ++uu) acc[uu] += cs * w1[b * 64 + u0 + uu] + sn * w1[(16 + b) * 64 + u0 + uu];
    }
#pragma unroll
    for (int uu = 0; uu < 8; ++uu) h1[tt * 65 + u0 + uu] = sin_rev(INV_2PI * (fr[u0 + uu] * (acc[uu] + b1[u0 + uu])));
  }
  __syncthreads();
  {
    float acc[8];
#pragma unroll
    for (int uu = 0; uu < 8; ++uu) acc[uu] = 0.f;
#pragma unroll 8
    for (int v = 0; v < 64; ++v) {
      const float hv = h1[tt * 65 + v];
#pragma unroll
      for (int uu = 0; uu < 8; ++uu) acc[uu] += hv * w2[v * 64 + u0 + uu];
    }
#pragma unroll
    for (int uu = 0; uu < 8; ++uu) h2[tt * 65 + u0 + uu] = sin_rev(INV_2PI * (fr[64 + u0 + uu] * (acc[uu] + b2[u0 + uu])));
  }
  __syncthreads();
  float* fsq = (float*)(p.ws + WS_FSQP) + ((size_t)((j * 2 + lsel) * 16 + tchunk)) * 2048;
  const int nb = nchunk * 256 + wid * 32;
  float acc[32];
#pragma unroll
  for (int q = 0; q < 32; ++q) acc[q] = 0.f;
#pragma unroll 4
  for (int v = 0; v < 64; ++v) {
    const float hv = h2[tt * 65 + v];
    const float* wr = w3 + v * 256 + wid * 32;
#pragma unroll
    for (int q = 0; q < 32; ++q) acc[q] += hv * wr[q];
  }
#pragma unroll
  for (int q = 0; q < 32; ++q) {
    const int n = nb + q, c = n & 1023; const bool isb = n >= 1024;
    const float delta = fabsf(MIN_DECAY + (MAX_DECAY - MIN_DECAY) * ((float)c / 1023.f));
    float val = acc[q] * __expf(-tn * delta);
    if (isb && tpos == 0) val = 0.f;
    bf16_t* rec = (bf16_t*)(p.ws + WS_FRG) + (size_t)j * FRG_J + (lsel ? FRG_L1 : 0) + (size_t)c * (4 * L + 40);
    if (isb && tpos == 0) rec[0] = 0;
    else { const int i = isb ? (L + tpos) : (L - tpos); const bf16_t bv = f2bf(val); rec[i] = bv; rec[2 * L + 40 + i - 1] = bv; }
    acc[q] = val * val;
  }
  __syncthreads();
#pragma unroll
  for (int q = 0; q < 32; ++q) h1[(wid * 32 + q) * 65 + lane] = acc[q];
  __syncthreads();
  if (tid < 256) { float s = 0.f; for (int k = 0; k < 64; ++k) s += h1[tid * 65 + ((k + tid) & 63)]; fsq[nchunk * 256 + tid] = s; }
}

__device__ void phase_p0(const Params& p, unsigned char* lds) {
  float* fl = (float*)lds;
  const int G = gridDim.x, b = blockIdx.x, tid = tidx();
  for (int t = b; t < NT_FILT + NT_MOD / 2; t += G) {
    __syncthreads();
    if (t < NT_FILT) task_filt(p, t, fl);
    else task_mod(p, t - NT_FILT, fl);
  }
  cvt_all(p, fl, 0, b, (NT_CVT_HALF - b + G - 1) / G, G);
  {
    bf16_t* KS = (bf16_t*)(p.ws + WS_KS); bf16_t* VS = (bf16_t*)(p.ws + WS_VS);
    const int n = 4 * 2 * 512 * 256;
    for (int i = b * 512 + tid; i < n; i += G * 512) {
      const int e = i & 255, pos = (i >> 8) & 511, j = (i >> 17) & 1, bb = i >> 18;
      const size_t o = ((size_t)(j * 4 + bb) * 1536 + 1024 + pos) * 256 + e;
      KS[o] = f2bf(p.in[I_CK][i]); VS[o] = f2bf(p.in[I_CV][i]);
    }
  }
}

__device__ void mod_finalize(const Params& p, int late) {
  const int G = gridDim.x, b = blockIdx.x, tid = tidx();
  float* MOD = (float*)(p.ws + WS_MOD); const float* MP = (const float*)(p.ws + WS_ZT);
  for (int i = late * (2 * 5 * 6144) + b * 512 + tid; i < (late + 1) * (2 * 5 * 6144); i += G * 512) {
    const int n = i % 6144, l = i / (5 * 6144);
    float s = p.in[I_MODB][l * 6144 + n];
#pragma unroll
    for (int kc = 0; kc < 16; ++kc) s += MP[(size_t)kc * (4 * 5 * 6144) + i];
    MOD[i] = s;
  }
}
__device__ void phase_p0b(const Params& p) {
  const int G = gridDim.x, b = blockIdx.x, tid = tidx();
  mod_finalize(p, 0);
  float* RN = (float*)(p.ws + WS_RNORM); const float* FS = (const float*)(p.ws + WS_FSQP);
  for (int i = b * 512 + tid; i < 4096; i += G * 512) {
    const int c = i & 1023, jl = i >> 10, nch = (jl & 1) ? 16 : 4;
    float s = 0.f;
    for (int ch = 0; ch < nch; ++ch) s += FS[((size_t)jl * 16 + ch) * 2048 + c] + FS[((size_t)jl * 16 + ch) * 2048 + 1024 + c];
    RN[i] = 1.f / sqrtf(s + EPS);
  }
}

__device__ void phase_nm(const Params& p, int layer, int which, bool addp) {
  const int lane = tidx() & 63, wid = tidx() >> 6;
  float* Y = (float*)(p.ws + WS_Y); const bf16_t* P1 = (const bf16_t*)(p.ws + WS_P1); bf16_t* XN = (bf16_t*)(p.ws + WS_XN);
  const float* g = p.in[which ? I_NFFN : I_NMIX] + layer * D;
  const int stride = gridDim.x * 8;
  for (int ma = blockIdx.x * 8 + wid; ma < MTOK; ma += 2 * stride) {
    const int mb = ma + stride; const bool hb = mb < MTOK;
    f32x4 v[2][4]; uint2 pa[2][4], pb[2][4];
#pragma unroll
    for (int r = 0; r < 2; ++r) {
      const int m = r == 0 ? ma : (hb ? mb : ma);
      const float* src = layer == 0 ? (m < NPR ? p.in[I_XP] + (size_t)m * D : p.in[I_XS] + (size_t)(m - NPR) * D) : Y + (size_t)m * D;
#pragma unroll
      for (int i = 0; i < 4; ++i) { v[r][i] = *(const f32x4*)(src + i * 256 + lane * 4);
        if (addp) { pa[r][i] = *(const uint2*)(P1 + (size_t)m * D + i * 256 + lane * 4); pb[r][i] = *(const uint2*)(P1 + P1_HALF + (size_t)m * D + i * 256 + lane * 4); } }
    }
#pragma unroll
    for (int r = 0; r < 2; ++r) if (r == 0 || hb) {
      const int m = r == 0 ? ma : mb;
      float ss = 0.f;
#pragma unroll
      for (int i = 0; i < 4; ++i) {
        if (addp) {
          v[r][i][0] += __uint_as_float(pa[r][i].x << 16) + __uint_as_float(pb[r][i].x << 16); v[r][i][1] += __uint_as_float(pa[r][i].x & 0xFFFF0000u) + __uint_as_float(pb[r][i].x & 0xFFFF0000u);
          v[r][i][2] += __uint_as_float(pa[r][i].y << 16) + __uint_as_float(pb[r][i].y << 16); v[r][i][3] += __uint_as_float(pa[r][i].y & 0xFFFF0000u) + __uint_as_float(pb[r][i].y & 0xFFFF0000u);
          *(f32x4*)(Y + (size_t)m * D + i * 256 + lane * 4) = v[r][i]; }
        ss += v[r][i][0] * v[r][i][0] + v[r][i][1] * v[r][i][1] + v[r][i][2] * v[r][i][2] + v[r][i][3] * v[r][i][3]; }
      ss = wave_sum(ss);
      const float rs = rsqrtf(ss * (1.f / D) + EPS);
      const float* mod = (const float*)(p.ws + WS_MOD) + (size_t)(layer * 5 + cond_of(m)) * 6144 + which * 3072;
#pragma unroll
      for (int i = 0; i < 4; ++i) {
        const int k = i * 256 + lane * 4;
        const f32x4 gg = *(const f32x4*)(g + k), sh = *(const f32x4*)(mod + k), sc = *(const f32x4*)(mod + 1024 + k);
        float o[4];
#pragma unroll
        for (int e = 0; e < 4; ++e) o[e] = (v[r][i][e] * rs * gg[e]) * (1.f + sc[e]) + sh[e];
        uint2 w; w.x = pack2(o[0], o[1]); w.y = pack2(o[2], o[3]);
        *(uint2*)(XN + (size_t)m * D + k) = w;
      }
    }
  }
}

__device__ void phase_final(const Params& p) {
  const int lane = tidx() & 63, wid = tidx() >> 6;
  const float* Y = (const float*)(p.ws + WS_Y);
  const float* g = p.in[I_FN];
  for (int m = blockIdx.x * 8 + wid; m < MTOK; m += gridDim.x * 8) {
    const float* y = Y + (size_t)m * D;
    f32x4 v[4]; float ss = 0.f;
#pragma unroll
    for (int i = 0; i < 4; ++i) { v[i] = *(const f32x4*)(y + i * 256 + lane * 4);
      { const bf16_t* P1 = (const bf16_t*)(p.ws + WS_P1); const uint2 pa = *(const uint2*)(P1 + (size_t)m * D + i * 256 + lane * 4), pb = *(const uint2*)(P1 + P1_HALF + (size_t)m * D + i * 256 + lane * 4);
        v[i][0] += __uint_as_float(pa.x << 16) + __uint_as_float(pb.x << 16); v[i][1] += __uint_as_float(pa.x & 0xFFFF0000u) + __uint_as_float(pb.x & 0xFFFF0000u);
        v[i][2] += __uint_as_float(pa.y << 16) + __uint_as_float(pb.y << 16); v[i][3] += __uint_as_float(pa.y & 0xFFFF0000u) + __uint_as_float(pb.y & 0xFFFF0000u); }
      ss += v[i][0] * v[i][0] + v[i][1] * v[i][1] + v[i][2] * v[i][2] + v[i][3] * v[i][3]; }
    ss = wave_sum(ss);
    const float r = rsqrtf(ss * (1.f / D) + EPS);
#pragma unroll
    for (int i = 0; i < 4; ++i) {
      const int k = i * 256 + lane * 4;
      const f32x4 gg = *(const f32x4*)(g + k);
      f32x4 o; o[0] = v[i][0] * r * gg[0]; o[1] = v[i][1] * r * gg[1]; o[2] = v[i][2] * r * gg[2]; o[3] = v[i][3] * r * gg[3];
      *(f32x4*)(p.out + (size_t)m * D + k) = o;
    }
  }
}


namespace pg8 {
#define PG8_LAS __attribute__((address_space(3)))
constexpr int BM = 256, BK = 64, HALF = 128, HTB = HALF * BK * 2, STAGE_BYTES = 8 * HTB, NXCD = 8, WGM = 8;
__host__ __device__ __forceinline__ int lds_byte(int r, int c) { const int st = (r >> 4) * 2 + (c >> 5), rr = r & 15, cc = c & 31, ob = rr * 64 + cc * 2; return st * 1024 + (ob ^ (((ob >> 9) & 1) << 5)); }
__host__ __device__ __forceinline__ void stage_rc(int b, int& R, int& C) { const int st = b / 1024, sb = b % 1024, swz = sb ^ (((sb >> 9) & 1) << 5); R = (st >> 1) * 16 + swz / 64; C = (st & 1) * 32 + (swz % 64) / 2; }
__host__ __device__ __forceinline__ int perm32(int rho) { const int n = rho >> 4, i = rho & 15; return 8 * (i >> 2) + 4 * n + (i & 3); }
struct Unit { int pm, pn, ks; };
struct Gemm { const bf16_t* A; const bf16_t* Bt; int M, N, K, ld; };
struct StaticOrder {
    int nM, nN, nwg, G, c, KS;
    __device__ void init(int M, int N, int KS_, int G_, int c_) { nM = M / BM; KS = KS_; nN = (N / BM) * KS_; nwg = nM * nN; G = G_; c = c_; }
    __device__ bool next(int i, Unit& u) const {
        const long L = (long)i * G + c; if (L >= nwg) return false;
        int wgid = (int)L; { const int q = nwg / NXCD, r = nwg % NXCD, xcd = wgid % NXCD, off = wgid / NXCD; wgid = (xcd < r ? xcd * (q + 1) : r * (q + 1) + (xcd - r) * q) + off; }
        const int nig = WGM * nN, gid = wgid / nig, fm = gid * WGM, gsz = (nM - fm) < WGM ? (nM - fm) : WGM;
        u.pm = fm + ((wgid % nig) % gsz); const int pn2 = (wgid % nig) / gsz; u.pn = pn2 / KS; u.ks = pn2 % KS; return true;
    }
    __device__ __forceinline__ void a_ready(const Unit&) const {}
    __device__ __forceinline__ void done(const Unit&) const {}
};
__device__ __forceinline__ unsigned cvt_pk_bf16(float lo, float hi) { unsigned r; asm volatile("v_cvt_pk_bf16_f32 %0, %1, %2" : "=v"(r) : "v"(lo), "v"(hi)); return r; }
struct EpiBf16 {
    static constexpr bool PERM = true, AFTER_DRAIN = false;
    bf16_t* O; int ldc;
    __device__ __forceinline__ void operator()(const f32x4 (&acc)[2][2][4][2], const Unit& u, int wr, int wc, int fr, int fq) const {
        const int row0 = u.pm * BM + wr * 64 + fr, col0 = u.pn * BM + wc * 32 + 8 * fq;
#pragma unroll
        for (int ai = 0; ai < 2; ++ai)
#pragma unroll
            for (int m = 0; m < 4; ++m) { bf16_t* rowp = O + (size_t)(row0 + ai * HALF + m * 16) * ldc + col0;
#pragma unroll
                for (int bj = 0; bj < 2; ++bj) { const f32x4 v0 = acc[ai][bj][m][0], v1 = acc[ai][bj][m][1];
                    u32x4 w; w.x = cvt_pk_bf16(v0[0], v0[1]); w.y = cvt_pk_bf16(v0[2], v0[3]); w.z = cvt_pk_bf16(v1[0], v1[1]); w.w = cvt_pk_bf16(v1[2], v1[3]);
                    *(u32x4*)(rowp + bj * HALF) = w; } }
    }
};
struct EpiSwiglu {
    static constexpr bool PERM = true, AFTER_DRAIN = false;
    bf16_t* H;
    __device__ __forceinline__ void operator()(const f32x4 (&acc)[2][2][4][2], const Unit& u, int wr, int wc, int fr, int fq) const {
        const int row0 = u.pm * BM + wr * 64 + fr, col0 = u.pn * HALF + wc * 32 + 8 * fq;
#pragma unroll
        for (int ai = 0; ai < 2; ++ai)
#pragma unroll
            for (int m = 0; m < 4; ++m) {
                float h[8];
#pragma unroll
                for (int n = 0; n < 2; ++n)
#pragma unroll
                    for (int e = 0; e < 4; ++e) { const float gv = acc[ai][0][m][n][e], uv = acc[ai][1][m][n][e]; h[4 * n + e] = gv * __builtin_amdgcn_rcpf(1.f + __expf(-gv)) * uv; }
                u32x4 w; w.x = cvt_pk_bf16(h[0], h[1]); w.y = cvt_pk_bf16(h[2], h[3]); w.z = cvt_pk_bf16(h[4], h[5]); w.w = cvt_pk_bf16(h[6], h[7]);
                *(u32x4*)(H + (size_t)(row0 + ai * HALF + m * 16) * DFF + col0) = w; }
    }
};
struct EpiGate {
    static constexpr bool PERM = true, AFTER_DRAIN = false;
    bf16_t* P; const float* gate;
    __device__ __forceinline__ void operator()(const f32x4 (&acc)[2][2][4][2], const Unit& u, int wr, int wc, int fr, int fq) const {
        const int row0 = u.pm * BM + wr * 64 + fr, col0 = u.pn * BM + wc * 32 + 8 * fq;
        bf16_t* const dstb = P + (size_t)u.ks * P1_HALF;
#pragma unroll
        for (int ai = 0; ai < 2; ++ai)
#pragma unroll
            for (int m = 0; m < 4; ++m) { const int row = row0 + ai * HALF + m * 16; const float* gp = gate + cond_of(row) * 6144 + col0; bf16_t* rowp = dstb + (size_t)row * D + col0;
#pragma unroll
                for (int bj = 0; bj < 2; ++bj) { const f32x4 v0 = acc[ai][bj][m][0] * *(const f32x4*)(gp + bj * HALF), v1 = acc[ai][bj][m][1] * *(const f32x4*)(gp + bj * HALF + 4);
                    u32x4 w; w.x = cvt_pk_bf16(v0[0], v0[1]); w.y = cvt_pk_bf16(v0[2], v0[3]); w.z = cvt_pk_bf16(v1[0], v1[1]); w.w = cvt_pk_bf16(v1[2], v1[3]);
                    *(u32x4*)(rowp + bj * HALF) = w; } }
    }
};
template <class Epi, class Sched, bool ALIGN_EPI = false, bool SP2 = false>
__device__ __forceinline__ void gemm_phase(PG8_LAS unsigned char* lds, const Gemm g, const Sched& S, const Epi& E) {
    int tid_ = tidx();
    const int tid = tid_, wid = __builtin_amdgcn_readfirstlane(tid >> 6), lane = tid & 63, wr = wid >> 2, wc = wid & 3, fr = lane & 15, fq = lane >> 4;
    const int K = g.ld, nt = g.K / BK;
    unsigned voffA[2], voffB[2];
#pragma unroll
    for (int i = 0; i < 2; ++i) { int R, C; stage_rc(tid * 16 + i * 8192, R, C); const int Rb = Epi::PERM ? ((R & ~31) + perm32(R & 31)) : R;
        voffA[i] = (unsigned)(R * K + C) * 2u; voffB[i] = (unsigned)(Rb * K + C) * 2u; }
    const size_t kstep = (size_t)(BK * 2);
    const size_t hstep = (size_t)HALF * K * 2;
    const size_t tstep = 2 * hstep;
    const unsigned ldsw = (unsigned)wid * 1024u;
    const int aoff = lds_byte(wr * 64 + fr, fq * 8), boff = lds_byte(wc * 32 + fr, fq * 8);
#define PG8_SA(b, h) (((b) * 2 + (h)) * HTB)
#define PG8_SB(b, h) ((4 + (b) * 2 + (h)) * HTB)
#define PG8_STAGE(bufoff, gbase, voff) do { _Pragma("unroll") for (int _i = 0; _i < 2; ++_i) \
        __builtin_amdgcn_global_load_lds((const unsigned*)((const char*)(gbase) + (voff)[_i]), (PG8_LAS unsigned*)(lds + (bufoff) + ldsw + _i * 8192), 16, 0, 0); } while (0)
#define PG8_LDA(dst, b, h) do { _Pragma("unroll") for (int m = 0; m < 4; ++m) _Pragma("unroll") for (int k = 0; k < 2; ++k) dst[m][k] = *(const PG8_LAS bf16x8*)(lds + PG8_SA(b, h) + aoff + m * 2048 + k * 1024); } while (0)
#define PG8_LDB(dst, b, h) do { _Pragma("unroll") for (int n = 0; n < 2; ++n) _Pragma("unroll") for (int k = 0; k < 2; ++k) dst[n][k] = *(const PG8_LAS bf16x8*)(lds + PG8_SB(b, h) + boff + n * 2048 + k * 1024); } while (0)
#define PG8_MMA(ai, bj, At, Bt) do { __builtin_amdgcn_s_setprio(1); _Pragma("unroll") for (int m = 0; m < 4; ++m) _Pragma("unroll") for (int n = 0; n < 2; ++n) _Pragma("unroll") for (int k = 0; k < 2; ++k) \
        acc[ai][bj][m][n] = __builtin_amdgcn_mfma_f32_16x16x32_bf16(Bt[n][k], At[m][k], acc[ai][bj][m][n], 0, 0, 0); __builtin_amdgcn_s_setprio(0); } while (0)
#define PG8_WAIT_V(n) asm volatile("s_waitcnt vmcnt(" #n ")" ::: "memory")
#define PG8_WAIT_L(n) asm volatile("s_waitcnt lgkmcnt(" #n ")" ::: "memory")
#define PG8_BAR __builtin_amdgcn_s_barrier()
#define PG8_SCHED __builtin_amdgcn_sched_barrier(0)
    Unit cur, nxt; int ui = 0;
    if (!S.next(0, cur)) return;
    f32x4 acc[2][2][4][2];
#pragma unroll
    for (int a = 0; a < 2; ++a)
#pragma unroll
        for (int b = 0; b < 2; ++b)
#pragma unroll
            for (int m = 0; m < 4; ++m)
#pragma unroll
                for (int n = 0; n < 2; ++n) acc[a][b][m][n] = (f32x4){0.f, 0.f, 0.f, 0.f};
    bf16x8 At[4][2], B0[2][2], B1[2][2];
    const size_t ksb = (size_t)g.K * 2; const char* cA = (const char*)g.A + (size_t)cur.pm * tstep + cur.ks * ksb; const char* cB = (const char*)g.Bt + (size_t)cur.pn * tstep + cur.ks * ksb;
    S.a_ready(cur);
    if constexpr (SP2) {
        PG8_STAGE(PG8_SB(0, 0), cB, voffB); PG8_STAGE(PG8_SB(0, 1), cB + hstep, voffB); PG8_STAGE(PG8_SA(0, 0), cA, voffA); PG8_STAGE(PG8_SA(0, 1), cA + hstep, voffA);
        if (wr == 1) PG8_BAR;
        PG8_WAIT_V(2); PG8_BAR;
        PG8_STAGE(PG8_SB(1, 0), cB + kstep, voffB); PG8_STAGE(PG8_SA(1, 0), cA + kstep, voffA); PG8_STAGE(PG8_SB(1, 1), cB + hstep + kstep, voffB);
        PG8_WAIT_V(6); PG8_BAR;
    } else {
        PG8_STAGE(PG8_SB(0, 0), cB, voffB); PG8_STAGE(PG8_SA(0, 0), cA, voffA); PG8_STAGE(PG8_SB(0, 1), cB + hstep, voffB); PG8_STAGE(PG8_SA(0, 1), cA + hstep, voffA);
        if (wr == 1) PG8_BAR;
        PG8_WAIT_V(4); PG8_BAR;
        PG8_STAGE(PG8_SB(1, 0), cB + kstep, voffB); PG8_STAGE(PG8_SA(1, 0), cA + kstep, voffA); PG8_STAGE(PG8_SB(1, 1), cB + hstep + kstep, voffB);
        PG8_WAIT_V(6); PG8_BAR;
    }
    for (;;) {
        const bool has_next = S.next(ui + 1, nxt);
        const char* nA = has_next ? (const char*)g.A + (size_t)nxt.pm * tstep + nxt.ks * ksb : cA; const char* nB = has_next ? (const char*)g.Bt + (size_t)nxt.pn * tstep + nxt.ks * ksb : cB;
        for (int t = 0; t < nt; t += 2) {
            const bool last = (t == nt - 2);
            const char* a1 = cA + (size_t)(t + 1) * kstep;
            const char* a2 = last ? nA : cA + (size_t)(t + 2) * kstep; const char* b2 = last ? nB : cB + (size_t)(t + 2) * kstep;
            const char* a3 = a2 + kstep; const char* b3 = b2 + kstep;
            if (last && has_next) S.a_ready(nxt);
            if constexpr (SP2) {
            PG8_LDB(B0, 0, 0); PG8_LDB(B1, 0, 1); PG8_SCHED; PG8_LDA(At, 0, 0); PG8_STAGE(PG8_SA(1, 1), a1 + hstep, voffA);
            PG8_WAIT_V(8); PG8_WAIT_L(0); PG8_BAR; PG8_MMA(0, 0, At, B0); PG8_MMA(0, 1, At, B1); PG8_BAR; PG8_SCHED;
            PG8_LDA(At, 0, 1); PG8_STAGE(PG8_SB(0, 0), b2, voffB); PG8_STAGE(PG8_SB(0, 1), b2 + hstep, voffB); PG8_STAGE(PG8_SA(0, 0), a2, voffA);
            PG8_WAIT_V(8); PG8_WAIT_L(0); PG8_BAR; PG8_MMA(1, 0, At, B0); PG8_MMA(1, 1, At, B1); PG8_BAR; PG8_SCHED;
            PG8_LDB(B0, 1, 0); PG8_LDB(B1, 1, 1); PG8_SCHED; PG8_LDA(At, 1, 0); PG8_STAGE(PG8_SA(0, 1), a2 + hstep, voffA);
            PG8_WAIT_V(8); PG8_WAIT_L(0); PG8_BAR; PG8_MMA(0, 0, At, B0); PG8_MMA(0, 1, At, B1); PG8_BAR; PG8_SCHED;
            PG8_LDA(At, 1, 1); PG8_STAGE(PG8_SB(1, 0), b3, voffB); PG8_STAGE(PG8_SB(1, 1), b3 + hstep, voffB); PG8_STAGE(PG8_SA(1, 0), a3, voffA);
            PG8_WAIT_V(8); PG8_WAIT_L(0); PG8_BAR; PG8_MMA(1, 0, At, B0); PG8_MMA(1, 1, At, B1); PG8_BAR; PG8_SCHED;
            } else {
            PG8_LDB(B0, 0, 0); PG8_SCHED; PG8_LDA(At, 0, 0); PG8_STAGE(PG8_SA(1, 1), a1 + hstep, voffA);
            PG8_WAIT_L(8); PG8_BAR; PG8_WAIT_L(0); PG8_MMA(0, 0, At, B0); PG8_BAR; PG8_SCHED;
            PG8_LDB(B1, 0, 1); PG8_STAGE(PG8_SB(0, 0), b2, voffB);
            PG8_BAR; PG8_WAIT_L(0); PG8_MMA(0, 1, At, B1); PG8_BAR;
            PG8_LDA(At, 0, 1); PG8_STAGE(PG8_SA(0, 0), a2, voffA);
            PG8_BAR; PG8_WAIT_L(0); PG8_MMA(1, 0, At, B0); PG8_BAR; PG8_SCHED;
            PG8_STAGE(PG8_SB(0, 1), b2 + hstep, voffB);
            PG8_WAIT_V(6); PG8_BAR; PG8_MMA(1, 1, At, B1); PG8_BAR;
            PG8_LDB(B0, 1, 0); PG8_SCHED; PG8_LDA(At, 1, 0); PG8_STAGE(PG8_SA(0, 1), a2 + hstep, voffA);
            PG8_WAIT_L(8); PG8_BAR; PG8_WAIT_L(0); PG8_MMA(0, 0, At, B0); PG8_BAR; PG8_SCHED;
            PG8_LDB(B1, 1, 1); PG8_STAGE(PG8_SB(1, 0), b3, voffB);
            PG8_BAR; PG8_WAIT_L(0); PG8_MMA(0, 1, At, B1); PG8_BAR;
            PG8_LDA(At, 1, 1); PG8_STAGE(PG8_SA(1, 0), a3, voffA);
            PG8_BAR; PG8_WAIT_L(0); PG8_MMA(1, 0, At, B0); PG8_BAR; PG8_SCHED;
            PG8_STAGE(PG8_SB(1, 1), b3 + hstep, voffB);
            PG8_WAIT_V(6); PG8_BAR; PG8_MMA(1, 1, At, B1); PG8_BAR;
            }
        }
        if constexpr (ALIGN_EPI) { if (wr == 0) PG8_BAR; }
        if constexpr (!Epi::AFTER_DRAIN) { E(acc, cur, wr, wc, fr, fq); S.done(cur); }
        if (!has_next) break;
#pragma unroll
        for (int a = 0; a < 2; ++a)
#pragma unroll
            for (int b = 0; b < 2; ++b)
#pragma unroll
                for (int m = 0; m < 4; ++m)
#pragma unroll
                    for (int n = 0; n < 2; ++n) acc[a][b][m][n] = (f32x4){0.f, 0.f, 0.f, 0.f};
        cur = nxt; cA = nA; cB = nB; ++ui;
        if constexpr (ALIGN_EPI) { if (wr == 1) PG8_BAR; }
    }
    PG8_WAIT_V(0);
    if constexpr (!ALIGN_EPI) { if (wr == 0) PG8_BAR; }
    PG8_BAR;
    if constexpr (Epi::AFTER_DRAIN) { E.fused(acc, cur, wr, wc, fr, fq, lds, wid, lane); S.done(cur); }
#undef PG8_SA
#undef PG8_SB
#undef PG8_STAGE
#undef PG8_LDA
#undef PG8_LDB
#undef PG8_MMA
#undef PG8_WAIT_V
#undef PG8_WAIT_L
#undef PG8_BAR
#undef PG8_SCHED
}
}

template <class Epi>
__device__ __forceinline__ void gemm_run(unsigned char* lds, const bf16_t* A, const bf16_t* Bt, int M, int N, int Ktot, int KS, const Epi& E) {
    pg8::StaticOrder S; S.init(M, N, KS, (int)gridDim.x, (int)blockIdx.x);
    pg8::Gemm g; g.A = A; g.Bt = Bt; g.M = M; g.N = N; g.K = Ktot / KS; g.ld = Ktot;
    __syncthreads();
    pg8::gemm_phase<Epi, pg8::StaticOrder, true, true>((PG8_LAS unsigned char*)lds, g, S, E);
    __syncthreads();
}


#define LDSP __attribute__((address_space(3)))
constexpr int LC_FR = 0, LC_U = 66176, LC_X0 = LC_U + 20480, LC_S = LC_X0 + 20480, LC_Z = LC_S + 17408;
__device__ void phase_lc(const Params& p, int j, unsigned char* lds_) {
  LDSP unsigned char* lds = (LDSP unsigned char*)lds_;
  const int tid = tidx(), lane = tid & 63, wid = tid >> 6, n = lane & 31, hi = lane >> 5;
  const bf16_t* ZT = (const bf16_t*)(p.ws + WS_ZT); bf16_t* YG = (bf16_t*)(p.ws + WS_YG);
  const float* cw = p.in[I_HCW] + (size_t)j * 3 * 3072; const float* cb = p.in[I_HCB] + (size_t)j * 3072;
  for (int q = blockIdx.x; q < 1024; q += gridDim.x) {
    const int lsel = q < 512 ? 1 : 0, qq = q & 511, cg = qq >> 2, tb = (lsel ? 4 : 0) + (qq & 3);
    const int L = lsel ? 1024 : 256, P = L >> 5, REC = 4 * L + 40, c0 = cg * 8;
    const size_t m0 = (size_t)tb * 1024;
    __syncthreads();
    {
      const u32x4* src = (const u32x4*)((const bf16_t*)(p.ws + WS_FRG) + (size_t)j * FRG_J + (lsel ? FRG_L1 : 0) + (size_t)c0 * REC);
      LDSP u32x4* dst = (LDSP u32x4*)(lds + LC_FR);
      for (int i = tid; i < REC; i += 512) dst[i] = src[i];
    }
    for (int task = tid; task < 1024; task += 512) {
      const int ch = task >> 7, tok0 = (task & 127) * 8;
      const bool first = (tok0 & (L - 1)) == 0, last = ((tok0 + 8) & (L - 1)) == 0;
      float sc[3][8];
#pragma unroll
      for (int part = 0; part < 3; ++part) {
        const int chn = part * 1024 + c0 + ch;
        const bf16_t* z = ZT + (size_t)chn * MTOK + m0 + tok0;
        const u32x4 w = *(const u32x4*)z;
        float zv[10];
        zv[0] = first ? 0.f : bf2f(z[-1]); zv[9] = last ? 0.f : bf2f(z[8]);
        zv[1] = __uint_as_float(w.x << 16); zv[2] = __uint_as_float(w.x & 0xFFFF0000u); zv[3] = __uint_as_float(w.y << 16); zv[4] = __uint_as_float(w.y & 0xFFFF0000u);
        zv[5] = __uint_as_float(w.z << 16); zv[6] = __uint_as_float(w.z & 0xFFFF0000u); zv[7] = __uint_as_float(w.w << 16); zv[8] = __uint_as_float(w.w & 0xFFFF0000u);
        const float w0 = cw[chn], w1 = cw[3072 + chn], w2 = cw[2 * 3072 + chn], bb = cb[chn];
#pragma unroll
        for (int i = 0; i < 8; ++i) sc[part][i] = zv[i] * w0 + zv[i + 1] * w1 + zv[i + 2] * w2 + bb;
      }
      u32x4 xo, uo;
      xo.x = pack2(sc[0][0], sc[0][1]); xo.y = pack2(sc[0][2], sc[0][3]); xo.z = pack2(sc[0][4], sc[0][5]); xo.w = pack2(sc[0][6], sc[0][7]);
      uo.x = pack2(sc[1][0] * sc[2][0], sc[1][1] * sc[2][1]); uo.y = pack2(sc[1][2] * sc[2][2], sc[1][3] * sc[2][3]);
      uo.z = pack2(sc[1][4] * sc[2][4], sc[1][5] * sc[2][5]); uo.w = pack2(sc[1][6] * sc[2][6], sc[1][7] * sc[2][7]);
      const int po = (ch * 1280 + tok0 + 8 * (tok0 >> 5)) * 2;
      *(LDSP u32x4*)(lds + LC_U + po) = uo; *(LDSP u32x4*)(lds + LC_X0 + po) = xo;
    }
    if (tid < 4) ((LDSP unsigned*)(lds + LC_Z))[tid] = 0u;
    __syncthreads();
    f32x16 acc;
#pragma unroll
    for (int r = 0; r < 16; ++r) acc[r] = 0.f;
    {
      const int par = n & 1;
      LDSP const unsigned char* fa = lds + LC_FR + wid * (REC * 2) + (par ? (2 * L + 40) * 2 : 0) + 2 * (L - n - par + 8 * hi);
      LDSP const unsigned char* ub = lds + LC_U + wid * 2560 + (40 * n + 8 * hi) * 2;
      const int ti = n & (P - 1);
#define LC_LOAD(s_, AW, BF) do { const int dl_ = ((s_) >> 1) - (P - 1), ks_ = (s_) & 1; \
        LDSP const volatile unsigned* ap_ = (LDSP const volatile unsigned*)(fa + 2 * (-32 * dl_ + 16 * ks_)); \
        AW.x = ap_[0]; AW.y = ap_[1]; AW.z = ap_[2]; AW.w = ap_[3]; \
        LDSP const unsigned char* bp_ = ((unsigned)(ti - dl_) < (unsigned)P) ? (ub + (-40 * dl_ + 16 * ks_) * 2) : (lds + LC_Z); \
        BF = *(LDSP const volatile bf16x8*)bp_; } while (0)
      const int nsteps = 2 * (2 * P - 1);
      u32x4 a0, a1; bf16x8 b0, b1;
      LC_LOAD(0, a0, b0);
      for (int s2 = 0; s2 < nsteps; s2 += 2) {
        LC_LOAD(s2 + 1, a1, b1);
        acc = __builtin_amdgcn_mfma_f32_32x32x16_bf16(__builtin_bit_cast(bf16x8, a0), b0, acc, 0, 0, 0);
        if (s2 + 2 < nsteps) LC_LOAD(s2 + 2, a0, b0);
        acc = __builtin_amdgcn_mfma_f32_32x32x16_bf16(__builtin_bit_cast(bf16x8, a1), b1, acc, 0, 0, 0);
      }
#undef LC_LOAD
    }
    {
      const float rn = ((const float*)(p.ws + WS_RNORM))[(j * 2 + lsel) * 1024 + c0 + wid], bs = p.in[I_HBIAS][j * D + c0 + wid];
      LDSP const bf16_t* uu = (LDSP const bf16_t*)(lds + LC_U) + wid * 1280 + 40 * n;
      LDSP const bf16_t* xx = (LDSP const bf16_t*)(lds + LC_X0) + wid * 1280 + 40 * n;
      LDSP bf16_t* so = (LDSP bf16_t*)(lds + LC_S) + wid * 1088 + 34 * n;
#pragma unroll
      for (int r = 0; r < 16; ++r) {
        const int row = (r & 3) + 8 * (r >> 2) + 4 * hi;
        const float y = acc[r] * rn + bf2f(uu[row]) * bs;
        so[row] = f2bf(bf2f(xx[row]) * y);
      }
    }
    __syncthreads();
    for (int tok = tid; tok < 1024; tok += 512) {
      LDSP const bf16_t* so = (LDSP const bf16_t*)(lds + LC_S) + tok + 2 * (tok >> 5);
      u32x4 w;
      w.x = (unsigned)so[0] | ((unsigned)so[1088] << 16); w.y = (unsigned)so[2 * 1088] | ((unsigned)so[3 * 1088] << 16);
      w.z = (unsigned)so[4 * 1088] | ((unsigned)so[5 * 1088] << 16); w.w = (unsigned)so[6 * 1088] | ((unsigned)so[7 * 1088] << 16);
      *(u32x4*)(YG + (m0 + tok) * D + c0) = w;
    }
  }
  __syncthreads();
}

__device__ void phase_qkvpost(const Params& p, int j) {
  const int lane = tidx() & 63, wid = tidx() >> 6;
  const unsigned* QKV = (const unsigned*)(p.ws + WS_QKV);
  unsigned* Q = (unsigned*)(p.ws + WS_Q); unsigned* KP = (unsigned*)(p.ws + WS_KP); unsigned* VP = (unsigned*)(p.ws + WS_VP);
  unsigned* KS = (unsigned*)(p.ws + WS_KS) + (size_t)j * 4 * 1536 * 128; unsigned* VS = (unsigned*)(p.ws + WS_VS) + (size_t)j * 4 * 1536 * 128;
  const float* qn = p.in[I_QN] + j * 128; const float* kn = p.in[I_KN] + j * 128;
  float* newk = p.out + (size_t)2 * NPR * D; float* newv = newk + (size_t)16 * 2 * 256 * 256;
  const float qg0 = qn[2 * lane], qg1 = qn[2 * lane + 1], kg0 = kn[2 * lane], kg1 = kn[2 * lane + 1];
  const float freq = exp2f(-(float)(lane & 31) * 0.41524101186092029f);
  for (int m = blockIdx.x * 8 + wid; m < MTOK; m += gridDim.x * 8) {
    const bool smp = m >= NPR;
    float cs = 1.f, sn = 0.f;
    if (smp) { const int t = (m - NPR) & 1023; const float pos = (float)(lane < 32 ? (t >> 6) : (t & 63)); const float rev = (pos * freq) * INV_2PI; cs = cos_rev(rev); sn = sin_rev(rev); }
#pragma unroll
    for (int s = 0; s < 12; ++s) {
      const unsigned raw = QKV[(size_t)m * 768 + s * 64 + lane];
      float x0 = __uint_as_float(raw << 16), x1 = __uint_as_float(raw & 0xFFFF0000u);
      if (s < 10) {
        const float ss = wave_sum(x0 * x0 + x1 * x1);
        const float r = rsqrtf(ss * (1.f / 128.f) + EPS);
        x0 = x0 * r * (s < 8 ? qg0 : kg0); x1 = x1 * r * (s < 8 ? qg1 : kg1);
        if (smp) { const float a = x0, b = x1; x0 = a * cs - b * sn; x1 = a * sn + b * cs; }
      }
      const unsigned w = pack2(x0, x1);
      if (s < 8) Q[(size_t)m * 512 + s * 64 + lane] = w;
      else {
        const int kv = (s - 8) & 1; const bool isk = s < 10;
        if (!smp) {
          (isk ? KP : VP)[(size_t)m * 128 + kv * 64 + lane] = w;
          const int b = m >> 8, t = m & 255;
          float* o = (isk ? newk : newv) + ((((size_t)b * 2 + j) * 256 + t) * 2 + kv) * 128 + 2 * lane;
          o[0] = x0; o[1] = x1;
        } else {
          const int b = (m - NPR) >> 10, t = (m - NPR) & 1023;
          (isk ? KS : VS)[((size_t)b * 1536 + t) * 128 + kv * 64 + lane] = w;
        }
      }
    }
  }
}


namespace att {
typedef unsigned short bf16;
constexpr int   D = 128, NW = 8, QBLK = 32, KVBLK = 64;
constexpr float SCALE = 0.088388347648318440f;
constexpr float THR = 8.f;
constexpr int SDEPTH = 2;
constexpr int LDQ = 1024, LDK = 256, LDO = 1024;
constexpr size_t SHM_V = KVBLK * D * 2, SHM_K = KVBLK * D * 2, SHM_ATTN = 2 * SHM_V + 2 * SHM_K + NW * 64 * 4;

using s16x4  = __attribute__((ext_vector_type(4))) short;
using f32x16 = __attribute__((ext_vector_type(16))) float;
using f32x8  = __attribute__((ext_vector_type(8))) float;

#define KSWZ(row, colB) ((row) * 256 + ((colB) ^ (((row) & 7) << 4)))
#define SBAR() __builtin_amdgcn_sched_barrier(0)
__device__ __forceinline__ int crow(int r, int hi) { return (r & 3) + 8 * (r >> 2) + 4 * hi; }
__device__ __forceinline__ unsigned cvtpk(float lo, float hi) {
  unsigned r; asm volatile("v_cvt_pk_bf16_f32 %0, %1, %2" : "=v"(r) : "v"(lo), "v"(hi)); return r;
}
template <typename TIn> struct Stage;
template <> struct Stage<bf16>  { using T = bf16x8;
  __device__ static __forceinline__ T ld8(const bf16* p) { return *reinterpret_cast<const bf16x8*>(p); }
  __device__ static __forceinline__ bf16x8 tobf(T x) { return x; } };
template <> struct Stage<float> { using T = f32x8;
  __device__ static __forceinline__ T ld8(const float* p) { return *reinterpret_cast<const f32x8*>(p); }
  __device__ static __forceinline__ bf16x8 tobf(T x) {
    u32x4 w = {cvtpk(x[0], x[1]), cvtpk(x[2], x[3]), cvtpk(x[4], x[5]), cvtpk(x[6], x[7])}; return *reinterpret_cast<bf16x8*>(&w); } };

__device__ __forceinline__ void partialSM(f32x16& p0, f32x16& p1, float& m_reg, float& mn, float& alpha) {
  constexpr float C = SCALE * 1.4426950408889634f;
  float pmax = p0[0]; for (int r = 1; r < 16; ++r) pmax = fmaxf(pmax, p0[r]); for (int r = 0; r < 16; ++r) pmax = fmaxf(pmax, p1[r]);
  { auto rr = __builtin_amdgcn_permlane32_swap(__float_as_uint(pmax), __float_as_uint(pmax), false, false);
    pmax = fmaxf(__uint_as_float(rr[0]), __uint_as_float(rr[1])); }
  if (__builtin_expect(__all(pmax - m_reg <= THR / SCALE), 1)) { mn = m_reg; alpha = 1.f; }
  else { mn = fmaxf(m_reg, pmax); alpha = __builtin_amdgcn_exp2f((m_reg - mn) * C); m_reg = mn; }
  float mnC = -mn * C;
  for (int r = 0; r < 16; ++r) p0[r] = fmaf(p0[r], C, mnC); for (int r = 0; r < 16; ++r) p1[r] = fmaf(p1[r], C, mnC);
  for (int r = 0; r < 16; ++r) p0[r] = __builtin_amdgcn_exp2f(p0[r]);
}
__device__ __forceinline__ void finishSM(f32x16& p0, f32x16& p1, float alpha, float& l_reg, bf16x8& pa0, bf16x8& pa1, bf16x8& pa2, bf16x8& pa3) {
  for (int r = 0; r < 16; ++r) p1[r] = __builtin_amdgcn_exp2f(p1[r]);
  float ps = 0; for (int r = 0; r < 16; ++r) ps += p0[r]; for (int r = 0; r < 16; ++r) ps += p1[r];
  { auto rr = __builtin_amdgcn_permlane32_swap(__float_as_uint(ps), __float_as_uint(ps), false, false);
    ps = __uint_as_float(rr[0]) + __uint_as_float(rr[1]); }
  l_reg = l_reg * alpha + ps;
#define PK4(P, BASE, OUT) do { unsigned a0 = cvtpk(P[BASE + 0], P[BASE + 1]), a1 = cvtpk(P[BASE + 2], P[BASE + 3]);   \
    unsigned b0 = cvtpk(P[BASE + 4], P[BASE + 5]), b1 = cvtpk(P[BASE + 6], P[BASE + 7]);                              \
    auto r0 = __builtin_amdgcn_permlane32_swap(a0, b0, false, false); auto r1 = __builtin_amdgcn_permlane32_swap(a1, b1, false, false); \
    u32x4 w = {r0[0], r1[0], r0[1], r1[1]}; OUT = *reinterpret_cast<bf16x8*>(&w); } while (0)
  PK4(p0, 0, pa0); PK4(p0, 8, pa1); PK4(p1, 0, pa2); PK4(p1, 8, pa3);
#undef PK4
}
__device__ __forceinline__ void qkt(f32x16& p0, f32x16& p1, const bf16* Ks, const bf16x8* qr, int r32, int hi) {
  p0 = f32x16{}; p1 = f32x16{};
  for (int d0 = 0; d0 < 8; ++d0) { int cb = (d0 * 16 + hi * 8) * 2;
    bf16x8 b0 = *reinterpret_cast<const bf16x8*>((const char*)Ks + KSWZ(r32, cb));
    bf16x8 b1 = *reinterpret_cast<const bf16x8*>((const char*)Ks + KSWZ(32 + r32, cb));
    p0 = __builtin_amdgcn_mfma_f32_32x32x16_bf16(b0, qr[d0], p0, 0, 0, 0);
    p1 = __builtin_amdgcn_mfma_f32_32x32x16_bf16(b1, qr[d0], p1, 0, 0, 0); }
}
__device__ __forceinline__ int v_st(int k, int c) { const int kk = (k & ~0xC) | ((k & 4) << 1) | ((k & 8) >> 1); return ((kk >> 3) * 4 + (c >> 5)) * 512 + ((kk & 7) * 32 + (c & 31)) * 2; }
__device__ __forceinline__ int v_rd_base(int lane) { return ((lane & 3) << 3) | (((lane >> 2) & 3) << 6) | (((lane >> 4) & 1) << 5) | (((lane >> 5) & 1) << 8); }
constexpr int v_rd_off(int d0, int ks, int half) { return d0 * 512 + ks * 4096 + half * 2048; }
template <int OFF> __device__ __forceinline__ s16x4 tr_read(int vb) {
  s16x4 r; asm volatile("ds_read_b64_tr_b16 %0, %1 offset:%2" : "=&v"(r) : "v"(vb), "i"(OFF) : "memory"); return r;
}
template <int D0> __device__ __forceinline__ void pv_one(f32x16& od, int vb, bf16x8 pa0, bf16x8 pa1, bf16x8 pa2, bf16x8 pa3) {
  const s16x4 l0 = tr_read<v_rd_off(D0, 0, 0)>(vb), h0 = tr_read<v_rd_off(D0, 0, 1)>(vb), l1 = tr_read<v_rd_off(D0, 1, 0)>(vb), h1 = tr_read<v_rd_off(D0, 1, 1)>(vb);
  const s16x4 l2 = tr_read<v_rd_off(D0, 2, 0)>(vb), h2 = tr_read<v_rd_off(D0, 2, 1)>(vb), l3 = tr_read<v_rd_off(D0, 3, 0)>(vb), h3 = tr_read<v_rd_off(D0, 3, 1)>(vb);
  asm volatile("s_waitcnt lgkmcnt(0)" ::: "memory"); SBAR();
#define PK(L, H) (bf16x8){L[0], L[1], L[2], L[3], H[0], H[1], H[2], H[3]}
  od = __builtin_amdgcn_mfma_f32_32x32x16_bf16(pa0, PK(l0, h0), od, 0, 0, 0);
  od = __builtin_amdgcn_mfma_f32_32x32x16_bf16(pa1, PK(l1, h1), od, 0, 0, 0);
  od = __builtin_amdgcn_mfma_f32_32x32x16_bf16(pa2, PK(l2, h2), od, 0, 0, 0);
  od = __builtin_amdgcn_mfma_f32_32x32x16_bf16(pa3, PK(l3, h3), od, 0, 0, 0);
#undef PK
}
__device__ __forceinline__ void pv_d0(f32x16* o, int vb, bf16x8 pa0, bf16x8 pa1, bf16x8 pa2, bf16x8 pa3) {
  pv_one<0>(o[0], vb, pa0, pa1, pa2, pa3); pv_one<1>(o[1], vb, pa0, pa1, pa2, pa3); pv_one<2>(o[2], vb, pa0, pa1, pa2, pa3); pv_one<3>(o[3], vb, pa0, pa1, pa2, pa3);
}

template <typename TQ>
__device__ __forceinline__ void attn_dense_body(const TQ* __restrict__ Qb, const bf16* __restrict__ Kh, const bf16* __restrict__ Vh,
                                                bf16* __restrict__ Ob, int seq, char* lds) {
  using St = Stage<bf16>; using SQ = Stage<TQ>;
  const int tid = tidx(), wid = tid >> 6, lane = tid & 63, r32 = lane & 31, hi = lane >> 5;
  bf16* V_lds = (bf16*)lds; bf16* K_lds = (bf16*)(lds + 2 * SHM_V);
  float* ws = (float*)(lds + 2 * SHM_V + 2 * SHM_K) + wid * 64; float* li_l = ws; float* al_l = ws + 32;
  float m_reg = -1e30f, l_reg = 0; f32x16 o[4] = {}; bf16x8 qr[8];
  const TQ* Qw = Qb + (long)(wid * QBLK + r32) * LDQ + hi * 8;
#pragma unroll
  for (int d0 = 0; d0 < 8; ++d0) qr[d0] = SQ::tobf(SQ::ld8(Qw + d0 * 16));
  const int sr = tid >> 4, sc = (tid & 15) * 8, vst0 = v_st(sr, sc), vst1 = v_st(32 + sr, sc);
  const int vb0 = (int)(uintptr_t)V_lds + v_rd_base(lane);
  struct { typename St::T vs0, vs1, ks0, ks1; } sr_[SDEPTH];
#define SLOAD(i, k0) do { sr_[i].vs0 = St::ld8(&Vh[(long)((k0) + sr) * LDK + sc]); sr_[i].vs1 = St::ld8(&Vh[(long)((k0) + 32 + sr) * LDK + sc]); \
    sr_[i].ks0 = St::ld8(&Kh[(long)((k0) + sr) * LDK + sc]); sr_[i].ks1 = St::ld8(&Kh[(long)((k0) + 32 + sr) * LDK + sc]); } while (0)
#define SWRITE(b, i) do { *(bf16x8*)((char*)V_lds + (b) * SHM_V + vst0) = St::tobf(sr_[i].vs0);          \
    *(bf16x8*)((char*)V_lds + (b) * SHM_V + vst1) = St::tobf(sr_[i].vs1); int kc = sc * 2;               \
    *(bf16x8*)((char*)K_lds + (b) * SHM_K + KSWZ(sr, kc)) = St::tobf(sr_[i].ks0);                       \
    *(bf16x8*)((char*)K_lds + (b) * SHM_K + KSWZ(32 + sr, kc)) = St::tobf(sr_[i].ks1); } while (0)
#define SWAIT() do { if constexpr (SDEPTH == 2) asm volatile("s_waitcnt vmcnt(4)" ::: "memory"); else asm volatile("s_waitcnt vmcnt(0)" ::: "memory"); } while (0)
#define RESC(a) do { if (__any((a) < 1.f)) { if (hi == 0) al_l[r32] = (a); asm volatile("s_waitcnt lgkmcnt(0)" ::: "memory"); \
    for (int d = 0; d < 4; ++d) for (int r = 0; r < 16; ++r) o[d][r] *= al_l[crow(r, hi)]; } } while (0)
  f32x16 pA0, pA1, pB0, pB1; float mnA, mnB, alA, alB; bf16x8 pa0, pa1, pa2, pa3; const int NT = seq / KVBLK;
  constexpr int SE = 0, SO = SDEPTH - 1;
  SLOAD(SE, 0); asm volatile("s_waitcnt vmcnt(0)" ::: "memory"); SWRITE(0, SE); __syncthreads();
  qkt(pA0, pA1, K_lds, qr, r32, hi); partialSM(pA0, pA1, m_reg, mnA, alA);
  SLOAD(SO, KVBLK); if constexpr (SDEPTH == 2) { if (2 < NT) SLOAD(SE, 2 * KVBLK); }
  SWAIT(); SWRITE(1, SO); __syncthreads();
  for (int j = 1; j + 1 < NT; j += 2) {
    SBAR(); qkt(pB0, pB1, (bf16*)((char*)K_lds + SHM_K), qr, r32, hi);
    finishSM(pA0, pA1, alA, l_reg, pa0, pa1, pa2, pa3); SBAR();
    SLOAD(SO, (j + SDEPTH) * KVBLK); SBAR();
    pv_d0(o, vb0, pa0, pa1, pa2, pa3); partialSM(pB0, pB1, m_reg, mnB, alB);
    __syncthreads(); SWAIT(); SWRITE(0, SE);
    RESC(alB); __syncthreads();
    SBAR(); qkt(pA0, pA1, K_lds, qr, r32, hi);
    finishSM(pB0, pB1, alB, l_reg, pa0, pa1, pa2, pa3); SBAR();
    if (SDEPTH == 1 || j + 3 < NT) SLOAD(SE, (j + 1 + SDEPTH) * KVBLK); SBAR();
    pv_d0(o, vb0 + (int)SHM_V, pa0, pa1, pa2, pa3); partialSM(pA0, pA1, m_reg, mnA, alA);
    __syncthreads(); SWAIT(); SWRITE(1, SO);
    RESC(alA); __syncthreads();
  }
  SBAR(); qkt(pB0, pB1, (bf16*)((char*)K_lds + SHM_K), qr, r32, hi);
  finishSM(pA0, pA1, alA, l_reg, pa0, pa1, pa2, pa3); SBAR();
  pv_d0(o, vb0, pa0, pa1, pa2, pa3); partialSM(pB0, pB1, m_reg, mnB, alB);
  __syncthreads(); RESC(alB);
  finishSM(pB0, pB1, alB, l_reg, pa0, pa1, pa2, pa3); SBAR();
  pv_d0(o, vb0 + (int)SHM_V, pa0, pa1, pa2, pa3);
  if (hi == 0) li_l[r32] = l_reg; asm volatile("s_waitcnt lgkmcnt(0)" ::: "memory");
  float rli[16];
#pragma unroll
  for (int r = 0; r < 16; ++r) rli[r] = __builtin_amdgcn_rcpf(li_l[crow(r, hi)]);
  bf16* Ow = Ob + (long)(wid * QBLK) * LDO;
#pragma unroll
  for (int r = 0; r < 16; ++r) { int orow = crow(r, hi);
    for (int d0 = 0; d0 < 4; ++d0) Ow[(long)orow * LDO + d0 * 32 + r32] = f2bf(o[d0][r] * rli[r]); }
#undef SLOAD
#undef SWRITE
#undef SWAIT
#undef RESC
}
}

__device__ void phase_att(const Params& p, int j, unsigned char* lds) {
  const bf16_t* Q = (const bf16_t*)(p.ws + WS_Q); bf16_t* O = (bf16_t*)(p.ws + WS_O);
  const bf16_t* KP = (const bf16_t*)(p.ws + WS_KP); const bf16_t* VP = (const bf16_t*)(p.ws + WS_VP);
  const bf16_t* KS = (const bf16_t*)(p.ws + WS_KS) + (size_t)j * 4 * 1536 * 256; const bf16_t* VS = (const bf16_t*)(p.ws + WS_VS) + (size_t)j * 4 * 1536 * 256;
  for (int u = blockIdx.x; u < 256; u += gridDim.x) {
    __syncthreads();
    if (u < 128) {
      const int qb = u & 3, h = (u >> 2) & 7, b = u >> 5, kv = h >> 2;
      const size_t row0 = (size_t)NPR + b * 1024 + qb * 256, kb = ((size_t)b * 1536) * 256 + kv * 128;
      att::attn_dense_body<att::bf16>(Q + row0 * D + h * 128, KS + kb, VS + kb, O + row0 * D + h * 128, 1536, (char*)lds);
    } else {
      const int h = (u - 128) & 7, b = (u - 128) >> 3, kv = h >> 2;
      const size_t row0 = (size_t)b * 256, kb = row0 * 256 + kv * 128;
      att::attn_dense_body<att::bf16>(Q + row0 * D + h * 128, KP + kb, VP + kb, O + row0 * D + h * 128, 256, (char*)lds);
    }
  }
  __syncthreads();
  if (j == 0) {
    for (int w = (int)((blockIdx.x + gridDim.x - (128 % gridDim.x)) % gridDim.x); w < 128; w += gridDim.x) {
      if (w < 96) { task_mod(p, 96 + w, (float*)lds); __syncthreads(); cvt_all(p, (float*)lds, 1, w * 20, 20, 1); }
      else cvt_all(p, (float*)lds, 1, 1920 + (w - 96) * 32, 32, 1);
    }
    __syncthreads();
  }
}

#define XB_TMO      128
#define XB_XCNT(j)  (256  + 64 * (j))
#define XB_XSUB(j)  (1280 + 64 * (j))
#define XB_XGEN(j)  (2304 + 64 * (j))
#define XB_TOP      3328
#define XB_TOPGEN   3392
#define XCD_BAR_WORDS 3456
#define XB_SPIN_CAP (1u << 18)
#define LAS __attribute__((address_space(3)))

__device__ __forceinline__ unsigned xb_ld(unsigned* p)              { return __hip_atomic_load(p, __ATOMIC_RELAXED, __HIP_MEMORY_SCOPE_AGENT); }
__device__ __forceinline__ unsigned xb_add(unsigned* p, unsigned v) { return __hip_atomic_fetch_add(p, v, __ATOMIC_RELAXED, __HIP_MEMORY_SCOPE_AGENT); }
__device__ __forceinline__ unsigned xb_xcc_id() { return (unsigned)__builtin_amdgcn_s_getreg((3 << 11) | 20) & 0xFu; }
#define XB_SPIN(cond, bar) do { unsigned _sp = 0; while (cond) { __builtin_amdgcn_s_sleep(1); \
    if ((++_sp & 255u) == 0u) { if (xb_ld(&(bar)[XB_TMO])) break; if (_sp > XB_SPIN_CAP) { atomicAdd(&(bar)[XB_TMO], 1u); break; } } } } while (0)

struct XcdBarrier {
    unsigned* bar; unsigned x;
    volatile LAS unsigned* st;
};

__device__ __forceinline__ XcdBarrier xcd_barrier_post(unsigned* bar, volatile LAS unsigned* st) {
    XcdBarrier b; b.bar = bar; b.x = xb_xcc_id(); b.st = st;
    if (threadIdx.x == 0) (void)xb_add(&bar[XB_XCNT(b.x)], 1u);
    return b;
}
__device__ __forceinline__ void xcd_barrier_complete(unsigned* bar, unsigned x, unsigned& nloc, unsigned& nx) {
    const unsigned G = gridDim.x * gridDim.y * gridDim.z;
    unsigned sum, cnt, mine, sp = 0u;
    for (;;) {
        sum = 0u; cnt = 0u; mine = 0u;
#pragma unroll
        for (unsigned j = 0; j < 16; ++j) { const unsigned c = xb_ld(&bar[XB_XCNT(j)]); sum += c; cnt += (c > 0u) ? 1u : 0u; mine = (j == x) ? c : mine; }
        if (sum == G) break;
        __builtin_amdgcn_s_sleep(1);
        if ((++sp & 255u) == 0u) { if (xb_ld(&bar[XB_TMO])) break; if (sp > XB_SPIN_CAP) { atomicAdd(&bar[XB_TMO], 1u); break; } }
    }
    nloc = mine > 0u ? mine : 1u; nx = cnt > 0u ? cnt : 1u;
}

__device__ __forceinline__ void xcd_barrier(const XcdBarrier& b) {
    asm volatile("s_waitcnt vmcnt(0)" ::: "memory");
    __syncthreads();
    if (threadIdx.x == 0) {
        unsigned* bar = b.bar;
        __builtin_amdgcn_s_waitcnt(0);
        unsigned nloc = b.st[0], nx = b.st[1];
        if (nloc == 0u) { xcd_barrier_complete(bar, b.x, nloc, nx); b.st[0] = nloc; b.st[1] = nx; }
        const unsigned old = xb_add(&bar[XB_XSUB(b.x)], 1u);
        const unsigned gen = old / nloc;
        if (old + 1u == (gen + 1u) * nloc) {
            __builtin_amdgcn_fence(__ATOMIC_RELEASE, "agent");
            asm volatile("s_waitcnt vmcnt(0)" ::: "memory");
            const unsigned og = xb_add(&bar[XB_TOP], 1u);
            const unsigned tg = og / nx;
            if (og + 1u == (tg + 1u) * nx) xb_add(&bar[XB_TOPGEN], 1u);
            else XB_SPIN(xb_ld(&bar[XB_TOPGEN]) == tg, bar);
            __builtin_amdgcn_fence(__ATOMIC_ACQUIRE, "agent");
            xb_add(&bar[XB_XGEN(b.x)], 1u);
            asm volatile("s_waitcnt vmcnt(0)" ::: "memory");
        } else {
            XB_SPIN(xb_ld(&bar[XB_XGEN(b.x)]) == gen, bar);
            __builtin_amdgcn_fence(__ATOMIC_ACQUIRE, "agent");
            asm volatile("s_waitcnt vmcnt(0)" ::: "memory");
        }
    }
    __syncthreads();
}

__global__ void __launch_bounds__(512, 2) mega(Params p) {
  extern __shared__ __attribute__((aligned(16))) unsigned char lds[];
  cg::grid_group grid = cg::this_grid();
  volatile LAS unsigned* xst = (volatile LAS unsigned*)((LAS unsigned char*)lds + (LDS_BYTES - 16));
  if (threadIdx.x < 4) xst[threadIdx.x] = 0u;
  __syncthreads();
  const XcdBarrier xbar = xcd_barrier_post((unsigned*)p.ws, xst);
#define XN ((bf16_t*)(p.ws + WS_XN))
#define MOD ((const float*)(p.ws + WS_MOD))
#define RUN(stmt) do { int lv = l; asm volatile("" : "+s"(lv)); const int jv = lv >> 1; (void)jv; stmt; xcd_barrier(xbar); } while (0)
  phase_p0(p, lds);
  grid.sync();
  phase_p0b(p);
  xcd_barrier(xbar);
#pragma unroll 1
  for (int l = 0; l < 4; ++l) {
    RUN(phase_nm(p, lv, 0, lv > 0));
    if ((l & 1) == 0) {
      RUN(gemm_run(lds, (const bf16_t*)(p.ws + WS_WIN) + (size_t)jv * 3072 * D, XN, 3072, MTOK, D, 1, pg8::EpiBf16{(bf16_t*)(p.ws + WS_ZT), MTOK}));
      RUN(phase_lc(p, jv, lds));
      RUN(gemm_run(lds, (const bf16_t*)(p.ws + WS_YG), (const bf16_t*)(p.ws + WS_WHO) + (size_t)jv * D * D, MTOK, D, D, 2, pg8::EpiGate{(bf16_t*)(p.ws + WS_P1), MOD + (size_t)lv * 5 * 6144 + 2048}));
    } else {
      RUN(gemm_run(lds, XN, (const bf16_t*)(p.ws + WS_WQKV) + (size_t)jv * QKVD * D, MTOK, QKVD, D, 1, pg8::EpiBf16{(bf16_t*)(p.ws + WS_QKV), QKVD}));
      RUN(phase_qkvpost(p, jv));
      RUN(phase_att(p, jv, lds));
      RUN(gemm_run(lds, (const bf16_t*)(p.ws + WS_O), (const bf16_t*)(p.ws + WS_WAO) + (size_t)jv * D * D, MTOK, D, D, 2, pg8::EpiGate{(bf16_t*)(p.ws + WS_P1), MOD + (size_t)lv * 5 * 6144 + 2048}));
    }
    RUN({ phase_nm(p, lv, 1, true); if (lv == 1) mod_finalize(p, 1); });
    RUN(gemm_run(lds, XN, (const bf16_t*)(p.ws + WS_WGU) + (size_t)lv * 2 * DFF * D, MTOK, 2 * DFF, D, 1, pg8::EpiSwiglu{(bf16_t*)(p.ws + WS_H)}));
    RUN(gemm_run(lds, (const bf16_t*)(p.ws + WS_H), (const bf16_t*)(p.ws + WS_WDN) + (size_t)lv * D * DFF, MTOK, D, DFF, 2, pg8::EpiGate{(bf16_t*)(p.ws + WS_P1), MOD + (size_t)lv * 5 * 6144 + 5 * 1024}));
  }
  phase_final(p);
#undef RUN
#undef XN
#undef MOD
}
constexpr int N_PHASES = 2 + 2 * 7 + 2 * 8 + 1;


extern "C" void kernel_launch(void* const* d_in, const int* in_sizes, int n_in, void* d_out, int out_size, void* d_ws, size_t ws_size, hipStream_t stream) {
  static int grid = 0;
  if (grid == 0) {
    if (n_in != 29 || ws_size < WS_END) { fprintf(stderr, "kernel_launch: n_in %d ws %zu (need 29, >= %zu)\n", n_in, ws_size, (size_t)WS_END); grid = -1; return; }
    int dev = 0, cus = 0, per_cu = 0;
    hipGetDevice(&dev);
    hipDeviceGetAttribute(&cus, hipDeviceAttributeMultiprocessorCount, dev);
    if (hipFuncSetAttribute((const void*)mega, hipFuncAttributeMaxDynamicSharedMemorySize, LDS_BYTES) != hipSuccess) { fprintf(stderr, "kernel_launch: hipFuncSetAttribute failed\n"); grid = -1; return; }
    hipOccupancyMaxActiveBlocksPerMultiprocessor(&per_cu, (const void*)mega, 512, LDS_BYTES);
    if (per_cu < 1) { fprintf(stderr, "kernel_launch: occupancy query says %d blocks per CU\n", per_cu); per_cu = 1; }
    grid = cus * per_cu;
  }
  if (grid < 0) return;
  Params p{};
  for (int i = 0; i < 29; ++i) p.in[i] = (const float*)d_in[i];
  p.out = (float*)d_out; p.ws = (unsigned char*)d_ws;

  if (hipMemsetAsync(d_ws, 0, 16384, stream) != hipSuccess) { fprintf(stderr, "kernel_launch: memset of the barrier words failed\n"); return; }
  void* args[] = {&p};
  hipError_t e = hipLaunchCooperativeKernel((const void*)mega, dim3(grid), dim3(512), args, LDS_BYTES, stream);
  if (e != hipSuccess) fprintf(stderr, "cooperative launch failed: %s (grid %d)\n", hipGetErrorString(e), grid);

}
```

```cpp
#include <hip/hip_runtime.h>
#include <hip/hip_cooperative_groups.h>
#include <cstdio>
#include <cstdint>
namespace cg = cooperative_groups;

typedef unsigned short bf16_t;
typedef short bf16x8 __attribute__((ext_vector_type(8)));
typedef float f32x4 __attribute__((ext_vector_type(4)));
typedef unsigned u32x4 __attribute__((ext_vector_type(4)));
typedef float f32x16 __attribute__((ext_vector_type(16)));

constexpr int D = 1024, MTOK = 8192, NPR = 4096;
constexpr int DFF = 2816, QKVD = 1536;
constexpr float EPS = 1e-6f;
constexpr float MIN_DECAY = -3.0701134573253944f, MAX_DECAY = -15.350567286626972f;

constexpr size_t MiB = 1u << 20;
constexpr size_t WS_MOD = 1 * MiB, WS_MODP = 2 * MiB, WS_FSQP = 6 * MiB, WS_RNORM = 7 * MiB, WS_FILT = 8 * MiB;
constexpr size_t WS_WIN = 28 * MiB, WS_WHO = 40 * MiB, WS_WQKV = 44 * MiB, WS_WAO = 50 * MiB, WS_WGU = 54 * MiB, WS_WDN = 98 * MiB;
constexpr size_t WS_Y = 120 * MiB, WS_XN = 152 * MiB, WS_R = 168 * MiB;
constexpr size_t WS_ZT = WS_R, WS_YG = WS_R + 48 * MiB, WS_P1 = WS_R + 64 * MiB;
constexpr size_t P1_HALF = (size_t)MTOK * D;
constexpr size_t WS_QKV = WS_R, WS_Q = WS_R + 24 * MiB, WS_KP = WS_R + 40 * MiB, WS_VP = WS_R + 42 * MiB, WS_O = WS_R + 44 * MiB;
constexpr size_t WS_H = WS_R;
constexpr size_t WS_KS = WS_R + 96 * MiB, WS_VS = WS_R + 102 * MiB, WS_FRG = WS_R + 108 * MiB, WS_END = WS_R + 130 * MiB;
constexpr size_t FRG_J = 11 * MiB / 2, FRG_L1 = (size_t)1024 * (4 * 256 + 40);
constexpr size_t FILT_J = 10 * MiB / 4;
constexpr size_t FILT_L1 = 1024 * 512;

constexpr int LDS_BYTES = 147456;

struct Params {
  const float* in[29];
  float* out;
  unsigned char* ws;
  int ph_lo, ph_hi;
};
typedef const __attribute__((address_space(4))) Params* KP;
enum { I_XP = 0, I_XS, I_CK, I_CV, I_C, I_CCTX, I_MODW, I_MODB, I_NMIX, I_NFFN, I_HWIN, I_HCW, I_HCB, I_FW1, I_FB1, I_FFREQ, I_FW2, I_FB2, I_FW3,
       I_HBIAS, I_HWOUT, I_WQKV, I_QN, I_KN, I_WAO, I_WG, I_WU, I_WD, I_FN };

__device__ __forceinline__ bf16_t f2bf(float f) { unsigned u = __float_as_uint(f); u += 0x7FFFu + ((u >> 16) & 1u); return (bf16_t)(u >> 16); }
__device__ __forceinline__ float bf2f(bf16_t b) { return __uint_as_float(((unsigned)b) << 16); }
__device__ __forceinline__ unsigned pack2(float lo, float hi) { return (unsigned)f2bf(lo) | ((unsigned)f2bf(hi) << 16); }
__device__ __forceinline__ float wave_sum(float v) {
#pragma unroll
  for (int o = 32; o >= 1; o >>= 1) v += __shfl_xor(v, o);
  return v;
}
__device__ __forceinline__ float wave_max(float v) {
#pragma unroll
  for (int o = 32; o >= 1; o >>= 1) v = fmaxf(v, __shfl_xor(v, o));
  return v;
}
__device__ __forceinline__ int tidx() { int t = threadIdx.x; asm volatile("" : "+v"(t)); return t; }
__device__ __forceinline__ int cond_of(int m) { return m < NPR ? 4 : ((m - NPR) >> 10); }
__device__ __forceinline__ float silu_f(float x) { return x / (1.f + expf(-x)); }
__device__ __forceinline__ float sin_rev(float r) { return __builtin_amdgcn_sinf(r - rintf(r)); }
__device__ __forceinline__ float cos_rev(float r) { return __builtin_amdgcn_cosf(r - rintf(r)); }
constexpr float INV_2PI = 0.15915494309189535f;

struct TileDesc { const float* src; bf16_t* dst; int K, N, k0, n0, mode; };
constexpr int H_WIN = 16 * 24, H_WHO = 16 * 8, H_WQKV = 16 * 12, H_WAO = 16 * 8, H_G = 2 * 16 * 22, H_DN = 2 * 44 * 8;
constexpr int NT_CVT_HALF = H_WIN + H_WHO + H_WQKV + H_WAO + 2 * H_G + H_DN;
__device__ __forceinline__ TileDesc cvt_decode(KP p, int t, int late) {
  TileDesc d;
  if (t < H_WIN) { const int l = late, r = t; d.src = p->in[I_HWIN] + (size_t)l * D * 3072; d.dst = (bf16_t*)(p->ws + WS_WIN) + (size_t)l * 3072 * D; d.K = D; d.N = 3072; d.k0 = (r / 24) * 64; d.n0 = (r % 24) * 128; d.mode = 0; return d; }
  t -= H_WIN;
  if (t < H_WHO) { const int l = late, r = t; d.src = p->in[I_HWOUT] + (size_t)l * D * D; d.dst = (bf16_t*)(p->ws + WS_WHO) + (size_t)l * D * D; d.K = D; d.N = D; d.k0 = (r / 8) * 64; d.n0 = (r % 8) * 128; d.mode = 0; return d; }
  t -= H_WHO;
  if (t < H_WQKV) { const int l = late, r = t; d.src = p->in[I_WQKV] + (size_t)l * D * QKVD; d.dst = (bf16_t*)(p->ws + WS_WQKV) + (size_t)l * QKVD * D; d.K = D; d.N = QKVD; d.k0 = (r / 12) * 64; d.n0 = (r % 12) * 128; d.mode = 0; return d; }
  t -= H_WQKV;
  if (t < H_WAO) { const int l = late, r = t; d.src = p->in[I_WAO] + (size_t)l * D * D; d.dst = (bf16_t*)(p->ws + WS_WAO) + (size_t)l * D * D; d.K = D; d.N = D; d.k0 = (r / 8) * 64; d.n0 = (r % 8) * 128; d.mode = 0; return d; }
  t -= H_WAO;
  if (t < 2 * H_G) { const int up = t >= H_G ? 1 : 0; t -= up * H_G; const int l = 2 * late + t / (16 * 22), r = t % (16 * 22);
    d.src = p->in[up ? I_WU : I_WG] + (size_t)l * D * DFF; d.dst = (bf16_t*)(p->ws + WS_WGU) + (size_t)l * 2 * DFF * D; d.K = D; d.N = DFF; d.k0 = (r / 22) * 64; d.n0 = (r % 22) * 128; d.mode = 1 + up; return d; }
  t -= 2 * H_G;
  { const int l = 2 * late + t / (44 * 8), r = t % (44 * 8); d.src = p->in[I_WD] + (size_t)l * DFF * D; d.dst = (bf16_t*)(p->ws + WS_WDN) + (size_t)l * D * DFF; d.K = DFF; d.N = D; d.k0 = (r / 8) * 64; d.n0 = (r % 8) * 128; d.mode = 0; return d; }
}
__device__ __forceinline__ void cvt_load(const TileDesc& d, int tid, f32x4 (&v)[4]) {
  const int r = tid >> 5, c4 = (tid & 31) * 4;
#pragma unroll
  for (int h = 0; h < 4; ++h) v[h] = *(const f32x4*)(d.src + (size_t)(d.k0 + r + 16 * h) * d.N + d.n0 + c4);
}
__device__ __forceinline__ void cvt_to_lds(float* tile, int tid, const f32x4 (&v)[4]) {
  const int r = tid >> 5, c4 = (tid & 31) * 4;
#pragma unroll
  for (int h = 0; h < 4; ++h) { float* q = tile + (r + 16 * h) * 129 + c4; q[0] = v[h][0]; q[1] = v[h][1]; q[2] = v[h][2]; q[3] = v[h][3]; }
}
__device__ __forceinline__ void cvt_store(const TileDesc& cur, const float* tile, int tid) {
  const int n = tid >> 2, kc = (tid & 3) * 16;
  u32x4 w0, w1;
  w0.x = pack2(tile[(kc + 0) * 129 + n], tile[(kc + 1) * 129 + n]); w0.y = pack2(tile[(kc + 2) * 129 + n], tile[(kc + 3) * 129 + n]);
  w0.z = pack2(tile[(kc + 4) * 129 + n], tile[(kc + 5) * 129 + n]); w0.w = pack2(tile[(kc + 6) * 129 + n], tile[(kc + 7) * 129 + n]);
  w1.x = pack2(tile[(kc + 8) * 129 + n], tile[(kc + 9) * 129 + n]); w1.y = pack2(tile[(kc + 10) * 129 + n], tile[(kc + 11) * 129 + n]);
  w1.z = pack2(tile[(kc + 12) * 129 + n], tile[(kc + 13) * 129 + n]); w1.w = pack2(tile[(kc + 14) * 129 + n], tile[(kc + 15) * 129 + n]);
  const int ng = cur.n0 + n;
  const int row = cur.mode == 0 ? ng : ((ng >> 7) * 256 + (ng & 127) + (cur.mode == 2 ? 128 : 0));
  bf16_t* o = cur.dst + (size_t)row * cur.K + cur.k0 + kc;
  *(u32x4*)o = w0; *(u32x4*)(o + 8) = w1;
}
__device__ void cvt_all(KP p, float* lds_f, int late, int start, int count, int stride) {
  const int tid = tidx();
  float* tileA = lds_f; float* tileB = lds_f + 64 * 129 + 64;
  if (count <= 0) return;
  TileDesc d0 = cvt_decode(p, start, late), d1 = d0;
  f32x4 va[4], vb[4];
  cvt_load(d0, tid, va);
  if (count > 1) { d1 = cvt_decode(p, start + stride, late); cvt_load(d1, tid, vb); }
  __syncthreads();
  for (int i = 0;; i += 2) {
    cvt_to_lds(tileA, tid, va);
    const TileDesc ca = d0;
    const bool hasA = i + 2 < count;
    if (hasA) { d0 = cvt_decode(p, start + (i + 2) * stride, late); cvt_load(d0, tid, va); }
    __syncthreads();
    cvt_store(ca, tileA, tid);
    if (i + 1 >= count) break;
    cvt_to_lds(tileB, tid, vb);
    const TileDesc cb = d1;
    const bool hasB = i + 3 < count;
    if (hasB) { d1 = cvt_decode(p, start + (i + 3) * stride, late); cvt_load(d1, tid, vb); }
    __syncthreads();
    cvt_store(cb, tileB, tid);
    if (!hasA) break;
  }
  __syncthreads();
}

constexpr int NT_MOD = 4 * 3 * 16;
__device__ void task_mod(KP p, int t, float* sl  , float* modp) {
  const int tid = tidx();
  const int l = t / 48, rem = t % 48, cb = rem / 16, kc = rem % 16;
  __syncthreads();
  if (tid < 320) {
    const int j = tid >> 6, k = kc * 64 + (tid & 63);
    const float x = j < 4 ? p->in[I_C][j * D + k] : p->in[I_CCTX][k];
    sl[tid] = silu_f(x);
  }
  __syncthreads();
  const int n = cb * 2048 + tid * 4;
  const float* w = p->in[I_MODW] + ((size_t)l * D + kc * 64) * 6144 + n;
  f32x4 a0 = {0.f, 0.f, 0.f, 0.f}, a1 = a0, a2 = a0, a3 = a0, a4 = a0;
#pragma unroll 8
  for (int k = 0; k < 64; ++k) {
    const f32x4 wv = *(const f32x4*)(w + (size_t)k * 6144);
    a0 += wv * sl[k]; a1 += wv * sl[64 + k]; a2 += wv * sl[128 + k]; a3 += wv * sl[192 + k]; a4 += wv * sl[256 + k];
  }
  float* o = modp + ((size_t)(kc * 4 + l) * 5) * 6144 + n;
  *(f32x4*)o = a0; *(f32x4*)(o + 6144) = a1; *(f32x4*)(o + 2 * 6144) = a2; *(f32x4*)(o + 3 * 6144) = a3; *(f32x4*)(o + 4 * 6144) = a4;
}

constexpr int NT_FILT = 320;
constexpr int FL_H1 = 0, FL_H2 = 4160, FL_W1 = 8320, FL_W2 = FL_W1 + 2112, FL_W3 = FL_W2 + 4096, FL_END = FL_W3 + 16384;
__device__ void task_filt(KP p, int t, float* fl) {
  const int tid = tidx(), lane = tid & 63, wid = __builtin_amdgcn_readfirstlane(tid >> 6);
  const int combo = t >> 3, nchunk = t & 7;
  const int j = combo / 20, r = combo % 20;
  const int lsel = r < 4 ? 0 : 1, tchunk = r < 4 ? r : r - 4, L = lsel ? 1024 : 256;
  const int tt = lane, tpos = tchunk * 64 + tt;
  const float tn = (float)tpos / (float)L;
  float* h1 = fl + FL_H1; float* h2 = fl + FL_H2; float* w1 = fl + FL_W1; float* w2 = fl + FL_W2; float* w3 = fl + FL_W3;
  const float* b1 = p->in[I_FB1] + j * 64; const float* fr = p->in[I_FFREQ] + j * 128; const float* b2 = p->in[I_FB2] + j * 64;
  __syncthreads();
  {
    const f32x4* g1 = (const f32x4*)(p->in[I_FW1] + (size_t)j * 33 * 64); const f32x4* g2 = (const f32x4*)(p->in[I_FW2] + (size_t)j * 64 * 64);
    const float* g3 = p->in[I_FW3] + (size_t)j * 64 * 2048 + nchunk * 256;
    for (int i = tid; i < 528; i += 512) ((f32x4*)w1)[i] = g1[i];
    for (int i = tid; i < 1024; i += 512) ((f32x4*)w2)[i] = g2[i];
#pragma unroll
    for (int h = 0; h < 8; ++h) { const int i = tid + 512 * h, v = i >> 6, c4 = (i & 63) * 4; *(f32x4*)(w3 + v * 256 + c4) = *(const f32x4*)(g3 + (size_t)v * 2048 + c4); }
  }
  __syncthreads();
  const int u0 = wid * 8;
  {
    float acc[8];
#pragma unroll
    for (int uu = 0; uu < 8; ++uu) acc[uu] = tn * w1[u0 + uu];
#pragma unroll 4
    for (int b = 1; b <= 16; ++b) {
      const float rev = tn * (float)b;
      const float cs = cos_rev(rev), sn = sin_rev(rev);
#pragma unroll
      for (int uu = 0; uu < 8; ++uu) acc[uu] += cs * w1[b * 64 + u0 + uu] + sn * w1[(16 + b) * 64 + u0 + uu];
    }
#pragma unroll
    for (int uu = 0; uu < 8; ++uu) h1[tt * 65 + u0 + uu] = sin_rev(INV_2PI * (fr[u0 + uu] * (acc[uu] + b1[u0 + uu])));
  }
  __syncthreads();
  {
    float acc[8];
#pragma unroll
    for (int uu = 0; uu < 8; ++uu) acc[uu] = 0.f;
#pragma unroll 8
    for (int v = 0; v < 64; ++v) {
      const float hv = h1[tt * 65 + v];
#pragma unroll
      for (int uu = 0; uu < 8; ++uu) acc[uu] += hv * w2[v * 64 + u0 + uu];
    }
#pragma unroll
    for (int uu = 0; uu < 8; ++uu) h2[tt * 65 + u0 + uu] = sin_rev(INV_2PI * (fr[64 + u0 + uu] * (acc[uu] + b2[u0 + uu])));
  }
  __syncthreads();
  float* fsq = (float*)(p->ws + WS_FSQP) + ((size_t)((j * 2 + lsel) * 16 + tchunk)) * 2048;
  const int nb = nchunk * 256 + wid * 32;
  float acc[32];
#pragma unroll
  for (int q = 0; q < 32; ++q) acc[q] = 0.f;
#pragma unroll 4
  for (int v = 0; v < 64; ++v) {
    const float hv = h2[tt * 65 + v];
    const float* wr = w3 + v * 256 + wid * 32;
#pragma unroll
    for (int q = 0; q < 32; ++q) acc[q] += hv * wr[q];
  }
#pragma unroll
  for (int q = 0; q < 32; ++q) {
    const int n = nb + q, c = n & 1023; const bool isb = n >= 1024;
    const float delta = fabsf(MIN_DECAY + (MAX_DECAY - MIN_DECAY) * ((float)c / 1023.f));
    float val = acc[q] * __expf(-tn * delta);
    if (isb && tpos == 0) val = 0.f;
    bf16_t* rec = (bf16_t*)(p->ws + WS_FRG) + (size_t)j * FRG_J + (lsel ? FRG_L1 : 0) + (size_t)c * (4 * L + 40);
    if (isb && tpos == 0) rec[0] = 0;
    else { const int i = isb ? (L + tpos) : (L - tpos); const bf16_t bv = f2bf(val); rec[i] = bv; rec[2 * L + 40 + i - 1] = bv; }
    acc[q] = val * val;
  }
  __syncthreads();
#pragma unroll
  for (int q = 0; q < 32; ++q) h1[(wid * 32 + q) * 65 + lane] = acc[q];
  __syncthreads();
  if (tid < 256) { float s = 0.f; for (int k = 0; k < 64; ++k) s += h1[tid * 65 + ((k + tid) & 63)]; fsq[nchunk * 256 + tid] = s; }
}

__device__ void phase_p0(KP p, unsigned char* lds) {
  float* fl = (float*)lds;
  const int G = gridDim.x, b = blockIdx.x, tid = tidx();
  for (int t = b; t < NT_FILT + NT_MOD / 2; t += G) {
    __syncthreads();
    if (t < NT_FILT) task_filt(p, t, fl);
    else task_mod(p, t - NT_FILT, fl, (float*)(p->ws + WS_ZT));
  }
  cvt_all(p, fl, 0, b, (NT_CVT_HALF - b + G - 1) / G, G);
  {
    bf16_t* KS = (bf16_t*)(p->ws + WS_KS); bf16_t* VS = (bf16_t*)(p->ws + WS_VS);
    const int n = 4 * 2 * 512 * 256;
    for (int i = b * 512 + tid; i < n; i += G * 512) {
      const int e = i & 255, pos = (i >> 8) & 511, j = (i >> 17) & 1, bb = i >> 18;
      const size_t o = ((size_t)(j * 4 + bb) * 1536 + 1024 + pos) * 256 + e;
      KS[o] = f2bf(p->in[I_CK][i]); VS[o] = f2bf(p->in[I_CV][i]);
    }
  }
}

__device__ void mod_finalize(KP p, int late, const float* MP) {
  const int G = gridDim.x, b = blockIdx.x, tid = tidx();
  float* MOD = (float*)(p->ws + WS_MOD);
  for (int i = late * (2 * 5 * 6144) + b * 512 + tid; i < (late + 1) * (2 * 5 * 6144); i += G * 512) {
    const int n = i % 6144, l = i / (5 * 6144);
    float s = p->in[I_MODB][l * 6144 + n];
#pragma unroll
    for (int kc = 0; kc < 16; ++kc) s += MP[(size_t)kc * (4 * 5 * 6144) + i];
    MOD[i] = s;
  }
}
__device__ void phase_p0b(KP p) {
  const int G = gridDim.x, b = blockIdx.x, tid = tidx();
  mod_finalize(p, 0, (const float*)(p->ws + WS_ZT));
  float* RN = (float*)(p->ws + WS_RNORM); const float* FS = (const float*)(p->ws + WS_FSQP);
  for (int i = b * 512 + tid; i < 4096; i += G * 512) {
    const int c = i & 1023, jl = i >> 10, nch = (jl & 1) ? 16 : 4;
    float s = 0.f;
    for (int ch = 0; ch < nch; ++ch) s += FS[((size_t)jl * 16 + ch) * 2048 + c] + FS[((size_t)jl * 16 + ch) * 2048 + 1024 + c];
    RN[i] = 1.f / sqrtf(s + EPS);
  }
}

__device__ void phase_nm(KP p, int layer, int which, bool addp) {
  const int lane = tidx() & 63, wid = tidx() >> 6;
  float* Y = (float*)(p->ws + WS_Y); const bf16_t* P1 = (const bf16_t*)(p->ws + WS_P1); bf16_t* XN = (bf16_t*)(p->ws + WS_XN);
  const float* g = p->in[which ? I_NFFN : I_NMIX] + layer * D;
  const int stride = gridDim.x * 8;
  for (int ma = blockIdx.x * 8 + wid; ma < MTOK; ma += 2 * stride) {
    const int mb = ma + stride; const bool hb = mb < MTOK;
    f32x4 v[2][4]; uint2 pa[2][4], pb[2][4];
#pragma unroll
    for (int r = 0; r < 2; ++r) {
      const int m = r == 0 ? ma : (hb ? mb : ma);
      const float* src = layer == 0 ? (m < NPR ? p->in[I_XP] + (size_t)m * D : p->in[I_XS] + (size_t)(m - NPR) * D) : Y + (size_t)m * D;
#pragma unroll
      for (int i = 0; i < 4; ++i) { v[r][i] = *(const f32x4*)(src + i * 256 + lane * 4);
        if (addp) { pa[r][i] = *(const uint2*)(P1 + (size_t)m * D + i * 256 + lane * 4); pb[r][i] = *(const uint2*)(P1 + P1_HALF + (size_t)m * D + i * 256 + lane * 4); } }
    }
#pragma unroll
    for (int r = 0; r < 2; ++r) if (r == 0 || hb) {
      const int m = r == 0 ? ma : mb;
      float ss = 0.f;
#pragma unroll
      for (int i = 0; i < 4; ++i) {
        if (addp) {
          v[r][i][0] += __uint_as_float(pa[r][i].x << 16) + __uint_as_float(pb[r][i].x << 16); v[r][i][1] += __uint_as_float(pa[r][i].x & 0xFFFF0000u) + __uint_as_float(pb[r][i].x & 0xFFFF0000u);
          v[r][i][2] += __uint_as_float(pa[r][i].y << 16) + __uint_as_float(pb[r][i].y << 16); v[r][i][3] += __uint_as_float(pa[r][i].y & 0xFFFF0000u) + __uint_as_float(pb[r][i].y & 0xFFFF0000u);
          *(f32x4*)(Y + (size_t)m * D + i * 256 + lane * 4) = v[r][i]; }
        ss += v[r][i][0] * v[r][i][0] + v[r][i][1] * v[r][i][1] + v[r][i][2] * v[r][i][2] + v[r][i][3] * v[r][i][3]; }
      ss = wave_sum(ss);
      const float rs = rsqrtf(ss * (1.f / D) + EPS);
      const float* mod = (const float*)(p->ws + WS_MOD) + (size_t)(layer * 5 + cond_of(m)) * 6144 + which * 3072;
#pragma unroll
      for (int i = 0; i < 4; ++i) {
        const int k = i * 256 + lane * 4;
        const f32x4 gg = *(const f32x4*)(g + k), sh = *(const f32x4*)(mod + k), sc = *(const f32x4*)(mod + 1024 + k);
        float o[4];
#pragma unroll
        for (int e = 0; e < 4; ++e) o[e] = (v[r][i][e] * rs * gg[e]) * (1.f + sc[e]) + sh[e];
        uint2 w; w.x = pack2(o[0], o[1]); w.y = pack2(o[2], o[3]);
        *(uint2*)(XN + (size_t)m * D + k) = w;
      }
    }
  }
}

__device__ void phase_final(KP p) {
  const int lane = tidx() & 63, wid = tidx() >> 6;
  const float* Y = (const float*)(p->ws + WS_Y);
  const float* g = p->in[I_FN];
  for (int m = blockIdx.x * 8 + wid; m < MTOK; m += gridDim.x * 8) {
    const float* y = Y + (size_t)m * D;
    f32x4 v[4]; float ss = 0.f;
#pragma unroll
    for (int i = 0; i < 4; ++i) { v[i] = *(const f32x4*)(y + i * 256 + lane * 4);
      { const bf16_t* P1 = (const bf16_t*)(p->ws + WS_P1); const uint2 pa = *(const uint2*)(P1 + (size_t)m * D + i * 256 + lane * 4), pb = *(const uint2*)(P1 + P1_HALF + (size_t)m * D + i * 256 + lane * 4);
        v[i][0] += __uint_as_float(pa.x << 16) + __uint_as_float(pb.x << 16); v[i][1] += __uint_as_float(pa.x & 0xFFFF0000u) + __uint_as_float(pb.x & 0xFFFF0000u);
        v[i][2] += __uint_as_float(pa.y << 16) + __uint_as_float(pb.y << 16); v[i][3] += __uint_as_float(pa.y & 0xFFFF0000u) + __uint_as_float(pb.y & 0xFFFF0000u); }
      ss += v[i][0] * v[i][0] + v[i][1] * v[i][1] + v[i][2] * v[i][2] + v[i][3] * v[i][3]; }
    ss = wave_sum(ss);
    const float r = rsqrtf(ss * (1.f / D) + EPS);
#pragma unroll
    for (int i = 0; i < 4; ++i) {
      const int k = i * 256 + lane * 4;
      const f32x4 gg = *(const f32x4*)(g + k);
      f32x4 o; o[0] = v[i][0] * r * gg[0]; o[1] = v[i][1] * r * gg[1]; o[2] = v[i][2] * r * gg[2]; o[3] = v[i][3] * r * gg[3];
      *(f32x4*)(p->out + (size_t)m * D + k) = o;
    }
  }
}


namespace pg8 {
#define PG8_LAS __attribute__((address_space(3)))
constexpr int BM = 256, BK = 64, HALF = 128, HTB = HALF * BK * 2, STAGE_BYTES = 8 * HTB, NXCD = 8, WGM = 8;
__host__ __device__ __forceinline__ int lds_byte(int r, int c) { const int st = (r >> 4) * 2 + (c >> 5), rr = r & 15, cc = c & 31, ob = rr * 64 + cc * 2; return st * 1024 + (ob ^ (((ob >> 9) & 1) << 5)); }
__host__ __device__ __forceinline__ void stage_rc(int b, int& R, int& C) { const int st = b / 1024, sb = b % 1024, swz = sb ^ (((sb >> 9) & 1) << 5); R = (st >> 1) * 16 + swz / 64; C = (st & 1) * 32 + (swz % 64) / 2; }
__host__ __device__ __forceinline__ int perm32(int rho) { const int n = rho >> 4, i = rho & 15; return 8 * (i >> 2) + 4 * n + (i & 3); }
struct Unit { int pm, pn, ks; };
struct Gemm { const bf16_t* A; const bf16_t* Bt; int M, N, K, ld; };
struct StaticOrder {
    int nM, nN, nwg, G, c, KS;
    __device__ void init(int M, int N, int KS_, int G_, int c_) { nM = M / BM; KS = KS_; nN = (N / BM) * KS_; nwg = nM * nN; G = G_; c = c_; }
    __device__ bool next(int i, Unit& u) const {
        const long L = (long)i * G + c; if (L >= nwg) return false;
        int wgid = (int)L; { const int q = nwg / NXCD, r = nwg % NXCD, xcd = wgid % NXCD, off = wgid / NXCD; wgid = (xcd < r ? xcd * (q + 1) : r * (q + 1) + (xcd - r) * q) + off; }
        const int nig = WGM * nN, gid = wgid / nig, fm = gid * WGM, gsz = (nM - fm) < WGM ? (nM - fm) : WGM;
        u.pm = fm + ((wgid % nig) % gsz); const int pn2 = (wgid % nig) / gsz; u.pn = pn2 / KS; u.ks = pn2 % KS; return true;
    }
    __device__ __forceinline__ void a_ready(const Unit&) const {}
    __device__ __forceinline__ void done(const Unit&) const {}
};
__device__ __forceinline__ unsigned cvt_pk_bf16(float lo, float hi) { unsigned r; asm volatile("v_cvt_pk_bf16_f32 %0, %1, %2" : "=v"(r) : "v"(lo), "v"(hi)); return r; }
struct EpiBf16 {
    static constexpr bool PERM = true, AFTER_DRAIN = false;
    bf16_t* O; int ldc;
    __device__ __forceinline__ void operator()(const f32x4 (&acc)[2][2][4][2], const Unit& u, int wr, int wc, int fr, int fq) const {
        const int row0 = u.pm * BM + wr * 64 + fr, col0 = u.pn * BM + wc * 32 + 8 * fq;
#pragma unroll
        for (int ai = 0; ai < 2; ++ai)
#pragma unroll
            for (int m = 0; m < 4; ++m) { bf16_t* rowp = O + (size_t)(row0 + ai * HALF + m * 16) * ldc + col0;
#pragma unroll
                for (int bj = 0; bj < 2; ++bj) { const f32x4 v0 = acc[ai][bj][m][0], v1 = acc[ai][bj][m][1];
                    u32x4 w; w.x = cvt_pk_bf16(v0[0], v0[1]); w.y = cvt_pk_bf16(v0[2], v0[3]); w.z = cvt_pk_bf16(v1[0], v1[1]); w.w = cvt_pk_bf16(v1[2], v1[3]);
                    *(u32x4*)(rowp + bj * HALF) = w; } }
    }
};
struct EpiSwiglu {
    static constexpr bool PERM = true, AFTER_DRAIN = false;
    bf16_t* H;
    __device__ __forceinline__ void operator()(const f32x4 (&acc)[2][2][4][2], const Unit& u, int wr, int wc, int fr, int fq) const {
        const int row0 = u.pm * BM + wr * 64 + fr, col0 = u.pn * HALF + wc * 32 + 8 * fq;
#pragma unroll
        for (int ai = 0; ai < 2; ++ai)
#pragma unroll
            for (int m = 0; m < 4; ++m) {
                float h[8];
#pragma unroll
                for (int n = 0; n < 2; ++n)
#pragma unroll
                    for (int e = 0; e < 4; ++e) { const float gv = acc[ai][0][m][n][e], uv = acc[ai][1][m][n][e]; h[4 * n + e] = gv * __builtin_amdgcn_rcpf(1.f + __expf(-gv)) * uv; }
                u32x4 w; w.x = cvt_pk_bf16(h[0], h[1]); w.y = cvt_pk_bf16(h[2], h[3]); w.z = cvt_pk_bf16(h[4], h[5]); w.w = cvt_pk_bf16(h[6], h[7]);
                *(u32x4*)(H + (size_t)(row0 + ai * HALF + m * 16) * DFF + col0) = w; }
    }
};
struct EpiGate {
    static constexpr bool PERM = true, AFTER_DRAIN = false;
    bf16_t* P; const float* gate;
    __device__ __forceinline__ void operator()(const f32x4 (&acc)[2][2][4][2], const Unit& u, int wr, int wc, int fr, int fq) const {
        const int row0 = u.pm * BM + wr * 64 + fr, col0 = u.pn * BM + wc * 32 + 8 * fq;
        bf16_t* const dstb = P + (size_t)u.ks * P1_HALF;
#pragma unroll
        for (int ai = 0; ai < 2; ++ai)
#pragma unroll
            for (int m = 0; m < 4; ++m) { const int row = row0 + ai * HALF + m * 16; const float* gp = gate + cond_of(row) * 6144 + col0; bf16_t* rowp = dstb + (size_t)row * D + col0;
#pragma unroll
                for (int bj = 0; bj < 2; ++bj) { const f32x4 v0 = acc[ai][bj][m][0] * *(const f32x4*)(gp + bj * HALF), v1 = acc[ai][bj][m][1] * *(const f32x4*)(gp + bj * HALF + 4);
                    u32x4 w; w.x = cvt_pk_bf16(v0[0], v0[1]); w.y = cvt_pk_bf16(v0[2], v0[3]); w.z = cvt_pk_bf16(v1[0], v1[1]); w.w = cvt_pk_bf16(v1[2], v1[3]);
                    *(u32x4*)(rowp + bj * HALF) = w; } }
    }
};
template <class Epi, class Sched, bool ALIGN_EPI = false, bool SP2 = false>
__device__ __forceinline__ void gemm_phase(PG8_LAS unsigned char* lds, const Gemm g, const Sched& S, const Epi& E) {
    int tid_ = tidx();
    const int tid = tid_, wid = __builtin_amdgcn_readfirstlane(tid >> 6), lane = tid & 63, wr = wid >> 2, wc = wid & 3, fr = lane & 15, fq = lane >> 4;
    const int K = g.ld, nt = g.K / BK;
    unsigned voffA[2], voffB[2];
#pragma unroll
    for (int i = 0; i < 2; ++i) { int R, C; stage_rc(tid * 16 + i * 8192, R, C); const int Rb = Epi::PERM ? ((R & ~31) + perm32(R & 31)) : R;
        voffA[i] = (unsigned)(R * K + C) * 2u; voffB[i] = (unsigned)(Rb * K + C) * 2u; }
    const size_t kstep = (size_t)(BK * 2);
    const size_t hstep = (size_t)HALF * K * 2;
    const size_t tstep = 2 * hstep;
    const unsigned ldsw = (unsigned)wid * 1024u;
    const int aoff = lds_byte(wr * 64 + fr, fq * 8), boff = lds_byte(wc * 32 + fr, fq * 8);
#define PG8_SA(b, h) (((b) * 2 + (h)) * HTB)
#define PG8_SB(b, h) ((4 + (b) * 2 + (h)) * HTB)
#define PG8_STAGE(bufoff, gbase, voff) do { _Pragma("unroll") for (int _i = 0; _i < 2; ++_i) \
        __builtin_amdgcn_global_load_lds((const unsigned*)((const char*)(gbase) + (voff)[_i]), (PG8_LAS unsigned*)(lds + (bufoff) + ldsw + _i * 8192), 16, 0, 0); } while (0)
#define PG8_LDA(dst, b, h) do { _Pragma("unroll") for (int m = 0; m < 4; ++m) _Pragma("unroll") for (int k = 0; k < 2; ++k) dst[m][k] = *(const PG8_LAS bf16x8*)(lds + PG8_SA(b, h) + aoff + m * 2048 + k * 1024); } while (0)
#define PG8_LDB(dst, b, h) do { _Pragma("unroll") for (int n = 0; n < 2; ++n) _Pragma("unroll") for (int k = 0; k < 2; ++k) dst[n][k] = *(const PG8_LAS bf16x8*)(lds + PG8_SB(b, h) + boff + n * 2048 + k * 1024); } while (0)
#define PG8_MMA(ai, bj, At, Bt) do { __builtin_amdgcn_s_setprio(1); _Pragma("unroll") for (int m = 0; m < 4; ++m) _Pragma("unroll") for (int n = 0; n < 2; ++n) _Pragma("unroll") for (int k = 0; k < 2; ++k) \
        acc[ai][bj][m][n] = __builtin_amdgcn_mfma_f32_16x16x32_bf16(Bt[n][k], At[m][k], acc[ai][bj][m][n], 0, 0, 0); __builtin_amdgcn_s_setprio(0); } while (0)
#define PG8_WAIT_V(n) asm volatile("s_waitcnt vmcnt(" #n ")" ::: "memory")
#define PG8_WAIT_L(n) asm volatile("s_waitcnt lgkmcnt(" #n ")" ::: "memory")
#define PG8_BAR __builtin_amdgcn_s_barrier()
#define PG8_SCHED __builtin_amdgcn_sched_barrier(0)
    Unit cur, nxt; int ui = 0;
    if (!S.next(0, cur)) return;
    f32x4 acc[2][2][4][2];
#pragma unroll
    for (int a = 0; a < 2; ++a)
#pragma unroll
        for (int b = 0; b < 2; ++b)
#pragma unroll
            for (int m = 0; m < 4; ++m)
#pragma unroll
                for (int n = 0; n < 2; ++n) acc[a][b][m][n] = (f32x4){0.f, 0.f, 0.f, 0.f};
    bf16x8 At[4][2], B0[2][2], B1[2][2];
    const size_t ksb = (size_t)g.K * 2; const char* cA = (const char*)g.A + (size_t)cur.pm * tstep + cur.ks * ksb; const char* cB = (const char*)g.Bt + (size_t)cur.pn * tstep + cur.ks * ksb;
    S.a_ready(cur);
    if constexpr (SP2) {
        PG8_STAGE(PG8_SB(0, 0), cB, voffB); PG8_STAGE(PG8_SB(0, 1), cB + hstep, voffB); PG8_STAGE(PG8_SA(0, 0), cA, voffA); PG8_STAGE(PG8_SA(0, 1), cA + hstep, voffA);
        if (wr == 1) PG8_BAR;
        PG8_WAIT_V(2); PG8_BAR;
        PG8_STAGE(PG8_SB(1, 0), cB + kstep, voffB); PG8_STAGE(PG8_SA(1, 0), cA + kstep, voffA); PG8_STAGE(PG8_SB(1, 1), cB + hstep + kstep, voffB);
        PG8_WAIT_V(6); PG8_BAR;
    } else {
        PG8_STAGE(PG8_SB(0, 0), cB, voffB); PG8_STAGE(PG8_SA(0, 0), cA, voffA); PG8_STAGE(PG8_SB(0, 1), cB + hstep, voffB); PG8_STAGE(PG8_SA(0, 1), cA + hstep, voffA);
        if (wr == 1) PG8_BAR;
        PG8_WAIT_V(4); PG8_BAR;
        PG8_STAGE(PG8_SB(1, 0), cB + kstep, voffB); PG8_STAGE(PG8_SA(1, 0), cA + kstep, voffA); PG8_STAGE(PG8_SB(1, 1), cB + hstep + kstep, voffB);
        PG8_WAIT_V(6); PG8_BAR;
    }
    for (;;) {
        const bool has_next = S.next(ui + 1, nxt);
        const char* nA = has_next ? (const char*)g.A + (size_t)nxt.pm * tstep + nxt.ks * ksb : cA; const char* nB = has_next ? (const char*)g.Bt + (size_t)nxt.pn * tstep + nxt.ks * ksb : cB;
        for (int t = 0; t < nt; t += 2) {
            const bool last = (t == nt - 2);
            const char* a1 = cA + (size_t)(t + 1) * kstep;
            const char* a2 = last ? nA : cA + (size_t)(t + 2) * kstep; const char* b2 = last ? nB : cB + (size_t)(t + 2) * kstep;
            const char* a3 = a2 + kstep; const char* b3 = b2 + kstep;
            if (last && has_next) S.a_ready(nxt);
            if constexpr (SP2) {
            PG8_LDB(B0, 0, 0); PG8_LDB(B1, 0, 1); PG8_SCHED; PG8_LDA(At, 0, 0); PG8_STAGE(PG8_SA(1, 1), a1 + hstep, voffA);
            PG8_WAIT_V(8); PG8_WAIT_L(0); PG8_BAR; PG8_MMA(0, 0, At, B0); PG8_MMA(0, 1, At, B1); PG8_BAR; PG8_SCHED;
            PG8_LDA(At, 0, 1); PG8_STAGE(PG8_SB(0, 0), b2, voffB); PG8_STAGE(PG8_SB(0, 1), b2 + hstep, voffB); PG8_STAGE(PG8_SA(0, 0), a2, voffA);
            PG8_WAIT_V(8); PG8_WAIT_L(0); PG8_BAR; PG8_MMA(1, 0, At, B0); PG8_MMA(1, 1, At, B1); PG8_BAR; PG8_SCHED;
            PG8_LDB(B0, 1, 0); PG8_LDB(B1, 1, 1); PG8_SCHED; PG8_LDA(At, 1, 0); PG8_STAGE(PG8_SA(0, 1), a2 + hstep, voffA);
            PG8_WAIT_V(8); PG8_WAIT_L(0); PG8_BAR; PG8_MMA(0, 0, At, B0); PG8_MMA(0, 1, At, B1); PG8_BAR; PG8_SCHED;
            PG8_LDA(At, 1, 1); PG8_STAGE(PG8_SB(1, 0), b3, voffB); PG8_STAGE(PG8_SB(1, 1), b3 + hstep, voffB); PG8_STAGE(PG8_SA(1, 0), a3, voffA);
            PG8_WAIT_V(8); PG8_WAIT_L(0); PG8_BAR; PG8_MMA(1, 0, At, B0); PG8_MMA(1, 1, At, B1); PG8_BAR; PG8_SCHED;
            } else {
            PG8_LDB(B0, 0, 0); PG8_SCHED; PG8_LDA(At, 0, 0); PG8_STAGE(PG8_SA(1, 1), a1 + hstep, voffA);
            PG8_WAIT_L(8); PG8_BAR; PG8_WAIT_L(0); PG8_MMA(0, 0, At, B0); PG8_BAR; PG8_SCHED;
            PG8_LDB(B1, 0, 1); PG8_STAGE(PG8_SB(0, 0), b2, voffB);
            PG8_BAR; PG8_WAIT_L(0); PG8_MMA(0, 1, At, B1); PG8_BAR;
            PG8_LDA(At, 0, 1); PG8_STAGE(PG8_SA(0, 0), a2, voffA);
            PG8_BAR; PG8_WAIT_L(0); PG8_MMA(1, 0, At, B0); PG8_BAR; PG8_SCHED;
            PG8_STAGE(PG8_SB(0, 1), b2 + hstep, voffB);
            PG8_WAIT_V(6); PG8_BAR; PG8_MMA(1, 1, At, B1); PG8_BAR;
            PG8_LDB(B0, 1, 0); PG8_SCHED; PG8_LDA(At, 1, 0); PG8_STAGE(PG8_SA(0, 1), a2 + hstep, voffA);
            PG8_WAIT_L(8); PG8_BAR; PG8_WAIT_L(0); PG8_MMA(0, 0, At, B0); PG8_BAR; PG8_SCHED;
            PG8_LDB(B1, 1, 1); PG8_STAGE(PG8_SB(1, 0), b3, voffB);
            PG8_BAR; PG8_WAIT_L(0); PG8_MMA(0, 1, At, B1); PG8_BAR;
            PG8_LDA(At, 1, 1); PG8_STAGE(PG8_SA(1, 0), a3, voffA);
            PG8_BAR; PG8_WAIT_L(0); PG8_MMA(1, 0, At, B0); PG8_BAR; PG8_SCHED;
            PG8_STAGE(PG8_SB(1, 1), b3 + hstep, voffB);
            PG8_WAIT_V(6); PG8_BAR; PG8_MMA(1, 1, At, B1); PG8_BAR;
            }
        }
        if constexpr (ALIGN_EPI) { if (wr == 0) PG8_BAR; }
        if constexpr (!Epi::AFTER_DRAIN) { E(acc, cur, wr, wc, fr, fq); S.done(cur); }
        if (!has_next) break;
#pragma unroll
        for (int a = 0; a < 2; ++a)
#pragma unroll
            for (int b = 0; b < 2; ++b)
#pragma unroll
                for (int m = 0; m < 4; ++m)
#pragma unroll
                    for (int n = 0; n < 2; ++n) acc[a][b][m][n] = (f32x4){0.f, 0.f, 0.f, 0.f};
        cur = nxt; cA = nA; cB = nB; ++ui;
        if constexpr (ALIGN_EPI) { if (wr == 1) PG8_BAR; }
    }
    PG8_WAIT_V(0);
    if constexpr (!ALIGN_EPI) { if (wr == 0) PG8_BAR; }
    PG8_BAR;
    if constexpr (Epi::AFTER_DRAIN) { E.fused(acc, cur, wr, wc, fr, fq, lds, wid, lane); S.done(cur); }
#undef PG8_SA
#undef PG8_SB
#undef PG8_STAGE
#undef PG8_LDA
#undef PG8_LDB
#undef PG8_MMA
#undef PG8_WAIT_V
#undef PG8_WAIT_L
#undef PG8_BAR
#undef PG8_SCHED
}
}

template <class Epi>
__device__ __forceinline__ void gemm_run(unsigned char* lds, const bf16_t* A, const bf16_t* Bt, int M, int N, int Ktot, int KS, const Epi& E) {
    pg8::StaticOrder S; S.init(M, N, KS, (int)gridDim.x, (int)blockIdx.x);
    pg8::Gemm g; g.A = A; g.Bt = Bt; g.M = M; g.N = N; g.K = Ktot / KS; g.ld = Ktot;
    __syncthreads();
    pg8::gemm_phase<Epi, pg8::StaticOrder, true, true>((PG8_LAS unsigned char*)lds, g, S, E);
    __syncthreads();
}


#define LDSP __attribute__((address_space(3)))
constexpr int LC_FR = 0, LC_U = 66176, LC_X0 = LC_U + 20480, LC_S = LC_X0 + 20480, LC_Z = LC_S + 17408;
struct LcUnit { int lsel, L, P, REC, c0, m0; };
__device__ __forceinline__ LcUnit lc_unit(int q) {
  LcUnit u; u.lsel = q < 512 ? 1 : 0; const int qq = q & 511; u.c0 = (qq >> 2) * 8; u.m0 = ((u.lsel ? 4 : 0) + (qq & 3)) * 1024;
  u.L = u.lsel ? 1024 : 256; u.P = u.L >> 5; u.REC = 4 * u.L + 40; return u;
}
__device__ void phase_lc(KP p, int j, unsigned char* lds_) {
  LDSP unsigned char* lds = (LDSP unsigned char*)lds_;
  const int tid = tidx(), lane = tid & 63, wid = tid >> 6, n = lane & 31, hi = lane >> 5;
  const bf16_t* ZT = (const bf16_t*)(p->ws + WS_ZT); bf16_t* YG = (bf16_t*)(p->ws + WS_YG);
  const float* cw = p->in[I_HCW] + (size_t)j * 3 * 3072; const float* cb = p->in[I_HCB] + (size_t)j * 3072;
  u32x4 fr[9], zr[2][3]; float zh[2][3][2];
#define LC_PREFETCH(U) do { \
    const u32x4* src_ = (const u32x4*)((const bf16_t*)(p->ws + WS_FRG) + (size_t)j * FRG_J + ((U).lsel ? FRG_L1 : 0) + (size_t)(U).c0 * (U).REC); \
    _Pragma("unroll") for (int i_ = 0; i_ < 9; ++i_) if (i_ * 512 + tid < (U).REC) fr[i_] = src_[i_ * 512 + tid]; \
    _Pragma("unroll") for (int tk_ = 0; tk_ < 2; ++tk_) { const int task_ = tid + 512 * tk_, ch_ = task_ >> 7, tok0_ = (task_ & 127) * 8; \
      const bool first_ = (tok0_ & ((U).L - 1)) == 0, last_ = ((tok0_ + 8) & ((U).L - 1)) == 0; \
      _Pragma("unroll") for (int part_ = 0; part_ < 3; ++part_) { const bf16_t* z_ = ZT + (size_t)(part_ * 1024 + (U).c0 + ch_) * MTOK + (U).m0 + tok0_; \
        zr[tk_][part_] = *(const u32x4*)z_; zh[tk_][part_][0] = first_ ? 0.f : bf2f(z_[-1]); zh[tk_][part_][1] = last_ ? 0.f : bf2f(z_[8]); } } } while (0)
  int q = blockIdx.x;
  if (q >= 1024) return;
  LcUnit cur = lc_unit(q);
  LC_PREFETCH(cur);
  for (;;) {
    const int L = cur.L, P = cur.P, REC = cur.REC, c0 = cur.c0, lsel = cur.lsel; const size_t m0 = (size_t)cur.m0;
    __syncthreads();
    {
      LDSP u32x4* dst = (LDSP u32x4*)(lds + LC_FR);
#pragma unroll
      for (int i = 0; i < 9; ++i) if (i * 512 + tid < REC) dst[i * 512 + tid] = fr[i];
#pragma unroll
      for (int tk = 0; tk < 2; ++tk) {
        const int task = tid + 512 * tk, ch = task >> 7, tok0 = (task & 127) * 8;
        float sc[3][8];
#pragma unroll
        for (int part = 0; part < 3; ++part) {
          const int chn = part * 1024 + c0 + ch;
          const u32x4 w = zr[tk][part];
          float zv[10];
          zv[0] = zh[tk][part][0]; zv[9] = zh[tk][part][1];
          zv[1] = __uint_as_float(w.x << 16); zv[2] = __uint_as_float(w.x & 0xFFFF0000u); zv[3] = __uint_as_float(w.y << 16); zv[4] = __uint_as_float(w.y & 0xFFFF0000u);
          zv[5] = __uint_as_float(w.z << 16); zv[6] = __uint_as_float(w.z & 0xFFFF0000u); zv[7] = __uint_as_float(w.w << 16); zv[8] = __uint_as_float(w.w & 0xFFFF0000u);
          const float w0 = cw[chn], w1 = cw[3072 + chn], w2 = cw[2 * 3072 + chn], bb = cb[chn];
#pragma unroll
          for (int i = 0; i < 8; ++i) sc[part][i] = zv[i] * w0 + zv[i + 1] * w1 + zv[i + 2] * w2 + bb;
        }
        u32x4 xo, uo;
        xo.x = pack2(sc[0][0], sc[0][1]); xo.y = pack2(sc[0][2], sc[0][3]); xo.z = pack2(sc[0][4], sc[0][5]); xo.w = pack2(sc[0][6], sc[0][7]);
        uo.x = pack2(sc[1][0] * sc[2][0], sc[1][1] * sc[2][1]); uo.y = pack2(sc[1][2] * sc[2][2], sc[1][3] * sc[2][3]);
        uo.z = pack2(sc[1][4] * sc[2][4], sc[1][5] * sc[2][5]); uo.w = pack2(sc[1][6] * sc[2][6], sc[1][7] * sc[2][7]);
        const int po = (ch * 1280 + tok0 + 8 * (tok0 >> 5)) * 2;
        *(LDSP u32x4*)(lds + LC_U + po) = uo; *(LDSP u32x4*)(lds + LC_X0 + po) = xo;
      }
    }
    if (tid < 4) ((LDSP unsigned*)(lds + LC_Z))[tid] = 0u;
    __syncthreads();
    const int qn = q + gridDim.x; const bool has = qn < 1024;
    LcUnit nxt = cur;
    if (has) { nxt = lc_unit(qn); LC_PREFETCH(nxt); }
    f32x16 acc;
#pragma unroll
    for (int r = 0; r < 16; ++r) acc[r] = 0.f;
    {
      const int par = n & 1;
      LDSP const unsigned char* fa = lds + LC_FR + wid * (REC * 2) + (par ? (2 * L + 40) * 2 : 0) + 2 * (L - n - par + 8 * hi);
      LDSP const unsigned char* ub = lds + LC_U + wid * 2560 + (40 * n + 8 * hi) * 2;
      const int ti = n & (P - 1);
#define LC_LOAD(s_, AW, BF) do { const int dl_ = ((s_) >> 1) - (P - 1), ks_ = (s_) & 1; \
        LDSP const volatile unsigned* ap_ = (LDSP const volatile unsigned*)(fa + 2 * (-32 * dl_ + 16 * ks_)); \
        AW.x = ap_[0]; AW.y = ap_[1]; AW.z = ap_[2]; AW.w = ap_[3]; \
        LDSP const unsigned char* bp_ = ((unsigned)(ti - dl_) < (unsigned)P) ? (ub + (-40 * dl_ + 16 * ks_) * 2) : (lds + LC_Z); \
        BF = *(LDSP const volatile bf16x8*)bp_; } while (0)
      const int nsteps = 2 * (2 * P - 1);
      u32x4 a0, a1; bf16x8 b0, b1;
      LC_LOAD(0, a0, b0);
      for (int s2 = 0; s2 < nsteps; s2 += 2) {
        LC_LOAD(s2 + 1, a1, b1);
        acc = __builtin_amdgcn_mfma_f32_32x32x16_bf16(__builtin_bit_cast(bf16x8, a0), b0, acc, 0, 0, 0);
        if (s2 + 2 < nsteps) LC_LOAD(s2 + 2, a0, b0);
        acc = __builtin_amdgcn_mfma_f32_32x32x16_bf16(__builtin_bit_cast(bf16x8, a1), b1, acc, 0, 0, 0);
      }
#undef LC_LOAD
    }
    {
      const float rn = ((const float*)(p->ws + WS_RNORM))[(j * 2 + lsel) * 1024 + c0 + wid], bs = p->in[I_HBIAS][j * D + c0 + wid];
      LDSP const bf16_t* uu = (LDSP const bf16_t*)(lds + LC_U) + wid * 1280 + 40 * n;
      LDSP const bf16_t* xx = (LDSP const bf16_t*)(lds + LC_X0) + wid * 1280 + 40 * n;
      LDSP bf16_t* so = (LDSP bf16_t*)(lds + LC_S) + wid * 1088 + 34 * n;
#pragma unroll
      for (int r = 0; r < 16; ++r) {
        const int row = (r & 3) + 8 * (r >> 2) + 4 * hi;
        const float y = acc[r] * rn + bf2f(uu[row]) * bs;
        so[row] = f2bf(bf2f(xx[row]) * y);
      }
    }
    __syncthreads();
    for (int tok = tid; tok < 1024; tok += 512) {
      LDSP const bf16_t* so = (LDSP const bf16_t*)(lds + LC_S) + tok + 2 * (tok >> 5);
      u32x4 w;
      w.x = (unsigned)so[0] | ((unsigned)so[1088] << 16); w.y = (unsigned)so[2 * 1088] | ((unsigned)so[3 * 1088] << 16);
      w.z = (unsigned)so[4 * 1088] | ((unsigned)so[5 * 1088] << 16); w.w = (unsigned)so[6 * 1088] | ((unsigned)so[7 * 1088] << 16);
      *(u32x4*)(YG + (m0 + tok) * D + c0) = w;
    }
    if (!has) break;
    cur = nxt; q = qn;
  }
#undef LC_PREFETCH
  __syncthreads();
}

__device__ void phase_qkvpost(KP p, int j) {
  const int lane = tidx() & 63, wid = tidx() >> 6;
  const unsigned* QKV = (const unsigned*)(p->ws + WS_QKV);
  unsigned* Q = (unsigned*)(p->ws + WS_Q); unsigned* KP = (unsigned*)(p->ws + WS_KP); unsigned* VP = (unsigned*)(p->ws + WS_VP);
  unsigned* KS = (unsigned*)(p->ws + WS_KS) + (size_t)j * 4 * 1536 * 128; unsigned* VS = (unsigned*)(p->ws + WS_VS) + (size_t)j * 4 * 1536 * 128;
  const float* qn = p->in[I_QN] + j * 128; const float* kn = p->in[I_KN] + j * 128;
  float* newk = p->out + (size_t)2 * NPR * D; float* newv = newk + (size_t)16 * 2 * 256 * 256;
  const float qg0 = qn[2 * lane], qg1 = qn[2 * lane + 1], kg0 = kn[2 * lane], kg1 = kn[2 * lane + 1];
  const float freq = exp2f(-(float)(lane & 31) * 0.41524101186092029f);
  for (int m = blockIdx.x * 8 + wid; m < MTOK; m += gridDim.x * 8) {
    const bool smp = m >= NPR;
    float cs = 1.f, sn = 0.f;
    if (smp) { const int t = (m - NPR) & 1023; const float pos = (float)(lane < 32 ? (t >> 6) : (t & 63)); const float rev = (pos * freq) * INV_2PI; cs = cos_rev(rev); sn = sin_rev(rev); }
#pragma unroll
    for (int s = 0; s < 12; ++s) {
      const unsigned raw = QKV[(size_t)m * 768 + s * 64 + lane];
      float x0 = __uint_as_float(raw << 16), x1 = __uint_as_float(raw & 0xFFFF0000u);
      if (s < 10) {
        const float ss = wave_sum(x0 * x0 + x1 * x1);
        const float r = rsqrtf(ss * (1.f / 128.f) + EPS);
        x0 = x0 * r * (s < 8 ? qg0 : kg0); x1 = x1 * r * (s < 8 ? qg1 : kg1);
        if (smp) { const float a = x0, b = x1; x0 = a * cs - b * sn; x1 = a * sn + b * cs; }
      }
      const unsigned w = pack2(x0, x1);
      if (s < 8) Q[(size_t)m * 512 + s * 64 + lane] = w;
      else {
        const int kv = (s - 8) & 1; const bool isk = s < 10;
        if (!smp) {
          (isk ? KP : VP)[(size_t)m * 128 + kv * 64 + lane] = w;
          const int b = m >> 8, t = m & 255;
          float* o = (isk ? newk : newv) + ((((size_t)b * 2 + j) * 256 + t) * 2 + kv) * 128 + 2 * lane;
          o[0] = x0; o[1] = x1;
        } else {
          const int b = (m - NPR) >> 10, t = (m - NPR) & 1023;
          (isk ? KS : VS)[((size_t)b * 1536 + t) * 128 + kv * 64 + lane] = w;
        }
      }
    }
  }
}


namespace att {
typedef unsigned short bf16;
constexpr int   D = 128, NW = 8, QBLK = 32, KVBLK = 64;
constexpr float SCALE = 0.088388347648318440f;
constexpr float THR = 8.f;
constexpr int SDEPTH = 2;
constexpr int LDQ = 1024, LDK = 256, LDO = 1024;
constexpr size_t SHM_V = KVBLK * D * 2, SHM_K = KVBLK * D * 2, SHM_ATTN = 2 * SHM_V + 2 * SHM_K + NW * 64 * 4;

using s16x4  = __attribute__((ext_vector_type(4))) short;
using f32x16 = __attribute__((ext_vector_type(16))) float;
using f32x8  = __attribute__((ext_vector_type(8))) float;

#define KSWZ(row, colB) ((row) * 256 + ((colB) ^ (((row) & 7) << 4)))
#define SBAR() __builtin_amdgcn_sched_barrier(0)
__device__ __forceinline__ int crow(int r, int hi) { return (r & 3) + 8 * (r >> 2) + 4 * hi; }
__device__ __forceinline__ unsigned cvtpk(float lo, float hi) {
  unsigned r; asm volatile("v_cvt_pk_bf16_f32 %0, %1, %2" : "=v"(r) : "v"(lo), "v"(hi)); return r;
}
template <typename TIn> struct Stage;
template <> struct Stage<bf16>  { using T = bf16x8;
  __device__ static __forceinline__ T ld8(const bf16* p) { return *reinterpret_cast<const bf16x8*>(p); }
  __device__ static __forceinline__ bf16x8 tobf(T x) { return x; } };
template <> struct Stage<float> { using T = f32x8;
  __device__ static __forceinline__ T ld8(const float* p) { return *reinterpret_cast<const f32x8*>(p); }
  __device__ static __forceinline__ bf16x8 tobf(T x) {
    u32x4 w = {cvtpk(x[0], x[1]), cvtpk(x[2], x[3]), cvtpk(x[4], x[5]), cvtpk(x[6], x[7])}; return *reinterpret_cast<bf16x8*>(&w); } };

__device__ __forceinline__ void partialSM(f32x16& p0, f32x16& p1, float& m_reg, float& mn, float& alpha) {
  constexpr float C = SCALE * 1.4426950408889634f;
  float pmax = p0[0]; for (int r = 1; r < 16; ++r) pmax = fmaxf(pmax, p0[r]); for (int r = 0; r < 16; ++r) pmax = fmaxf(pmax, p1[r]);
  { auto rr = __builtin_amdgcn_permlane32_swap(__float_as_uint(pmax), __float_as_uint(pmax), false, false);
    pmax = fmaxf(__uint_as_float(rr[0]), __uint_as_float(rr[1])); }
  if (__builtin_expect(__all(pmax - m_reg <= THR / SCALE), 1)) { mn = m_reg; alpha = 1.f; }
  else { mn = fmaxf(m_reg, pmax); alpha = __builtin_amdgcn_exp2f((m_reg - mn) * C); m_reg = mn; }
  float mnC = -mn * C;
  for (int r = 0; r < 16; ++r) p0[r] = fmaf(p0[r], C, mnC); for (int r = 0; r < 16; ++r) p1[r] = fmaf(p1[r], C, mnC);
  for (int r = 0; r < 16; ++r) p0[r] = __builtin_amdgcn_exp2f(p0[r]);
}
__device__ __forceinline__ void finishSM(f32x16& p0, f32x16& p1, float alpha, float& l_reg, bf16x8& pa0, bf16x8& pa1, bf16x8& pa2, bf16x8& pa3) {
  for (int r = 0; r < 16; ++r) p1[r] = __builtin_amdgcn_exp2f(p1[r]);
  float ps = 0; for (int r = 0; r < 16; ++r) ps += p0[r]; for (int r = 0; r < 16; ++r) ps += p1[r];
  { auto rr = __builtin_amdgcn_permlane32_swap(__float_as_uint(ps), __float_as_uint(ps), false, false);
    ps = __uint_as_float(rr[0]) + __uint_as_float(rr[1]); }
  l_reg = l_reg * alpha + ps;
#define PK4(P, BASE, OUT) do { unsigned a0 = cvtpk(P[BASE + 0], P[BASE + 1]), a1 = cvtpk(P[BASE + 2], P[BASE + 3]);   \
    unsigned b0 = cvtpk(P[BASE + 4], P[BASE + 5]), b1 = cvtpk(P[BASE + 6], P[BASE + 7]);                              \
    auto r0 = __builtin_amdgcn_permlane32_swap(a0, b0, false, false); auto r1 = __builtin_amdgcn_permlane32_swap(a1, b1, false, false); \
    u32x4 w = {r0[0], r1[0], r0[1], r1[1]}; OUT = *reinterpret_cast<bf16x8*>(&w); } while (0)
  PK4(p0, 0, pa0); PK4(p0, 8, pa1); PK4(p1, 0, pa2); PK4(p1, 8, pa3);
#undef PK4
}
__device__ __forceinline__ void qkt(f32x16& p0, f32x16& p1, const bf16* Ks, const bf16x8* qr, int r32, int hi) {
  p0 = f32x16{}; p1 = f32x16{};
  for (int d0 = 0; d0 < 8; ++d0) { int cb = (d0 * 16 + hi * 8) * 2;
    bf16x8 b0 = *reinterpret_cast<const bf16x8*>((const char*)Ks + KSWZ(r32, cb));
    bf16x8 b1 = *reinterpret_cast<const bf16x8*>((const char*)Ks + KSWZ(32 + r32, cb));
    p0 = __builtin_amdgcn_mfma_f32_32x32x16_bf16(b0, qr[d0], p0, 0, 0, 0);
    p1 = __builtin_amdgcn_mfma_f32_32x32x16_bf16(b1, qr[d0], p1, 0, 0, 0); }
}
__device__ __forceinline__ int v_st(int k, int c) { const int kk = (k & ~0xC) | ((k & 4) << 1) | ((k & 8) >> 1); return ((kk >> 3) * 4 + (c >> 5)) * 512 + ((kk & 7) * 32 + (c & 31)) * 2; }
__device__ __forceinline__ int v_rd_base(int lane) { return ((lane & 3) << 3) | (((lane >> 2) & 3) << 6) | (((lane >> 4) & 1) << 5) | (((lane >> 5) & 1) << 8); }
constexpr int v_rd_off(int d0, int ks, int half) { return d0 * 512 + ks * 4096 + half * 2048; }
template <int OFF> __device__ __forceinline__ s16x4 tr_read(int vb) {
  s16x4 r; asm volatile("ds_read_b64_tr_b16 %0, %1 offset:%2" : "=&v"(r) : "v"(vb), "i"(OFF) : "memory"); return r;
}
template <int D0> __device__ __forceinline__ void pv_one(f32x16& od, int vb, bf16x8 pa0, bf16x8 pa1, bf16x8 pa2, bf16x8 pa3) {
  const s16x4 l0 = tr_read<v_rd_off(D0, 0, 0)>(vb), h0 = tr_read<v_rd_off(D0, 0, 1)>(vb), l1 = tr_read<v_rd_off(D0, 1, 0)>(vb), h1 = tr_read<v_rd_off(D0, 1, 1)>(vb);
  const s16x4 l2 = tr_read<v_rd_off(D0, 2, 0)>(vb), h2 = tr_read<v_rd_off(D0, 2, 1)>(vb), l3 = tr_read<v_rd_off(D0, 3, 0)>(vb), h3 = tr_read<v_rd_off(D0, 3, 1)>(vb);
  asm volatile("s_waitcnt lgkmcnt(0)" ::: "memory"); SBAR();
#define PK(L, H) (bf16x8){L[0], L[1], L[2], L[3], H[0], H[1], H[2], H[3]}
  od = __builtin_amdgcn_mfma_f32_32x32x16_bf16(pa0, PK(l0, h0), od, 0, 0, 0);
  od = __builtin_amdgcn_mfma_f32_32x32x16_bf16(pa1, PK(l1, h1), od, 0, 0, 0);
  od = __builtin_amdgcn_mfma_f32_32x32x16_bf16(pa2, PK(l2, h2), od, 0, 0, 0);
  od = __builtin_amdgcn_mfma_f32_32x32x16_bf16(pa3, PK(l3, h3), od, 0, 0, 0);
#undef PK
}
__device__ __forceinline__ void pv_d0(f32x16* o, int vb, bf16x8 pa0, bf16x8 pa1, bf16x8 pa2, bf16x8 pa3) {
  pv_one<0>(o[0], vb, pa0, pa1, pa2, pa3); pv_one<1>(o[1], vb, pa0, pa1, pa2, pa3); pv_one<2>(o[2], vb, pa0, pa1, pa2, pa3); pv_one<3>(o[3], vb, pa0, pa1, pa2, pa3);
}

template <typename TQ>
__device__ __forceinline__ void attn_dense_body(const TQ* __restrict__ Qb, const bf16* __restrict__ Kh, const bf16* __restrict__ Vh,
                                                bf16* __restrict__ Ob, int seq, char* lds) {
  using St = Stage<bf16>; using SQ = Stage<TQ>;
  const int tid = tidx(), wid = tid >> 6, lane = tid & 63, r32 = lane & 31, hi = lane >> 5;
  bf16* V_lds = (bf16*)lds; bf16* K_lds = (bf16*)(lds + 2 * SHM_V);
  float* ws = (float*)(lds + 2 * SHM_V + 2 * SHM_K) + wid * 64; float* li_l = ws; float* al_l = ws + 32;
  float m_reg = -1e30f, l_reg = 0; f32x16 o[4] = {}; bf16x8 qr[8];
  const TQ* Qw = Qb + (long)(wid * QBLK + r32) * LDQ + hi * 8;
#pragma unroll
  for (int d0 = 0; d0 < 8; ++d0) qr[d0] = SQ::tobf(SQ::ld8(Qw + d0 * 16));
  const int sr = tid >> 4, sc = (tid & 15) * 8, vst0 = v_st(sr, sc), vst1 = v_st(32 + sr, sc);
  const int vb0 = (int)(uintptr_t)V_lds + v_rd_base(lane);
  struct { typename St::T vs0, vs1, ks0, ks1; } sr_[SDEPTH];
#define SLOAD(i, k0) do { sr_[i].vs0 = St::ld8(&Vh[(long)((k0) + sr) * LDK + sc]); sr_[i].vs1 = St::ld8(&Vh[(long)((k0) + 32 + sr) * LDK + sc]); \
    sr_[i].ks0 = St::ld8(&Kh[(long)((k0) + sr) * LDK + sc]); sr_[i].ks1 = St::ld8(&Kh[(long)((k0) + 32 + sr) * LDK + sc]); } while (0)
#define SWRITE(b, i) do { *(bf16x8*)((char*)V_lds + (b) * SHM_V + vst0) = St::tobf(sr_[i].vs0);          \
    *(bf16x8*)((char*)V_lds + (b) * SHM_V + vst1) = St::tobf(sr_[i].vs1); int kc = sc * 2;               \
    *(bf16x8*)((char*)K_lds + (b) * SHM_K + KSWZ(sr, kc)) = St::tobf(sr_[i].ks0);                       \
    *(bf16x8*)((char*)K_lds + (b) * SHM_K + KSWZ(32 + sr, kc)) = St::tobf(sr_[i].ks1); } while (0)
#define SWAIT() do { if constexpr (SDEPTH == 2) asm volatile("s_waitcnt vmcnt(4)" ::: "memory"); else asm volatile("s_waitcnt vmcnt(0)" ::: "memory"); } while (0)
#define RESC(a) do { if (__any((a) < 1.f)) { if (hi == 0) al_l[r32] = (a); asm volatile("s_waitcnt lgkmcnt(0)" ::: "memory"); \
    for (int d = 0; d < 4; ++d) for (int r = 0; r < 16; ++r) o[d][r] *= al_l[crow(r, hi)]; } } while (0)
  f32x16 pA0, pA1, pB0, pB1; float mnA, mnB, alA, alB; bf16x8 pa0, pa1, pa2, pa3; const int NT = seq / KVBLK;
  constexpr int SE = 0, SO = SDEPTH - 1;
  SLOAD(SE, 0); asm volatile("s_waitcnt vmcnt(0)" ::: "memory"); SWRITE(0, SE); __syncthreads();
  qkt(pA0, pA1, K_lds, qr, r32, hi); partialSM(pA0, pA1, m_reg, mnA, alA);
  SLOAD(SO, KVBLK); if constexpr (SDEPTH == 2) { if (2 < NT) SLOAD(SE, 2 * KVBLK); }
  SWAIT(); SWRITE(1, SO); __syncthreads();
  for (int j = 1; j + 1 < NT; j += 2) {
    SBAR(); qkt(pB0, pB1, (bf16*)((char*)K_lds + SHM_K), qr, r32, hi);
    finishSM(pA0, pA1, alA, l_reg, pa0, pa1, pa2, pa3); SBAR();
    SLOAD(SO, (j + SDEPTH) * KVBLK); SBAR();
    pv_d0(o, vb0, pa0, pa1, pa2, pa3); partialSM(pB0, pB1, m_reg, mnB, alB);
    __syncthreads(); SWAIT(); SWRITE(0, SE);
    RESC(alB); __syncthreads();
    SBAR(); qkt(pA0, pA1, K_lds, qr, r32, hi);
    finishSM(pB0, pB1, alB, l_reg, pa0, pa1, pa2, pa3); SBAR();
    if (SDEPTH == 1 || j + 3 < NT) SLOAD(SE, (j + 1 + SDEPTH) * KVBLK); SBAR();
    pv_d0(o, vb0 + (int)SHM_V, pa0, pa1, pa2, pa3); partialSM(pA0, pA1, m_reg, mnA, alA);
    __syncthreads(); SWAIT(); SWRITE(1, SO);
    RESC(alA); __syncthreads();
  }
  SBAR(); qkt(pB0, pB1, (bf16*)((char*)K_lds + SHM_K), qr, r32, hi);
  finishSM(pA0, pA1, alA, l_reg, pa0, pa1, pa2, pa3); SBAR();
  pv_d0(o, vb0, pa0, pa1, pa2, pa3); partialSM(pB0, pB1, m_reg, mnB, alB);
  __syncthreads(); RESC(alB);
  finishSM(pB0, pB1, alB, l_reg, pa0, pa1, pa2, pa3); SBAR();
  pv_d0(o, vb0 + (int)SHM_V, pa0, pa1, pa2, pa3);
  if (hi == 0) li_l[r32] = l_reg; asm volatile("s_waitcnt lgkmcnt(0)" ::: "memory");
  float rli[16];
#pragma unroll
  for (int r = 0; r < 16; ++r) rli[r] = __builtin_amdgcn_rcpf(li_l[crow(r, hi)]);
  bf16* Ow = Ob + (long)(wid * QBLK) * LDO;
#pragma unroll
  for (int r = 0; r < 16; ++r) { int orow = crow(r, hi);
    for (int d0 = 0; d0 < 4; ++d0) Ow[(long)orow * LDO + d0 * 32 + r32] = f2bf(o[d0][r] * rli[r]); }
#undef SLOAD
#undef SWRITE
#undef SWAIT
#undef RESC
}
}

__device__ void phase_att(KP p, int j, unsigned char* lds) {
  const bf16_t* Q = (const bf16_t*)(p->ws + WS_Q); bf16_t* O = (bf16_t*)(p->ws + WS_O);
  const bf16_t* KP = (const bf16_t*)(p->ws + WS_KP); const bf16_t* VP = (const bf16_t*)(p->ws + WS_VP);
  const bf16_t* KS = (const bf16_t*)(p->ws + WS_KS) + (size_t)j * 4 * 1536 * 256; const bf16_t* VS = (const bf16_t*)(p->ws + WS_VS) + (size_t)j * 4 * 1536 * 256;
  for (int u = blockIdx.x; u < 256; u += gridDim.x) {
    __syncthreads();
    if (u < 128) {
      const int qb = u & 3, h = (u >> 2) & 7, b = u >> 5, kv = h >> 2;
      const size_t row0 = (size_t)NPR + b * 1024 + qb * 256, kb = ((size_t)b * 1536) * 256 + kv * 128;
      att::attn_dense_body<att::bf16>(Q + row0 * D + h * 128, KS + kb, VS + kb, O + row0 * D + h * 128, 1536, (char*)lds);
    } else {
      const int h = (u - 128) & 7, b = (u - 128) >> 3, kv = h >> 2;
      const size_t row0 = (size_t)b * 256, kb = row0 * 256 + kv * 128;
      att::attn_dense_body<att::bf16>(Q + row0 * D + h * 128, KP + kb, VP + kb, O + row0 * D + h * 128, 256, (char*)lds);
    }
  }
  __syncthreads();
  if (j == 0) {
    for (int w = (int)((blockIdx.x + gridDim.x - (128 % gridDim.x)) % gridDim.x); w < 128; w += gridDim.x)
      cvt_all(p, (float*)lds, 1, w * 23, 23, 1);
    __syncthreads();
  }
}

__device__ void qkv_idle_work(KP p, unsigned char* lds) {
  const int G = (int)gridDim.x, b = (int)blockIdx.x, first = G > 192 ? 192 : 0, nw = G - first;
  if (b >= first) for (int t = b - first; t < 96; t += nw) task_mod(p, 96 + t, (float*)lds, (float*)(p->ws + WS_FILT));
  __syncthreads();
}

#define XB_TMO      128
#define XB_XCNT(j)  (256  + 64 * (j))
#define XB_XSUB(j)  (1280 + 64 * (j))
#define XB_XGEN(j)  (2304 + 64 * (j))
#define XB_TOP      3328
#define XB_TOPGEN   3392
#define XCD_BAR_WORDS 3456
#define XB_SPIN_CAP (1u << 18)
#define LAS __attribute__((address_space(3)))

__device__ __forceinline__ unsigned xb_ld(unsigned* p)              { return __hip_atomic_load(p, __ATOMIC_RELAXED, __HIP_MEMORY_SCOPE_AGENT); }
__device__ __forceinline__ unsigned xb_add(unsigned* p, unsigned v) { return __hip_atomic_fetch_add(p, v, __ATOMIC_RELAXED, __HIP_MEMORY_SCOPE_AGENT); }
__device__ __forceinline__ unsigned xb_xcc_id() { return (unsigned)__builtin_amdgcn_s_getreg((3 << 11) | 20) & 0xFu; }
#define XB_SPIN(cond, bar) do { unsigned _sp = 0; while (cond) { __builtin_amdgcn_s_sleep(1); \
    if ((++_sp & 255u) == 0u) { if (xb_ld(&(bar)[XB_TMO])) break; if (_sp > XB_SPIN_CAP) { atomicAdd(&(bar)[XB_TMO], 1u); break; } } } } while (0)

struct XcdBarrier {
    unsigned* bar; unsigned x;
    volatile LAS unsigned* st;
};

__device__ __forceinline__ XcdBarrier xcd_barrier_post(unsigned* bar, volatile LAS unsigned* st) {
    XcdBarrier b; b.bar = bar; b.x = xb_xcc_id(); b.st = st;
    if (threadIdx.x == 0) (void)xb_add(&bar[XB_XCNT(b.x)], 1u);
    return b;
}
__device__ __forceinline__ void xcd_barrier_complete(unsigned* bar, unsigned x, unsigned& nloc, unsigned& nx) {
    const unsigned G = gridDim.x * gridDim.y * gridDim.z;
    unsigned sum, cnt, mine, sp = 0u;
    for (;;) {
        sum = 0u; cnt = 0u; mine = 0u;
#pragma unroll
        for (unsigned j = 0; j < 16; ++j) { const unsigned c = xb_ld(&bar[XB_XCNT(j)]); sum += c; cnt += (c > 0u) ? 1u : 0u; mine = (j == x) ? c : mine; }
        if (sum == G) break;
        __builtin_amdgcn_s_sleep(1);
        if ((++sp & 255u) == 0u) { if (xb_ld(&bar[XB_TMO])) break; if (sp > XB_SPIN_CAP) { atomicAdd(&bar[XB_TMO], 1u); break; } }
    }
    nloc = mine > 0u ? mine : 1u; nx = cnt > 0u ? cnt : 1u;
}

__device__ __forceinline__ void xcd_barrier(const XcdBarrier& b) {
    asm volatile("s_waitcnt vmcnt(0)" ::: "memory");
    __syncthreads();
    if (threadIdx.x == 0) {
        unsigned* bar = b.bar;
        __builtin_amdgcn_s_waitcnt(0);
        unsigned nloc = b.st[0], nx = b.st[1];
        if (nloc == 0u) { xcd_barrier_complete(bar, b.x, nloc, nx); b.st[0] = nloc; b.st[1] = nx; }
        const unsigned old = xb_add(&bar[XB_XSUB(b.x)], 1u);
        const unsigned gen = old / nloc;
        if (old + 1u == (gen + 1u) * nloc) {
            __builtin_amdgcn_fence(__ATOMIC_RELEASE, "agent");
            asm volatile("s_waitcnt vmcnt(0)" ::: "memory");
            const unsigned og = xb_add(&bar[XB_TOP], 1u);
            const unsigned tg = og / nx;
            if (og + 1u == (tg + 1u) * nx) xb_add(&bar[XB_TOPGEN], 1u);
            else XB_SPIN(xb_ld(&bar[XB_TOPGEN]) == tg, bar);
            __builtin_amdgcn_fence(__ATOMIC_ACQUIRE, "agent");
            xb_add(&bar[XB_XGEN(b.x)], 1u);
            asm volatile("s_waitcnt vmcnt(0)" ::: "memory");
        } else {
            XB_SPIN(xb_ld(&bar[XB_XGEN(b.x)]) == gen, bar);
            __builtin_amdgcn_fence(__ATOMIC_ACQUIRE, "agent");
            asm volatile("s_waitcnt vmcnt(0)" ::: "memory");
        }
    }
    __syncthreads();
}

__global__ void __launch_bounds__(512, 2) mega(Params pv) {
  extern __shared__ __attribute__((aligned(16))) unsigned char lds[];
  cg::grid_group grid = cg::this_grid();
  volatile LAS unsigned* xst = (volatile LAS unsigned*)((LAS unsigned char*)lds + (LDS_BYTES - 16));
  if (threadIdx.x < 4) xst[threadIdx.x] = 0u;
  __syncthreads();
  (void)xcd_barrier_post((unsigned*)((KP)__builtin_amdgcn_kernarg_segment_ptr())->ws, xst);
#define XN ((bf16_t*)(p->ws + WS_XN))
#define MOD ((const float*)(p->ws + WS_MOD))
#define XBAR() do { XcdBarrier b_; b_.bar = (unsigned*)KPARAMS()->ws; b_.x = xb_xcc_id(); b_.st = xst; xcd_barrier(b_); } while (0)
#define KPARAMS() ({ unsigned long long a_ = (unsigned long long)__builtin_amdgcn_kernarg_segment_ptr(); asm volatile("" : "+s"(a_)); (KP)a_; })
#define RUN(stmt) do { int lv = l; asm volatile("" : "+s"(lv)); const int jv = lv >> 1; (void)jv; const KP p = KPARAMS(); stmt; XBAR(); } while (0)
  { const KP p = KPARAMS(); phase_p0(p, lds); if (p->ph_lo != 0) grid.sync(); }
  XBAR();
  { const KP p = KPARAMS(); phase_p0b(p); }
  XBAR();
#pragma unroll 1
  for (int l = 0; l < 4; ++l) {
    RUN(phase_nm(p, lv, 0, lv > 0));
    if ((l & 1) == 0) {
      RUN(gemm_run(lds, (const bf16_t*)(p->ws + WS_WIN) + (size_t)jv * 3072 * D, XN, 3072, MTOK, D, 1, pg8::EpiBf16{(bf16_t*)(p->ws + WS_ZT), MTOK}));
      RUN(phase_lc(p, jv, lds));
      RUN(gemm_run(lds, (const bf16_t*)(p->ws + WS_YG), (const bf16_t*)(p->ws + WS_WHO) + (size_t)jv * D * D, MTOK, D, D, 2, pg8::EpiGate{(bf16_t*)(p->ws + WS_P1), MOD + (size_t)lv * 5 * 6144 + 2048}));
    } else {
      RUN({ gemm_run(lds, XN, (const bf16_t*)(p->ws + WS_WQKV) + (size_t)jv * QKVD * D, MTOK, QKVD, D, 1, pg8::EpiBf16{(bf16_t*)(p->ws + WS_QKV), QKVD}); if (lv == 1) qkv_idle_work(p, lds); });
      RUN(phase_qkvpost(p, jv));
      RUN(phase_att(p, jv, lds));
      RUN(gemm_run(lds, (const bf16_t*)(p->ws + WS_O), (const bf16_t*)(p->ws + WS_WAO) + (size_t)jv * D * D, MTOK, D, D, 2, pg8::EpiGate{(bf16_t*)(p->ws + WS_P1), MOD + (size_t)lv * 5 * 6144 + 2048}));
    }
    RUN({ phase_nm(p, lv, 1, true); if (lv == 1) mod_finalize(p, 1, (const float*)(p->ws + WS_FILT)); });
    RUN(gemm_run(lds, XN, (const bf16_t*)(p->ws + WS_WGU) + (size_t)lv * 2 * DFF * D, MTOK, 2 * DFF, D, 1, pg8::EpiSwiglu{(bf16_t*)(p->ws + WS_H)}));
    RUN(gemm_run(lds, (const bf16_t*)(p->ws + WS_H), (const bf16_t*)(p->ws + WS_WDN) + (size_t)lv * D * DFF, MTOK, D, DFF, 2, pg8::EpiGate{(bf16_t*)(p->ws + WS_P1), MOD + (size_t)lv * 5 * 6144 + 5 * 1024}));
  }
  { const KP p = KPARAMS(); phase_final(p); }
#undef RUN
#undef KPARAMS
#undef XN
#undef MOD
}
constexpr int N_PHASES = 2 + 2 * 7 + 2 * 8 + 1;


extern "C" void kernel_launch(void* const* d_in, const int* in_sizes, int n_in, void* d_out, int out_size, void* d_ws, size_t ws_size, hipStream_t stream) {
  static int grid = 0;
  if (grid == 0) {
    if (n_in != 29 || ws_size < WS_END) { fprintf(stderr, "kernel_launch: n_in %d ws %zu (need 29, >= %zu)\n", n_in, ws_size, (size_t)WS_END); grid = -1; return; }
    int dev = 0, cus = 0, per_cu = 0;
    hipGetDevice(&dev);
    hipDeviceGetAttribute(&cus, hipDeviceAttributeMultiprocessorCount, dev);
    if (hipFuncSetAttribute((const void*)mega, hipFuncAttributeMaxDynamicSharedMemorySize, LDS_BYTES) != hipSuccess) { fprintf(stderr, "kernel_launch: hipFuncSetAttribute failed\n"); grid = -1; return; }
    hipOccupancyMaxActiveBlocksPerMultiprocessor(&per_cu, (const void*)mega, 512, LDS_BYTES);
    if (per_cu < 1) { fprintf(stderr, "kernel_launch: occupancy query says %d blocks per CU\n", per_cu); per_cu = 1; }
    grid = cus * per_cu;
  }
  if (grid < 0) return;
  Params p{};
  for (int i = 0; i < 29; ++i) p.in[i] = (const float*)d_in[i];
  p.out = (float*)d_out; p.ws = (unsigned char*)d_ws;

  if (hipMemsetAsync(d_ws, 0, 16384, stream) != hipSuccess) { fprintf(stderr, "kernel_launch: memset of the barrier words failed\n"); return; }
  void* args[] = {&p};
  hipError_t e = hipLaunchCooperativeKernel((const void*)mega, dim3(grid), dim3(512), args, LDS_BYTES, stream);
  if (e != hipSuccess) fprintf(stderr, "cooperative launch failed: %s (grid %d)\n", hipGetErrorString(e), grid);

}
```

```cpp
#include <hip/hip_runtime.h>
#include <hip/hip_cooperative_groups.h>
#include <cstdio>
#include <cstdint>
namespace cg = cooperative_groups;

typedef unsigned short bf16_t;
typedef short bf16x8 __attribute__((ext_vector_type(8)));
typedef float f32x4 __attribute__((ext_vector_type(4)));
typedef unsigned u32x4 __attribute__((ext_vector_type(4)));
typedef float f32x16 __attribute__((ext_vector_type(16)));

constexpr int D = 1024, MTOK = 8192, NPR = 4096;
constexpr int DFF = 2816, QKVD = 1536;
constexpr float EPS = 1e-6f;
constexpr float MIN_DECAY = -3.0701134573253944f, MAX_DECAY = -15.350567286626972f;

constexpr size_t MiB = 1u << 20;
constexpr size_t WS_MOD = 1 * MiB, WS_MODP = 2 * MiB, WS_FSQP = 6 * MiB, WS_RNORM = 7 * MiB, WS_FILT = 8 * MiB;
constexpr size_t WS_WIN = 28 * MiB, WS_WHO = 40 * MiB, WS_WQKV = 44 * MiB, WS_WAO = 50 * MiB, WS_WGU = 54 * MiB, WS_WDN = 98 * MiB;
constexpr size_t WS_Y = 120 * MiB, WS_XN = 152 * MiB, WS_R = 168 * MiB;
constexpr size_t WS_ZT = WS_R, WS_YG = WS_R + 48 * MiB, WS_P1 = WS_R + 64 * MiB;
constexpr size_t P1_HALF = (size_t)MTOK * D;
constexpr size_t WS_QKV = WS_R, WS_Q = WS_R + 24 * MiB, WS_KP = WS_R + 40 * MiB, WS_VP = WS_R + 42 * MiB, WS_O = WS_R + 44 * MiB;
constexpr size_t WS_H = WS_R;
constexpr size_t WS_KS = WS_R + 96 * MiB, WS_VS = WS_R + 102 * MiB, WS_FRG = WS_R + 108 * MiB, WS_END = WS_R + 130 * MiB;
constexpr size_t FRG_J = 11 * MiB / 2, FRG_L1 = (size_t)1024 * (4 * 256 + 34);
constexpr size_t FILT_J = 10 * MiB / 4;
constexpr size_t FILT_L1 = 1024 * 512;

constexpr int LDS_BYTES = 147456;

struct Params {
  const float* in[29];
  float* out;
  unsigned char* ws;
  int ph_lo, ph_hi;
};
typedef const __attribute__((address_space(4))) Params* KP;
enum { I_XP = 0, I_XS, I_CK, I_CV, I_C, I_CCTX, I_MODW, I_MODB, I_NMIX, I_NFFN, I_HWIN, I_HCW, I_HCB, I_FW1, I_FB1, I_FFREQ, I_FW2, I_FB2, I_FW3,
       I_HBIAS, I_HWOUT, I_WQKV, I_QN, I_KN, I_WAO, I_WG, I_WU, I_WD, I_FN };

__device__ __forceinline__ bf16_t f2bf(float f) { unsigned u = __float_as_uint(f); u += 0x7FFFu + ((u >> 16) & 1u); return (bf16_t)(u >> 16); }
__device__ __forceinline__ float bf2f(bf16_t b) { return __uint_as_float(((unsigned)b) << 16); }
__device__ __forceinline__ unsigned pack2(float lo, float hi) { unsigned r; asm("v_cvt_pk_bf16_f32 %0, %1, %2" : "=v"(r) : "v"(lo), "v"(hi)); return r; }
__device__ __forceinline__ float wave_sum(float v) {
#pragma unroll
  for (int o = 32; o >= 1; o >>= 1) v += __shfl_xor(v, o);
  return v;
}
__device__ __forceinline__ float wave_max(float v) {
#pragma unroll
  for (int o = 32; o >= 1; o >>= 1) v = fmaxf(v, __shfl_xor(v, o));
  return v;
}
__device__ __forceinline__ unsigned bidx() { unsigned b; asm volatile("s_mov_b32 %0, %1" : "=s"(b) : "s"(__builtin_amdgcn_workgroup_id_x())); return b; }
__device__ __forceinline__ unsigned gdim() { unsigned g = __builtin_amdgcn_grid_size_x() / __builtin_amdgcn_workgroup_size_x(); asm volatile("" : "+s"(g)); return g; }
__device__ __forceinline__ int tidx() { int t = threadIdx.x; asm volatile("" : "+v"(t)); return t; }
__device__ __forceinline__ int cond_of(int m) { return m < NPR ? 4 : ((m - NPR) >> 10); }
__device__ __forceinline__ float silu_f(float x) { return x / (1.f + expf(-x)); }
__device__ __forceinline__ float sin_rev(float r) { return __builtin_amdgcn_sinf(r - rintf(r)); }
__device__ __forceinline__ float cos_rev(float r) { return __builtin_amdgcn_cosf(r - rintf(r)); }
constexpr float INV_2PI = 0.15915494309189535f;

struct TileDesc { const float* src; bf16_t* dst; int K, N, k0, n0, mode; };
constexpr int H_WIN = 16 * 24, H_WHO = 16 * 8, H_WQKV = 16 * 12, H_WAO = 16 * 8, H_G = 2 * 16 * 22, H_DN = 2 * 44 * 8;
constexpr int NT_CVT_HALF = H_WIN + H_WHO + H_WQKV + H_WAO + 2 * H_G + H_DN;
__device__ __forceinline__ TileDesc cvt_decode(KP p, int t, int late) {
  TileDesc d;
  if (t < H_WIN) { const int l = late, r = t; d.src = p->in[I_HWIN] + (size_t)l * D * 3072; d.dst = (bf16_t*)(p->ws + WS_WIN) + (size_t)l * 3072 * D; d.K = D; d.N = 3072; d.k0 = (r / 24) * 64; d.n0 = (r % 24) * 128; d.mode = 0; return d; }
  t -= H_WIN;
  if (t < H_WHO) { const int l = late, r = t; d.src = p->in[I_HWOUT] + (size_t)l * D * D; d.dst = (bf16_t*)(p->ws + WS_WHO) + (size_t)l * D * D; d.K = D; d.N = D; d.k0 = (r / 8) * 64; d.n0 = (r % 8) * 128; d.mode = 0; return d; }
  t -= H_WHO;
  if (t < H_WQKV) { const int l = late, r = t; d.src = p->in[I_WQKV] + (size_t)l * D * QKVD; d.dst = (bf16_t*)(p->ws + WS_WQKV) + (size_t)l * QKVD * D; d.K = D; d.N = QKVD; d.k0 = (r / 12) * 64; d.n0 = (r % 12) * 128; d.mode = 0; return d; }
  t -= H_WQKV;
  if (t < H_WAO) { const int l = late, r = t; d.src = p->in[I_WAO] + (size_t)l * D * D; d.dst = (bf16_t*)(p->ws + WS_WAO) + (size_t)l * D * D; d.K = D; d.N = D; d.k0 = (r / 8) * 64; d.n0 = (r % 8) * 128; d.mode = 0; return d; }
  t -= H_WAO;
  if (t < 2 * H_G) { const int up = t >= H_G ? 1 : 0; t -= up * H_G; const int l = 2 * late + t / (16 * 22), r = t % (16 * 22);
    d.src = p->in[up ? I_WU : I_WG] + (size_t)l * D * DFF; d.dst = (bf16_t*)(p->ws + WS_WGU) + (size_t)l * 2 * DFF * D; d.K = D; d.N = DFF; d.k0 = (r / 22) * 64; d.n0 = (r % 22) * 128; d.mode = 1 + up; return d; }
  t -= 2 * H_G;
  { const int l = 2 * late + t / (44 * 8), r = t % (44 * 8); d.src = p->in[I_WD] + (size_t)l * DFF * D; d.dst = (bf16_t*)(p->ws + WS_WDN) + (size_t)l * D * DFF; d.K = DFF; d.N = D; d.k0 = (r / 8) * 64; d.n0 = (r % 8) * 128; d.mode = 0; return d; }
}
__device__ __forceinline__ void cvt_load(const TileDesc& d, int tid, f32x4 (&v)[4]) {
  const int r = tid >> 5, c4 = (tid & 31) * 4;
#pragma unroll
  for (int h = 0; h < 4; ++h) v[h] = *(const f32x4*)(d.src + (size_t)(d.k0 + r + 16 * h) * d.N + d.n0 + c4);
}
__device__ __forceinline__ void cvt_to_lds(float* tile, int tid, const f32x4 (&v)[4]) {
  const int r = tid >> 5, c4 = (tid & 31) * 4;
#pragma unroll
  for (int h = 0; h < 4; ++h) { float* q = tile + (r + 16 * h) * 129 + c4; q[0] = v[h][0]; q[1] = v[h][1]; q[2] = v[h][2]; q[3] = v[h][3]; }
}
__device__ __forceinline__ void cvt_store(const TileDesc& cur, const float* tile, int tid) {
  const int n = tid >> 2, kc = (tid & 3) * 16;
  u32x4 w0, w1;
  w0.x = pack2(tile[(kc + 0) * 129 + n], tile[(kc + 1) * 129 + n]); w0.y = pack2(tile[(kc + 2) * 129 + n], tile[(kc + 3) * 129 + n]);
  w0.z = pack2(tile[(kc + 4) * 129 + n], tile[(kc + 5) * 129 + n]); w0.w = pack2(tile[(kc + 6) * 129 + n], tile[(kc + 7) * 129 + n]);
  w1.x = pack2(tile[(kc + 8) * 129 + n], tile[(kc + 9) * 129 + n]); w1.y = pack2(tile[(kc + 10) * 129 + n], tile[(kc + 11) * 129 + n]);
  w1.z = pack2(tile[(kc + 12) * 129 + n], tile[(kc + 13) * 129 + n]); w1.w = pack2(tile[(kc + 14) * 129 + n], tile[(kc + 15) * 129 + n]);
  const int ng = cur.n0 + n;
  const int row = cur.mode == 0 ? ng : ((ng >> 7) * 256 + (ng & 127) + (cur.mode == 2 ? 128 : 0));
  bf16_t* o = cur.dst + (size_t)row * cur.K + cur.k0 + kc;
  *(u32x4*)o = w0; *(u32x4*)(o + 8) = w1;
}
__device__ __forceinline__ void cvt_all(KP p, float* lds_f, int late, int start, int count, int stride) {
  const int tid = tidx();
  float* tileA = lds_f; float* tileB = lds_f + 64 * 129 + 64;
  if (count <= 0) return;
  TileDesc d0 = cvt_decode(p, start, late), d1 = d0;
  f32x4 va[4], vb[4];
  cvt_load(d0, tid, va);
  if (count > 1) { d1 = cvt_decode(p, start + stride, late); cvt_load(d1, tid, vb); }
  __syncthreads();
  for (int i = 0;; i += 2) {
    cvt_to_lds(tileA, tid, va);
    const TileDesc ca = d0;
    const bool hasA = i + 2 < count;
    if (hasA) { d0 = cvt_decode(p, start + (i + 2) * stride, late); cvt_load(d0, tid, va); }
    __syncthreads();
    cvt_store(ca, tileA, tid);
    if (i + 1 >= count) break;
    cvt_to_lds(tileB, tid, vb);
    const TileDesc cb = d1;
    const bool hasB = i + 3 < count;
    if (hasB) { d1 = cvt_decode(p, start + (i + 3) * stride, late); cvt_load(d1, tid, vb); }
    __syncthreads();
    cvt_store(cb, tileB, tid);
    if (!hasA) break;
  }
  __syncthreads();
}

constexpr int NT_MOD = 4 * 3 * 16;
__device__ __forceinline__ void task_mod(KP p, int t, float* sl  , float* modp) {
  const int tid = tidx();
  const int l = t / 48, rem = t % 48, cb = rem / 16, kc = rem % 16;
  __syncthreads();
  if (tid < 320) {
    const int j = tid >> 6, k = kc * 64 + (tid & 63);
    const float x = j < 4 ? p->in[I_C][j * D + k] : p->in[I_CCTX][k];
    sl[tid] = silu_f(x);
  }
  __syncthreads();
  const int n = cb * 2048 + tid * 4;
  const float* w = p->in[I_MODW] + ((size_t)l * D + kc * 64) * 6144 + n;
  f32x4 a0 = {0.f, 0.f, 0.f, 0.f}, a1 = a0, a2 = a0, a3 = a0, a4 = a0;
#pragma unroll 8
  for (int k = 0; k < 64; ++k) {
    const f32x4 wv = *(const f32x4*)(w + (size_t)k * 6144);
    a0 += wv * sl[k]; a1 += wv * sl[64 + k]; a2 += wv * sl[128 + k]; a3 += wv * sl[192 + k]; a4 += wv * sl[256 + k];
  }
  float* o = modp + ((size_t)(kc * 4 + l) * 5) * 6144 + n;
  *(f32x4*)o = a0; *(f32x4*)(o + 6144) = a1; *(f32x4*)(o + 2 * 6144) = a2; *(f32x4*)(o + 3 * 6144) = a3; *(f32x4*)(o + 4 * 6144) = a4;
}

constexpr int NT_FILT = 320;
constexpr int FL_H1 = 0, FL_H2 = 4160, FL_W1 = 8320, FL_W2 = FL_W1 + 2112, FL_W3 = FL_W2 + 4096, FL_END = FL_W3 + 16384;
__device__ __forceinline__ void task_filt(KP p, int t, float* fl) {
  const int tid = tidx(), lane = tid & 63, wid = __builtin_amdgcn_readfirstlane(tid >> 6);
  const int combo = t >> 3, nchunk = t & 7;
  const int j = combo / 20, r = combo % 20;
  const int lsel = r < 4 ? 0 : 1, tchunk = r < 4 ? r : r - 4, L = lsel ? 1024 : 256;
  const int tt = lane, tpos = tchunk * 64 + tt;
  const float tn = (float)tpos / (float)L;
  float* h1 = fl + FL_H1; float* h2 = fl + FL_H2; float* w1 = fl + FL_W1; float* w2 = fl + FL_W2; float* w3 = fl + FL_W3;
  const float* b1 = p->in[I_FB1] + j * 64; const float* fr = p->in[I_FFREQ] + j * 128; const float* b2 = p->in[I_FB2] + j * 64;
  __syncthreads();
  {
    const f32x4* g1 = (const f32x4*)(p->in[I_FW1] + (size_t)j * 33 * 64); const f32x4* g2 = (const f32x4*)(p->in[I_FW2] + (size_t)j * 64 * 64);
    const float* g3 = p->in[I_FW3] + (size_t)j * 64 * 2048 + nchunk * 256;
    for (int i = tid; i < 528; i += 512) ((f32x4*)w1)[i] = g1[i];
    for (int i = tid; i < 1024; i += 512) ((f32x4*)w2)[i] = g2[i];
#pragma unroll
    for (int h = 0; h < 8; ++h) { const int i = tid + 512 * h, v = i >> 6, c4 = (i & 63) * 4; *(f32x4*)(w3 + v * 256 + c4) = *(const f32x4*)(g3 + (size_t)v * 2048 + c4); }
  }
  __syncthreads();
  const int u0 = wid * 8;
  {
    float acc[8];
#pragma unroll
    for (int uu = 0; uu < 8; ++uu) acc[uu] = tn * w1[u0 + uu];
#pragma unroll 4
    for (int b = 1; b <= 16; ++b) {
      const float rev = tn * (float)b;
      const float cs = cos_rev(rev), sn = sin_rev(rev);
#pragma unroll
      for (int uu = 0; uu < 8; ++uu) acc[uu] += cs * w1[b * 64 + u0 + uu] + sn * w1[(16 + b) * 64 + u0 + uu];
    }
#pragma unroll
    for (int uu = 0; uu < 8; ++uu) h1[tt * 65 + u0 + uu] = sin_rev(INV_2PI * (fr[u0 + uu] * (acc[uu] + b1[u0 + uu])));
  }
  __syncthreads();
  {
    float acc[8];
#pragma unroll
    for (int uu = 0; uu < 8; ++uu) acc[uu] = 0.f;
#pragma unroll 8
    for (int v = 0; v < 64; ++v) {
      const float hv = h1[tt * 65 + v];
#pragma unroll
      for (int uu = 0; uu < 8; ++uu) acc[uu] += hv * w2[v * 64 + u0 + uu];
    }
#pragma unroll
    for (int uu = 0; uu < 8; ++uu) h2[tt * 65 + u0 + uu] = sin_rev(INV_2PI * (fr[64 + u0 + uu] * (acc[uu] + b2[u0 + uu])));
  }
  __syncthreads();
  float* fsq = (float*)(p->ws + WS_FSQP) + ((size_t)((j * 2 + lsel) * 16 + tchunk)) * 2048;
  const int nb = nchunk * 256 + wid * 32;
  float acc[32];
#pragma unroll
  for (int q = 0; q < 32; ++q) acc[q] = 0.f;
#pragma unroll 4
  for (int v = 0; v < 64; ++v) {
    const float hv = h2[tt * 65 + v];
    const float* wr = w3 + v * 256 + wid * 32;
#pragma unroll
    for (int q = 0; q < 32; ++q) acc[q] += hv * wr[q];
  }
#pragma unroll
  for (int q = 0; q < 32; ++q) {
    const int n = nb + q, c = n & 1023; const bool isb = n >= 1024;
    const float delta = fabsf(MIN_DECAY + (MAX_DECAY - MIN_DECAY) * ((float)c / 1023.f));
    float val = acc[q] * __expf(-tn * delta);
    if (isb && tpos == 0) val = 0.f;
    bf16_t* rec = (bf16_t*)(p->ws + WS_FRG) + (size_t)j * FRG_J + (lsel ? FRG_L1 : 0) + (size_t)c * (4 * L + 34);
    if (isb && tpos == 0) rec[0] = 0;
    else { const int i = isb ? (L + tpos) : (L - tpos); const bf16_t bv = f2bf(val); rec[i] = bv; rec[2 * L + 34 + i - 1] = bv; }
    acc[q] = val * val;
  }
  __syncthreads();
#pragma unroll
  for (int q = 0; q < 32; ++q) h1[(wid * 32 + q) * 65 + lane] = acc[q];
  __syncthreads();
  if (tid < 256) { float s = 0.f; for (int k = 0; k < 64; ++k) s += h1[tid * 65 + ((k + tid) & 63)]; fsq[nchunk * 256 + tid] = s; }
}

__device__ __forceinline__ void phase_p0(KP p, unsigned char* lds) {
  float* fl = (float*)lds;
  const int G = gdim(), b = bidx(), tid = tidx();
  for (int t = b; t < NT_FILT + NT_MOD / 2; t += G) {
    __syncthreads();
    if (t < NT_FILT) task_filt(p, t, fl);
    else task_mod(p, t - NT_FILT, fl, (float*)(p->ws + WS_ZT));
  }
  cvt_all(p, fl, 0, b, (NT_CVT_HALF - b + G - 1) / G, G);
  {
    bf16_t* KS = (bf16_t*)(p->ws + WS_KS); bf16_t* VS = (bf16_t*)(p->ws + WS_VS);
    const int n8 = 4 * 2 * 512 * 256 / 8;
    for (int i8 = b * 512 + tid; i8 < n8; i8 += G * 512) {
      const int i = i8 * 8;
      const int e = i & 255, pos = (i >> 8) & 511, j = (i >> 17) & 1, bb = i >> 18;
      const size_t o = ((size_t)(j * 4 + bb) * 1536 + 1024 + pos) * 256 + e;
      const f32x4 k0 = *(const f32x4*)(p->in[I_CK] + i), k1 = *(const f32x4*)(p->in[I_CK] + i + 4), v0 = *(const f32x4*)(p->in[I_CV] + i), v1 = *(const f32x4*)(p->in[I_CV] + i + 4);
      u32x4 kw, vw;
      kw.x = pack2(k0[0], k0[1]); kw.y = pack2(k0[2], k0[3]); kw.z = pack2(k1[0], k1[1]); kw.w = pack2(k1[2], k1[3]);
      vw.x = pack2(v0[0], v0[1]); vw.y = pack2(v0[2], v0[3]); vw.z = pack2(v1[0], v1[1]); vw.w = pack2(v1[2], v1[3]);
      *(u32x4*)(KS + o) = kw; *(u32x4*)(VS + o) = vw;
    }
  }
}

__device__ __forceinline__ void mod_finalize(KP p, int late, const float* MP) {
  const int G = gdim(), b = bidx(), tid = tidx();
  float* MOD = (float*)(p->ws + WS_MOD);
  for (int i = late * (2 * 5 * 6144) + b * 512 + tid; i < (late + 1) * (2 * 5 * 6144); i += G * 512) {
    const int n = i % 6144, l = i / (5 * 6144);
    float s = p->in[I_MODB][l * 6144 + n];
#pragma unroll
    for (int kc = 0; kc < 16; ++kc) s += MP[(size_t)kc * (4 * 5 * 6144) + i];
    MOD[i] = s;
  }
}
__device__ __forceinline__ void phase_p0b(KP p) {
  const int G = gdim(), b = bidx(), tid = tidx();
  mod_finalize(p, 0, (const float*)(p->ws + WS_ZT));
  float* RN = (float*)(p->ws + WS_RNORM); const float* FS = (const float*)(p->ws + WS_FSQP);
  for (int i = b + tid * G; i < 4096; i += G * 512) {
    const int c = i & 1023, jl = i >> 10, nch = (jl & 1) ? 16 : 4;
    float s = 0.f;
#pragma unroll
    for (int ch = 0; ch < 16; ++ch) if (ch < nch) s += FS[((size_t)jl * 16 + ch) * 2048 + c] + FS[((size_t)jl * 16 + ch) * 2048 + 1024 + c];
    RN[i] = 1.f / sqrtf(s + EPS);
  }
}

typedef float f32x2v __attribute__((ext_vector_type(2)));
__device__ __forceinline__ void phase_nm(KP p, int layer, int which, bool addp, unsigned char* lds_) {
  const int tid = tidx(), lane = tid & 63, wid = __builtin_amdgcn_readfirstlane(tid >> 6);
  float* Y = (float*)(p->ws + WS_Y); const bf16_t* P1 = (const bf16_t*)(p->ws + WS_P1); bf16_t* XN = (bf16_t*)(p->ws + WS_XN);
  const float* g = p->in[which ? I_NFFN : I_NMIX] + layer * D;
  __attribute__((address_space(3))) float* ml = (__attribute__((address_space(3))) float*)lds_;
  for (int mb = bidx() * 32; mb < MTOK; mb += gdim() * 32) {
    const float* mod = (const float*)(p->ws + WS_MOD) + (size_t)(layer * 5 + cond_of(mb)) * 6144 + which * 3072;
    { const int k = tid * 2;
      *(__attribute__((address_space(3))) f32x2v*)(ml + k) = *(const f32x2v*)(g + k);
      *(__attribute__((address_space(3))) f32x2v*)(ml + 1024 + k) = *(const f32x2v*)(mod + k);
      *(__attribute__((address_space(3))) f32x2v*)(ml + 2048 + k) = *(const f32x2v*)(mod + 1024 + k); }
    const int m0 = mb + wid * 4;
    f32x4 v[4][4]; uint2 pa[4][4], pb[4][4];
#pragma unroll
    for (int r = 0; r < 4; ++r) {
      const int m = m0 + r;
      const float* src = layer == 0 ? (m < NPR ? p->in[I_XP] + (size_t)m * D : p->in[I_XS] + (size_t)(m - NPR) * D) : Y + (size_t)m * D;
#pragma unroll
      for (int i = 0; i < 4; ++i) { v[r][i] = *(const f32x4*)(src + i * 256 + lane * 4);
        if (addp) { pa[r][i] = *(const uint2*)(P1 + (size_t)m * D + i * 256 + lane * 4); pb[r][i] = *(const uint2*)(P1 + P1_HALF + (size_t)m * D + i * 256 + lane * 4); } }
    }
    __syncthreads();
    float ss[4];
#pragma unroll
    for (int r = 0; r < 4; ++r) {
      const int m = m0 + r;
      ss[r] = 0.f;
#pragma unroll
      for (int i = 0; i < 4; ++i) {
        if (addp) {
          v[r][i][0] += __uint_as_float(pa[r][i].x << 16) + __uint_as_float(pb[r][i].x << 16); v[r][i][1] += __uint_as_float(pa[r][i].x & 0xFFFF0000u) + __uint_as_float(pb[r][i].x & 0xFFFF0000u);
          v[r][i][2] += __uint_as_float(pa[r][i].y << 16) + __uint_as_float(pb[r][i].y << 16); v[r][i][3] += __uint_as_float(pa[r][i].y & 0xFFFF0000u) + __uint_as_float(pb[r][i].y & 0xFFFF0000u);
          *(f32x4*)(Y + (size_t)m * D + i * 256 + lane * 4) = v[r][i]; }
        ss[r] += v[r][i][0] * v[r][i][0] + v[r][i][1] * v[r][i][1] + v[r][i][2] * v[r][i][2] + v[r][i][3] * v[r][i][3]; }
    }
#pragma unroll
    for (int o = 32; o >= 1; o >>= 1) {
#pragma unroll
      for (int r = 0; r < 4; ++r) ss[r] += __shfl_xor(ss[r], o);
    }
    float rs[4];
#pragma unroll
    for (int r = 0; r < 4; ++r) rs[r] = rsqrtf(ss[r] * (1.f / D) + EPS);
#pragma unroll
    for (int i = 0; i < 4; ++i) {
      const int k = i * 256 + lane * 4;
      const f32x4 gg = *(const __attribute__((address_space(3))) f32x4*)(ml + k), sh = *(const __attribute__((address_space(3))) f32x4*)(ml + 1024 + k), sc = *(const __attribute__((address_space(3))) f32x4*)(ml + 2048 + k);
#pragma unroll
      for (int r = 0; r < 4; ++r) {
        float o[4];
#pragma unroll
        for (int e = 0; e < 4; ++e) o[e] = (v[r][i][e] * rs[r] * gg[e]) * (1.f + sc[e]) + sh[e];
        uint2 w; w.x = pack2(o[0], o[1]); w.y = pack2(o[2], o[3]);
        *(uint2*)(XN + (size_t)(m0 + r) * D + k) = w;
      }
    }
    if (mb + (int)gdim() * 32 < MTOK) __syncthreads();
  }
}

__device__ __forceinline__ void phase_final(KP p) {
  const int tid_ = tidx(), lane = tid_ & 63, wid = __builtin_amdgcn_readfirstlane(tid_ >> 6);
  const float* Y = (const float*)(p->ws + WS_Y); const bf16_t* P1 = (const bf16_t*)(p->ws + WS_P1);
  const float* g = p->in[I_FN];
  constexpr int NR = 4;
  for (int m0 = (bidx() * 8 + wid) * NR; m0 < MTOK; m0 += gdim() * 8 * NR) {
    f32x4 v[NR][4]; uint2 pa[NR][4], pb[NR][4]; f32x4 gg[4];
#pragma unroll
    for (int r = 0; r < NR; ++r) {
      const int m = m0 + r;
#pragma unroll
      for (int i = 0; i < 4; ++i) { v[r][i] = *(const f32x4*)(Y + (size_t)m * D + i * 256 + lane * 4);
        pa[r][i] = *(const uint2*)(P1 + (size_t)m * D + i * 256 + lane * 4); pb[r][i] = *(const uint2*)(P1 + P1_HALF + (size_t)m * D + i * 256 + lane * 4); }
    }
#pragma unroll
    for (int i = 0; i < 4; ++i) gg[i] = *(const f32x4*)(g + i * 256 + lane * 4);
    float ss[NR];
#pragma unroll
    for (int r = 0; r < NR; ++r) {
      ss[r] = 0.f;
#pragma unroll
      for (int i = 0; i < 4; ++i) {
        v[r][i][0] += __uint_as_float(pa[r][i].x << 16) + __uint_as_float(pb[r][i].x << 16); v[r][i][1] += __uint_as_float(pa[r][i].x & 0xFFFF0000u) + __uint_as_float(pb[r][i].x & 0xFFFF0000u);
        v[r][i][2] += __uint_as_float(pa[r][i].y << 16) + __uint_as_float(pb[r][i].y << 16); v[r][i][3] += __uint_as_float(pa[r][i].y & 0xFFFF0000u) + __uint_as_float(pb[r][i].y & 0xFFFF0000u);
        ss[r] += v[r][i][0] * v[r][i][0] + v[r][i][1] * v[r][i][1] + v[r][i][2] * v[r][i][2] + v[r][i][3] * v[r][i][3]; }
    }
#pragma unroll
    for (int o = 32; o >= 1; o >>= 1) {
#pragma unroll
      for (int r = 0; r < NR; ++r) ss[r] += __shfl_xor(ss[r], o);
    }
#pragma unroll
    for (int r = 0; r < NR; ++r) {
      const float rs = rsqrtf(ss[r] * (1.f / D) + EPS);
#pragma unroll
      for (int i = 0; i < 4; ++i) {
        f32x4 o; o[0] = v[r][i][0] * rs * gg[i][0]; o[1] = v[r][i][1] * rs * gg[i][1]; o[2] = v[r][i][2] * rs * gg[i][2]; o[3] = v[r][i][3] * rs * gg[i][3];
        *(f32x4*)(p->out + (size_t)(m0 + r) * D + i * 256 + lane * 4) = o;
      }
    }
  }
}

namespace pg8 {
#define PG8_LAS __attribute__((address_space(3)))
constexpr int BM = 256, BK = 64, HALF = 128, HTB = HALF * BK * 2, STAGE_BYTES = 8 * HTB, NXCD = 8, WGM = 8;
__host__ __device__ __forceinline__ int lds_byte(int r, int c) { const int st = (r >> 4) * 2 + (c >> 5), rr = r & 15, cc = c & 31, ob = rr * 64 + cc * 2; return st * 1024 + (ob ^ (((ob >> 9) & 1) << 5)); }
__host__ __device__ __forceinline__ void stage_rc(int b, int& R, int& C) { const int st = b / 1024, sb = b % 1024, swz = sb ^ (((sb >> 9) & 1) << 5); R = (st >> 1) * 16 + swz / 64; C = (st & 1) * 32 + (swz % 64) / 2; }
__host__ __device__ __forceinline__ int perm32(int rho) { const int n = rho >> 4, i = rho & 15; return 8 * (i >> 2) + 4 * n + (i & 3); }
struct Unit { int pm, pn, ks; };
struct Gemm { const bf16_t* A; const bf16_t* Bt; int M, N, K, ld; };
struct StaticOrder {
    int nM, nN, nwg, G, c, KS;
    __device__ void init(int M, int N, int KS_, int G_, int c_) { nM = M / BM; KS = KS_; nN = (N / BM) * KS_; nwg = nM * nN; G = G_; c = c_; }
    __device__ bool next(int i, Unit& u) const {
        const long L = (long)i * G + c; if (L >= nwg) return false;
        int wgid = (int)L; { const int q = nwg / NXCD, r = nwg % NXCD, xcd = wgid % NXCD, off = wgid / NXCD; wgid = (xcd < r ? xcd * (q + 1) : r * (q + 1) + (xcd - r) * q) + off; }
        const int nig = WGM * nN, gid = wgid / nig, fm = gid * WGM, gsz = (nM - fm) < WGM ? (nM - fm) : WGM;
        u.pm = fm + ((wgid % nig) % gsz); const int pn2 = (wgid % nig) / gsz; u.pn = pn2 / KS; u.ks = pn2 % KS; return true;
    }
    __device__ __forceinline__ void a_ready(const Unit&) const {}
    __device__ __forceinline__ void done(const Unit&) const {}
};
__device__ __forceinline__ unsigned cvt_pk_bf16(float lo, float hi) { unsigned r; asm volatile("v_cvt_pk_bf16_f32 %0, %1, %2" : "=v"(r) : "v"(lo), "v"(hi)); return r; }
struct EpiBf16 {
    static constexpr bool PERM = true, AFTER_DRAIN = false;
    bf16_t* O; int ldc;
    __device__ __forceinline__ void operator()(const f32x4 (&acc)[2][2][4][2], const Unit& u, int wr, int wc, int fr, int fq) const {
        const int row0 = u.pm * BM + wr * 64 + fr, col0 = u.pn * BM + wc * 32 + 8 * fq;
#pragma unroll
        for (int ai = 0; ai < 2; ++ai)
#pragma unroll
            for (int m = 0; m < 4; ++m) { bf16_t* rowp = O + (size_t)(row0 + ai * HALF + m * 16) * ldc + col0;
#pragma unroll
                for (int bj = 0; bj < 2; ++bj) { const f32x4 v0 = acc[ai][bj][m][0], v1 = acc[ai][bj][m][1];
                    u32x4 w; w.x = cvt_pk_bf16(v0[0], v0[1]); w.y = cvt_pk_bf16(v0[2], v0[3]); w.z = cvt_pk_bf16(v1[0], v1[1]); w.w = cvt_pk_bf16(v1[2], v1[3]);
                    *(u32x4*)(rowp + bj * HALF) = w; } }
    }
};
struct EpiSwiglu {
    static constexpr bool PERM = true, AFTER_DRAIN = false;
    bf16_t* H;
    __device__ __forceinline__ void operator()(const f32x4 (&acc)[2][2][4][2], const Unit& u, int wr, int wc, int fr, int fq) const {
        const int row0 = u.pm * BM + wr * 64 + fr, col0 = u.pn * HALF + wc * 32 + 8 * fq;
#pragma unroll
        for (int ai = 0; ai < 2; ++ai)
#pragma unroll
            for (int m = 0; m < 4; ++m) {
                float h[8];
#pragma unroll
                for (int n = 0; n < 2; ++n)
#pragma unroll
                    for (int e = 0; e < 4; ++e) { const float gv = acc[ai][0][m][n][e], uv = acc[ai][1][m][n][e]; h[4 * n + e] = gv * __builtin_amdgcn_rcpf(1.f + __expf(-gv)) * uv; }
                u32x4 w; w.x = cvt_pk_bf16(h[0], h[1]); w.y = cvt_pk_bf16(h[2], h[3]); w.z = cvt_pk_bf16(h[4], h[5]); w.w = cvt_pk_bf16(h[6], h[7]);
                *(u32x4*)(H + (size_t)(row0 + ai * HALF + m * 16) * DFF + col0) = w; }
    }
};
struct EpiQkv {
    static constexpr bool PERM = true, AFTER_DRAIN = false;
    KP p; PG8_LAS float* xl; int j;
    __device__ __forceinline__ void operator()(const f32x4 (&acc)[2][2][4][2], const Unit& u, int wr, int wc, int fr, int fq) const {
        bf16_t* const Q = (bf16_t*)(p->ws + WS_Q); bf16_t* const KPr = (bf16_t*)(p->ws + WS_KP); bf16_t* const VP = (bf16_t*)(p->ws + WS_VP);
        bf16_t* const KS = (bf16_t*)(p->ws + WS_KS) + (size_t)j * 4 * 1536 * 256; bf16_t* const VS = (bf16_t*)(p->ws + WS_VS) + (size_t)j * 4 * 1536 * 256;
        float* const newk = p->out + (size_t)2 * NPR * D; float* const newv = newk + (size_t)16 * 2 * 256 * 256;
        const float* const qn = p->in[I_QN] + j * 128; const float* const kn = p->in[I_KN] + j * 128;
        const int pn = u.pn, pm = u.pm, dbase = wc * 32 + 8 * fq;
        const bool isq = pn < 4, isv = pn == 5, smp = pm >= 16;
        if (!isv) {
#pragma unroll
            for (int ai = 0; ai < 2; ++ai)
#pragma unroll
                for (int m = 0; m < 4; ++m)
#pragma unroll
                    for (int bj = 0; bj < 2; ++bj) {
                        const f32x4 a = acc[ai][bj][m][0], b = acc[ai][bj][m][1];
                        float sq = (a[0] * a[0] + a[1] * a[1]) + (a[2] * a[2] + a[3] * a[3]) + (b[0] * b[0] + b[1] * b[1]) + (b[2] * b[2] + b[3] * b[3]);
                        sq += __shfl_xor(sq, 16); sq += __shfl_xor(sq, 32);
                        if (fq == 0) xl[(((((wr * 2 + ai) * 4 + m) * 16 + fr) * 2 + bj) << 2) + wc] = sq;
                    }
            asm volatile("s_waitcnt lgkmcnt(0)" ::: "memory"); __builtin_amdgcn_s_barrier(); asm volatile("" ::: "memory");
        }
        const float* gn = isq ? qn : kn;
        f32x4 g0 = {1.f, 1.f, 1.f, 1.f}, g1 = g0;
        if (!isv) { g0 = *(const f32x4*)(gn + dbase); g1 = *(const f32x4*)(gn + dbase + 4); }
#pragma unroll
        for (int ai = 0; ai < 2; ++ai)
#pragma unroll
            for (int m = 0; m < 4; ++m) {
                const int row = pm * BM + ai * HALF + wr * 64 + m * 16 + fr;
                float cs[4], sn[4];
                if (smp && !isv) {
                    const int t = (row - NPR) & 1023; const float pos = (float)(wc < 2 ? (t >> 6) : (t & 63));
#pragma unroll
                    for (int k = 0; k < 4; ++k) { const float rev = pos * (__builtin_amdgcn_exp2f(-(float)(((dbase >> 1) + k) & 31) * 0.41524101186092029f) * INV_2PI); cs[k] = cos_rev(rev); sn[k] = sin_rev(rev); }
                }
#pragma unroll
                for (int bj = 0; bj < 2; ++bj) {
                    f32x4 v0 = acc[ai][bj][m][0], v1 = acc[ai][bj][m][1];
                    if (!isv) {
                        const f32x4 q4 = *(const PG8_LAS f32x4*)(xl + (((((wr * 2 + ai) * 4 + m) * 16 + fr) * 2 + bj) << 2));
                        const float r = rsqrtf(((q4[0] + q4[1]) + (q4[2] + q4[3])) * (1.f / 128.f) + EPS);
                        v0 = v0 * r * g0; v1 = v1 * r * g1;
                        if (smp) {
                            f32x4 w0, w1;
                            w0[0] = v0[0] * cs[0] - v0[1] * sn[0]; w0[1] = v0[0] * sn[0] + v0[1] * cs[0]; w0[2] = v0[2] * cs[1] - v0[3] * sn[1]; w0[3] = v0[2] * sn[1] + v0[3] * cs[1];
                            w1[0] = v1[0] * cs[2] - v1[1] * sn[2]; w1[1] = v1[0] * sn[2] + v1[1] * cs[2]; w1[2] = v1[2] * cs[3] - v1[3] * sn[3]; w1[3] = v1[2] * sn[3] + v1[3] * cs[3];
                            v0 = w0; v1 = w1;
                        }
                    }
                    u32x4 w; w.x = cvt_pk_bf16(v0[0], v0[1]); w.y = cvt_pk_bf16(v0[2], v0[3]); w.z = cvt_pk_bf16(v1[0], v1[1]); w.w = cvt_pk_bf16(v1[2], v1[3]);
                    if (isq) *(u32x4*)(Q + (size_t)row * D + pn * BM + bj * HALF + dbase) = w;
                    else if (!smp) {
                        *(u32x4*)((isv ? VP : KPr) + (size_t)row * 256 + bj * HALF + dbase) = w;
                        float* o = (isv ? newv : newk) + ((((size_t)(row >> 8) * 2 + j) * 256 + (row & 255)) * 2 + bj) * 128 + dbase;
                        *(f32x4*)o = v0; *(f32x4*)(o + 4) = v1;
                    } else {
                        const int b = (row - NPR) >> 10, t = (row - NPR) & 1023;
                        *(u32x4*)((isv ? VS : KS) + ((size_t)b * 1536 + t) * 256 + bj * HALF + dbase) = w;
                    }
                }
            }
        if (!isv) { asm volatile("s_waitcnt lgkmcnt(0)" ::: "memory"); __builtin_amdgcn_s_barrier(); asm volatile("" ::: "memory"); }
    }
};
struct EpiGate {
    static constexpr bool PERM = true, AFTER_DRAIN = false;
    bf16_t* P; const float* gate; const PG8_LAS float* lg;
    __device__ __forceinline__ void operator()(const f32x4 (&acc)[2][2][4][2], const Unit& u, int wr, int wc, int fr, int fq) const {
        const int row0 = u.pm * BM + wr * 64 + fr, col0 = u.pn * BM + wc * 32 + 8 * fq;
        bf16_t* const dstb = P + (size_t)u.ks * P1_HALF;
        f32x4 gv[2][2];
        if (lg) {
#pragma unroll
            for (int bj = 0; bj < 2; ++bj) { gv[bj][0] = *(const PG8_LAS f32x4*)(lg + wc * 32 + 8 * fq + bj * HALF); gv[bj][1] = *(const PG8_LAS f32x4*)(lg + wc * 32 + 8 * fq + bj * HALF + 4); }
        } else {
            const float* gp = gate + cond_of(u.pm * BM) * 6144 + col0;
#pragma unroll
            for (int bj = 0; bj < 2; ++bj) { gv[bj][0] = *(const f32x4*)(gp + bj * HALF); gv[bj][1] = *(const f32x4*)(gp + bj * HALF + 4); }
        }
#pragma unroll
        for (int ai = 0; ai < 2; ++ai)
#pragma unroll
            for (int m = 0; m < 4; ++m) { const int row = row0 + ai * HALF + m * 16; bf16_t* rowp = dstb + (size_t)row * D + col0;
#pragma unroll
                for (int bj = 0; bj < 2; ++bj) { const f32x4 v0 = acc[ai][bj][m][0] * gv[bj][0], v1 = acc[ai][bj][m][1] * gv[bj][1];
                    u32x4 w; w.x = cvt_pk_bf16(v0[0], v0[1]); w.y = cvt_pk_bf16(v0[2], v0[3]); w.z = cvt_pk_bf16(v1[0], v1[1]); w.w = cvt_pk_bf16(v1[2], v1[3]);
                    *(u32x4*)(rowp + bj * HALF) = w; } }
    }
};
template <class Epi, class Sched, bool ALIGN_EPI = false, bool SP2 = false>
__device__ __forceinline__ void gemm_phase(PG8_LAS unsigned char* lds, const Gemm g, const Sched& S, const Epi& E) {
    int tid_ = tidx();
    const int tid = tid_, wid = __builtin_amdgcn_readfirstlane(tid >> 6), lane = tid & 63, wr = wid >> 2, wc = wid & 3, fr = lane & 15, fq = lane >> 4;
    const int K = g.ld, nt = g.K / BK;
    unsigned voffA[2], voffB[2];
#pragma unroll
    for (int i = 0; i < 2; ++i) { int R, C; stage_rc(tid * 16 + i * 8192, R, C); const int Rb = Epi::PERM ? ((R & ~31) + perm32(R & 31)) : R;
        voffA[i] = (unsigned)(R * K + C) * 2u; voffB[i] = (unsigned)(Rb * K + C) * 2u; }
    const size_t kstep = (size_t)(BK * 2);
    const size_t hstep = (size_t)HALF * K * 2;
    const size_t tstep = 2 * hstep;
    const unsigned ldsw = (unsigned)wid * 1024u;
    const int aoff = lds_byte(wr * 64 + fr, fq * 8), boff = lds_byte(wc * 32 + fr, fq * 8);
#define PG8_SA(b, h) (((b) * 2 + (h)) * HTB)
#define PG8_SB(b, h) ((4 + (b) * 2 + (h)) * HTB)
#define PG8_STAGE(bufoff, gbase, voff) do { _Pragma("unroll") for (int _i = 0; _i < 2; ++_i) \
        __builtin_amdgcn_global_load_lds((const unsigned*)((const char*)(gbase) + (voff)[_i]), (PG8_LAS unsigned*)(lds + (bufoff) + ldsw + _i * 8192), 16, 0, 0); } while (0)
#define PG8_LDA(dst, b, h) do { _Pragma("unroll") for (int m = 0; m < 4; ++m) _Pragma("unroll") for (int k = 0; k < 2; ++k) dst[m][k] = *(const PG8_LAS bf16x8*)(lds + PG8_SA(b, h) + aoff + m * 2048 + k * 1024); } while (0)
#define PG8_LDB(dst, b, h) do { _Pragma("unroll") for (int n = 0; n < 2; ++n) _Pragma("unroll") for (int k = 0; k < 2; ++k) dst[n][k] = *(const PG8_LAS bf16x8*)(lds + PG8_SB(b, h) + boff + n * 2048 + k * 1024); } while (0)
#define PG8_MMA(ai, bj, At, Bt) do { __builtin_amdgcn_s_setprio(1); _Pragma("unroll") for (int m = 0; m < 4; ++m) _Pragma("unroll") for (int n = 0; n < 2; ++n) _Pragma("unroll") for (int k = 0; k < 2; ++k) \
        acc[ai][bj][m][n] = __builtin_amdgcn_mfma_f32_16x16x32_bf16(Bt[n][k], At[m][k], acc[ai][bj][m][n], 0, 0, 0); __builtin_amdgcn_s_setprio(0); } while (0)
#define PG8_WAIT_V(n) asm volatile("s_waitcnt vmcnt(" #n ")" ::: "memory")
#define PG8_WAIT_L(n) asm volatile("s_waitcnt lgkmcnt(" #n ")" ::: "memory")
#define PG8_BAR __builtin_amdgcn_s_barrier()
#define PG8_SCHED __builtin_amdgcn_sched_barrier(0)
    Unit cur, nxt; int ui = 0;
    if (!S.next(0, cur)) return;
    f32x4 acc[2][2][4][2];
#pragma unroll
    for (int a = 0; a < 2; ++a)
#pragma unroll
        for (int b = 0; b < 2; ++b)
#pragma unroll
            for (int m = 0; m < 4; ++m)
#pragma unroll
                for (int n = 0; n < 2; ++n) acc[a][b][m][n] = (f32x4){0.f, 0.f, 0.f, 0.f};
    bf16x8 At[4][2], B0[2][2], B1[2][2];
    const size_t ksb = (size_t)g.K * 2; const char* cA = (const char*)g.A + (size_t)cur.pm * tstep + cur.ks * ksb; const char* cB = (const char*)g.Bt + (size_t)cur.pn * tstep + cur.ks * ksb;
    S.a_ready(cur);
    if constexpr (SP2) {
        PG8_STAGE(PG8_SB(0, 0), cB, voffB); PG8_STAGE(PG8_SB(0, 1), cB + hstep, voffB); PG8_STAGE(PG8_SA(0, 0), cA, voffA); PG8_STAGE(PG8_SA(0, 1), cA + hstep, voffA);
        if (wr == 1) PG8_BAR;
        PG8_WAIT_V(2); PG8_BAR;
        PG8_STAGE(PG8_SB(1, 0), cB + kstep, voffB); PG8_STAGE(PG8_SA(1, 0), cA + kstep, voffA); PG8_STAGE(PG8_SB(1, 1), cB + hstep + kstep, voffB);
        PG8_WAIT_V(6); PG8_BAR;
    } else {
        PG8_STAGE(PG8_SB(0, 0), cB, voffB); PG8_STAGE(PG8_SA(0, 0), cA, voffA); PG8_STAGE(PG8_SB(0, 1), cB + hstep, voffB); PG8_STAGE(PG8_SA(0, 1), cA + hstep, voffA);
        if (wr == 1) PG8_BAR;
        PG8_WAIT_V(4); PG8_BAR;
        PG8_STAGE(PG8_SB(1, 0), cB + kstep, voffB); PG8_STAGE(PG8_SA(1, 0), cA + kstep, voffA); PG8_STAGE(PG8_SB(1, 1), cB + hstep + kstep, voffB);
        PG8_WAIT_V(6); PG8_BAR;
    }
    for (;;) {
        const bool has_next = S.next(ui + 1, nxt);
        const char* nA = has_next ? (const char*)g.A + (size_t)nxt.pm * tstep + nxt.ks * ksb : cA; const char* nB = has_next ? (const char*)g.Bt + (size_t)nxt.pn * tstep + nxt.ks * ksb : cB;
        for (int t = 0; t < nt; t += 2) {
            const bool last = (t == nt - 2);
            const char* a1 = cA + (size_t)(t + 1) * kstep;
            const char* a2 = last ? nA : cA + (size_t)(t + 2) * kstep; const char* b2 = last ? nB : cB + (size_t)(t + 2) * kstep;
            const char* a3 = a2 + kstep; const char* b3 = b2 + kstep;
            if (last && has_next) S.a_ready(nxt);
            if constexpr (SP2) {
            PG8_LDB(B0, 0, 0); PG8_LDB(B1, 0, 1); PG8_SCHED; PG8_LDA(At, 0, 0); PG8_STAGE(PG8_SA(1, 1), a1 + hstep, voffA);
            PG8_WAIT_V(8); PG8_WAIT_L(0); PG8_BAR; PG8_MMA(0, 0, At, B0); PG8_MMA(0, 1, At, B1); PG8_BAR; PG8_SCHED;
            PG8_LDA(At, 0, 1); PG8_STAGE(PG8_SB(0, 0), b2, voffB); PG8_STAGE(PG8_SB(0, 1), b2 + hstep, voffB); PG8_STAGE(PG8_SA(0, 0), a2, voffA);
            PG8_WAIT_V(8); PG8_WAIT_L(0); PG8_BAR; PG8_MMA(1, 0, At, B0); PG8_MMA(1, 1, At, B1); PG8_BAR; PG8_SCHED;
            PG8_LDB(B0, 1, 0); PG8_LDB(B1, 1, 1); PG8_SCHED; PG8_LDA(At, 1, 0); PG8_STAGE(PG8_SA(0, 1), a2 + hstep, voffA);
            PG8_WAIT_V(8); PG8_WAIT_L(0); PG8_BAR; PG8_MMA(0, 0, At, B0); PG8_MMA(0, 1, At, B1); PG8_BAR; PG8_SCHED;
            PG8_LDA(At, 1, 1); PG8_STAGE(PG8_SB(1, 0), b3, voffB); PG8_STAGE(PG8_SB(1, 1), b3 + hstep, voffB); PG8_STAGE(PG8_SA(1, 0), a3, voffA);
            PG8_WAIT_V(8); PG8_WAIT_L(0); PG8_BAR; PG8_MMA(1, 0, At, B0); PG8_MMA(1, 1, At, B1); PG8_BAR; PG8_SCHED;
            } else {
            PG8_LDB(B0, 0, 0); PG8_SCHED; PG8_LDA(At, 0, 0); PG8_STAGE(PG8_SA(1, 1), a1 + hstep, voffA);
            PG8_WAIT_L(8); PG8_BAR; PG8_WAIT_L(0); PG8_MMA(0, 0, At, B0); PG8_BAR; PG8_SCHED;
            PG8_LDB(B1, 0, 1); PG8_STAGE(PG8_SB(0, 0), b2, voffB);
            PG8_BAR; PG8_WAIT_L(0); PG8_MMA(0, 1, At, B1); PG8_BAR;
            PG8_LDA(At, 0, 1); PG8_STAGE(PG8_SA(0, 0), a2, voffA);
            PG8_BAR; PG8_WAIT_L(0); PG8_MMA(1, 0, At, B0); PG8_BAR; PG8_SCHED;
            PG8_STAGE(PG8_SB(0, 1), b2 + hstep, voffB);
            PG8_WAIT_V(6); PG8_BAR; PG8_MMA(1, 1, At, B1); PG8_BAR;
            PG8_LDB(B0, 1, 0); PG8_SCHED; PG8_LDA(At, 1, 0); PG8_STAGE(PG8_SA(0, 1), a2 + hstep, voffA);
            PG8_WAIT_L(8); PG8_BAR; PG8_WAIT_L(0); PG8_MMA(0, 0, At, B0); PG8_BAR; PG8_SCHED;
            PG8_LDB(B1, 1, 1); PG8_STAGE(PG8_SB(1, 0), b3, voffB);
            PG8_BAR; PG8_WAIT_L(0); PG8_MMA(0, 1, At, B1); PG8_BAR;
            PG8_LDA(At, 1, 1); PG8_STAGE(PG8_SA(1, 0), a3, voffA);
            PG8_BAR; PG8_WAIT_L(0); PG8_MMA(1, 0, At, B0); PG8_BAR; PG8_SCHED;
            PG8_STAGE(PG8_SB(1, 1), b3 + hstep, voffB);
            PG8_WAIT_V(6); PG8_BAR; PG8_MMA(1, 1, At, B1); PG8_BAR;
            }
        }
        if constexpr (ALIGN_EPI) { if (wr == 0) PG8_BAR; }
        if constexpr (!Epi::AFTER_DRAIN) { E(acc, cur, wr, wc, fr, fq); S.done(cur); }
        if (!has_next) break;
#pragma unroll
        for (int a = 0; a < 2; ++a)
#pragma unroll
            for (int b = 0; b < 2; ++b)
#pragma unroll
                for (int m = 0; m < 4; ++m)
#pragma unroll
                    for (int n = 0; n < 2; ++n) acc[a][b][m][n] = (f32x4){0.f, 0.f, 0.f, 0.f};
        cur = nxt; cA = nA; cB = nB; ++ui;
        if constexpr (ALIGN_EPI) { if (wr == 1) PG8_BAR; }
    }
    PG8_WAIT_V(0);
    if constexpr (!ALIGN_EPI) { if (wr == 0) PG8_BAR; }
    PG8_BAR;
    if constexpr (Epi::AFTER_DRAIN) { E.fused(acc, cur, wr, wc, fr, fq, lds, wid, lane); S.done(cur); }
#undef PG8_SA
#undef PG8_SB
#undef PG8_STAGE
#undef PG8_LDA
#undef PG8_LDB
#undef PG8_MMA
#undef PG8_WAIT_V
#undef PG8_WAIT_L
#undef PG8_BAR
#undef PG8_SCHED
}
}

__device__ __forceinline__ void gemm_run(unsigned char* lds, const bf16_t* A, const bf16_t* Bt, int M, int N, int Ktot, int KS, const pg8::EpiGate& E0) {
    pg8::StaticOrder S; S.init(M, N, KS, (int)gdim(), (int)bidx());
    pg8::Gemm g; g.A = A; g.Bt = Bt; g.M = M; g.N = N; g.K = Ktot / KS; g.ld = Ktot;
    pg8::EpiGate E = E0;
    pg8::Unit u0;
    if (S.nwg <= (int)gdim() && S.next(0, u0)) {
        PG8_LAS float* lg = (PG8_LAS float*)((PG8_LAS unsigned char*)lds + pg8::STAGE_BYTES);
        const int tid = tidx();
        if (tid < 64) *(PG8_LAS f32x4*)(lg + tid * 4) = *(const f32x4*)(E0.gate + cond_of(u0.pm * pg8::BM) * 6144 + u0.pn * pg8::BM + tid * 4);
        E.lg = lg;
    }
    __syncthreads();
    pg8::gemm_phase<pg8::EpiGate, pg8::StaticOrder, true, true>((PG8_LAS unsigned char*)lds, g, S, E);
}
template <class Epi>
__device__ __forceinline__ void gemm_run(unsigned char* lds, const bf16_t* A, const bf16_t* Bt, int M, int N, int Ktot, int KS, const Epi& E) {
    pg8::StaticOrder S; S.init(M, N, KS, (int)gdim(), (int)bidx());
    pg8::Gemm g; g.A = A; g.Bt = Bt; g.M = M; g.N = N; g.K = Ktot / KS; g.ld = Ktot;
    pg8::gemm_phase<Epi, pg8::StaticOrder, true, true>((PG8_LAS unsigned char*)lds, g, S, E);
}


#define LDSP __attribute__((address_space(3)))
constexpr int LC_FR = 0, LC_U = 66176, LC_X0 = LC_U + 20480, LC_S = LC_X0 + 20480, LC_Z = LC_S + 17408;
struct LcUnit { int lsel, L, P, REC, c0, m0; };
__device__ __forceinline__ LcUnit lc_unit(int q) {
  LcUnit u; u.lsel = q < 512 ? 1 : 0; const int qq = q & 511; u.c0 = (qq >> 2) * 8; u.m0 = ((u.lsel ? 4 : 0) + (qq & 3)) * 1024;
  u.L = u.lsel ? 1024 : 256; u.P = u.L >> 5; u.REC = 4 * u.L + 34; return u;
}
__device__ __forceinline__ void phase_lc(KP p, int j, unsigned char* lds_) {
  LDSP unsigned char* lds = (LDSP unsigned char*)lds_;
  const int tid = tidx(), lane = tid & 63, wid = tid >> 6, n = lane & 31, hi = lane >> 5;
  const bf16_t* ZT = (const bf16_t*)(p->ws + WS_ZT); bf16_t* YG = (bf16_t*)(p->ws + WS_YG);
  const float* cw = p->in[I_HCW] + (size_t)j * 3 * 3072; const float* cb = p->in[I_HCB] + (size_t)j * 3072;
  u32x4 fr[9], zr[2][3]; float zh[2][3][2];
#define LC_PREFETCH(U) do { \
    const u32x4* src_ = (const u32x4*)((const bf16_t*)(p->ws + WS_FRG) + (size_t)j * FRG_J + ((U).lsel ? FRG_L1 : 0) + (size_t)(U).c0 * (U).REC); \
    _Pragma("unroll") for (int i_ = 0; i_ < 9; ++i_) if (i_ * 512 + tid < (U).REC) fr[i_] = src_[i_ * 512 + tid]; \
    _Pragma("unroll") for (int tk_ = 0; tk_ < 2; ++tk_) { const int task_ = tid + 512 * tk_, ch_ = task_ >> 7, tok0_ = (task_ & 127) * 8; \
      const bool first_ = (tok0_ & ((U).L - 1)) == 0, last_ = ((tok0_ + 8) & ((U).L - 1)) == 0; \
      _Pragma("unroll") for (int part_ = 0; part_ < 3; ++part_) { const bf16_t* z_ = ZT + (size_t)(part_ * 1024 + (U).c0 + ch_) * MTOK + (U).m0 + tok0_; \
        zr[tk_][part_] = *(const u32x4*)z_; zh[tk_][part_][0] = first_ ? 0.f : bf2f(z_[-1]); zh[tk_][part_][1] = last_ ? 0.f : bf2f(z_[8]); } } } while (0)
  int q = bidx();
  if (q >= 1024) return;
  LcUnit cur = lc_unit(q);
  LC_PREFETCH(cur);
  for (;;) {
    const int L = cur.L, P = cur.P, REC = cur.REC, c0 = cur.c0, lsel = cur.lsel; const size_t m0 = (size_t)cur.m0;
    {
      LDSP u32x4* dst = (LDSP u32x4*)(lds + LC_FR);
#pragma unroll
      for (int i = 0; i < 9; ++i) if (i * 512 + tid < REC) dst[i * 512 + tid] = fr[i];
#pragma unroll
      for (int tk = 0; tk < 2; ++tk) {
        const int task = tid + 512 * tk, ch = task >> 7, tok0 = (task & 127) * 8;
        float sc[3][8];
#pragma unroll
        for (int part = 0; part < 3; ++part) {
          const int chn = part * 1024 + c0 + ch;
          const u32x4 w = zr[tk][part];
          float zv[10];
          zv[0] = zh[tk][part][0]; zv[9] = zh[tk][part][1];
          zv[1] = __uint_as_float(w.x << 16); zv[2] = __uint_as_float(w.x & 0xFFFF0000u); zv[3] = __uint_as_float(w.y << 16); zv[4] = __uint_as_float(w.y & 0xFFFF0000u);
          zv[5] = __uint_as_float(w.z << 16); zv[6] = __uint_as_float(w.z & 0xFFFF0000u); zv[7] = __uint_as_float(w.w << 16); zv[8] = __uint_as_float(w.w & 0xFFFF0000u);
          const float w0 = cw[chn], w1 = cw[3072 + chn], w2 = cw[2 * 3072 + chn], bb = cb[chn];
#pragma unroll
          for (int i = 0; i < 8; ++i) sc[part][i] = zv[i] * w0 + zv[i + 1] * w1 + zv[i + 2] * w2 + bb;
        }
        u32x4 xo, uo;
        xo.x = pack2(sc[0][0], sc[0][1]); xo.y = pack2(sc[0][2], sc[0][3]); xo.z = pack2(sc[0][4], sc[0][5]); xo.w = pack2(sc[0][6], sc[0][7]);
        uo.x = pack2(sc[1][0] * sc[2][0], sc[1][1] * sc[2][1]); uo.y = pack2(sc[1][2] * sc[2][2], sc[1][3] * sc[2][3]);
        uo.z = pack2(sc[1][4] * sc[2][4], sc[1][5] * sc[2][5]); uo.w = pack2(sc[1][6] * sc[2][6], sc[1][7] * sc[2][7]);
        const int po = (ch * 1280 + tok0 + 8 * (tok0 >> 5)) * 2;
        *(LDSP u32x4*)(lds + LC_U + po) = uo; *(LDSP u32x4*)(lds + LC_X0 + po) = xo;
      }
    }
    if (tid < 4) ((LDSP unsigned*)(lds + LC_Z))[tid] = 0u;
    __syncthreads();
    const int qn = q + gdim(); const bool has = qn < 1024;
    LcUnit nxt = cur;
    if (has) { nxt = lc_unit(qn); LC_PREFETCH(nxt); }
    const float rn = ((const float*)(p->ws + WS_RNORM))[(j * 2 + lsel) * 1024 + c0 + wid], bs = p->in[I_HBIAS][j * D + c0 + wid];
    f32x16 acc;
#pragma unroll
    for (int r = 0; r < 16; ++r) acc[r] = 0.f;
    {
      const int par = n & 1;
      LDSP const unsigned char* fa = lds + LC_FR + wid * (REC * 2) + (par ? (2 * L + 34) * 2 : 0) + 2 * (L - n - par + 8 * hi);
      LDSP const unsigned char* ub = lds + LC_U + wid * 2560 + (40 * n + 8 * hi) * 2;
      const int ti = n & (P - 1);
#define LC_LOAD(s_, AW, BF) do { const int dl_ = ((s_) >> 1) - (P - 1), ks_ = (s_) & 1; \
        LDSP const volatile unsigned* ap_ = (LDSP const volatile unsigned*)(fa + 2 * (-32 * dl_ + 16 * ks_)); \
        AW.x = ap_[0]; AW.y = ap_[1]; AW.z = ap_[2]; AW.w = ap_[3]; \
        LDSP const unsigned char* bp_ = ((unsigned)(ti - dl_) < (unsigned)P) ? (ub + (-40 * dl_ + 16 * ks_) * 2) : (lds + LC_Z); \
        BF = *(LDSP const volatile bf16x8*)bp_; } while (0)
      const int nsteps = 2 * (2 * P - 1);
      u32x4 a0, a1, a2, a3, a4, a5; bf16x8 b0, b1, b2, b3, b4, b5;
      LC_LOAD(0, a0, b0); LC_LOAD(1, a1, b1); LC_LOAD(2, a2, b2); LC_LOAD(3, a3, b3); LC_LOAD(4, a4, b4);
#define LC_STEP(k_, AC, BC, AN, BN) do { if (s6 + (k_) + 5 < nsteps) LC_LOAD(s6 + (k_) + 5, AN, BN); \
        acc = __builtin_amdgcn_mfma_f32_32x32x16_bf16(__builtin_bit_cast(bf16x8, AC), BC, acc, 0, 0, 0); } while (0)
      for (int s6 = 0; s6 < nsteps; s6 += 6) {
        LC_STEP(0, a0, b0, a5, b5); LC_STEP(1, a1, b1, a0, b0); LC_STEP(2, a2, b2, a1, b1);
        LC_STEP(3, a3, b3, a2, b2); LC_STEP(4, a4, b4, a3, b3); LC_STEP(5, a5, b5, a4, b4);
      }
#undef LC_STEP
#undef LC_LOAD
    }
    {
      LDSP const bf16_t* uu = (LDSP const bf16_t*)(lds + LC_U) + wid * 1280 + 40 * n;
      LDSP const bf16_t* xx = (LDSP const bf16_t*)(lds + LC_X0) + wid * 1280 + 40 * n;
      LDSP bf16_t* so = (LDSP bf16_t*)(lds + LC_S) + wid * 1088 + 34 * n;
#pragma unroll
      for (int r = 0; r < 16; ++r) {
        const int row = (r & 3) + 8 * (r >> 2) + 4 * hi;
        const float y = acc[r] * rn + bf2f(uu[row]) * bs;
        so[row] = f2bf(bf2f(xx[row]) * y);
      }
    }
    __syncthreads();
    for (int tok = tid; tok < 1024; tok += 512) {
      LDSP const bf16_t* so = (LDSP const bf16_t*)(lds + LC_S) + tok + 2 * (tok >> 5);
      u32x4 w;
      w.x = (unsigned)so[0] | ((unsigned)so[1088] << 16); w.y = (unsigned)so[2 * 1088] | ((unsigned)so[3 * 1088] << 16);
      w.z = (unsigned)so[4 * 1088] | ((unsigned)so[5 * 1088] << 16); w.w = (unsigned)so[6 * 1088] | ((unsigned)so[7 * 1088] << 16);
      *(u32x4*)(YG + (m0 + tok) * D + c0) = w;
    }
    if (!has) break;
    cur = nxt; q = qn;
  }
#undef LC_PREFETCH
}

namespace att {
typedef unsigned short bf16;
constexpr int   D = 128, NW = 8, QBLK = 32, KVBLK = 64;
constexpr float SCALE = 0.088388347648318440f;
constexpr float THR = 8.f;
constexpr int SDEPTH = 2;
constexpr int LDQ = 1024, LDK = 256, LDO = 1024;
constexpr size_t SHM_V = KVBLK * D * 2, SHM_K = KVBLK * D * 2, SHM_ATTN = 2 * SHM_V + 2 * SHM_K + NW * 64 * 4;

using s16x4  = __attribute__((ext_vector_type(4))) short;
using f32x16 = __attribute__((ext_vector_type(16))) float;
using f32x8  = __attribute__((ext_vector_type(8))) float;

#define KSWZ(row, colB) ((row) * 256 + ((colB) ^ (((row) & 7) << 4)))
#define SBAR() __builtin_amdgcn_sched_barrier(0)
__device__ __forceinline__ int crow(int r, int hi) { return (r & 3) + 8 * (r >> 2) + 4 * hi; }
__device__ __forceinline__ unsigned cvtpk(float lo, float hi) {
  unsigned r; asm volatile("v_cvt_pk_bf16_f32 %0, %1, %2" : "=v"(r) : "v"(lo), "v"(hi)); return r;
}
template <typename TIn> struct Stage;
template <> struct Stage<bf16>  { using T = bf16x8;
  __device__ static __forceinline__ T ld8(const bf16* p) { return *reinterpret_cast<const bf16x8*>(p); }
  __device__ static __forceinline__ bf16x8 tobf(T x) { return x; } };
template <> struct Stage<float> { using T = f32x8;
  __device__ static __forceinline__ T ld8(const float* p) { return *reinterpret_cast<const f32x8*>(p); }
  __device__ static __forceinline__ bf16x8 tobf(T x) {
    u32x4 w = {cvtpk(x[0], x[1]), cvtpk(x[2], x[3]), cvtpk(x[4], x[5]), cvtpk(x[6], x[7])}; return *reinterpret_cast<bf16x8*>(&w); } };

__device__ __forceinline__ void partialSM(f32x16& p0, f32x16& p1, float& m_reg, float& mn, float& alpha) {
  constexpr float C = SCALE * 1.4426950408889634f;
  float pmax = p0[0]; for (int r = 1; r < 16; ++r) pmax = fmaxf(pmax, p0[r]); for (int r = 0; r < 16; ++r) pmax = fmaxf(pmax, p1[r]);
  { auto rr = __builtin_amdgcn_permlane32_swap(__float_as_uint(pmax), __float_as_uint(pmax), false, false);
    pmax = fmaxf(__uint_as_float(rr[0]), __uint_as_float(rr[1])); }
  if (__builtin_expect(__all(pmax - m_reg <= THR / SCALE), 1)) { mn = m_reg; alpha = 1.f; }
  else { mn = fmaxf(m_reg, pmax); alpha = __builtin_amdgcn_exp2f((m_reg - mn) * C); m_reg = mn; }
  float mnC = -mn * C;
  for (int r = 0; r < 16; ++r) p0[r] = fmaf(p0[r], C, mnC); for (int r = 0; r < 16; ++r) p1[r] = fmaf(p1[r], C, mnC);
  for (int r = 0; r < 16; ++r) p0[r] = __builtin_amdgcn_exp2f(p0[r]);
}
__device__ __forceinline__ void finishSM(f32x16& p0, f32x16& p1, float alpha, float& l_reg, bf16x8& pa0, bf16x8& pa1, bf16x8& pa2, bf16x8& pa3) {
  for (int r = 0; r < 16; ++r) p1[r] = __builtin_amdgcn_exp2f(p1[r]);
  float ps = 0; for (int r = 0; r < 16; ++r) ps += p0[r]; for (int r = 0; r < 16; ++r) ps += p1[r];
  { auto rr = __builtin_amdgcn_permlane32_swap(__float_as_uint(ps), __float_as_uint(ps), false, false);
    ps = __uint_as_float(rr[0]) + __uint_as_float(rr[1]); }
  l_reg = l_reg * alpha + ps;
#define PK4(P, BASE, OUT) do { unsigned a0 = cvtpk(P[BASE + 0], P[BASE + 1]), a1 = cvtpk(P[BASE + 2], P[BASE + 3]);   \
    unsigned b0 = cvtpk(P[BASE + 4], P[BASE + 5]), b1 = cvtpk(P[BASE + 6], P[BASE + 7]);                              \
    auto r0 = __builtin_amdgcn_permlane32_swap(a0, b0, false, false); auto r1 = __builtin_amdgcn_permlane32_swap(a1, b1, false, false); \
    u32x4 w = {r0[0], r1[0], r0[1], r1[1]}; OUT = *reinterpret_cast<bf16x8*>(&w); } while (0)
  PK4(p0, 0, pa0); PK4(p0, 8, pa1); PK4(p1, 0, pa2); PK4(p1, 8, pa3);
#undef PK4
}
__device__ __forceinline__ void qkt(f32x16& p0, f32x16& p1, const bf16* Ks, const bf16x8* qr, int r32, int hi) {
  p0 = f32x16{}; p1 = f32x16{};
  for (int d0 = 0; d0 < 8; ++d0) { int cb = (d0 * 16 + hi * 8) * 2;
    bf16x8 b0 = *reinterpret_cast<const bf16x8*>((const char*)Ks + KSWZ(r32, cb));
    bf16x8 b1 = *reinterpret_cast<const bf16x8*>((const char*)Ks + KSWZ(32 + r32, cb));
    p0 = __builtin_amdgcn_mfma_f32_32x32x16_bf16(b0, qr[d0], p0, 0, 0, 0);
    p1 = __builtin_amdgcn_mfma_f32_32x32x16_bf16(b1, qr[d0], p1, 0, 0, 0); }
}
__device__ __forceinline__ int v_st(int k, int c) { const int kk = (k & ~0xC) | ((k & 4) << 1) | ((k & 8) >> 1); return ((kk >> 3) * 4 + (c >> 5)) * 512 + ((kk & 7) * 32 + (c & 31)) * 2; }
__device__ __forceinline__ int v_rd_base(int lane) { return ((lane & 3) << 3) | (((lane >> 2) & 3) << 6) | (((lane >> 4) & 1) << 5) | (((lane >> 5) & 1) << 8); }
constexpr int v_rd_off(int d0, int ks, int half) { return d0 * 512 + ks * 4096 + half * 2048; }
template <int OFF> __device__ __forceinline__ s16x4 tr_read(int vb) {
  s16x4 r; asm volatile("ds_read_b64_tr_b16 %0, %1 offset:%2" : "=&v"(r) : "v"(vb), "i"(OFF) : "memory"); return r;
}
template <int D0> __device__ __forceinline__ void pv_one(f32x16& od, int vb, bf16x8 pa0, bf16x8 pa1, bf16x8 pa2, bf16x8 pa3) {
  const s16x4 l0 = tr_read<v_rd_off(D0, 0, 0)>(vb), h0 = tr_read<v_rd_off(D0, 0, 1)>(vb), l1 = tr_read<v_rd_off(D0, 1, 0)>(vb), h1 = tr_read<v_rd_off(D0, 1, 1)>(vb);
  const s16x4 l2 = tr_read<v_rd_off(D0, 2, 0)>(vb), h2 = tr_read<v_rd_off(D0, 2, 1)>(vb), l3 = tr_read<v_rd_off(D0, 3, 0)>(vb), h3 = tr_read<v_rd_off(D0, 3, 1)>(vb);
  asm volatile("s_waitcnt lgkmcnt(0)" ::: "memory"); SBAR();
#define PK(L, H) (bf16x8){L[0], L[1], L[2], L[3], H[0], H[1], H[2], H[3]}
  od = __builtin_amdgcn_mfma_f32_32x32x16_bf16(pa0, PK(l0, h0), od, 0, 0, 0);
  od = __builtin_amdgcn_mfma_f32_32x32x16_bf16(pa1, PK(l1, h1), od, 0, 0, 0);
  od = __builtin_amdgcn_mfma_f32_32x32x16_bf16(pa2, PK(l2, h2), od, 0, 0, 0);
  od = __builtin_amdgcn_mfma_f32_32x32x16_bf16(pa3, PK(l3, h3), od, 0, 0, 0);
#undef PK
}
__device__ __forceinline__ void pv_d0(f32x16* o, int vb, bf16x8 pa0, bf16x8 pa1, bf16x8 pa2, bf16x8 pa3) {
  pv_one<0>(o[0], vb, pa0, pa1, pa2, pa3); pv_one<1>(o[1], vb, pa0, pa1, pa2, pa3); pv_one<2>(o[2], vb, pa0, pa1, pa2, pa3); pv_one<3>(o[3], vb, pa0, pa1, pa2, pa3);
}

template <typename TQ>
__device__ __forceinline__ void attn_dense_body(const TQ* __restrict__ Qb, const bf16* __restrict__ Kh, const bf16* __restrict__ Vh,
                                                bf16* __restrict__ Ob, int seq, char* lds) {
  using St = Stage<bf16>; using SQ = Stage<TQ>;
  const int tid = tidx(), wid = tid >> 6, lane = tid & 63, r32 = lane & 31, hi = lane >> 5;
  bf16* V_lds = (bf16*)lds; bf16* K_lds = (bf16*)(lds + 2 * SHM_V);
  float* ws = (float*)(lds + 2 * SHM_V + 2 * SHM_K) + wid * 64; float* li_l = ws; float* al_l = ws + 32;
  float m_reg = -1e30f, l_reg = 0; f32x16 o[4] = {}; bf16x8 qr[8];
  const TQ* Qw = Qb + (long)(wid * QBLK + r32) * LDQ + hi * 8;
#pragma unroll
  for (int d0 = 0; d0 < 8; ++d0) qr[d0] = SQ::tobf(SQ::ld8(Qw + d0 * 16));
  const int sr = tid >> 4, sc = (tid & 15) * 8, vst0 = v_st(sr, sc), vst1 = v_st(32 + sr, sc);
  const int vb0 = (int)(uintptr_t)V_lds + v_rd_base(lane);
  struct { typename St::T vs0, vs1, ks0, ks1; } sr_[SDEPTH];
#define SLOAD(i, k0) do { sr_[i].vs0 = St::ld8(&Vh[(long)((k0) + sr) * LDK + sc]); sr_[i].vs1 = St::ld8(&Vh[(long)((k0) + 32 + sr) * LDK + sc]); \
    sr_[i].ks0 = St::ld8(&Kh[(long)((k0) + sr) * LDK + sc]); sr_[i].ks1 = St::ld8(&Kh[(long)((k0) + 32 + sr) * LDK + sc]); } while (0)
#define SWRITE(b, i) do { *(bf16x8*)((char*)V_lds + (b) * SHM_V + vst0) = St::tobf(sr_[i].vs0);          \
    *(bf16x8*)((char*)V_lds + (b) * SHM_V + vst1) = St::tobf(sr_[i].vs1); int kc = sc * 2;               \
    *(bf16x8*)((char*)K_lds + (b) * SHM_K + KSWZ(sr, kc)) = St::tobf(sr_[i].ks0);                       \
    *(bf16x8*)((char*)K_lds + (b) * SHM_K + KSWZ(32 + sr, kc)) = St::tobf(sr_[i].ks1); } while (0)
#define SWAIT() do { if constexpr (SDEPTH == 2) asm volatile("s_waitcnt vmcnt(4)" ::: "memory"); else asm volatile("s_waitcnt vmcnt(0)" ::: "memory"); } while (0)
#define RESC(a) do { if (__any((a) < 1.f)) { if (hi == 0) al_l[r32] = (a); asm volatile("s_waitcnt lgkmcnt(0)" ::: "memory"); \
    for (int d = 0; d < 4; ++d) for (int r = 0; r < 16; ++r) o[d][r] *= al_l[crow(r, hi)]; } } while (0)
  f32x16 pA0, pA1, pB0, pB1; float mnA, mnB, alA, alB; bf16x8 pa0, pa1, pa2, pa3; const int NT = seq / KVBLK;
  constexpr int SE = 0, SO = SDEPTH - 1;
  SLOAD(SE, 0); asm volatile("s_waitcnt vmcnt(0)" ::: "memory"); SWRITE(0, SE); __syncthreads();
  qkt(pA0, pA1, K_lds, qr, r32, hi); partialSM(pA0, pA1, m_reg, mnA, alA);
  SLOAD(SO, KVBLK); if constexpr (SDEPTH == 2) { if (2 < NT) SLOAD(SE, 2 * KVBLK); }
  SWAIT(); SWRITE(1, SO); __syncthreads();
  for (int j = 1; j + 1 < NT; j += 2) {
    SBAR(); qkt(pB0, pB1, (bf16*)((char*)K_lds + SHM_K), qr, r32, hi);
    finishSM(pA0, pA1, alA, l_reg, pa0, pa1, pa2, pa3); SBAR();
    SLOAD(SO, (j + SDEPTH) * KVBLK); SBAR();
    pv_d0(o, vb0, pa0, pa1, pa2, pa3); partialSM(pB0, pB1, m_reg, mnB, alB);
    __syncthreads(); SWAIT(); SWRITE(0, SE);
    RESC(alB); __syncthreads();
    SBAR(); qkt(pA0, pA1, K_lds, qr, r32, hi);
    finishSM(pB0, pB1, alB, l_reg, pa0, pa1, pa2, pa3); SBAR();
    if (SDEPTH == 1 || j + 3 < NT) SLOAD(SE, (j + 1 + SDEPTH) * KVBLK); SBAR();
    pv_d0(o, vb0 + (int)SHM_V, pa0, pa1, pa2, pa3); partialSM(pA0, pA1, m_reg, mnA, alA);
    __syncthreads(); SWAIT(); SWRITE(1, SO);
    RESC(alA); __syncthreads();
  }
  SBAR(); qkt(pB0, pB1, (bf16*)((char*)K_lds + SHM_K), qr, r32, hi);
  finishSM(pA0, pA1, alA, l_reg, pa0, pa1, pa2, pa3); SBAR();
  pv_d0(o, vb0, pa0, pa1, pa2, pa3); partialSM(pB0, pB1, m_reg, mnB, alB);
  __syncthreads(); RESC(alB);
  finishSM(pB0, pB1, alB, l_reg, pa0, pa1, pa2, pa3); SBAR();
  pv_d0(o, vb0 + (int)SHM_V, pa0, pa1, pa2, pa3);
  if (hi == 0) li_l[r32] = l_reg; asm volatile("s_waitcnt lgkmcnt(0)" ::: "memory");
  float rli[16];
#pragma unroll
  for (int r = 0; r < 16; ++r) rli[r] = __builtin_amdgcn_rcpf(li_l[crow(r, hi)]);
  bf16* Ow = Ob + (long)(wid * QBLK) * LDO;
#pragma unroll
  for (int r = 0; r < 16; ++r) { int orow = crow(r, hi);
    for (int d0 = 0; d0 < 4; ++d0) Ow[(long)orow * LDO + d0 * 32 + r32] = f2bf(o[d0][r] * rli[r]); }
#undef SLOAD
#undef SWRITE
#undef SWAIT
#undef RESC
}
}

__device__ __forceinline__ void phase_att(KP p, int j, unsigned char* lds) {
  const bf16_t* Q = (const bf16_t*)(p->ws + WS_Q); bf16_t* O = (bf16_t*)(p->ws + WS_O);
  const bf16_t* KP = (const bf16_t*)(p->ws + WS_KP); const bf16_t* VP = (const bf16_t*)(p->ws + WS_VP);
  const bf16_t* KS = (const bf16_t*)(p->ws + WS_KS) + (size_t)j * 4 * 1536 * 256; const bf16_t* VS = (const bf16_t*)(p->ws + WS_VS) + (size_t)j * 4 * 1536 * 256;
  for (int u = bidx(); u < 256; u += gdim()) {
    __syncthreads();
    if (u < 128) {
      const int qb = u & 3, h = (u >> 2) & 7, b = u >> 5, kv = h >> 2;
      const size_t row0 = (size_t)NPR + b * 1024 + qb * 256, kb = ((size_t)b * 1536) * 256 + kv * 128;
      att::attn_dense_body<att::bf16>(Q + row0 * D + h * 128, KS + kb, VS + kb, O + row0 * D + h * 128, 1536, (char*)lds);
    } else {
      const int h = (u - 128) & 7, b = (u - 128) >> 3, kv = h >> 2;
      const size_t row0 = (size_t)b * 256, kb = row0 * 256 + kv * 128;
      att::attn_dense_body<att::bf16>(Q + row0 * D + h * 128, KP + kb, VP + kb, O + row0 * D + h * 128, 256, (char*)lds);
    }
  }
  __syncthreads();
  if (j == 0) {
    for (int w = (int)((bidx() + gdim() - (128 % gdim())) % gdim()); w < 128; w += gdim())
      cvt_all(p, (float*)lds, 1, w * 23, 23, 1);
    __syncthreads();
  }
}

__device__ __forceinline__ pg8::EpiQkv make_epi_qkv(KP p, int j, unsigned char* lds) {
  pg8::EpiQkv e; e.p = p; e.xl = (PG8_LAS float*)((PG8_LAS unsigned char*)lds + pg8::STAGE_BYTES); e.j = j;
  return e;
}
__device__ __forceinline__ void qkv_idle_work(KP p, unsigned char* lds) {
  const int G = (int)gdim(), b = (int)bidx(), first = G > 192 ? 192 : 0, nw = G - first;
  if (b >= first) for (int t = b - first; t < 96; t += nw) task_mod(p, 96 + t, (float*)lds, (float*)(p->ws + WS_FILT));
  __syncthreads();
}

#define XB_TMO      128
#define XB_XCNT(j)  (256  + 64 * (j))
#define XB_XSUB(j)  (1280 + 64 * (j))
#define XB_XGEN(j)  (2304 + 64 * (j))
#define XB_TOP      3328
#define XB_TOPGEN   3392
#define XCD_BAR_WORDS 3456
#define XB_SPIN_CAP (1u << 18)
#define LAS __attribute__((address_space(3)))

__device__ __forceinline__ unsigned xb_ld(unsigned* p)              { return __hip_atomic_load(p, __ATOMIC_RELAXED, __HIP_MEMORY_SCOPE_AGENT); }
__device__ __forceinline__ unsigned xb_add(unsigned* p, unsigned v) { return __hip_atomic_fetch_add(p, v, __ATOMIC_RELAXED, __HIP_MEMORY_SCOPE_AGENT); }
__device__ __forceinline__ unsigned xb_xcc_id() { return (unsigned)__builtin_amdgcn_s_getreg((3 << 11) | 20) & 0xFu; }
#define XB_SPIN(cond, bar) do { unsigned _sp = 0; while (cond) { __builtin_amdgcn_s_sleep(1); \
    if ((++_sp & 255u) == 0u) { if (xb_ld(&(bar)[XB_TMO])) break; if (_sp > XB_SPIN_CAP) { atomicAdd(&(bar)[XB_TMO], 1u); break; } } } } while (0)

struct XcdBarrier {
    unsigned* bar; unsigned x;
    volatile LAS unsigned* st;
};

__device__ __forceinline__ XcdBarrier xcd_barrier_post(unsigned* bar, volatile LAS unsigned* st) {
    XcdBarrier b; b.bar = bar; b.x = xb_xcc_id(); b.st = st;
    if (threadIdx.x == 0) (void)xb_add(&bar[XB_XCNT(b.x)], 1u);
    return b;
}
__device__ __forceinline__ void xcd_barrier_complete(unsigned* bar, unsigned x, unsigned& nloc, unsigned& nx) {
    const unsigned G = gdim() * gridDim.y * gridDim.z;
    unsigned sum, cnt, mine, sp = 0u;
    for (;;) {
        sum = 0u; cnt = 0u; mine = 0u;
#pragma unroll
        for (unsigned j = 0; j < 16; ++j) { const unsigned c = xb_ld(&bar[XB_XCNT(j)]); sum += c; cnt += (c > 0u) ? 1u : 0u; mine = (j == x) ? c : mine; }
        if (sum == G) break;
        __builtin_amdgcn_s_sleep(1);
        if ((++sp & 255u) == 0u) { if (xb_ld(&bar[XB_TMO])) break; if (sp > XB_SPIN_CAP) { atomicAdd(&bar[XB_TMO], 1u); break; } }
    }
    nloc = mine > 0u ? mine : 1u; nx = cnt > 0u ? cnt : 1u;
}

__device__ __forceinline__ void xcd_barrier(const XcdBarrier& b) {
    asm volatile("s_waitcnt vmcnt(0)" ::: "memory");
    __syncthreads();
    if (threadIdx.x == 0) {
        unsigned* bar = b.bar;
        __builtin_amdgcn_s_waitcnt(0);
        unsigned nloc = b.st[0], nx = b.st[1];
        if (nloc == 0u) { xcd_barrier_complete(bar, b.x, nloc, nx); b.st[0] = nloc; b.st[1] = nx; }
        const unsigned old = xb_add(&bar[XB_XSUB(b.x)], 1u);
        const unsigned gen = old / nloc;
        if (old + 1u == (gen + 1u) * nloc) {
            __builtin_amdgcn_fence(__ATOMIC_RELEASE, "agent");
            asm volatile("s_waitcnt vmcnt(0)" ::: "memory");
            const unsigned og = xb_add(&bar[XB_TOP], 1u);
            const unsigned tg = og / nx;
            if (og + 1u == (tg + 1u) * nx) xb_add(&bar[XB_TOPGEN], 1u);
            else XB_SPIN(xb_ld(&bar[XB_TOPGEN]) == tg, bar);
            __builtin_amdgcn_fence(__ATOMIC_ACQUIRE, "agent");
            xb_add(&bar[XB_XGEN(b.x)], 1u);
            asm volatile("s_waitcnt vmcnt(0)" ::: "memory");
        } else {
            XB_SPIN(xb_ld(&bar[XB_XGEN(b.x)]) == gen, bar);
            __builtin_amdgcn_fence(__ATOMIC_ACQUIRE, "agent");
            asm volatile("s_waitcnt vmcnt(0)" ::: "memory");
        }
    }
    __syncthreads();
}

__global__ void __launch_bounds__(512, 2) mega(Params pv) {
  extern __shared__ __attribute__((aligned(16))) unsigned char lds[];
  cg::grid_group grid = cg::this_grid();
  volatile LAS unsigned* xst = (volatile LAS unsigned*)((LAS unsigned char*)lds + (LDS_BYTES - 16));
  if (threadIdx.x < 4) xst[threadIdx.x] = 0u;
  __syncthreads();
  if (bidx() == 0) { unsigned* bw = (unsigned*)((KP)__builtin_amdgcn_kernarg_segment_ptr())->ws; for (int i = threadIdx.x; i < 4096; i += 512) bw[i] = 0u; }
#define XN ((bf16_t*)(p->ws + WS_XN))
#define MOD ((const float*)(p->ws + WS_MOD))
#define XBAR() do { XcdBarrier b_; b_.bar = (unsigned*)KPARAMS()->ws; b_.x = xb_xcc_id(); b_.st = xst; xcd_barrier(b_); } while (0)
#define KPARAMS() ({ unsigned long long a_ = (unsigned long long)__builtin_amdgcn_kernarg_segment_ptr(); asm volatile("" : "+s"(a_)); (KP)a_; })
#define RUN(stmt) do { int lv = l; asm volatile("" : "+s"(lv)); const int jv = lv >> 1; (void)jv; const KP p = KPARAMS(); stmt; XBAR(); } while (0)
  { const KP p = KPARAMS(); phase_p0(p, lds); }
  grid.sync();
  (void)xcd_barrier_post((unsigned*)((KP)__builtin_amdgcn_kernarg_segment_ptr())->ws, xst);
  { const KP p = KPARAMS(); phase_p0b(p); }
  XBAR();
#pragma unroll 1
  for (int l = 0; l < 4; ++l) {
    RUN(phase_nm(p, lv, 0, lv > 0, lds));
    if ((l & 1) == 0) {
      RUN(gemm_run(lds, (const bf16_t*)(p->ws + WS_WIN) + (size_t)jv * 3072 * D, XN, 3072, MTOK, D, 1, pg8::EpiBf16{(bf16_t*)(p->ws + WS_ZT), MTOK}));
      RUN(phase_lc(p, jv, lds));
      RUN(gemm_run(lds, (const bf16_t*)(p->ws + WS_YG), (const bf16_t*)(p->ws + WS_WHO) + (size_t)jv * D * D, MTOK, D, D, 2, pg8::EpiGate{(bf16_t*)(p->ws + WS_P1), MOD + (size_t)lv * 5 * 6144 + 2048, nullptr}));
    } else {
      RUN({ gemm_run(lds, XN, (const bf16_t*)(p->ws + WS_WQKV) + (size_t)jv * QKVD * D, MTOK, QKVD, D, 1, make_epi_qkv(p, jv, lds)); if (lv == 1) qkv_idle_work(p, lds); });
      RUN(phase_att(p, jv, lds));
      RUN(gemm_run(lds, (const bf16_t*)(p->ws + WS_O), (const bf16_t*)(p->ws + WS_WAO) + (size_t)jv * D * D, MTOK, D, D, 2, pg8::EpiGate{(bf16_t*)(p->ws + WS_P1), MOD + (size_t)lv * 5 * 6144 + 2048, nullptr}));
    }
    RUN({ phase_nm(p, lv, 1, true, lds); if (lv == 1) mod_finalize(p, 1, (const float*)(p->ws + WS_FILT)); });
    RUN(gemm_run(lds, XN, (const bf16_t*)(p->ws + WS_WGU) + (size_t)lv * 2 * DFF * D, MTOK, 2 * DFF, D, 1, pg8::EpiSwiglu{(bf16_t*)(p->ws + WS_H)}));
    RUN(gemm_run(lds, (const bf16_t*)(p->ws + WS_H), (const bf16_t*)(p->ws + WS_WDN) + (size_t)lv * D * DFF, MTOK, D, DFF, 2, pg8::EpiGate{(bf16_t*)(p->ws + WS_P1), MOD + (size_t)lv * 5 * 6144 + 5 * 1024, nullptr}));
  }
  { const KP p = KPARAMS(); phase_final(p); }
#undef RUN
#undef KPARAMS
#undef XN
#undef MOD
}
constexpr int N_PHASES = 2 + 2 * 7 + 2 * 8 + 1;


extern "C" void kernel_launch(void* const* d_in, const int* in_sizes, int n_in, void* d_out, int out_size, void* d_ws, size_t ws_size, hipStream_t stream) {
  static int grid = 0;
  if (grid == 0) {
    if (n_in != 29 || ws_size < WS_END) { fprintf(stderr, "kernel_launch: n_in %d ws %zu (need 29, >= %zu)\n", n_in, ws_size, (size_t)WS_END); grid = -1; return; }
    int dev = 0, cus = 0, per_cu = 0;
    hipGetDevice(&dev);
    hipDeviceGetAttribute(&cus, hipDeviceAttributeMultiprocessorCount, dev);
    if (hipFuncSetAttribute((const void*)mega, hipFuncAttributeMaxDynamicSharedMemorySize, LDS_BYTES) != hipSuccess) { fprintf(stderr, "kernel_launch: hipFuncSetAttribute failed\n"); grid = -1; return; }
    hipOccupancyMaxActiveBlocksPerMultiprocessor(&per_cu, (const void*)mega, 512, LDS_BYTES);
    if (per_cu < 1) { fprintf(stderr, "kernel_launch: occupancy query says %d blocks per CU\n", per_cu); per_cu = 1; }
    grid = cus * per_cu;
  }
  if (grid < 0) return;
  Params p{};
  for (int i = 0; i < 29; ++i) p.in[i] = (const float*)d_in[i];
  p.out = (float*)d_out; p.ws = (unsigned char*)d_ws;

  void* args[] = {&p};
  hipError_t e = hipLaunchCooperativeKernel((const void*)mega, dim3(grid), dim3(512), args, LDS_BYTES, stream);
  if (e != hipSuccess) fprintf(stderr, "cooperative launch failed: %s (grid %d)\n", hipGetErrorString(e), grid);

}
```

```cpp
#include <hip/hip_runtime.h>
#include <hip/hip_cooperative_groups.h>
#include <cstdio>
#include <cstdint>
namespace cg = cooperative_groups;

typedef unsigned short bf16_t;
typedef short bf16x8 __attribute__((ext_vector_type(8)));
typedef float f32x4 __attribute__((ext_vector_type(4)));
typedef unsigned u32x4 __attribute__((ext_vector_type(4)));
typedef float f32x16 __attribute__((ext_vector_type(16)));

constexpr int D = 1024, MTOK = 8192, NPR = 4096;
constexpr int DFF = 2816, QKVD = 1536;
constexpr float EPS = 1e-6f;
constexpr float MIN_DECAY = -3.0701134573253944f, MAX_DECAY = -15.350567286626972f;

constexpr size_t MiB = 1u << 20;
constexpr size_t WS_MOD = 1 * MiB, WS_MODP = 2 * MiB, WS_FSQP = 6 * MiB, WS_RNORM = 7 * MiB, WS_FILT = 8 * MiB;
constexpr size_t WS_WIN = 28 * MiB, WS_WHO = 40 * MiB, WS_WQKV = 44 * MiB, WS_WAO = 50 * MiB, WS_WGU = 54 * MiB, WS_WDN = 98 * MiB;
constexpr size_t WS_Y = 120 * MiB, WS_XN = 152 * MiB, WS_R = 168 * MiB;
constexpr size_t WS_ZT = WS_R, WS_YG = WS_R + 48 * MiB, WS_P1 = WS_R + 64 * MiB;
constexpr size_t P1_HALF = (size_t)MTOK * D;
constexpr size_t WS_QKV = WS_R, WS_Q = WS_R + 24 * MiB, WS_KP = WS_R + 40 * MiB, WS_VP = WS_R + 42 * MiB, WS_O = WS_R + 44 * MiB;
constexpr size_t WS_H = WS_R;
constexpr size_t WS_KS = WS_R + 96 * MiB, WS_VS = WS_R + 102 * MiB, WS_FRG = WS_R + 108 * MiB, WS_END = WS_R + 130 * MiB;
constexpr size_t FRG_J = 11 * MiB / 2, FRG_L1 = (size_t)1024 * (4 * 256 + 34);
constexpr size_t FILT_J = 10 * MiB / 4;
constexpr size_t FILT_L1 = 1024 * 512;

constexpr int LDS_BYTES = 147456;

struct Params {
  const float* in[29];
  float* out;
  unsigned char* ws;
  int ph_lo, ph_hi;
};
typedef const __attribute__((address_space(4))) Params* KP;
enum { I_XP = 0, I_XS, I_CK, I_CV, I_C, I_CCTX, I_MODW, I_MODB, I_NMIX, I_NFFN, I_HWIN, I_HCW, I_HCB, I_FW1, I_FB1, I_FFREQ, I_FW2, I_FB2, I_FW3,
       I_HBIAS, I_HWOUT, I_WQKV, I_QN, I_KN, I_WAO, I_WG, I_WU, I_WD, I_FN };

__device__ __forceinline__ bf16_t f2bf(float f) { unsigned u = __float_as_uint(f); u += 0x7FFFu + ((u >> 16) & 1u); return (bf16_t)(u >> 16); }
__device__ __forceinline__ float bf2f(bf16_t b) { return __uint_as_float(((unsigned)b) << 16); }
__device__ __forceinline__ unsigned pack2(float lo, float hi) { unsigned r; asm("v_cvt_pk_bf16_f32 %0, %1, %2" : "=v"(r) : "v"(lo), "v"(hi)); return r; }
__device__ __forceinline__ float wave_sum(float v) {
#pragma unroll
  for (int o = 32; o >= 1; o >>= 1) v += __shfl_xor(v, o);
  return v;
}
__device__ __forceinline__ float wave_max(float v) {
#pragma unroll
  for (int o = 32; o >= 1; o >>= 1) v = fmaxf(v, __shfl_xor(v, o));
  return v;
}
__device__ __forceinline__ unsigned bidx() { unsigned b; asm volatile("s_mov_b32 %0, %1" : "=s"(b) : "s"(__builtin_amdgcn_workgroup_id_x())); return b; }
__device__ __forceinline__ unsigned gdim() { unsigned g = __builtin_amdgcn_grid_size_x() / __builtin_amdgcn_workgroup_size_x(); asm volatile("" : "+s"(g)); return g; }
__device__ __forceinline__ int tidx() { int t = threadIdx.x; asm volatile("" : "+v"(t)); return t; }
__device__ __forceinline__ int cond_of(int m) { return m < NPR ? 4 : ((m - NPR) >> 10); }
__device__ __forceinline__ float silu_f(float x) { return x / (1.f + expf(-x)); }
__device__ __forceinline__ float sin_rev(float r) { return __builtin_amdgcn_sinf(r - rintf(r)); }
__device__ __forceinline__ float cos_rev(float r) { return __builtin_amdgcn_cosf(r - rintf(r)); }
constexpr float INV_2PI = 0.15915494309189535f;

struct TileDesc { const float* src; bf16_t* dst; int K, N, k0, n0, mode; };
constexpr int H_WIN = 16 * 24, H_WHO = 16 * 8, H_WQKV = 16 * 12, H_WAO = 16 * 8, H_G = 2 * 16 * 22, H_DN = 2 * 44 * 8;
constexpr int NT_CVT_HALF = H_WIN + H_WHO + H_WQKV + H_WAO + 2 * H_G + H_DN;
__device__ __forceinline__ TileDesc cvt_decode(KP p, int t, int late) {
  TileDesc d;
  if (t < H_WIN) { const int l = late, r = t; d.src = p->in[I_HWIN] + (size_t)l * D * 3072; d.dst = (bf16_t*)(p->ws + WS_WIN) + (size_t)l * 3072 * D; d.K = D; d.N = 3072; d.k0 = (r / 24) * 64; d.n0 = (r % 24) * 128; d.mode = 0; return d; }
  t -= H_WIN;
  if (t < H_WHO) { const int l = late, r = t; d.src = p->in[I_HWOUT] + (size_t)l * D * D; d.dst = (bf16_t*)(p->ws + WS_WHO) + (size_t)l * D * D; d.K = D; d.N = D; d.k0 = (r / 8) * 64; d.n0 = (r % 8) * 128; d.mode = 0; return d; }
  t -= H_WHO;
  if (t < H_WQKV) { const int l = late, r = t; d.src = p->in[I_WQKV] + (size_t)l * D * QKVD; d.dst = (bf16_t*)(p->ws + WS_WQKV) + (size_t)l * QKVD * D; d.K = D; d.N = QKVD; d.k0 = (r / 12) * 64; d.n0 = (r % 12) * 128; d.mode = 0; return d; }
  t -= H_WQKV;
  if (t < H_WAO) { const int l = late, r = t; d.src = p->in[I_WAO] + (size_t)l * D * D; d.dst = (bf16_t*)(p->ws + WS_WAO) + (size_t)l * D * D; d.K = D; d.N = D; d.k0 = (r / 8) * 64; d.n0 = (r % 8) * 128; d.mode = 0; return d; }
  t -= H_WAO;
  if (t < 2 * H_G) { const int up = t >= H_G ? 1 : 0; t -= up * H_G; const int l = 2 * late + t / (16 * 22), r = t % (16 * 22);
    d.src = p->in[up ? I_WU : I_WG] + (size_t)l * D * DFF; d.dst = (bf16_t*)(p->ws + WS_WGU) + (size_t)l * 2 * DFF * D; d.K = D; d.N = DFF; d.k0 = (r / 22) * 64; d.n0 = (r % 22) * 128; d.mode = 1 + up; return d; }
  t -= 2 * H_G;
  { const int l = 2 * late + t / (44 * 8), r = t % (44 * 8); d.src = p->in[I_WD] + (size_t)l * DFF * D; d.dst = (bf16_t*)(p->ws + WS_WDN) + (size_t)l * D * DFF; d.K = DFF; d.N = D; d.k0 = (r / 8) * 64; d.n0 = (r % 8) * 128; d.mode = 0; return d; }
}
__device__ __forceinline__ void cvt_load(const TileDesc& d, int tid, f32x4 (&v)[4]) {
  const int r = tid >> 5, c4 = (tid & 31) * 4;
#pragma unroll
  for (int h = 0; h < 4; ++h) v[h] = *(const f32x4*)(d.src + (size_t)(d.k0 + r + 16 * h) * d.N + d.n0 + c4);
}
__device__ __forceinline__ void cvt_to_lds(float* tile, int tid, const f32x4 (&v)[4]) {
  const int r = tid >> 5, c4 = (tid & 31) * 4;
#pragma unroll
  for (int h = 0; h < 4; ++h) { float* q = tile + (r + 16 * h) * 129 + c4; q[0] = v[h][0]; q[1] = v[h][1]; q[2] = v[h][2]; q[3] = v[h][3]; }
}
__device__ __forceinline__ void cvt_store(const TileDesc& cur, const float* tile, int tid) {
  const int n = tid >> 2, kc = (tid & 3) * 16;
  u32x4 w0, w1;
  w0.x = pack2(tile[(kc + 0) * 129 + n], tile[(kc + 1) * 129 + n]); w0.y = pack2(tile[(kc + 2) * 129 + n], tile[(kc + 3) * 129 + n]);
  w0.z = pack2(tile[(kc + 4) * 129 + n], tile[(kc + 5) * 129 + n]); w0.w = pack2(tile[(kc + 6) * 129 + n], tile[(kc + 7) * 129 + n]);
  w1.x = pack2(tile[(kc + 8) * 129 + n], tile[(kc + 9) * 129 + n]); w1.y = pack2(tile[(kc + 10) * 129 + n], tile[(kc + 11) * 129 + n]);
  w1.z = pack2(tile[(kc + 12) * 129 + n], tile[(kc + 13) * 129 + n]); w1.w = pack2(tile[(kc + 14) * 129 + n], tile[(kc + 15) * 129 + n]);
  const int ng = cur.n0 + n;
  const int row = cur.mode == 0 ? ng : ((ng >> 7) * 256 + (ng & 127) + (cur.mode == 2 ? 128 : 0));
  bf16_t* o = cur.dst + (size_t)row * cur.K + cur.k0 + kc;
  *(u32x4*)o = w0; *(u32x4*)(o + 8) = w1;
}
__device__ __forceinline__ void cvt_all(KP p, float* lds_f, int late, int start, int count, int stride) {
  const int tid = tidx();
  float* tileA = lds_f; float* tileB = lds_f + 64 * 129 + 64;
  if (count <= 0) return;
  TileDesc d0 = cvt_decode(p, start, late), d1 = d0;
  f32x4 va[4], vb[4];
  cvt_load(d0, tid, va);
  if (count > 1) { d1 = cvt_decode(p, start + stride, late); cvt_load(d1, tid, vb); }
  __syncthreads();
  for (int i = 0;; i += 2) {
    cvt_to_lds(tileA, tid, va);
    const TileDesc ca = d0;
    const bool hasA = i + 2 < count;
    if (hasA) { d0 = cvt_decode(p, start + (i + 2) * stride, late); cvt_load(d0, tid, va); }
    __syncthreads();
    cvt_store(ca, tileA, tid);
    if (i + 1 >= count) break;
    cvt_to_lds(tileB, tid, vb);
    const TileDesc cb = d1;
    const bool hasB = i + 3 < count;
    if (hasB) { d1 = cvt_decode(p, start + (i + 3) * stride, late); cvt_load(d1, tid, vb); }
    __syncthreads();
    cvt_store(cb, tileB, tid);
    if (!hasA) break;
  }
  __syncthreads();
}

constexpr int NT_MOD = 4 * 3 * 16;
__device__ __forceinline__ void task_mod(KP p, int t, float* sl  , float* modp) {
  const int tid = tidx();
  const int l = t / 48, rem = t % 48, cb = rem / 16, kc = rem % 16;
  __syncthreads();
  if (tid < 320) {
    const int j = tid >> 6, k = kc * 64 + (tid & 63);
    const float x = j < 4 ? p->in[I_C][j * D + k] : p->in[I_CCTX][k];
    sl[tid] = silu_f(x);
  }
  __syncthreads();
  const int n = cb * 2048 + tid * 4;
  const float* w = p->in[I_MODW] + ((size_t)l * D + kc * 64) * 6144 + n;
  f32x4 a0 = {0.f, 0.f, 0.f, 0.f}, a1 = a0, a2 = a0, a3 = a0, a4 = a0;
#pragma unroll 8
  for (int k = 0; k < 64; ++k) {
    const f32x4 wv = *(const f32x4*)(w + (size_t)k * 6144);
    a0 += wv * sl[k]; a1 += wv * sl[64 + k]; a2 += wv * sl[128 + k]; a3 += wv * sl[192 + k]; a4 += wv * sl[256 + k];
  }
  float* o = modp + ((size_t)(kc * 4 + l) * 5) * 6144 + n;
  *(f32x4*)o = a0; *(f32x4*)(o + 6144) = a1; *(f32x4*)(o + 2 * 6144) = a2; *(f32x4*)(o + 3 * 6144) = a3; *(f32x4*)(o + 4 * 6144) = a4;
}

constexpr int NT_FILT = 320;
constexpr int FL_H1 = 0, FL_H2 = 4160, FL_W1 = 8320, FL_W2 = FL_W1 + 2112, FL_W3 = FL_W2 + 4096, FL_END = FL_W3 + 16384;
__device__ __forceinline__ void task_filt(KP p, int t, float* fl) {
  const int tid = tidx(), lane = tid & 63, wid = __builtin_amdgcn_readfirstlane(tid >> 6);
  const int combo = t >> 3, nchunk = t & 7;
  const int j = combo / 20, r = combo % 20;
  const int lsel = r < 4 ? 0 : 1, tchunk = r < 4 ? r : r - 4, L = lsel ? 1024 : 256;
  const int tt = lane, tpos = tchunk * 64 + tt;
  const float tn = (float)tpos / (float)L;
  float* h1 = fl + FL_H1; float* h2 = fl + FL_H2; float* w1 = fl + FL_W1; float* w2 = fl + FL_W2; float* w3 = fl + FL_W3;
  const float* b1 = p->in[I_FB1] + j * 64; const float* fr = p->in[I_FFREQ] + j * 128; const float* b2 = p->in[I_FB2] + j * 64;
  __syncthreads();
  {
    const f32x4* g1 = (const f32x4*)(p->in[I_FW1] + (size_t)j * 33 * 64); const f32x4* g2 = (const f32x4*)(p->in[I_FW2] + (size_t)j * 64 * 64);
    const float* g3 = p->in[I_FW3] + (size_t)j * 64 * 2048 + nchunk * 256;
    for (int i = tid; i < 528; i += 512) ((f32x4*)w1)[i] = g1[i];
    for (int i = tid; i < 1024; i += 512) ((f32x4*)w2)[i] = g2[i];
#pragma unroll
    for (int h = 0; h < 8; ++h) { const int i = tid + 512 * h, v = i >> 6, c4 = (i & 63) * 4; *(f32x4*)(w3 + v * 256 + c4) = *(const f32x4*)(g3 + (size_t)v * 2048 + c4); }
  }
  __syncthreads();
  const int u0 = wid * 8;
  {
    float acc[8];
#pragma unroll
    for (int uu = 0; uu < 8; ++uu) acc[uu] = tn * w1[u0 + uu];
#pragma unroll 4
    for (int b = 1; b <= 16; ++b) {
      const float rev = tn * (float)b;
      const float cs = cos_rev(rev), sn = sin_rev(rev);
#pragma unroll
      for (int uu = 0; uu < 8; ++uu) acc[uu] += cs * w1[b * 64 + u0 + uu] + sn * w1[(16 + b) * 64 + u0 + uu];
    }
#pragma unroll
    for (int uu = 0; uu < 8; ++uu) h1[tt * 65 + u0 + uu] = sin_rev(INV_2PI * (fr[u0 + uu] * (acc[uu] + b1[u0 + uu])));
  }
  __syncthreads();
  {
    float acc[8];
#pragma unroll
    for (int uu = 0; uu < 8; ++uu) acc[uu] = 0.f;
#pragma unroll 8
    for (int v = 0; v < 64; ++v) {
      const float hv = h1[tt * 65 + v];
#pragma unroll
      for (int uu = 0; uu < 8; ++uu) acc[uu] += hv * w2[v * 64 + u0 + uu];
    }
#pragma unroll
    for (int uu = 0; uu < 8; ++uu) h2[tt * 65 + u0 + uu] = sin_rev(INV_2PI * (fr[64 + u0 + uu] * (acc[uu] + b2[u0 + uu])));
  }
  __syncthreads();
  float* fsq = (float*)(p->ws + WS_FSQP) + ((size_t)((j * 2 + lsel) * 16 + tchunk)) * 2048;
  const int nb = nchunk * 256 + wid * 32;
  float acc[32];
#pragma unroll
  for (int q = 0; q < 32; ++q) acc[q] = 0.f;
#pragma unroll 4
  for (int v = 0; v < 64; ++v) {
    const float hv = h2[tt * 65 + v];
    const float* wr = w3 + v * 256 + wid * 32;
#pragma unroll
    for (int q = 0; q < 32; ++q) acc[q] += hv * wr[q];
  }
#pragma unroll
  for (int q = 0; q < 32; ++q) {
    const int n = nb + q, c = n & 1023; const bool isb = n >= 1024;
    const float delta = fabsf(MIN_DECAY + (MAX_DECAY - MIN_DECAY) * ((float)c / 1023.f));
    float val = acc[q] * __expf(-tn * delta);
    if (isb && tpos == 0) val = 0.f;
    bf16_t* rec = (bf16_t*)(p->ws + WS_FRG) + (size_t)j * FRG_J + (lsel ? FRG_L1 : 0) + (size_t)c * (4 * L + 34);
    if (isb && tpos == 0) rec[0] = 0;
    else { const int i = isb ? (L + tpos) : (L - tpos); const bf16_t bv = f2bf(val); rec[i] = bv; rec[2 * L + 34 + i - 1] = bv; }
    acc[q] = val * val;
  }
  __syncthreads();
#pragma unroll
  for (int q = 0; q < 32; ++q) h1[(wid * 32 + q) * 65 + lane] = acc[q];
  __syncthreads();
  if (tid < 256) { float s = 0.f; for (int k = 0; k < 64; ++k) s += h1[tid * 65 + ((k + tid) & 63)]; fsq[nchunk * 256 + tid] = s; }
}

__device__ __forceinline__ void phase_p0(KP p, unsigned char* lds) {
  float* fl = (float*)lds;
  const int G = gdim(), b = bidx(), tid = tidx();
  for (int t = b; t < NT_FILT + NT_MOD / 2; t += G) {
    __syncthreads();
    if (t < NT_FILT) task_filt(p, t, fl);
    else task_mod(p, t - NT_FILT, fl, (float*)(p->ws + WS_ZT));
  }
  cvt_all(p, fl, 0, b, (NT_CVT_HALF - b + G - 1) / G, G);
  {
    bf16_t* KS = (bf16_t*)(p->ws + WS_KS); bf16_t* VS = (bf16_t*)(p->ws + WS_VS);
    const int n8 = 4 * 2 * 512 * 256 / 8;
    for (int i8 = b * 512 + tid; i8 < n8; i8 += G * 512) {
      const int i = i8 * 8;
      const int e = i & 255, pos = (i >> 8) & 511, j = (i >> 17) & 1, bb = i >> 18;
      const size_t o = ((size_t)(j * 4 + bb) * 1536 + 1024 + pos) * 256 + e;
      const f32x4 k0 = *(const f32x4*)(p->in[I_CK] + i), k1 = *(const f32x4*)(p->in[I_CK] + i + 4), v0 = *(const f32x4*)(p->in[I_CV] + i), v1 = *(const f32x4*)(p->in[I_CV] + i + 4);
      u32x4 kw, vw;
      kw.x = pack2(k0[0], k0[1]); kw.y = pack2(k0[2], k0[3]); kw.z = pack2(k1[0], k1[1]); kw.w = pack2(k1[2], k1[3]);
      vw.x = pack2(v0[0], v0[1]); vw.y = pack2(v0[2], v0[3]); vw.z = pack2(v1[0], v1[1]); vw.w = pack2(v1[2], v1[3]);
      *(u32x4*)(KS + o) = kw; *(u32x4*)(VS + o) = vw;
    }
  }
}

__device__ __forceinline__ void mod_finalize(KP p, int late, const float* MP) {
  const int G = gdim(), b = bidx(), tid = tidx();
  float* MOD = (float*)(p->ws + WS_MOD);
  for (int i = late * (2 * 5 * 6144) + b * 512 + tid; i < (late + 1) * (2 * 5 * 6144); i += G * 512) {
    const int n = i % 6144, l = i / (5 * 6144);
    float s = p->in[I_MODB][l * 6144 + n];
#pragma unroll
    for (int kc = 0; kc < 16; ++kc) s += MP[(size_t)kc * (4 * 5 * 6144) + i];
    MOD[i] = s;
  }
}
__device__ __forceinline__ void phase_p0b(KP p) {
  const int G = gdim(), b = bidx(), tid = tidx();
  mod_finalize(p, 0, (const float*)(p->ws + WS_ZT));
  float* RN = (float*)(p->ws + WS_RNORM); const float* FS = (const float*)(p->ws + WS_FSQP);
  for (int i = b + tid * G; i < 4096; i += G * 512) {
    const int c = i & 1023, jl = i >> 10, nch = (jl & 1) ? 16 : 4;
    float s = 0.f;
#pragma unroll
    for (int ch = 0; ch < 16; ++ch) if (ch < nch) s += FS[((size_t)jl * 16 + ch) * 2048 + c] + FS[((size_t)jl * 16 + ch) * 2048 + 1024 + c];
    RN[i] = 1.f / sqrtf(s + EPS);
  }
}

typedef float f32x2v __attribute__((ext_vector_type(2)));
__device__ __forceinline__ void phase_nm(KP p, int layer, int which, bool addp, unsigned char* lds_) {
  const int tid = tidx(), lane = tid & 63, wid = __builtin_amdgcn_readfirstlane(tid >> 6);
  float* Y = (float*)(p->ws + WS_Y); const bf16_t* P1 = (const bf16_t*)(p->ws + WS_P1); bf16_t* XN = (bf16_t*)(p->ws + WS_XN);
  const float* g = p->in[which ? I_NFFN : I_NMIX] + layer * D;
  __attribute__((address_space(3))) float* ml = (__attribute__((address_space(3))) float*)lds_;
  for (int mb = bidx() * 32; mb < MTOK; mb += gdim() * 32) {
    const float* mod = (const float*)(p->ws + WS_MOD) + (size_t)(layer * 5 + cond_of(mb)) * 6144 + which * 3072;
    { const int k = tid * 2;
      *(__attribute__((address_space(3))) f32x2v*)(ml + k) = *(const f32x2v*)(g + k);
      *(__attribute__((address_space(3))) f32x2v*)(ml + 1024 + k) = *(const f32x2v*)(mod + k);
      *(__attribute__((address_space(3))) f32x2v*)(ml + 2048 + k) = *(const f32x2v*)(mod + 1024 + k); }
    const int m0 = mb + wid * 4;
    f32x4 v[4][4]; uint2 pa[4][4], pb[4][4];
#pragma unroll
    for (int r = 0; r < 4; ++r) {
      const int m = m0 + r;
      const float* src = layer == 0 ? (m < NPR ? p->in[I_XP] + (size_t)m * D : p->in[I_XS] + (size_t)(m - NPR) * D) : Y + (size_t)m * D;
#pragma unroll
      for (int i = 0; i < 4; ++i) { v[r][i] = *(const f32x4*)(src + i * 256 + lane * 4);
        if (addp) { pa[r][i] = *(const uint2*)(P1 + (size_t)m * D + i * 256 + lane * 4); pb[r][i] = *(const uint2*)(P1 + P1_HALF + (size_t)m * D + i * 256 + lane * 4); } }
    }
    __syncthreads();
    float ss[4];
#pragma unroll
    for (int r = 0; r < 4; ++r) {
      const int m = m0 + r;
      ss[r] = 0.f;
#pragma unroll
      for (int i = 0; i < 4; ++i) {
        if (addp) {
          v[r][i][0] += __uint_as_float(pa[r][i].x << 16) + __uint_as_float(pb[r][i].x << 16); v[r][i][1] += __uint_as_float(pa[r][i].x & 0xFFFF0000u) + __uint_as_float(pb[r][i].x & 0xFFFF0000u);
          v[r][i][2] += __uint_as_float(pa[r][i].y << 16) + __uint_as_float(pb[r][i].y << 16); v[r][i][3] += __uint_as_float(pa[r][i].y & 0xFFFF0000u) + __uint_as_float(pb[r][i].y & 0xFFFF0000u);
          *(f32x4*)(Y + (size_t)m * D + i * 256 + lane * 4) = v[r][i]; }
        ss[r] += v[r][i][0] * v[r][i][0] + v[r][i][1] * v[r][i][1] + v[r][i][2] * v[r][i][2] + v[r][i][3] * v[r][i][3]; }
    }
#pragma unroll
    for (int o = 32; o >= 1; o >>= 1) {
#pragma unroll
      for (int r = 0; r < 4; ++r) ss[r] += __shfl_xor(ss[r], o);
    }
    float rs[4];
#pragma unroll
    for (int r = 0; r < 4; ++r) rs[r] = rsqrtf(ss[r] * (1.f / D) + EPS);
#pragma unroll
    for (int i = 0; i < 4; ++i) {
      const int k = i * 256 + lane * 4;
      const f32x4 gg = *(const __attribute__((address_space(3))) f32x4*)(ml + k), sh = *(const __attribute__((address_space(3))) f32x4*)(ml + 1024 + k), sc = *(const __attribute__((address_space(3))) f32x4*)(ml + 2048 + k);
#pragma unroll
      for (int r = 0; r < 4; ++r) {
        float o[4];
#pragma unroll
        for (int e = 0; e < 4; ++e) o[e] = (v[r][i][e] * rs[r] * gg[e]) * (1.f + sc[e]) + sh[e];
        uint2 w; w.x = pack2(o[0], o[1]); w.y = pack2(o[2], o[3]);
        *(uint2*)(XN + (size_t)(m0 + r) * D + k) = w;
      }
    }
    if (mb + (int)gdim() * 32 < MTOK) __syncthreads();
  }
}

__device__ __forceinline__ void phase_final(KP p) {
  const int tid_ = tidx(), lane = tid_ & 63, wid = __builtin_amdgcn_readfirstlane(tid_ >> 6);
  const float* Y = (const float*)(p->ws + WS_Y); const bf16_t* P1 = (const bf16_t*)(p->ws + WS_P1);
  const float* g = p->in[I_FN];
  constexpr int NR = 4;
  for (int m0 = (bidx() * 8 + wid) * NR; m0 < MTOK; m0 += gdim() * 8 * NR) {
    f32x4 v[NR][4]; uint2 pa[NR][4], pb[NR][4]; f32x4 gg[4];
#pragma unroll
    for (int r = 0; r < NR; ++r) {
      const int m = m0 + r;
#pragma unroll
      for (int i = 0; i < 4; ++i) { v[r][i] = *(const f32x4*)(Y + (size_t)m * D + i * 256 + lane * 4);
        pa[r][i] = *(const uint2*)(P1 + (size_t)m * D + i * 256 + lane * 4); pb[r][i] = *(const uint2*)(P1 + P1_HALF + (size_t)m * D + i * 256 + lane * 4); }
    }
#pragma unroll
    for (int i = 0; i < 4; ++i) gg[i] = *(const f32x4*)(g + i * 256 + lane * 4);
    float ss[NR];
#pragma unroll
    for (int r = 0; r < NR; ++r) {
      ss[r] = 0.f;
#pragma unroll
      for (int i = 0; i < 4; ++i) {
        v[r][i][0] += __uint_as_float(pa[r][i].x << 16) + __uint_as_float(pb[r][i].x << 16); v[r][i][1] += __uint_as_float(pa[r][i].x & 0xFFFF0000u) + __uint_as_float(pb[r][i].x & 0xFFFF0000u);
        v[r][i][2] += __uint_as_float(pa[r][i].y << 16) + __uint_as_float(pb[r][i].y << 16); v[r][i][3] += __uint_as_float(pa[r][i].y & 0xFFFF0000u) + __uint_as_float(pb[r][i].y & 0xFFFF0000u);
        ss[r] += v[r][i][0] * v[r][i][0] + v[r][i][1] * v[r][i][1] + v[r][i][2] * v[r][i][2] + v[r][i][3] * v[r][i][3]; }
    }
#pragma unroll
    for (int o = 32; o >= 1; o >>= 1) {
#pragma unroll
      for (int r = 0; r < NR; ++r) ss[r] += __shfl_xor(ss[r], o);
    }
#pragma unroll
    for (int r = 0; r < NR; ++r) {
      const float rs = rsqrtf(ss[r] * (1.f / D) + EPS);
#pragma unroll
      for (int i = 0; i < 4; ++i) {
        f32x4 o; o[0] = v[r][i][0] * rs * gg[i][0]; o[1] = v[r][i][1] * rs * gg[i][1]; o[2] = v[r][i][2] * rs * gg[i][2]; o[3] = v[r][i][3] * rs * gg[i][3];
        *(f32x4*)(p->out + (size_t)(m0 + r) * D + i * 256 + lane * 4) = o;
      }
    }
  }
}

namespace pg8 {
#define PG8_LAS __attribute__((address_space(3)))
constexpr int BM = 256, BK = 64, HALF = 128, HTB = HALF * BK * 2, STAGE_BYTES = 8 * HTB, NXCD = 8, WGM = 8;
__host__ __device__ __forceinline__ int lds_byte(int r, int c) { const int st = (r >> 4) * 2 + (c >> 5), rr = r & 15, cc = c & 31, ob = rr * 64 + cc * 2; return st * 1024 + (ob ^ (((ob >> 9) & 1) << 5)); }
__host__ __device__ __forceinline__ void stage_rc(int b, int& R, int& C) { const int st = b / 1024, sb = b % 1024, swz = sb ^ (((sb >> 9) & 1) << 5); R = (st >> 1) * 16 + swz / 64; C = (st & 1) * 32 + (swz % 64) / 2; }
__host__ __device__ __forceinline__ int perm32(int rho) { const int n = rho >> 4, i = rho & 15; return 8 * (i >> 2) + 4 * n + (i & 3); }
struct Unit { int pm, pn, ks; };
struct Gemm { const bf16_t* A; const bf16_t* Bt; int M, N, K, ld; };
struct StaticOrder {
    int nM, nN, nwg, G, c, KS;
    __device__ void init(int M, int N, int KS_, int G_, int c_) { nM = M / BM; KS = KS_; nN = (N / BM) * KS_; nwg = nM * nN; G = G_; c = c_; }
    __device__ bool next(int i, Unit& u) const {
        const long L = (long)i * G + c; if (L >= nwg) return false;
        int wgid = (int)L; { const int q = nwg / NXCD, r = nwg % NXCD, xcd = wgid % NXCD, off = wgid / NXCD; wgid = (xcd < r ? xcd * (q + 1) : r * (q + 1) + (xcd - r) * q) + off; }
        const int nig = WGM * nN, gid = wgid / nig, fm = gid * WGM, gsz = (nM - fm) < WGM ? (nM - fm) : WGM;
        u.pm = fm + ((wgid % nig) % gsz); const int pn2 = (wgid % nig) / gsz; u.pn = pn2 / KS; u.ks = pn2 % KS; return true;
    }
    __device__ __forceinline__ void a_ready(const Unit&) const {}
    __device__ __forceinline__ void done(const Unit&) const {}
};
__device__ __forceinline__ unsigned cvt_pk_bf16(float lo, float hi) { unsigned r; asm volatile("v_cvt_pk_bf16_f32 %0, %1, %2" : "=v"(r) : "v"(lo), "v"(hi)); return r; }
struct EpiBf16 {
    static constexpr bool PERM = true, AFTER_DRAIN = false;
    bf16_t* O; int ldc;
    __device__ __forceinline__ void operator()(const f32x4 (&acc)[2][2][4][2], const Unit& u, int wr, int wc, int fr, int fq) const {
        const int row0 = u.pm * BM + wr * 64 + fr, col0 = u.pn * BM + wc * 32 + 8 * fq;
#pragma unroll
        for (int ai = 0; ai < 2; ++ai)
#pragma unroll
            for (int m = 0; m < 4; ++m) { bf16_t* rowp = O + (size_t)(row0 + ai * HALF + m * 16) * ldc + col0;
#pragma unroll
                for (int bj = 0; bj < 2; ++bj) { const f32x4 v0 = acc[ai][bj][m][0], v1 = acc[ai][bj][m][1];
                    u32x4 w; w.x = cvt_pk_bf16(v0[0], v0[1]); w.y = cvt_pk_bf16(v0[2], v0[3]); w.z = cvt_pk_bf16(v1[0], v1[1]); w.w = cvt_pk_bf16(v1[2], v1[3]);
                    *(u32x4*)(rowp + bj * HALF) = w; } }
    }
};
struct EpiSwiglu {
    static constexpr bool PERM = true, AFTER_DRAIN = false;
    bf16_t* H;
    __device__ __forceinline__ void operator()(const f32x4 (&acc)[2][2][4][2], const Unit& u, int wr, int wc, int fr, int fq) const {
        const int row0 = u.pm * BM + wr * 64 + fr, col0 = u.pn * HALF + wc * 32 + 8 * fq;
#pragma unroll
        for (int ai = 0; ai < 2; ++ai)
#pragma unroll
            for (int m = 0; m < 4; ++m) {
                float h[8];
#pragma unroll
                for (int n = 0; n < 2; ++n)
#pragma unroll
                    for (int e = 0; e < 4; ++e) { const float gv = acc[ai][0][m][n][e], uv = acc[ai][1][m][n][e]; h[4 * n + e] = gv * __builtin_amdgcn_rcpf(1.f + __expf(-gv)) * uv; }
                u32x4 w; w.x = cvt_pk_bf16(h[0], h[1]); w.y = cvt_pk_bf16(h[2], h[3]); w.z = cvt_pk_bf16(h[4], h[5]); w.w = cvt_pk_bf16(h[6], h[7]);
                *(u32x4*)(H + (size_t)(row0 + ai * HALF + m * 16) * DFF + col0) = w; }
    }
};
struct EpiQkv {
    static constexpr bool PERM = true, AFTER_DRAIN = false;
    KP p; PG8_LAS float* xl; int j;
    __device__ __forceinline__ void operator()(const f32x4 (&acc)[2][2][4][2], const Unit& u, int wr, int wc, int fr, int fq) const {
        bf16_t* const Q = (bf16_t*)(p->ws + WS_Q); bf16_t* const KPr = (bf16_t*)(p->ws + WS_KP); bf16_t* const VP = (bf16_t*)(p->ws + WS_VP);
        bf16_t* const KS = (bf16_t*)(p->ws + WS_KS) + (size_t)j * 4 * 1536 * 256; bf16_t* const VS = (bf16_t*)(p->ws + WS_VS) + (size_t)j * 4 * 1536 * 256;
        float* const newk = p->out + (size_t)2 * NPR * D; float* const newv = newk + (size_t)16 * 2 * 256 * 256;
        const float* const qn = p->in[I_QN] + j * 128; const float* const kn = p->in[I_KN] + j * 128;
        const int pn = u.pn, pm = u.pm, dbase = wc * 32 + 8 * fq;
        const bool isq = pn < 4, isv = pn == 5, smp = pm >= 16;
        if (!isv) {
#pragma unroll
            for (int ai = 0; ai < 2; ++ai)
#pragma unroll
                for (int m = 0; m < 4; ++m)
#pragma unroll
                    for (int bj = 0; bj < 2; ++bj) {
                        const f32x4 a = acc[ai][bj][m][0], b = acc[ai][bj][m][1];
                        float sq = (a[0] * a[0] + a[1] * a[1]) + (a[2] * a[2] + a[3] * a[3]) + (b[0] * b[0] + b[1] * b[1]) + (b[2] * b[2] + b[3] * b[3]);
                        sq += __shfl_xor(sq, 16); sq += __shfl_xor(sq, 32);
                        if (fq == 0) xl[(((((wr * 2 + ai) * 4 + m) * 16 + fr) * 2 + bj) << 2) + wc] = sq;
                    }
            asm volatile("s_waitcnt lgkmcnt(0)" ::: "memory"); __builtin_amdgcn_s_barrier(); asm volatile("" ::: "memory");
        }
        const float* gn = isq ? qn : kn;
        f32x4 g0 = {1.f, 1.f, 1.f, 1.f}, g1 = g0;
        if (!isv) { g0 = *(const f32x4*)(gn + dbase); g1 = *(const f32x4*)(gn + dbase + 4); }
#pragma unroll
        for (int ai = 0; ai < 2; ++ai)
#pragma unroll
            for (int m = 0; m < 4; ++m) {
                const int row = pm * BM + ai * HALF + wr * 64 + m * 16 + fr;
                float cs[4], sn[4];
                if (smp && !isv) {
                    const int t = (row - NPR) & 1023; const float pos = (float)(wc < 2 ? (t >> 6) : (t & 63));
#pragma unroll
                    for (int k = 0; k < 4; ++k) { const float rev = pos * (__builtin_amdgcn_exp2f(-(float)(((dbase >> 1) + k) & 31) * 0.41524101186092029f) * INV_2PI); cs[k] = cos_rev(rev); sn[k] = sin_rev(rev); }
                }
#pragma unroll
                for (int bj = 0; bj < 2; ++bj) {
                    f32x4 v0 = acc[ai][bj][m][0], v1 = acc[ai][bj][m][1];
                    if (!isv) {
                        const f32x4 q4 = *(const PG8_LAS f32x4*)(xl + (((((wr * 2 + ai) * 4 + m) * 16 + fr) * 2 + bj) << 2));
                        const float r = rsqrtf(((q4[0] + q4[1]) + (q4[2] + q4[3])) * (1.f / 128.f) + EPS);
                        v0 = v0 * r * g0; v1 = v1 * r * g1;
                        if (smp) {
                            f32x4 w0, w1;
                            w0[0] = v0[0] * cs[0] - v0[1] * sn[0]; w0[1] = v0[0] * sn[0] + v0[1] * cs[0]; w0[2] = v0[2] * cs[1] - v0[3] * sn[1]; w0[3] = v0[2] * sn[1] + v0[3] * cs[1];
                            w1[0] = v1[0] * cs[2] - v1[1] * sn[2]; w1[1] = v1[0] * sn[2] + v1[1] * cs[2]; w1[2] = v1[2] * cs[3] - v1[3] * sn[3]; w1[3] = v1[2] * sn[3] + v1[3] * cs[3];
                            v0 = w0; v1 = w1;
                        }
                    }
                    u32x4 w; w.x = cvt_pk_bf16(v0[0], v0[1]); w.y = cvt_pk_bf16(v0[2], v0[3]); w.z = cvt_pk_bf16(v1[0], v1[1]); w.w = cvt_pk_bf16(v1[2], v1[3]);
                    if (isq) *(u32x4*)(Q + (size_t)row * D + pn * BM + bj * HALF + dbase) = w;
                    else if (!smp) {
                        *(u32x4*)((isv ? VP : KPr) + (size_t)row * 256 + bj * HALF + dbase) = w;
                        float* o = (isv ? newv : newk) + ((((size_t)(row >> 8) * 2 + j) * 256 + (row & 255)) * 2 + bj) * 128 + dbase;
                        *(f32x4*)o = v0; *(f32x4*)(o + 4) = v1;
                    } else {
                        const int b = (row - NPR) >> 10, t = (row - NPR) & 1023;
                        *(u32x4*)((isv ? VS : KS) + ((size_t)b * 1536 + t) * 256 + bj * HALF + dbase) = w;
                    }
                }
            }
        if (!isv) { asm volatile("s_waitcnt lgkmcnt(0)" ::: "memory"); __builtin_amdgcn_s_barrier(); asm volatile("" ::: "memory"); }
    }
};
struct EpiGate {
    static constexpr bool PERM = true, AFTER_DRAIN = false;
    bf16_t* P; const float* gate; const PG8_LAS float* lg;
    __device__ __forceinline__ void operator()(const f32x4 (&acc)[2][2][4][2], const Unit& u, int wr, int wc, int fr, int fq) const {
        const int row0 = u.pm * BM + wr * 64 + fr, col0 = u.pn * BM + wc * 32 + 8 * fq;
        bf16_t* const dstb = P + (size_t)u.ks * P1_HALF;
        f32x4 gv[2][2];
        if (lg) {
#pragma unroll
            for (int bj = 0; bj < 2; ++bj) { gv[bj][0] = *(const PG8_LAS f32x4*)(lg + wc * 32 + 8 * fq + bj * HALF); gv[bj][1] = *(const PG8_LAS f32x4*)(lg + wc * 32 + 8 * fq + bj * HALF + 4); }
        } else {
            const float* gp = gate + cond_of(u.pm * BM) * 6144 + col0;
#pragma unroll
            for (int bj = 0; bj < 2; ++bj) { gv[bj][0] = *(const f32x4*)(gp + bj * HALF); gv[bj][1] = *(const f32x4*)(gp + bj * HALF + 4); }
        }
#pragma unroll
        for (int ai = 0; ai < 2; ++ai)
#pragma unroll
            for (int m = 0; m < 4; ++m) { const int row = row0 + ai * HALF + m * 16; bf16_t* rowp = dstb + (size_t)row * D + col0;
#pragma unroll
                for (int bj = 0; bj < 2; ++bj) { const f32x4 v0 = acc[ai][bj][m][0] * gv[bj][0], v1 = acc[ai][bj][m][1] * gv[bj][1];
                    u32x4 w; w.x = cvt_pk_bf16(v0[0], v0[1]); w.y = cvt_pk_bf16(v0[2], v0[3]); w.z = cvt_pk_bf16(v1[0], v1[1]); w.w = cvt_pk_bf16(v1[2], v1[3]);
                    *(u32x4*)(rowp + bj * HALF) = w; } }
    }
};
template <class Epi, class Sched, bool ALIGN_EPI = false, bool SP2 = false>
__device__ __forceinline__ void gemm_phase(PG8_LAS unsigned char* lds, const Gemm g, const Sched& S, const Epi& E) {
    int tid_ = tidx();
    const int tid = tid_, wid = __builtin_amdgcn_readfirstlane(tid >> 6), lane = tid & 63, wr = wid >> 2, wc = wid & 3, fr = lane & 15, fq = lane >> 4;
    const int K = g.ld, nt = g.K / BK;
    unsigned voffA[2], voffB[2];
#pragma unroll
    for (int i = 0; i < 2; ++i) { int R, C; stage_rc(tid * 16 + i * 8192, R, C); const int Rb = Epi::PERM ? ((R & ~31) + perm32(R & 31)) : R;
        voffA[i] = (unsigned)(R * K + C) * 2u; voffB[i] = (unsigned)(Rb * K + C) * 2u; }
    const size_t kstep = (size_t)(BK * 2);
    const size_t hstep = (size_t)HALF * K * 2;
    const size_t tstep = 2 * hstep;
    const unsigned ldsw = (unsigned)wid * 1024u;
    const int aoff = lds_byte(wr * 64 + fr, fq * 8), boff = lds_byte(wc * 32 + fr, fq * 8);
#define PG8_SA(b, h) (((b) * 2 + (h)) * HTB)
#define PG8_SB(b, h) ((4 + (b) * 2 + (h)) * HTB)
#define PG8_STAGE(bufoff, gbase, voff) do { _Pragma("unroll") for (int _i = 0; _i < 2; ++_i) \
        __builtin_amdgcn_global_load_lds((const unsigned*)((const char*)(gbase) + (voff)[_i]), (PG8_LAS unsigned*)(lds + (bufoff) + ldsw + _i * 8192), 16, 0, 0); } while (0)
#define PG8_LDA(dst, b, h) do { _Pragma("unroll") for (int m = 0; m < 4; ++m) _Pragma("unroll") for (int k = 0; k < 2; ++k) dst[m][k] = *(const PG8_LAS bf16x8*)(lds + PG8_SA(b, h) + aoff + m * 2048 + k * 1024); } while (0)
#define PG8_LDB(dst, b, h) do { _Pragma("unroll") for (int n = 0; n < 2; ++n) _Pragma("unroll") for (int k = 0; k < 2; ++k) dst[n][k] = *(const PG8_LAS bf16x8*)(lds + PG8_SB(b, h) + boff + n * 2048 + k * 1024); } while (0)
#define PG8_MMA(ai, bj, At, Bt) do { __builtin_amdgcn_s_setprio(1); _Pragma("unroll") for (int m = 0; m < 4; ++m) _Pragma("unroll") for (int n = 0; n < 2; ++n) _Pragma("unroll") for (int k = 0; k < 2; ++k) \
        acc[ai][bj][m][n] = __builtin_amdgcn_mfma_f32_16x16x32_bf16(Bt[n][k], At[m][k], acc[ai][bj][m][n], 0, 0, 0); __builtin_amdgcn_s_setprio(0); } while (0)
#define PG8_WAIT_V(n) asm volatile("s_waitcnt vmcnt(" #n ")" ::: "memory")
#define PG8_WAIT_L(n) asm volatile("s_waitcnt lgkmcnt(" #n ")" ::: "memory")
#define PG8_BAR __builtin_amdgcn_s_barrier()
#define PG8_SCHED __builtin_amdgcn_sched_barrier(0)
    Unit cur, nxt; int ui = 0;
    if (!S.next(0, cur)) return;
    f32x4 acc[2][2][4][2];
#pragma unroll
    for (int a = 0; a < 2; ++a)
#pragma unroll
        for (int b = 0; b < 2; ++b)
#pragma unroll
            for (int m = 0; m < 4; ++m)
#pragma unroll
                for (int n = 0; n < 2; ++n) acc[a][b][m][n] = (f32x4){0.f, 0.f, 0.f, 0.f};
    bf16x8 At[4][2], B0[2][2], B1[2][2];
    const size_t ksb = (size_t)g.K * 2; const char* cA = (const char*)g.A + (size_t)cur.pm * tstep + cur.ks * ksb; const char* cB = (const char*)g.Bt + (size_t)cur.pn * tstep + cur.ks * ksb;
    S.a_ready(cur);
    if constexpr (SP2) {
        PG8_STAGE(PG8_SB(0, 0), cB, voffB); PG8_STAGE(PG8_SB(0, 1), cB + hstep, voffB); PG8_STAGE(PG8_SA(0, 0), cA, voffA); PG8_STAGE(PG8_SA(0, 1), cA + hstep, voffA);
        if (wr == 1) PG8_BAR;
        PG8_WAIT_V(2); PG8_BAR;
        PG8_STAGE(PG8_SB(1, 0), cB + kstep, voffB); PG8_STAGE(PG8_SA(1, 0), cA + kstep, voffA); PG8_STAGE(PG8_SB(1, 1), cB + hstep + kstep, voffB);
        PG8_WAIT_V(6); PG8_BAR;
    } else {
        PG8_STAGE(PG8_SB(0, 0), cB, voffB); PG8_STAGE(PG8_SA(0, 0), cA, voffA); PG8_STAGE(PG8_SB(0, 1), cB + hstep, voffB); PG8_STAGE(PG8_SA(0, 1), cA + hstep, voffA);
        if (wr == 1) PG8_BAR;
        PG8_WAIT_V(4); PG8_BAR;
        PG8_STAGE(PG8_SB(1, 0), cB + kstep, voffB); PG8_STAGE(PG8_SA(1, 0), cA + kstep, voffA); PG8_STAGE(PG8_SB(1, 1), cB + hstep + kstep, voffB);
        PG8_WAIT_V(6); PG8_BAR;
    }
    for (;;) {
        const bool has_next = S.next(ui + 1, nxt);
        const char* nA = has_next ? (const char*)g.A + (size_t)nxt.pm * tstep + nxt.ks * ksb : cA; const char* nB = has_next ? (const char*)g.Bt + (size_t)nxt.pn * tstep + nxt.ks * ksb : cB;
        for (int t = 0; t < nt; t += 2) {
            const bool last = (t == nt - 2);
            const char* a1 = cA + (size_t)(t + 1) * kstep;
            const char* a2 = last ? nA : cA + (size_t)(t + 2) * kstep; const char* b2 = last ? nB : cB + (size_t)(t + 2) * kstep;
            const char* a3 = a2 + kstep; const char* b3 = b2 + kstep;
            if (last && has_next) S.a_ready(nxt);
            if constexpr (SP2) {
            PG8_LDB(B0, 0, 0); PG8_LDB(B1, 0, 1); PG8_SCHED; PG8_LDA(At, 0, 0); PG8_STAGE(PG8_SA(1, 1), a1 + hstep, voffA);
            PG8_WAIT_V(8); PG8_WAIT_L(0); PG8_BAR; PG8_MMA(0, 0, At, B0); PG8_MMA(0, 1, At, B1); PG8_BAR; PG8_SCHED;
            PG8_LDA(At, 0, 1); PG8_STAGE(PG8_SB(0, 0), b2, voffB); PG8_STAGE(PG8_SB(0, 1), b2 + hstep, voffB); PG8_STAGE(PG8_SA(0, 0), a2, voffA);
            PG8_WAIT_V(8); PG8_WAIT_L(0); PG8_BAR; PG8_MMA(1, 0, At, B0); PG8_MMA(1, 1, At, B1); PG8_BAR; PG8_SCHED;
            PG8_LDB(B0, 1, 0); PG8_LDB(B1, 1, 1); PG8_SCHED; PG8_LDA(At, 1, 0); PG8_STAGE(PG8_SA(0, 1), a2 + hstep, voffA);
            PG8_WAIT_V(8); PG8_WAIT_L(0); PG8_BAR; PG8_MMA(0, 0, At, B0); PG8_MMA(0, 1, At, B1); PG8_BAR; PG8_SCHED;
            PG8_LDA(At, 1, 1); PG8_STAGE(PG8_SB(1, 0), b3, voffB); PG8_STAGE(PG8_SB(1, 1), b3 + hstep, voffB); PG8_STAGE(PG8_SA(1, 0), a3, voffA);
            PG8_WAIT_V(8); PG8_WAIT_L(0); PG8_BAR; PG8_MMA(1, 0, At, B0); PG8_MMA(1, 1, At, B1); PG8_BAR; PG8_SCHED;
            } else {
            PG8_LDB(B0, 0, 0); PG8_SCHED; PG8_LDA(At, 0, 0); PG8_STAGE(PG8_SA(1, 1), a1 + hstep, voffA);
            PG8_WAIT_L(8); PG8_BAR; PG8_WAIT_L(0); PG8_MMA(0, 0, At, B0); PG8_BAR; PG8_SCHED;
            PG8_LDB(B1, 0, 1); PG8_STAGE(PG8_SB(0, 0), b2, voffB);
            PG8_BAR; PG8_WAIT_L(0); PG8_MMA(0, 1, At, B1); PG8_BAR;
            PG8_LDA(At, 0, 1); PG8_STAGE(PG8_SA(0, 0), a2, voffA);
            PG8_BAR; PG8_WAIT_L(0); PG8_MMA(1, 0, At, B0); PG8_BAR; PG8_SCHED;
            PG8_STAGE(PG8_SB(0, 1), b2 + hstep, voffB);
            PG8_WAIT_V(6); PG8_BAR; PG8_MMA(1, 1, At, B1); PG8_BAR;
            PG8_LDB(B0, 1, 0); PG8_SCHED; PG8_LDA(At, 1, 0); PG8_STAGE(PG8_SA(0, 1), a2 + hstep, voffA);
            PG8_WAIT_L(8); PG8_BAR; PG8_WAIT_L(0); PG8_MMA(0, 0, At, B0); PG8_BAR; PG8_SCHED;
            PG8_LDB(B1, 1, 1); PG8_STAGE(PG8_SB(1, 0), b3, voffB);
            PG8_BAR; PG8_WAIT_L(0); PG8_MMA(0, 1, At, B1); PG8_BAR;
            PG8_LDA(At, 1, 1); PG8_STAGE(PG8_SA(1, 0), a3, voffA);
            PG8_BAR; PG8_WAIT_L(0); PG8_MMA(1, 0, At, B0); PG8_BAR; PG8_SCHED;
            PG8_STAGE(PG8_SB(1, 1), b3 + hstep, voffB);
            PG8_WAIT_V(6); PG8_BAR; PG8_MMA(1, 1, At, B1); PG8_BAR;
            }
        }
        if constexpr (ALIGN_EPI) { if (wr == 0) PG8_BAR; }
        if constexpr (!Epi::AFTER_DRAIN) { E(acc, cur, wr, wc, fr, fq); S.done(cur); }
        if (!has_next) break;
#pragma unroll
        for (int a = 0; a < 2; ++a)
#pragma unroll
            for (int b = 0; b < 2; ++b)
#pragma unroll
                for (int m = 0; m < 4; ++m)
#pragma unroll
                    for (int n = 0; n < 2; ++n) acc[a][b][m][n] = (f32x4){0.f, 0.f, 0.f, 0.f};
        cur = nxt; cA = nA; cB = nB; ++ui;
        if constexpr (ALIGN_EPI) { if (wr == 1) PG8_BAR; }
    }
    PG8_WAIT_V(0);
    if constexpr (!ALIGN_EPI) { if (wr == 0) PG8_BAR; }
    PG8_BAR;
    if constexpr (Epi::AFTER_DRAIN) { E.fused(acc, cur, wr, wc, fr, fq, lds, wid, lane); S.done(cur); }
#undef PG8_SA
#undef PG8_SB
#undef PG8_STAGE
#undef PG8_LDA
#undef PG8_LDB
#undef PG8_MMA
#undef PG8_WAIT_V
#undef PG8_WAIT_L
#undef PG8_BAR
#undef PG8_SCHED
}
}

__device__ __forceinline__ void gemm_run(unsigned char* lds, const bf16_t* A, const bf16_t* Bt, int M, int N, int Ktot, int KS, const pg8::EpiGate& E0) {
    pg8::StaticOrder S; S.init(M, N, KS, (int)gdim(), (int)bidx());
    pg8::Gemm g; g.A = A; g.Bt = Bt; g.M = M; g.N = N; g.K = Ktot / KS; g.ld = Ktot;
    pg8::EpiGate E = E0;
    pg8::Unit u0;
    if (S.nwg <= (int)gdim() && S.next(0, u0)) {
        PG8_LAS float* lg = (PG8_LAS float*)((PG8_LAS unsigned char*)lds + pg8::STAGE_BYTES);
        const int tid = tidx();
        if (tid < 64) *(PG8_LAS f32x4*)(lg + tid * 4) = *(const f32x4*)(E0.gate + cond_of(u0.pm * pg8::BM) * 6144 + u0.pn * pg8::BM + tid * 4);
        E.lg = lg;
    }
    __syncthreads();
    pg8::gemm_phase<pg8::EpiGate, pg8::StaticOrder, true, true>((PG8_LAS unsigned char*)lds, g, S, E);
    __syncthreads();
}
template <class Epi>
__device__ __forceinline__ void gemm_run(unsigned char* lds, const bf16_t* A, const bf16_t* Bt, int M, int N, int Ktot, int KS, const Epi& E) {
    pg8::StaticOrder S; S.init(M, N, KS, (int)gdim(), (int)bidx());
    pg8::Gemm g; g.A = A; g.Bt = Bt; g.M = M; g.N = N; g.K = Ktot / KS; g.ld = Ktot;
    __syncthreads();
    pg8::gemm_phase<Epi, pg8::StaticOrder, true, true>((PG8_LAS unsigned char*)lds, g, S, E);
    __syncthreads();
}


#define LDSP __attribute__((address_space(3)))
constexpr int LC_FR = 0, LC_U = 66176, LC_X0 = LC_U + 20480, LC_S = LC_X0 + 20480, LC_Z = LC_S + 17408;
struct LcUnit { int lsel, L, P, REC, c0, m0; };
__device__ __forceinline__ LcUnit lc_unit(int q) {
  LcUnit u; u.lsel = q < 512 ? 1 : 0; const int qq = q & 511; u.c0 = (qq >> 2) * 8; u.m0 = ((u.lsel ? 4 : 0) + (qq & 3)) * 1024;
  u.L = u.lsel ? 1024 : 256; u.P = u.L >> 5; u.REC = 4 * u.L + 34; return u;
}
__device__ __forceinline__ void phase_lc(KP p, int j, unsigned char* lds_) {
  LDSP unsigned char* lds = (LDSP unsigned char*)lds_;
  const int tid = tidx(), lane = tid & 63, wid = tid >> 6, n = lane & 31, hi = lane >> 5;
  const bf16_t* ZT = (const bf16_t*)(p->ws + WS_ZT); bf16_t* YG = (bf16_t*)(p->ws + WS_YG);
  const float* cw = p->in[I_HCW] + (size_t)j * 3 * 3072; const float* cb = p->in[I_HCB] + (size_t)j * 3072;
  u32x4 fr[9], zr[2][3]; float zh[2][3][2];
#define LC_PREFETCH(U) do { \
    const u32x4* src_ = (const u32x4*)((const bf16_t*)(p->ws + WS_FRG) + (size_t)j * FRG_J + ((U).lsel ? FRG_L1 : 0) + (size_t)(U).c0 * (U).REC); \
    _Pragma("unroll") for (int i_ = 0; i_ < 9; ++i_) if (i_ * 512 + tid < (U).REC) fr[i_] = src_[i_ * 512 + tid]; \
    _Pragma("unroll") for (int tk_ = 0; tk_ < 2; ++tk_) { const int task_ = tid + 512 * tk_, ch_ = task_ >> 7, tok0_ = (task_ & 127) * 8; \
      const bool first_ = (tok0_ & ((U).L - 1)) == 0, last_ = ((tok0_ + 8) & ((U).L - 1)) == 0; \
      _Pragma("unroll") for (int part_ = 0; part_ < 3; ++part_) { const bf16_t* z_ = ZT + (size_t)(part_ * 1024 + (U).c0 + ch_) * MTOK + (U).m0 + tok0_; \
        zr[tk_][part_] = *(const u32x4*)z_; zh[tk_][part_][0] = first_ ? 0.f : bf2f(z_[-1]); zh[tk_][part_][1] = last_ ? 0.f : bf2f(z_[8]); } } } while (0)
  int q = bidx();
  if (q >= 1024) return;
  LcUnit cur = lc_unit(q);
  LC_PREFETCH(cur);
  for (;;) {
    const int L = cur.L, P = cur.P, REC = cur.REC, c0 = cur.c0, lsel = cur.lsel; const size_t m0 = (size_t)cur.m0;
    {
      LDSP u32x4* dst = (LDSP u32x4*)(lds + LC_FR);
#pragma unroll
      for (int i = 0; i < 9; ++i) if (i * 512 + tid < REC) dst[i * 512 + tid] = fr[i];
#pragma unroll
      for (int tk = 0; tk < 2; ++tk) {
        const int task = tid + 512 * tk, ch = task >> 7, tok0 = (task & 127) * 8;
        float sc[3][8];
#pragma unroll
        for (int part = 0; part < 3; ++part) {
          const int chn = part * 1024 + c0 + ch;
          const u32x4 w = zr[tk][part];
          float zv[10];
          zv[0] = zh[tk][part][0]; zv[9] = zh[tk][part][1];
          zv[1] = __uint_as_float(w.x << 16); zv[2] = __uint_as_float(w.x & 0xFFFF0000u); zv[3] = __uint_as_float(w.y << 16); zv[4] = __uint_as_float(w.y & 0xFFFF0000u);
          zv[5] = __uint_as_float(w.z << 16); zv[6] = __uint_as_float(w.z & 0xFFFF0000u); zv[7] = __uint_as_float(w.w << 16); zv[8] = __uint_as_float(w.w & 0xFFFF0000u);
          const float w0 = cw[chn], w1 = cw[3072 + chn], w2 = cw[2 * 3072 + chn], bb = cb[chn];
#pragma unroll
          for (int i = 0; i < 8; ++i) sc[part][i] = zv[i] * w0 + zv[i + 1] * w1 + zv[i + 2] * w2 + bb;
        }
        u32x4 xo, uo;
        xo.x = pack2(sc[0][0], sc[0][1]); xo.y = pack2(sc[0][2], sc[0][3]); xo.z = pack2(sc[0][4], sc[0][5]); xo.w = pack2(sc[0][6], sc[0][7]);
        uo.x = pack2(sc[1][0] * sc[2][0], sc[1][1] * sc[2][1]); uo.y = pack2(sc[1][2] * sc[2][2], sc[1][3] * sc[2][3]);
        uo.z = pack2(sc[1][4] * sc[2][4], sc[1][5] * sc[2][5]); uo.w = pack2(sc[1][6] * sc[2][6], sc[1][7] * sc[2][7]);
        const int po = (ch * 1280 + tok0 + 8 * (tok0 >> 5)) * 2;
        *(LDSP u32x4*)(lds + LC_U + po) = uo; *(LDSP u32x4*)(lds + LC_X0 + po) = xo;
      }
    }
    if (tid < 4) ((LDSP unsigned*)(lds + LC_Z))[tid] = 0u;
    __syncthreads();
    const int qn = q + gdim(); const bool has = qn < 1024;
    LcUnit nxt = cur;
    if (has) { nxt = lc_unit(qn); LC_PREFETCH(nxt); }
    const float rn = ((const float*)(p->ws + WS_RNORM))[(j * 2 + lsel) * 1024 + c0 + wid], bs = p->in[I_HBIAS][j * D + c0 + wid];
    f32x16 acc;
#pragma unroll
    for (int r = 0; r < 16; ++r) acc[r] = 0.f;
    {
      const int par = n & 1;
      LDSP const unsigned char* fa = lds + LC_FR + wid * (REC * 2) + (par ? (2 * L + 34) * 2 : 0) + 2 * (L - n - par + 8 * hi);
      LDSP const unsigned char* ub = lds + LC_U + wid * 2560 + (40 * n + 8 * hi) * 2;
      const int ti = n & (P - 1);
#define LC_LOAD(s_, AW, BF) do { const int dl_ = ((s_) >> 1) - (P - 1), ks_ = (s_) & 1; \
        LDSP const volatile unsigned* ap_ = (LDSP const volatile unsigned*)(fa + 2 * (-32 * dl_ + 16 * ks_)); \
        AW.x = ap_[0]; AW.y = ap_[1]; AW.z = ap_[2]; AW.w = ap_[3]; \
        LDSP const unsigned char* bp_ = ((unsigned)(ti - dl_) < (unsigned)P) ? (ub + (-40 * dl_ + 16 * ks_) * 2) : (lds + LC_Z); \
        BF = *(LDSP const volatile bf16x8*)bp_; } while (0)
      const int nsteps = 2 * (2 * P - 1);
      u32x4 a0, a1, a2, a3, a4, a5; bf16x8 b0, b1, b2, b3, b4, b5;
      LC_LOAD(0, a0, b0); LC_LOAD(1, a1, b1); LC_LOAD(2, a2, b2); LC_LOAD(3, a3, b3); LC_LOAD(4, a4, b4);
#define LC_STEP(k_, AC, BC, AN, BN) do { if (s6 + (k_) + 5 < nsteps) LC_LOAD(s6 + (k_) + 5, AN, BN); \
        acc = __builtin_amdgcn_mfma_f32_32x32x16_bf16(__builtin_bit_cast(bf16x8, AC), BC, acc, 0, 0, 0); } while (0)
      for (int s6 = 0; s6 < nsteps; s6 += 6) {
        LC_STEP(0, a0, b0, a5, b5); LC_STEP(1, a1, b1, a0, b0); LC_STEP(2, a2, b2, a1, b1);
        LC_STEP(3, a3, b3, a2, b2); LC_STEP(4, a4, b4, a3, b3); LC_STEP(5, a5, b5, a4, b4);
      }
#undef LC_STEP
#undef LC_LOAD
    }
    {
      LDSP const bf16_t* uu = (LDSP const bf16_t*)(lds + LC_U) + wid * 1280 + 40 * n;
      LDSP const bf16_t* xx = (LDSP const bf16_t*)(lds + LC_X0) + wid * 1280 + 40 * n;
      LDSP bf16_t* so = (LDSP bf16_t*)(lds + LC_S) + wid * 1088 + 34 * n;
#pragma unroll
      for (int r = 0; r < 16; ++r) {
        const int row = (r & 3) + 8 * (r >> 2) + 4 * hi;
        const float y = acc[r] * rn + bf2f(uu[row]) * bs;
        so[row] = f2bf(bf2f(xx[row]) * y);
      }
    }
    __syncthreads();
    for (int tok = tid; tok < 1024; tok += 512) {
      LDSP const bf16_t* so = (LDSP const bf16_t*)(lds + LC_S) + tok + 2 * (tok >> 5);
      u32x4 w;
      w.x = (unsigned)so[0] | ((unsigned)so[1088] << 16); w.y = (unsigned)so[2 * 1088] | ((unsigned)so[3 * 1088] << 16);
      w.z = (unsigned)so[4 * 1088] | ((unsigned)so[5 * 1088] << 16); w.w = (unsigned)so[6 * 1088] | ((unsigned)so[7 * 1088] << 16);
      *(u32x4*)(YG + (m0 + tok) * D + c0) = w;
    }
    if (!has) break;
    cur = nxt; q = qn;
  }
#undef LC_PREFETCH
  __syncthreads();
}

namespace att {
typedef unsigned short bf16;
constexpr int   D = 128, NW = 8, QBLK = 32, KVBLK = 64;
constexpr float SCALE = 0.088388347648318440f;
constexpr float THR = 8.f;
constexpr int SDEPTH = 2;
constexpr int LDQ = 1024, LDK = 256, LDO = 1024;
constexpr size_t SHM_V = KVBLK * D * 2, SHM_K = KVBLK * D * 2, SHM_ATTN = 2 * SHM_V + 2 * SHM_K + NW * 64 * 4;

using s16x4  = __attribute__((ext_vector_type(4))) short;
using f32x16 = __attribute__((ext_vector_type(16))) float;
using f32x8  = __attribute__((ext_vector_type(8))) float;

#define KSWZ(row, colB) ((row) * 256 + ((colB) ^ (((row) & 7) << 4)))
#define SBAR() __builtin_amdgcn_sched_barrier(0)
__device__ __forceinline__ int crow(int r, int hi) { return (r & 3) + 8 * (r >> 2) + 4 * hi; }
__device__ __forceinline__ unsigned cvtpk(float lo, float hi) {
  unsigned r; asm volatile("v_cvt_pk_bf16_f32 %0, %1, %2" : "=v"(r) : "v"(lo), "v"(hi)); return r;
}
template <typename TIn> struct Stage;
template <> struct Stage<bf16>  { using T = bf16x8;
  __device__ static __forceinline__ T ld8(const bf16* p) { return *reinterpret_cast<const bf16x8*>(p); }
  __device__ static __forceinline__ bf16x8 tobf(T x) { return x; } };
template <> struct Stage<float> { using T = f32x8;
  __device__ static __forceinline__ T ld8(const float* p) { return *reinterpret_cast<const f32x8*>(p); }
  __device__ static __forceinline__ bf16x8 tobf(T x) {
    u32x4 w = {cvtpk(x[0], x[1]), cvtpk(x[2], x[3]), cvtpk(x[4], x[5]), cvtpk(x[6], x[7])}; return *reinterpret_cast<bf16x8*>(&w); } };

__device__ __forceinline__ void partialSM(f32x16& p0, f32x16& p1, float& m_reg, float& mn, float& alpha) {
  constexpr float C = SCALE * 1.4426950408889634f;
  float pmax = p0[0]; for (int r = 1; r < 16; ++r) pmax = fmaxf(pmax, p0[r]); for (int r = 0; r < 16; ++r) pmax = fmaxf(pmax, p1[r]);
  { auto rr = __builtin_amdgcn_permlane32_swap(__float_as_uint(pmax), __float_as_uint(pmax), false, false);
    pmax = fmaxf(__uint_as_float(rr[0]), __uint_as_float(rr[1])); }
  if (__builtin_expect(__all(pmax - m_reg <= THR / SCALE), 1)) { mn = m_reg; alpha = 1.f; }
  else { mn = fmaxf(m_reg, pmax); alpha = __builtin_amdgcn_exp2f((m_reg - mn) * C); m_reg = mn; }
  float mnC = -mn * C;
  for (int r = 0; r < 16; ++r) p0[r] = fmaf(p0[r], C, mnC); for (int r = 0; r < 16; ++r) p1[r] = fmaf(p1[r], C, mnC);
  for (int r = 0; r < 16; ++r) p0[r] = __builtin_amdgcn_exp2f(p0[r]);
}
__device__ __forceinline__ void finishSM(f32x16& p0, f32x16& p1, float alpha, float& l_reg, bf16x8& pa0, bf16x8& pa1, bf16x8& pa2, bf16x8& pa3) {
  for (int r = 0; r < 16; ++r) p1[r] = __builtin_amdgcn_exp2f(p1[r]);
  float ps = 0; for (int r = 0; r < 16; ++r) ps += p0[r]; for (int r = 0; r < 16; ++r) ps += p1[r];
  { auto rr = __builtin_amdgcn_permlane32_swap(__float_as_uint(ps), __float_as_uint(ps), false, false);
    ps = __uint_as_float(rr[0]) + __uint_as_float(rr[1]); }
  l_reg = l_reg * alpha + ps;
#define PK4(P, BASE, OUT) do { unsigned a0 = cvtpk(P[BASE + 0], P[BASE + 1]), a1 = cvtpk(P[BASE + 2], P[BASE + 3]);   \
    unsigned b0 = cvtpk(P[BASE + 4], P[BASE + 5]), b1 = cvtpk(P[BASE + 6], P[BASE + 7]);                              \
    auto r0 = __builtin_amdgcn_permlane32_swap(a0, b0, false, false); auto r1 = __builtin_amdgcn_permlane32_swap(a1, b1, false, false); \
    u32x4 w = {r0[0], r1[0], r0[1], r1[1]}; OUT = *reinterpret_cast<bf16x8*>(&w); } while (0)
  PK4(p0, 0, pa0); PK4(p0, 8, pa1); PK4(p1, 0, pa2); PK4(p1, 8, pa3);
#undef PK4
}
__device__ __forceinline__ void qkt(f32x16& p0, f32x16& p1, const bf16* Ks, const bf16x8* qr, int r32, int hi) {
  p0 = f32x16{}; p1 = f32x16{};
  for (int d0 = 0; d0 < 8; ++d0) { int cb = (d0 * 16 + hi * 8) * 2;
    bf16x8 b0 = *reinterpret_cast<const bf16x8*>((const char*)Ks + KSWZ(r32, cb));
    bf16x8 b1 = *reinterpret_cast<const bf16x8*>((const char*)Ks + KSWZ(32 + r32, cb));
    p0 = __builtin_amdgcn_mfma_f32_32x32x16_bf16(b0, qr[d0], p0, 0, 0, 0);
    p1 = __builtin_amdgcn_mfma_f32_32x32x16_bf16(b1, qr[d0], p1, 0, 0, 0); }
}
__device__ __forceinline__ int v_st(int k, int c) { const int kk = (k & ~0xC) | ((k & 4) << 1) | ((k & 8) >> 1); return ((kk >> 3) * 4 + (c >> 5)) * 512 + ((kk & 7) * 32 + (c & 31)) * 2; }
__device__ __forceinline__ int v_rd_base(int lane) { return ((lane & 3) << 3) | (((lane >> 2) & 3) << 6) | (((lane >> 4) & 1) << 5) | (((lane >> 5) & 1) << 8); }
constexpr int v_rd_off(int d0, int ks, int half) { return d0 * 512 + ks * 4096 + half * 2048; }
template <int OFF> __device__ __forceinline__ s16x4 tr_read(int vb) {
  s16x4 r; asm volatile("ds_read_b64_tr_b16 %0, %1 offset:%2" : "=&v"(r) : "v"(vb), "i"(OFF) : "memory"); return r;
}
template <int D0> __device__ __forceinline__ void pv_one(f32x16& od, int vb, bf16x8 pa0, bf16x8 pa1, bf16x8 pa2, bf16x8 pa3) {
  const s16x4 l0 = tr_read<v_rd_off(D0, 0, 0)>(vb), h0 = tr_read<v_rd_off(D0, 0, 1)>(vb), l1 = tr_read<v_rd_off(D0, 1, 0)>(vb), h1 = tr_read<v_rd_off(D0, 1, 1)>(vb);
  const s16x4 l2 = tr_read<v_rd_off(D0, 2, 0)>(vb), h2 = tr_read<v_rd_off(D0, 2, 1)>(vb), l3 = tr_read<v_rd_off(D0, 3, 0)>(vb), h3 = tr_read<v_rd_off(D0, 3, 1)>(vb);
  asm volatile("s_waitcnt lgkmcnt(0)" ::: "memory"); SBAR();
#define PK(L, H) (bf16x8){L[0], L[1], L[2], L[3], H[0], H[1], H[2], H[3]}
  od = __builtin_amdgcn_mfma_f32_32x32x16_bf16(pa0, PK(l0, h0), od, 0, 0, 0);
  od = __builtin_amdgcn_mfma_f32_32x32x16_bf16(pa1, PK(l1, h1), od, 0, 0, 0);
  od = __builtin_amdgcn_mfma_f32_32x32x16_bf16(pa2, PK(l2, h2), od, 0, 0, 0);
  od = __builtin_amdgcn_mfma_f32_32x32x16_bf16(pa3, PK(l3, h3), od, 0, 0, 0);
#undef PK
}
__device__ __forceinline__ void pv_d0(f32x16* o, int vb, bf16x8 pa0, bf16x8 pa1, bf16x8 pa2, bf16x8 pa3) {
  pv_one<0>(o[0], vb, pa0, pa1, pa2, pa3); pv_one<1>(o[1], vb, pa0, pa1, pa2, pa3); pv_one<2>(o[2], vb, pa0, pa1, pa2, pa3); pv_one<3>(o[3], vb, pa0, pa1, pa2, pa3);
}

template <typename TQ>
__device__ __forceinline__ void attn_dense_body(const TQ* __restrict__ Qb, const bf16* __restrict__ Kh, const bf16* __restrict__ Vh,
                                                bf16* __restrict__ Ob, int seq, char* lds) {
  using St = Stage<bf16>; using SQ = Stage<TQ>;
  const int tid = tidx(), wid = tid >> 6, lane = tid & 63, r32 = lane & 31, hi = lane >> 5;
  bf16* V_lds = (bf16*)lds; bf16* K_lds = (bf16*)(lds + 2 * SHM_V);
  float* ws = (float*)(lds + 2 * SHM_V + 2 * SHM_K) + wid * 64; float* li_l = ws; float* al_l = ws + 32;
  float m_reg = -1e30f, l_reg = 0; f32x16 o[4] = {}; bf16x8 qr[8];
  const TQ* Qw = Qb + (long)(wid * QBLK + r32) * LDQ + hi * 8;
#pragma unroll
  for (int d0 = 0; d0 < 8; ++d0) qr[d0] = SQ::tobf(SQ::ld8(Qw + d0 * 16));
  const int sr = tid >> 4, sc = (tid & 15) * 8, vst0 = v_st(sr, sc), vst1 = v_st(32 + sr, sc);
  const int vb0 = (int)(uintptr_t)V_lds + v_rd_base(lane);
  struct { typename St::T vs0, vs1, ks0, ks1; } sr_[SDEPTH];
#define SLOAD(i, k0) do { sr_[i].vs0 = St::ld8(&Vh[(long)((k0) + sr) * LDK + sc]); sr_[i].vs1 = St::ld8(&Vh[(long)((k0) + 32 + sr) * LDK + sc]); \
    sr_[i].ks0 = St::ld8(&Kh[(long)((k0) + sr) * LDK + sc]); sr_[i].ks1 = St::ld8(&Kh[(long)((k0) + 32 + sr) * LDK + sc]); } while (0)
#define SWRITE(b, i) do { *(bf16x8*)((char*)V_lds + (b) * SHM_V + vst0) = St::tobf(sr_[i].vs0);          \
    *(bf16x8*)((char*)V_lds + (b) * SHM_V + vst1) = St::tobf(sr_[i].vs1); int kc = sc * 2;               \
    *(bf16x8*)((char*)K_lds + (b) * SHM_K + KSWZ(sr, kc)) = St::tobf(sr_[i].ks0);                       \
    *(bf16x8*)((char*)K_lds + (b) * SHM_K + KSWZ(32 + sr, kc)) = St::tobf(sr_[i].ks1); } while (0)
#define SWAIT() do { if constexpr (SDEPTH == 2) asm volatile("s_waitcnt vmcnt(4)" ::: "memory"); else asm volatile("s_waitcnt vmcnt(0)" ::: "memory"); } while (0)
#define RESC(a) do { if (__any((a) < 1.f)) { if (hi == 0) al_l[r32] = (a); asm volatile("s_waitcnt lgkmcnt(0)" ::: "memory"); \
    for (int d = 0; d < 4; ++d) for (int r = 0; r < 16; ++r) o[d][r] *= al_l[crow(r, hi)]; } } while (0)
  f32x16 pA0, pA1, pB0, pB1; float mnA, mnB, alA, alB; bf16x8 pa0, pa1, pa2, pa3; const int NT = seq / KVBLK;
  constexpr int SE = 0, SO = SDEPTH - 1;
  SLOAD(SE, 0); asm volatile("s_waitcnt vmcnt(0)" ::: "memory"); SWRITE(0, SE); __syncthreads();
  qkt(pA0, pA1, K_lds, qr, r32, hi); partialSM(pA0, pA1, m_reg, mnA, alA);
  SLOAD(SO, KVBLK); if constexpr (SDEPTH == 2) { if (2 < NT) SLOAD(SE, 2 * KVBLK); }
  SWAIT(); SWRITE(1, SO); __syncthreads();
  for (int j = 1; j + 1 < NT; j += 2) {
    SBAR(); qkt(pB0, pB1, (bf16*)((char*)K_lds + SHM_K), qr, r32, hi);
    finishSM(pA0, pA1, alA, l_reg, pa0, pa1, pa2, pa3); SBAR();
    SLOAD(SO, (j + SDEPTH) * KVBLK); SBAR();
    pv_d0(o, vb0, pa0, pa1, pa2, pa3); partialSM(pB0, pB1, m_reg, mnB, alB);
    __syncthreads(); SWAIT(); SWRITE(0, SE);
    RESC(alB); __syncthreads();
    SBAR(); qkt(pA0, pA1, K_lds, qr, r32, hi);
    finishSM(pB0, pB1, alB, l_reg, pa0, pa1, pa2, pa3); SBAR();
    if (SDEPTH == 1 || j + 3 < NT) SLOAD(SE, (j + 1 + SDEPTH) * KVBLK); SBAR();
    pv_d0(o, vb0 + (int)SHM_V, pa0, pa1, pa2, pa3); partialSM(pA0, pA1, m_reg, mnA, alA);
    __syncthreads(); SWAIT(); SWRITE(1, SO);
    RESC(alA); __syncthreads();
  }
  SBAR(); qkt(pB0, pB1, (bf16*)((char*)K_lds + SHM_K), qr, r32, hi);
  finishSM(pA0, pA1, alA, l_reg, pa0, pa1, pa2, pa3); SBAR();
  pv_d0(o, vb0, pa0, pa1, pa2, pa3); partialSM(pB0, pB1, m_reg, mnB, alB);
  __syncthreads(); RESC(alB);
  finishSM(pB0, pB1, alB, l_reg, pa0, pa1, pa2, pa3); SBAR();
  pv_d0(o, vb0 + (int)SHM_V, pa0, pa1, pa2, pa3);
  if (hi == 0) li_l[r32] = l_reg; asm volatile("s_waitcnt lgkmcnt(0)" ::: "memory");
  float rli[16];
#pragma unroll
  for (int r = 0; r < 16; ++r) rli[r] = __builtin_amdgcn_rcpf(li_l[crow(r, hi)]);
  bf16* Ow = Ob + (long)(wid * QBLK) * LDO;
#pragma unroll
  for (int r = 0; r < 16; ++r) { int orow = crow(r, hi);
    for (int d0 = 0; d0 < 4; ++d0) Ow[(long)orow * LDO + d0 * 32 + r32] = f2bf(o[d0][r] * rli[r]); }
#undef SLOAD
#undef SWRITE
#undef SWAIT
#undef RESC
}
}

__device__ __forceinline__ void phase_att(KP p, int j, unsigned char* lds) {
  const bf16_t* Q = (const bf16_t*)(p->ws + WS_Q); bf16_t* O = (bf16_t*)(p->ws + WS_O);
  const bf16_t* KP = (const bf16_t*)(p->ws + WS_KP); const bf16_t* VP = (const bf16_t*)(p->ws + WS_VP);
  const bf16_t* KS = (const bf16_t*)(p->ws + WS_KS) + (size_t)j * 4 * 1536 * 256; const bf16_t* VS = (const bf16_t*)(p->ws + WS_VS) + (size_t)j * 4 * 1536 * 256;
  for (int u = bidx(); u < 256; u += gdim()) {
    if (u != (int)bidx()) __syncthreads();
    if (u < 128) {
      const int qb = u & 3, h = (u >> 2) & 7, b = u >> 5, kv = h >> 2;
      const size_t row0 = (size_t)NPR + b * 1024 + qb * 256, kb = ((size_t)b * 1536) * 256 + kv * 128;
      att::attn_dense_body<att::bf16>(Q + row0 * D + h * 128, KS + kb, VS + kb, O + row0 * D + h * 128, 1536, (char*)lds);
    } else {
      const int h = (u - 128) & 7, b = (u - 128) >> 3, kv = h >> 2;
      const size_t row0 = (size_t)b * 256, kb = row0 * 256 + kv * 128;
      att::attn_dense_body<att::bf16>(Q + row0 * D + h * 128, KP + kb, VP + kb, O + row0 * D + h * 128, 256, (char*)lds);
    }
  }
  if (j == 0) {
    for (int w = (int)((bidx() + gdim() - (128 % gdim())) % gdim()); w < 128; w += gdim())
      cvt_all(p, (float*)lds, 1, w * 23, 23, 1);
    __syncthreads();
  }
}

__device__ __forceinline__ pg8::EpiQkv make_epi_qkv(KP p, int j, unsigned char* lds) {
  pg8::EpiQkv e; e.p = p; e.xl = (PG8_LAS float*)((PG8_LAS unsigned char*)lds + pg8::STAGE_BYTES); e.j = j;
  return e;
}
__device__ __forceinline__ void qkv_idle_work(KP p, unsigned char* lds) {
  const int G = (int)gdim(), b = (int)bidx(), first = G > 192 ? 192 : 0, nw = G - first;
  if (b >= first) for (int t = b - first; t < 96; t += nw) task_mod(p, 96 + t, (float*)lds, (float*)(p->ws + WS_FILT));
  __syncthreads();
}

#define XB_TMO      128
#define XB_XCNT(j)  (256  + 64 * (j))
#define XB_XSUB(j)  (1280 + 64 * (j))
#define XB_XGEN(j)  (2304 + 64 * (j))
#define XB_TOP      3328
#define XB_TOPGEN   3392
#define XCD_BAR_WORDS 3456
#define XB_SPIN_CAP (1u << 18)
#define LAS __attribute__((address_space(3)))

__device__ __forceinline__ unsigned xb_ld(unsigned* p)              { return __hip_atomic_load(p, __ATOMIC_RELAXED, __HIP_MEMORY_SCOPE_AGENT); }
__device__ __forceinline__ unsigned xb_add(unsigned* p, unsigned v) { return __hip_atomic_fetch_add(p, v, __ATOMIC_RELAXED, __HIP_MEMORY_SCOPE_AGENT); }
__device__ __forceinline__ unsigned xb_xcc_id() { return (unsigned)__builtin_amdgcn_s_getreg((3 << 11) | 20) & 0xFu; }
#define XB_SPIN(cond, bar) do { unsigned _sp = 0; while (cond) { __builtin_amdgcn_s_sleep(1); \
    if ((++_sp & 255u) == 0u) { if (xb_ld(&(bar)[XB_TMO])) break; if (_sp > XB_SPIN_CAP) { atomicAdd(&(bar)[XB_TMO], 1u); break; } } } } while (0)

struct XcdBarrier {
    unsigned* bar; unsigned x;
    volatile LAS unsigned* st;
};

__device__ __forceinline__ XcdBarrier xcd_barrier_post(unsigned* bar, volatile LAS unsigned* st) {
    XcdBarrier b; b.bar = bar; b.x = xb_xcc_id(); b.st = st;
    if (threadIdx.x == 0) (void)xb_add(&bar[XB_XCNT(b.x)], 1u);
    return b;
}
__device__ __forceinline__ void xcd_barrier_complete(unsigned* bar, unsigned x, unsigned& nloc, unsigned& nx) {
    const unsigned G = gdim() * gridDim.y * gridDim.z;
    unsigned sum, cnt, mine, sp = 0u;
    for (;;) {
        sum = 0u; cnt = 0u; mine = 0u;
#pragma unroll
        for (unsigned j = 0; j < 16; ++j) { const unsigned c = xb_ld(&bar[XB_XCNT(j)]); sum += c; cnt += (c > 0u) ? 1u : 0u; mine = (j == x) ? c : mine; }
        if (sum == G) break;
        __builtin_amdgcn_s_sleep(1);
        if ((++sp & 255u) == 0u) { if (xb_ld(&bar[XB_TMO])) break; if (sp > XB_SPIN_CAP) { atomicAdd(&bar[XB_TMO], 1u); break; } }
    }
    nloc = mine > 0u ? mine : 1u; nx = cnt > 0u ? cnt : 1u;
}

__device__ __forceinline__ void xcd_barrier(const XcdBarrier& b) {
    asm volatile("s_waitcnt vmcnt(0)" ::: "memory");
    __syncthreads();
    if (threadIdx.x == 0) {
        unsigned* bar = b.bar;
        __builtin_amdgcn_s_waitcnt(0);
        unsigned nloc = b.st[0], nx = b.st[1];
        if (nloc == 0u) { xcd_barrier_complete(bar, b.x, nloc, nx); b.st[0] = nloc; b.st[1] = nx; }
        const unsigned old = xb_add(&bar[XB_XSUB(b.x)], 1u);
        const unsigned gen = old / nloc;
        if (old + 1u == (gen + 1u) * nloc) {
            __builtin_amdgcn_fence(__ATOMIC_RELEASE, "agent");
            asm volatile("s_waitcnt vmcnt(0)" ::: "memory");
            const unsigned og = xb_add(&bar[XB_TOP], 1u);
            const unsigned tg = og / nx;
            if (og + 1u == (tg + 1u) * nx) xb_add(&bar[XB_TOPGEN], 1u);
            else XB_SPIN(xb_ld(&bar[XB_TOPGEN]) == tg, bar);
            __builtin_amdgcn_fence(__ATOMIC_ACQUIRE, "agent");
            xb_add(&bar[XB_XGEN(b.x)], 1u);
            asm volatile("s_waitcnt vmcnt(0)" ::: "memory");
        } else {
            XB_SPIN(xb_ld(&bar[XB_XGEN(b.x)]) == gen, bar);
            __builtin_amdgcn_fence(__ATOMIC_ACQUIRE, "agent");
            asm volatile("s_waitcnt vmcnt(0)" ::: "memory");
        }
    }
    __syncthreads();
}

__global__ void __launch_bounds__(512, 2) mega(Params pv) {
  extern __shared__ __attribute__((aligned(16))) unsigned char lds[];
  cg::grid_group grid = cg::this_grid();
  volatile LAS unsigned* xst = (volatile LAS unsigned*)((LAS unsigned char*)lds + (LDS_BYTES - 16));
  if (threadIdx.x < 4) xst[threadIdx.x] = 0u;
  __syncthreads();
  if (bidx() == 0) { unsigned* bw = (unsigned*)((KP)__builtin_amdgcn_kernarg_segment_ptr())->ws; for (int i = threadIdx.x; i < 4096; i += 512) bw[i] = 0u; }
#define XN ((bf16_t*)(p->ws + WS_XN))
#define MOD ((const float*)(p->ws + WS_MOD))
#define XBAR() do { XcdBarrier b_; b_.bar = (unsigned*)KPARAMS()->ws; b_.x = xb_xcc_id(); b_.st = xst; xcd_barrier(b_); } while (0)
#define KPARAMS() ({ unsigned long long a_ = (unsigned long long)__builtin_amdgcn_kernarg_segment_ptr(); asm volatile("" : "+s"(a_)); (KP)a_; })
#define RUN(stmt) do { int lv = l; asm volatile("" : "+s"(lv)); const int jv = lv >> 1; (void)jv; const KP p = KPARAMS(); stmt; XBAR(); } while (0)
  { const KP p = KPARAMS(); phase_p0(p, lds); }
  grid.sync();
  (void)xcd_barrier_post((unsigned*)((KP)__builtin_amdgcn_kernarg_segment_ptr())->ws, xst);
  { const KP p = KPARAMS(); phase_p0b(p); }
  XBAR();
#pragma unroll 1
  for (int l = 0; l < 4; ++l) {
    RUN(phase_nm(p, lv, 0, lv > 0, lds));
    if ((l & 1) == 0) {
      RUN(gemm_run(lds, (const bf16_t*)(p->ws + WS_WIN) + (size_t)jv * 3072 * D, XN, 3072, MTOK, D, 1, pg8::EpiBf16{(bf16_t*)(p->ws + WS_ZT), MTOK}));
      RUN(phase_lc(p, jv, lds));
      RUN(gemm_run(lds, (const bf16_t*)(p->ws + WS_YG), (const bf16_t*)(p->ws + WS_WHO) + (size_t)jv * D * D, MTOK, D, D, 2, pg8::EpiGate{(bf16_t*)(p->ws + WS_P1), MOD + (size_t)lv * 5 * 6144 + 2048, nullptr}));
    } else {
      RUN({ gemm_run(lds, XN, (const bf16_t*)(p->ws + WS_WQKV) + (size_t)jv * QKVD * D, MTOK, QKVD, D, 1, make_epi_qkv(p, jv, lds)); if (lv == 1) qkv_idle_work(p, lds); });
      RUN(phase_att(p, jv, lds));
      RUN(gemm_run(lds, (const bf16_t*)(p->ws + WS_O), (const bf16_t*)(p->ws + WS_WAO) + (size_t)jv * D * D, MTOK, D, D, 2, pg8::EpiGate{(bf16_t*)(p->ws + WS_P1), MOD + (size_t)lv * 5 * 6144 + 2048, nullptr}));
    }
    RUN({ phase_nm(p, lv, 1, true, lds); if (lv == 1) mod_finalize(p, 1, (const float*)(p->ws + WS_FILT)); });
    RUN(gemm_run(lds, XN, (const bf16_t*)(p->ws + WS_WGU) + (size_t)lv * 2 * DFF * D, MTOK, 2 * DFF, D, 1, pg8::EpiSwiglu{(bf16_t*)(p->ws + WS_H)}));
    RUN(gemm_run(lds, (const bf16_t*)(p->ws + WS_H), (const bf16_t*)(p->ws + WS_WDN) + (size_t)lv * D * DFF, MTOK, D, DFF, 2, pg8::EpiGate{(bf16_t*)(p->ws + WS_P1), MOD + (size_t)lv * 5 * 6144 + 5 * 1024, nullptr}));
  }
  { const KP p = KPARAMS(); phase_final(p); }
#undef RUN
#undef KPARAMS
#undef XN
#undef MOD
}
constexpr int N_PHASES = 2 + 2 * 7 + 2 * 8 + 1;


extern "C" void kernel_launch(void* const* d_in, const int* in_sizes, int n_in, void* d_out, int out_size, void* d_ws, size_t ws_size, hipStream_t stream) {
  static int grid = 0;
  if (grid == 0) {
    if (n_in != 29 || ws_size < WS_END) { fprintf(stderr, "kernel_launch: n_in %d ws %zu (need 29, >= %zu)\n", n_in, ws_size, (size_t)WS_END); grid = -1; return; }
    int dev = 0, cus = 0, per_cu = 0;
    hipGetDevice(&dev);
    hipDeviceGetAttribute(&cus, hipDeviceAttributeMultiprocessorCount, dev);
    if (hipFuncSetAttribute((const void*)mega, hipFuncAttributeMaxDynamicSharedMemorySize, LDS_BYTES) != hipSuccess) { fprintf(stderr, "kernel_launch: hipFuncSetAttribute failed\n"); grid = -1; return; }
    hipOccupancyMaxActiveBlocksPerMultiprocessor(&per_cu, (const void*)mega, 512, LDS_BYTES);
    if (per_cu < 1) { fprintf(stderr, "kernel_launch: occupancy query says %d blocks per CU\n", per_cu); per_cu = 1; }
    grid = cus * per_cu;
  }
  if (grid < 0) return;
  Params p{};
  for (int i = 0; i < 29; ++i) p.in[i] = (const float*)d_in[i];
  p.out = (float*)d_out; p.ws = (unsigned char*)d_ws;

  void* args[] = {&p};
  hipError_t e = hipLaunchCooperativeKernel((const void*)mega, dim3(grid), dim3(512), args, LDS_BYTES, stream);
  if (e != hipSuccess) fprintf(stderr, "cooperative launch failed: %s (grid %d)\n", hipGetErrorString(e), grid);

}
```
